# Optimizing an MI355X kernel written in HIP

```python
import jax, jax.numpy as jnp
from jax import lax
import numpy as np

D_MODEL = 1024
BATCH = 8
SEQ = 4096
DEPTH = 2

EPS = 1e-6
HEAD_DIM = 64
ROPE_THETA = 10000.0
BLOCK = 128
SWA_HEADS = 8
SWA_KV_HEADS = 2
SWA_WINDOW = BLOCK
DSA_HEADS = 8
DSA_KV_HEADS = 2
IDX_HEADS = 4
IDX_DIM = 64
DSA_TOPK = 256
RET_HEADS = 4
RET_KEY_DIM = 64
RET_VAL_DIM = 128
RET_CHUNK = 128
POOL_WINDOWS = (2, 4, 8, 16)
POOL_GROUP_DIM = 128
N_BRANCH = 4
BRANCH_WIDTH = 512
MEM_LEN = 256
X_HEADS = 4
X_HEAD_DIM = D_MODEL // X_HEADS
D_FF = (7 * D_MODEL) // 2
N_EXPERTS = 8
TOP_K = 2

IN_SIZES = (
    SWA_HEADS * HEAD_DIM, SWA_KV_HEADS * HEAD_DIM, SWA_KV_HEADS * HEAD_DIM,
    DSA_HEADS * HEAD_DIM, DSA_KV_HEADS * HEAD_DIM, DSA_KV_HEADS * HEAD_DIM,
    IDX_HEADS * IDX_DIM, IDX_DIM, IDX_HEADS,
    RET_HEADS * RET_KEY_DIM, RET_HEADS * RET_KEY_DIM, RET_HEADS * RET_VAL_DIM, RET_HEADS * RET_VAL_DIM,
    len(POOL_WINDOWS) * POOL_GROUP_DIM,
    N_BRANCH * D_MODEL,
)
D_IN = sum(IN_SIZES)

kernel_name = "hybrid_gated_parallel_mixer_block"


def rms_norm(x, g):
    xf = x.astype(jnp.float32)
    y = xf * lax.rsqrt(jnp.mean(xf * xf, axis=-1, keepdims=True) + EPS)
    return (y * g.astype(jnp.float32)).astype(x.dtype)


def rope_tables(positions):
    inv = 1.0 / (ROPE_THETA ** (jnp.arange(0, HEAD_DIM, 2, dtype=jnp.float32) / HEAD_DIM))
    ang = positions.astype(jnp.float32)[..., None] * inv
    return jnp.cos(ang)[:, :, None, :], jnp.sin(ang)[:, :, None, :]


def apply_rope(x, cos, sin):
    x1, x2 = jnp.split(x.astype(jnp.float32), 2, axis=-1)
    return jnp.concatenate([x1 * cos - x2 * sin, x2 * cos + x1 * sin], axis=-1).astype(x.dtype)


def sliding_window_attention(q, k, v, sink):
    B, T, Hq, Dh = q.shape
    Hkv = k.shape[2]
    G = Hq // Hkv
    nb = T // BLOCK
    qb = q.reshape(B, nb, BLOCK, Hkv, G, Dh)
    kb = k.reshape(B, nb, BLOCK, Hkv, Dh)
    vb = v.reshape(B, nb, BLOCK, Hkv, Dh)
    prev = lambda z: jnp.concatenate([jnp.zeros_like(z[:, :1]), z[:, :-1]], axis=1)
    kw = jnp.concatenate([prev(kb), kb], axis=2)
    vw = jnp.concatenate([prev(vb), vb], axis=2)
    s = jnp.einsum("bnqhgd,bnkhd->bnhgqk", qb, kw).astype(jnp.float32) * (Dh ** -0.5)
    qi = jnp.arange(BLOCK)[:, None] + BLOCK
    ki = jnp.arange(2 * BLOCK)[None, :]
    rel = qi - ki
    band = (rel >= 0) & (rel < SWA_WINDOW)
    blk = jnp.arange(nb)[:, None, None]
    mask = band[None] & ((blk > 0) | (ki >= BLOCK)[None])
    s = jnp.where(mask[None, :, None, None], s, -jnp.inf)
    sk = sink.astype(jnp.float32).reshape(Hkv, G)[None, None, :, :, None, None]
    m = jnp.maximum(jnp.max(s, axis=-1, keepdims=True), sk)
    p = jnp.exp(s - m)
    p = p / (jnp.sum(p, axis=-1, keepdims=True) + jnp.exp(sk - m))
    o = jnp.einsum("bnhgqk,bnkhd->bnqhgd", p.astype(v.dtype), vw)
    return o.reshape(B, T, Hq * Dh)


def dsa_attention(q, k, v, q_idx, k_idx, w_idx):
    B, T, Hq, Dh = q.shape
    Hkv = k.shape[2]
    G = Hq // Hkv
    nb = T // BLOCK
    n_sel = min(DSA_TOPK, T // 4)
    to_blocks = lambda z: jnp.moveaxis(z.reshape(B, nb, BLOCK, *z.shape[2:]), 1, 0)
    gather = jax.vmap(lambda table, idx: table[idx])
    key_pos = jnp.arange(T)

    def one_block(args):
        q_b, qi_b, wi_b, start = args
        t = start + jnp.arange(BLOCK)
        logits = jnp.einsum("bqhd,bsd->bqhs", qi_b, k_idx).astype(jnp.float32) * (IDX_DIM ** -0.5)
        score = jnp.einsum("bqhs,bqh->bqs", jax.nn.relu(logits), wi_b.astype(jnp.float32))
        causal = key_pos[None, :] <= t[:, None]
        score = jnp.where(causal[None], score, -jnp.inf)
        _, idx = lax.top_k(score, n_sel)
        valid = idx <= t[None, :, None]
        k_sel = gather(k, idx)
        v_sel = gather(v, idx)
        qg = q_b.reshape(B, BLOCK, Hkv, G, Dh)
        s = jnp.einsum("bqhgd,bqkhd->bqhgk", qg, k_sel).astype(jnp.float32) * (Dh ** -0.5)
        s = jnp.where(valid[:, :, None, None, :], s, -jnp.inf)
        p = jax.nn.softmax(s, axis=-1)
        o = jnp.einsum("bqhgk,bqkhd->bqhgd", p.astype(v.dtype), v_sel)
        return o.reshape(B, BLOCK, Hq * Dh)

    starts = jnp.arange(nb, dtype=jnp.int32) * BLOCK
    out = lax.map(one_block, (to_blocks(q), to_blocks(q_idx), to_blocks(w_idx), starts))
    return jnp.moveaxis(out, 0, 1).reshape(B, T, Hq * Dh)


def retention(q, k, v, g):
    B, T, H, Dk = q.shape
    Dv = v.shape[-1]
    C = RET_CHUNK
    nc = T // C
    f32 = jnp.float32
    log_gamma = jnp.log1p(-(2.0 ** (-5.0 - jnp.arange(H, dtype=f32))))
    pos = jnp.arange(C, dtype=f32)
    rel = pos[:, None] - pos[None, :]
    decay = jnp.where(rel >= 0, jnp.exp(log_gamma[:, None, None] * jnp.maximum(rel, 0.0)), 0.0)
    q_decay = jnp.exp(log_gamma[:, None] * (pos + 1.0))[None, :, :, None]
    k_decay = jnp.exp(log_gamma[:, None] * (C - 1.0 - pos))[None, :, :, None]
    chunk_decay = jnp.exp(log_gamma * C)[None, :, None, None]
    to_chunks = lambda z: z.astype(f32).reshape(B, nc, C, H, z.shape[-1]).transpose(1, 0, 3, 2, 4)
    qc, kc, vc = to_chunks(q), to_chunks(k * (Dk ** -0.5)), to_chunks(v)

    def step(state, inp):
        qb, kb, vb = inp
        inner = jnp.einsum("bhnm,bhmv->bhnv", jnp.einsum("bhnd,bhmd->bhnm", qb, kb) * decay, vb)
        cross = jnp.einsum("bhnd,bhdv->bhnv", qb, state) * q_decay
        state = state * chunk_decay + jnp.einsum("bhmd,bhmv->bhdv", kb * k_decay, vb)
        return state, inner + cross

    state0 = jnp.zeros((B, H, Dk, Dv), f32)
    _, out = lax.scan(step, state0, (qc, kc, vc))
    out = out.transpose(1, 0, 3, 2, 4).reshape(B, T, H, Dv)
    out = out * lax.rsqrt(jnp.mean(out * out, axis=-1, keepdims=True) + EPS)
    return (jax.nn.silu(g.astype(f32)) * out.reshape(B, T, H * Dv)).astype(v.dtype)


def multiscale_pool(u, pool_w, pool_scale):
    B, T, _ = u.shape
    G = len(POOL_WINDOWS)
    uf = u.astype(jnp.float32).reshape(B, T, G, POOL_GROUP_DIM)
    csum = jnp.cumsum(uf, axis=1)
    t = jnp.arange(T)
    pooled = []
    for gi, w in enumerate(POOL_WINDOWS):
        c = csum[:, :, gi]
        lag = jnp.pad(c, ((0, 0), (w, 0), (0, 0)))[:, :T]
        cnt = jnp.minimum(t + 1, w).astype(jnp.float32)[None, :, None]
        pooled.append((c - lag) / cnt)
    pooled = jnp.stack(pooled, axis=2)
    y = jnp.einsum("btgc,gcd->btgd", pooled - uf, pool_w.astype(jnp.float32))
    return (y.reshape(B, T, G * POOL_GROUP_DIM) * pool_scale.astype(jnp.float32)).astype(u.dtype)


def token_mixer(h, cos, sin, w_in, sink, w_branch, w_out, pool_w, pool_scale):
    B, T, _ = h.shape
    proj = h @ w_in
    splits = np.cumsum(IN_SIZES)[:-1].tolist()
    (a_q, a_k, a_v, b_q, b_k, b_v, i_q, i_k, i_w,
     r_q, r_k, r_v, r_g, p_u, gates) = jnp.split(proj, splits, axis=-1)
    heads = lambda z, n: z.reshape(B, T, n, -1)
    rope = lambda z: apply_rope(z, cos, sin)
    o_a = sliding_window_attention(rope(heads(a_q, SWA_HEADS)), rope(heads(a_k, SWA_KV_HEADS)),
                                   heads(a_v, SWA_KV_HEADS), sink)
    o_b = dsa_attention(rope(heads(b_q, DSA_HEADS)), rope(heads(b_k, DSA_KV_HEADS)),
                        heads(b_v, DSA_KV_HEADS), rope(heads(i_q, IDX_HEADS)),
                        rope(i_k[:, :, None, :])[:, :, 0], i_w * (IDX_HEADS ** -0.5))
    o_c = retention(rope(heads(r_q, RET_HEADS)), rope(heads(r_k, RET_HEADS)),
                    heads(r_v, RET_HEADS), r_g)
    o_d = multiscale_pool(p_u, pool_w, pool_scale)
    branches = jnp.stack([o_a, o_b, o_c, o_d], axis=2)
    up = jnp.einsum("btnc,ncd->btnd", branches, w_branch)
    gate = jax.nn.sigmoid(gates.reshape(B, T, N_BRANCH, D_MODEL).astype(jnp.float32)).astype(h.dtype)
    merged = jnp.sum(gate * up, axis=2)
    return merged @ w_out


def memory_cross_attention(h, m, w_xq, w_xkv, w_xo):
    B, T, _ = h.shape
    M = m.shape[1]
    q = (h @ w_xq).reshape(B, T, X_HEADS, X_HEAD_DIM)
    k, v = jnp.split(m @ w_xkv, 2, axis=-1)
    k = k.reshape(B, M, X_HEADS, X_HEAD_DIM)
    v = v.reshape(B, M, X_HEADS, X_HEAD_DIM)
    s = jnp.einsum("bthd,bmhd->bhtm", q, k).astype(jnp.float32) * (X_HEAD_DIM ** -0.5)
    p = jax.nn.softmax(s, axis=-1)
    o = jnp.einsum("bhtm,bmhd->bthd", p.astype(v.dtype), v).reshape(B, T, X_HEADS * X_HEAD_DIM)
    return o @ w_xo


def swiglu(h, w_gu, w_down):
    g, u = jnp.split(h @ w_gu, 2, axis=-1)
    return (jax.nn.silu(g) * u) @ w_down


def moe_ffn(h, router_w, w_gu, w_down):
    logits = (h @ router_w).astype(jnp.float32)
    top_val, top_idx = lax.top_k(logits, TOP_K)
    top_w = jax.nn.softmax(top_val, axis=-1)
    gate = jnp.sum(jax.nn.one_hot(top_idx, N_EXPERTS, dtype=jnp.float32) * top_w[..., None], axis=-2)
    gate = gate.astype(h.dtype)
    out = jnp.zeros_like(h)
    for e in range(N_EXPERTS):
        out = out + gate[..., e:e + 1] * swiglu(h, w_gu[e], w_down[e])
    return out


def setup_inputs(seed: int = 0) -> dict:
    key = jax.random.key(seed)
    ks = jax.random.split(key, 24)
    f32 = jnp.float32
    n_dense = (DEPTH + 1) // 2
    n_moe = DEPTH // 2
    n_pool = len(POOL_WINDOWS)
    xw = X_HEADS * X_HEAD_DIM

    def dense(k, shape, fan_in):
        return jax.random.normal(k, shape, f32) * (fan_in ** -0.5)

    def gain(k, shape, scale=0.02):
        return 1.0 + scale * jax.random.normal(k, shape, f32)

    return {
        "x": jax.random.normal(ks[0], (BATCH, SEQ, D_MODEL), f32),
        "mem": jax.random.normal(ks[1], (BATCH, MEM_LEN, D_MODEL), f32),
        "positions": jnp.arange(SEQ, dtype=jnp.int32)[None, :]
        + jax.random.randint(ks[2], (BATCH, 1), 0, 1024, dtype=jnp.int32),
        "norm_mix": gain(ks[3], (DEPTH, D_MODEL)),
        "w_in": dense(ks[4], (DEPTH, D_MODEL, D_IN), D_MODEL),
        "attn_sink": 0.5 * jax.random.normal(ks[5], (DEPTH, SWA_HEADS), f32),
        "w_branch": dense(ks[6], (DEPTH, N_BRANCH, BRANCH_WIDTH, D_MODEL), BRANCH_WIDTH),
        "w_out": dense(ks[7], (DEPTH, D_MODEL, D_MODEL), D_MODEL),
        "pool_w": dense(ks[8], (DEPTH, n_pool, POOL_GROUP_DIM, POOL_GROUP_DIM), POOL_GROUP_DIM),
        "pool_scale": gain(ks[9], (DEPTH, n_pool * POOL_GROUP_DIM), 0.1),
        "norm_cross": gain(ks[10], (DEPTH, D_MODEL)),
        "norm_mem": gain(ks[11], (DEPTH, D_MODEL)),
        "w_xq": dense(ks[12], (DEPTH, D_MODEL, xw), D_MODEL),
        "w_xkv": dense(ks[13], (DEPTH, D_MODEL, 2 * xw), D_MODEL),
        "w_xo": dense(ks[14], (DEPTH, xw, D_MODEL), xw),
        "norm_ffn": gain(ks[15], (DEPTH, D_MODEL)),
        "dense_w_gu": dense(ks[16], (n_dense, D_MODEL, 2 * D_FF), D_MODEL),
        "dense_w_down": dense(ks[17], (n_dense, D_FF, D_MODEL), D_FF),
        "router_w": dense(ks[18], (n_moe, D_MODEL, N_EXPERTS), D_MODEL),
        "moe_w_gu": dense(ks[19], (n_moe, N_EXPERTS, D_MODEL, 2 * D_FF), D_MODEL),
        "moe_w_down": dense(ks[20], (n_moe, N_EXPERTS, D_FF, D_MODEL), D_FF),
        "norm_final": gain(ks[21], (D_MODEL,)),
    }


def reference(x, mem, positions, norm_mix, w_in, attn_sink, w_branch, w_out, pool_w, pool_scale,
              norm_cross, norm_mem, w_xq, w_xkv, w_xo, norm_ffn, dense_w_gu, dense_w_down,
              router_w, moe_w_gu, moe_w_down, norm_final):
    cos, sin = rope_tables(positions)
    for layer in range(DEPTH):
        h = rms_norm(x, norm_mix[layer])
        x = x + token_mixer(h, cos, sin, w_in[layer], attn_sink[layer], w_branch[layer],
                            w_out[layer], pool_w[layer], pool_scale[layer])
        h = rms_norm(x, norm_cross[layer])
        m = rms_norm(mem, norm_mem[layer])
        x = x + memory_cross_attention(h, m, w_xq[layer], w_xkv[layer], w_xo[layer])
        h = rms_norm(x, norm_ffn[layer])
        if layer % 2 == 0:
            x = x + swiglu(h, dense_w_gu[layer // 2], dense_w_down[layer // 2])
        else:
            x = x + moe_ffn(h, router_w[layer // 2], moe_w_gu[layer // 2], moe_w_down[layer // 2])
    return rms_norm(x, norm_final)
```

```cpp
#include <hip/hip_runtime.h>
#include <cstdio>
#include <cstdint>

#ifndef MK_PER_PHASE
#define MK_PER_PHASE 0
#endif

#ifndef PHASE_MASK
#define PHASE_MASK 0xFFFFFFFFu
#endif
#define PON(k) ((PHASE_MASK >> (k)) & 1u)
#define LAS __attribute__((address_space(3)))
#define GAS __attribute__((address_space(1)))
typedef unsigned short bf16;
typedef short bf16x8 __attribute__((ext_vector_type(8)));
typedef float f32x4 __attribute__((ext_vector_type(4)));
typedef float f32x2 __attribute__((ext_vector_type(2)));
typedef unsigned u32x4 __attribute__((ext_vector_type(4)));
typedef unsigned u32x2 __attribute__((ext_vector_type(2)));
typedef __bf16 bf16x2_t __attribute__((ext_vector_type(2)));

constexpr int BATCH = 8, T = 4096, D = 1024, M = BATCH * T, DEPTH = 2;
constexpr int D_IN = 8004, NPROJ = 4096, DFF = 3584, NEXP = 8, MEMLEN = 256, MROWS = BATCH * MEMLEN;
constexpr float EPS = 1e-6f;
constexpr int C_AQ = 0, C_AK = 512, C_AV = 640, C_BQ = 768, C_BK = 1280, C_BV = 1408, C_IQ = 1536, C_IK = 1792, C_RQ = 1856, C_RK = 2112, C_RV = 2368, C_RG = 2880, C_PU = 3392, C_IW = 3904;
constexpr unsigned long long ROPE_MASK = 0x3FFull | (0x3FFull << 12) | (0x1FFFull << 24);

constexpr size_t MiB = 1u << 20;
constexpr size_t WS_CTL = 0, CTL_ZERO_BYTES = 1 * MiB;
constexpr size_t WS_ROUTE = 1 * MiB;
constexpr size_t WS_TOKMAP = 2 * MiB;
constexpr size_t WS_ROWW = 3 * MiB;
constexpr size_t WS_HB = 4 * MiB;
constexpr size_t WS_ROPE = 68 * MiB;
constexpr size_t WS_MN = 76 * MiB;
constexpr size_t WS_KX = 84 * MiB;
constexpr size_t WS_VT = 92 * MiB;
constexpr size_t WS_W = 100 * MiB;
constexpr size_t W_IN = 0, W_G = 8 * MiB, W_B = 16 * MiB, W_OUT = 20 * MiB, W_XQ = 22 * MiB, W_XK = 24 * MiB, W_XV = 26 * MiB, W_XO = 28 * MiB, W_LAYER = 30 * MiB;
constexpr size_t WS_WGU = WS_W + 2 * W_LAYER;
constexpr size_t WS_WDN = WS_WGU + 14 * MiB;
constexpr size_t WS_R = 181 * MiB;
constexpr size_t WS_PROJ = WS_R;
constexpr size_t WS_BR01 = WS_R + 256 * MiB;
constexpr size_t WS_BR23 = WS_R + 320 * MiB;
constexpr size_t WS_U = WS_R + 384 * MiB;
constexpr size_t WS_R_END = WS_R + 416 * MiB;
constexpr size_t WS_MSCR = WS_PROJ;
constexpr size_t WS_MERGED = WS_PROJ + 192 * MiB;
constexpr size_t WS_XQ = WS_PROJ;
constexpr size_t WS_XP = WS_PROJ + 64 * MiB;
constexpr size_t WS_XO = WS_PROJ + 128 * MiB;
constexpr size_t WS_HID = WS_PROJ;
constexpr int MOE_ROWS = 2 * M + 16 * 256;
constexpr size_t WS_MWGU = 100 * MiB;
constexpr size_t WS_MWDN = 212 * MiB;
constexpr size_t WS_MHID = 268 * MiB;
constexpr size_t WS_XS = 744 * MiB;
constexpr size_t WS_END = 880 * MiB;
static_assert(WS_MHID + (size_t)MOE_ROWS * DFF * 2 <= WS_XS && WS_XS + (size_t)MOE_ROWS * D * 2 <= WS_END, "moe map");
static_assert(WS_WDN + 7 * MiB <= WS_R, "weights map");
constexpr int CW_BAR = 4096;
constexpr int CW_CNT = 16384;
constexpr int CW_CUR = 16384 + 64;

constexpr int LDS_STAGE = 131072;
constexpr int LDS_XCH = 131072;
constexpr int LDS_MISC = 131072 + 16384;
constexpr int LDS_BYTES = 131072 + 16384 + 8192;
constexpr int WAVE_LDS = 17408;

__device__ const float INV_FREQ[32] = {1.000000000e+00f, 7.498942018e-01f, 5.623413324e-01f, 4.216965139e-01f, 3.162277639e-01f, 2.371373922e-01f, 1.778279394e-01f, 1.333521456e-01f, 1.000000015e-01f, 7.498941571e-02f, 5.623412877e-02f, 4.216964915e-02f, 3.162277862e-02f, 2.371373586e-02f, 1.778279431e-02f, 1.333521493e-02f, 9.999999776e-03f, 7.498942316e-03f, 5.623413250e-03f, 4.216964822e-03f, 3.162277862e-03f, 2.371373819e-03f, 1.778279431e-03f, 1.333521446e-03f, 1.000000047e-03f, 7.498941850e-04f, 5.623413017e-04f, 4.216965463e-04f, 3.162277862e-04f, 2.371373848e-04f, 1.778279402e-04f, 1.333521504e-04f};
__device__ __forceinline__ float bf2f(unsigned short v) { return __uint_as_float(((unsigned)v) << 16); }
__device__ __forceinline__ unsigned f2bf(float f) { unsigned u = __float_as_uint(f); return (u + 0x7fffu + ((u >> 16) & 1u)) >> 16; }
__device__ __forceinline__ unsigned pk2(float lo, float hi) { return f2bf(lo) | (f2bf(hi) << 16); }
__device__ __forceinline__ unsigned cvt_pk_bf16(float lo, float hi) { unsigned r; asm volatile("v_cvt_pk_bf16_f32 %0, %1, %2" : "=v"(r) : "v"(lo), "v"(hi)); return r; }
__device__ __forceinline__ float dot2(unsigned a, unsigned b, float acc) { return __builtin_amdgcn_fdot2_f32_bf16(__builtin_bit_cast(bf16x2_t, a), __builtin_bit_cast(bf16x2_t, b), acc, false); }
__device__ __forceinline__ float wave_sum(float v) {
#pragma unroll
    for (int o = 1; o < 64; o <<= 1) v += __shfl_xor(v, o);
    return v;
}
__device__ __forceinline__ float wave_max(float v) {
#pragma unroll
    for (int o = 1; o < 64; o <<= 1) v = fmaxf(v, __shfl_xor(v, o));
    return v;
}
#define LDS_WAIT() asm volatile("s_waitcnt lgkmcnt(0)" ::: "memory")

namespace pg8 {
constexpr int BM = 256, BK = 64, HALF = 128, HTB = HALF * BK * 2, STAGE_BYTES = 8 * HTB, NXCD = 8, WGM = 8;
__host__ __device__ __forceinline__ int lds_byte(int r, int c) { const int st = (r >> 4) * 2 + (c >> 5), rr = r & 15, cc = c & 31, ob = rr * 64 + cc * 2; return st * 1024 + (ob ^ (((ob >> 9) & 1) << 5)); }
__host__ __device__ __forceinline__ void stage_rc(int b, int& R, int& C) { const int st = b / 1024, sb = b % 1024, swz = sb ^ (((sb >> 9) & 1) << 5); R = (st >> 1) * 16 + swz / 64; C = (st & 1) * 32 + (swz % 64) / 2; }
__host__ __device__ __forceinline__ int perm32(int rho) { const int n = rho >> 4, i = rho & 15; return 8 * (i >> 2) + 4 * n + (i & 3); }

struct Unit { const char* A; const char* B; int nt; int pm, pn, kind; };

__device__ __forceinline__ void tile_of(int wgid, int nM, int nN, int& pm, int& pn) {
    const int nwg = nM * nN;
    { const int q = nwg / NXCD, r = nwg % NXCD, xcd = wgid % NXCD, off = wgid / NXCD; wgid = (xcd < r ? xcd * (q + 1) : r * (q + 1) + (xcd - r) * q) + off; }
    const int nig = WGM * nN, gid = wgid / nig, fm = gid * WGM, gsz = (nM - fm) < WGM ? (nM - fm) : WGM;
    pm = fm + ((wgid % nig) % gsz); pn = (wgid % nig) / gsz;
}
struct GridSched {
    const char* A; const char* B; unsigned lda, ldb; int nM, nN, nt, G, c;
    __device__ __forceinline__ bool next(int i, Unit& u) const {
        const long L = (long)i * G + c; if (L >= (long)nM * nN) return false;
        tile_of((int)L, nM, nN, u.pm, u.pn);
        u.A = A + (size_t)u.pm * 256 * lda; u.B = B + (size_t)u.pn * 256 * ldb; u.nt = nt; u.kind = 0; return true;
    }
};

template <class Epi, class Sched>
__device__ __forceinline__ void gemm_stream(LAS unsigned char* lds, const Sched& S, const Epi& E, const unsigned lda, const unsigned ldb) {
    int tid = threadIdx.x; asm volatile("" : "+v"(tid));
    const int wid = __builtin_amdgcn_readfirstlane(tid >> 6), lane = tid & 63, wr = wid >> 2, wc = wid & 3, fr = lane & 15, fq = lane >> 4;
    unsigned voffA, voffB;
    { int R, C; stage_rc(tid * 16, R, C); const int Rb = (R & ~31) + perm32(R & 31); voffA = (unsigned)R * lda + (unsigned)C * 2u; voffB = (unsigned)Rb * ldb + (unsigned)C * 2u; }
    const size_t kstep = (size_t)(BK * 2);
    const size_t hA = (size_t)HALF * lda, hB = (size_t)HALF * ldb, qA = (size_t)64 * lda, qB = (size_t)64 * ldb;
    const unsigned ldsw = (unsigned)wid * 1024u;
    const int aoff = lds_byte(wr * 64 + fr, fq * 8), boff = lds_byte(wc * 32 + fr, fq * 8);
#define PG8_SA(b, h) (((b) * 2 + (h)) * HTB)
#define PG8_SB(b, h) ((4 + (b) * 2 + (h)) * HTB)
#define PG8_STAGE(bufoff, gbase, voff) do { \
        __builtin_amdgcn_global_load_lds((const unsigned*)((const char*)(gbase) + (voff)), (LAS unsigned*)(lds + (bufoff) + ldsw), 16, 0, 0); \
        __builtin_amdgcn_global_load_lds((const unsigned*)((const char*)(gbase) + ((&(voff) == &voffA) ? qA : qB) + (voff)), (LAS unsigned*)(lds + (bufoff) + ldsw + 8192), 16, 0, 0); } while (0)
#define PG8_LDA(dst, b, h) do { _Pragma("unroll") for (int m = 0; m < 4; ++m) _Pragma("unroll") for (int k = 0; k < 2; ++k) dst[m][k] = *(const LAS bf16x8*)(lds + PG8_SA(b, h) + aoff + m * 2048 + k * 1024); } while (0)
#define PG8_LDB(dst, b, h) do { _Pragma("unroll") for (int n = 0; n < 2; ++n) _Pragma("unroll") for (int k = 0; k < 2; ++k) dst[n][k] = *(const LAS bf16x8*)(lds + PG8_SB(b, h) + boff + n * 2048 + k * 1024); } while (0)
#define PG8_MMA(ai, bj, At, Bt) do { __builtin_amdgcn_s_setprio(1); _Pragma("unroll") for (int m = 0; m < 4; ++m) _Pragma("unroll") for (int n = 0; n < 2; ++n) _Pragma("unroll") for (int k = 0; k < 2; ++k) \
        acc[ai][bj][m][n] = __builtin_amdgcn_mfma_f32_16x16x32_bf16(Bt[n][k], At[m][k], acc[ai][bj][m][n], 0, 0, 0); __builtin_amdgcn_s_setprio(0); } while (0)
#define PG8_WAIT_V(n) asm volatile("s_waitcnt vmcnt(" #n ")" ::: "memory")
#define PG8_WAIT_L(n) asm volatile("s_waitcnt lgkmcnt(" #n ")" ::: "memory")
#define PG8_BAR __builtin_amdgcn_s_barrier()
#define PG8_SCHED __builtin_amdgcn_sched_barrier(0)
    Unit cur, nxt; int ui = 0;
    if (!S.next(0, cur)) return;
    f32x4 acc[2][2][4][2];
#pragma unroll
    for (int a = 0; a < 2; ++a)
#pragma unroll
        for (int b = 0; b < 2; ++b)
#pragma unroll
            for (int m = 0; m < 4; ++m)
#pragma unroll
                for (int n = 0; n < 2; ++n) acc[a][b][m][n] = (f32x4){0.f, 0.f, 0.f, 0.f};
    bf16x8 At[4][2], B0[2][2], B1[2][2];
    const char* cA = cur.A; const char* cB = cur.B;
    PG8_STAGE(PG8_SB(0, 0), cB, voffB); PG8_STAGE(PG8_SB(0, 1), cB + hB, voffB); PG8_STAGE(PG8_SA(0, 0), cA, voffA); PG8_STAGE(PG8_SA(0, 1), cA + hA, voffA);
    if (wr == 1) PG8_BAR;
    PG8_WAIT_V(2); PG8_BAR;
    PG8_STAGE(PG8_SB(1, 0), cB + kstep, voffB); PG8_STAGE(PG8_SA(1, 0), cA + kstep, voffA); PG8_STAGE(PG8_SB(1, 1), cB + hB + kstep, voffB);
    PG8_WAIT_V(6); PG8_BAR;
    for (;;) {
        const bool has_next = S.next(ui + 1, nxt);
        const char* nA = has_next ? nxt.A : cA; const char* nB = has_next ? nxt.B : cB;
        int nt = cur.nt; asm volatile("" : "+s"(nt));
#pragma unroll 1
        for (int t = 0; t < nt; t += 2) {
            const bool last = (t == nt - 2);
            const char* a1 = cA + (size_t)(t + 1) * kstep;
            const char* a2 = last ? nA : cA + (size_t)(t + 2) * kstep; const char* b2 = last ? nB : cB + (size_t)(t + 2) * kstep;
            const char* a3 = a2 + kstep; const char* b3 = b2 + kstep;
            PG8_LDB(B0, 0, 0); PG8_LDB(B1, 0, 1); PG8_SCHED; PG8_LDA(At, 0, 0); PG8_STAGE(PG8_SA(1, 1), a1 + hA, voffA);
            PG8_WAIT_V(8); PG8_WAIT_L(0); PG8_BAR; PG8_MMA(0, 0, At, B0); PG8_MMA(0, 1, At, B1); PG8_BAR; PG8_SCHED;
            PG8_LDA(At, 0, 1); PG8_STAGE(PG8_SB(0, 0), b2, voffB); PG8_STAGE(PG8_SB(0, 1), b2 + hB, voffB); PG8_STAGE(PG8_SA(0, 0), a2, voffA);
            PG8_WAIT_V(8); PG8_WAIT_L(0); PG8_BAR; PG8_MMA(1, 0, At, B0); PG8_MMA(1, 1, At, B1); PG8_BAR; PG8_SCHED;
            PG8_LDB(B0, 1, 0); PG8_LDB(B1, 1, 1); PG8_SCHED; PG8_LDA(At, 1, 0); PG8_STAGE(PG8_SA(0, 1), a2 + hA, voffA);
            PG8_WAIT_V(8); PG8_WAIT_L(0); PG8_BAR; PG8_MMA(0, 0, At, B0); PG8_MMA(0, 1, At, B1); PG8_BAR; PG8_SCHED;
            PG8_LDA(At, 1, 1); PG8_STAGE(PG8_SB(1, 0), b3, voffB); PG8_STAGE(PG8_SB(1, 1), b3 + hB, voffB); PG8_STAGE(PG8_SA(1, 0), a3, voffA);
            PG8_WAIT_V(8); PG8_WAIT_L(0); PG8_BAR; PG8_MMA(1, 0, At, B0); PG8_MMA(1, 1, At, B1); PG8_BAR; PG8_SCHED;
        }
        if (wr == 0) PG8_BAR;
        const bool keep = E(acc, cur, wr, wc, fr, fq);
        if (!has_next) break;
        if constexpr (Epi::CHAIN) {
            const float kf = keep ? 1.f : 0.f;
#pragma unroll
            for (int a = 0; a < 2; ++a)
#pragma unroll
                for (int b = 0; b < 2; ++b)
#pragma unroll
                    for (int m = 0; m < 4; ++m)
#pragma unroll
                        for (int n = 0; n < 2; ++n) acc[a][b][m][n] = acc[a][b][m][n] * kf;
        } else {
#pragma unroll
            for (int a = 0; a < 2; ++a)
#pragma unroll
                for (int b = 0; b < 2; ++b)
#pragma unroll
                    for (int m = 0; m < 4; ++m)
#pragma unroll
                        for (int n = 0; n < 2; ++n) acc[a][b][m][n] = (f32x4){0.f, 0.f, 0.f, 0.f};
        }
        cur = nxt; cA = nA; cB = nB; ++ui;
        if (wr == 1) PG8_BAR;
    }
    PG8_WAIT_V(0);
    PG8_BAR;
#undef PG8_SA
#undef PG8_SB
#undef PG8_STAGE
#undef PG8_LDA
#undef PG8_LDB
#undef PG8_MMA
#undef PG8_WAIT_V
#undef PG8_WAIT_L
#undef PG8_BAR
#undef PG8_SCHED
}
}
using pg8::Unit;

#define EPI_ARGS f32x4 (&acc)[2][2][4][2], const Unit& u, int wr, int wc, int fr_in, int fq_in
#define EPI_LANE int lane_l = threadIdx.x & 63; asm volatile("" : "+v"(lane_l)); const int fr = lane_l & 15, fq = lane_l >> 4; (void)fr_in; (void)fq_in;
struct EpiProj {
    static constexpr bool CHAIN = false;
    bf16* O; const float* cosT; const float* sinT;
    __device__ __forceinline__ bool operator()(EPI_ARGS) const {
        EPI_LANE
        const int g = 4 * u.pn + wc; const bool rope = (ROPE_MASK >> g) & 1ull;
        const int row0 = u.pm * 256 + wr * 64 + fr;
#pragma unroll
        for (int ai = 0; ai < 2; ++ai)
#pragma unroll
            for (int m = 0; m < 4; ++m) {
                const int r = row0 + ai * 128 + m * 16;
                f32x4 x1a = acc[ai][0][m][0], x1b = acc[ai][0][m][1], x2a = acc[ai][1][m][0], x2b = acc[ai][1][m][1];
                if (rope) {
                    const f32x4 ca = *(const f32x4*)(cosT + (size_t)r * 32 + 8 * fq), cb = *(const f32x4*)(cosT + (size_t)r * 32 + 8 * fq + 4);
                    const f32x4 sa = *(const f32x4*)(sinT + (size_t)r * 32 + 8 * fq), sb = *(const f32x4*)(sinT + (size_t)r * 32 + 8 * fq + 4);
                    const f32x4 o1a = x1a * ca - x2a * sa, o1b = x1b * cb - x2b * sb, o2a = x2a * ca + x1a * sa, o2b = x2b * cb + x1b * sb;
                    x1a = o1a; x1b = o1b; x2a = o2a; x2b = o2b;
                }
                bf16* rowp = O + (size_t)r * NPROJ + 64 * g + 8 * fq;
                u32x4 w1, w2;
                w1.x = cvt_pk_bf16(x1a[0], x1a[1]); w1.y = cvt_pk_bf16(x1a[2], x1a[3]); w1.z = cvt_pk_bf16(x1b[0], x1b[1]); w1.w = cvt_pk_bf16(x1b[2], x1b[3]);
                w2.x = cvt_pk_bf16(x2a[0], x2a[1]); w2.y = cvt_pk_bf16(x2a[2], x2a[3]); w2.z = cvt_pk_bf16(x2b[0], x2b[1]); w2.w = cvt_pk_bf16(x2b[2], x2b[3]);
                *(u32x4*)(rowp) = w1; *(u32x4*)(rowp + 32) = w2;
            }
        return false;
    }
};
struct EpiPlain {
    static constexpr bool CHAIN = false;
    bf16* O; int ldc; float scale;
    __device__ __forceinline__ bool operator()(EPI_ARGS) const {
        EPI_LANE
        const int row0 = u.pm * 256 + wr * 64 + fr, col0 = u.pn * 256 + wc * 32 + 8 * fq;
#pragma unroll
        for (int ai = 0; ai < 2; ++ai)
#pragma unroll
            for (int m = 0; m < 4; ++m) { bf16* rowp = O + (size_t)(row0 + ai * 128 + m * 16) * ldc + col0;
#pragma unroll
                for (int bj = 0; bj < 2; ++bj) { const f32x4 v0 = acc[ai][bj][m][0] * scale, v1 = acc[ai][bj][m][1] * scale;
                    u32x4 w; w.x = cvt_pk_bf16(v0[0], v0[1]); w.y = cvt_pk_bf16(v0[2], v0[3]); w.z = cvt_pk_bf16(v1[0], v1[1]); w.w = cvt_pk_bf16(v1[2], v1[3]);
                    *(u32x4*)(rowp + bj * 128) = w; } }
        return false;
    }
};
struct EpiRes {
    static constexpr bool CHAIN = false;
    const float* in; float* out;
    __device__ __forceinline__ bool operator()(EPI_ARGS) const {
        EPI_LANE
        const int row0 = u.pm * 256 + wr * 64 + fr, col0 = u.pn * 256 + wc * 32 + 8 * fq;
#pragma unroll
        for (int ai = 0; ai < 2; ++ai)
#pragma unroll
            for (int m = 0; m < 4; ++m) { const size_t off = (size_t)(row0 + ai * 128 + m * 16) * D + col0;
#pragma unroll
                for (int bj = 0; bj < 2; ++bj) {
                    const f32x4 a0 = *(const f32x4*)(in + off + bj * 128), a1 = *(const f32x4*)(in + off + bj * 128 + 4);
                    *(f32x4*)(out + off + bj * 128) = a0 + acc[ai][bj][m][0]; *(f32x4*)(out + off + bj * 128 + 4) = a1 + acc[ai][bj][m][1]; }
                asm volatile("" ::: "memory"); }
        return false;
    }
};
struct EpiGate {
    static constexpr bool CHAIN = false;
    unsigned* scr;
    __device__ __forceinline__ bool operator()(EPI_ARGS) const {
        EPI_LANE
        const unsigned voff = (unsigned)(((unsigned)__builtin_amdgcn_readfirstlane(threadIdx.x >> 6) * 64u + (unsigned)lane_l) * 16u);
        char* sb = (char*)scr + (size_t)u.kind * 131072;
#pragma unroll
        for (int ai = 0; ai < 2; ++ai)
#pragma unroll
            for (int m = 0; m < 4; ++m)
#pragma unroll
                for (int bj = 0; bj < 2; ++bj) {
                    f32x4 v0 = acc[ai][bj][m][0], v1 = acc[ai][bj][m][1]; u32x4 w;
#pragma unroll
                    for (int j = 0; j < 4; ++j) { v0[j] = fmaxf(__builtin_amdgcn_rcpf(1.f + __builtin_amdgcn_exp2f(-1.44269504f * v0[j])), 1e-6f); v1[j] = fmaxf(__builtin_amdgcn_rcpf(1.f + __builtin_amdgcn_exp2f(-1.44269504f * v1[j])), 1e-6f); }
                    w.x = cvt_pk_bf16(v0[0], v0[1]); w.y = cvt_pk_bf16(v0[2], v0[3]); w.z = cvt_pk_bf16(v1[0], v1[1]); w.w = cvt_pk_bf16(v1[2], v1[3]);
                    *(u32x4*)(sb + (size_t)((ai * 4 + m) * 2 + bj) * 8192 + voff) = w; asm volatile("" ::: "memory"); }
        return false;
    }
};
struct EpiUp {
    static constexpr bool CHAIN = false;
    unsigned* scr; bf16* O;
    __device__ __forceinline__ bool operator()(EPI_ARGS) const {
        EPI_LANE
        const unsigned tl = (unsigned)__builtin_amdgcn_readfirstlane(threadIdx.x >> 6) * 64u + (unsigned)lane_l;
        const char* s0 = (const char*)scr + (size_t)u.kind * 131072;
        char* pb = (char*)scr + 4 * 131072;
        const int row0 = u.pm * 256 + wr * 64 + fr, col0 = u.pn * 256 + wc * 32 + 8 * fq;
#pragma unroll
        for (int ai = 0; ai < 2; ++ai)
#pragma unroll
            for (int m = 0; m < 4; ++m)
#pragma unroll
                for (int bj = 0; bj < 2; ++bj) {
                    const int slot = (ai * 4 + m) * 2 + bj;
                    const u32x4 a = *(const u32x4*)(s0 + (size_t)slot * 8192 + tl * 16u);
                    f32x4 p0 = (f32x4){0.f, 0.f, 0.f, 0.f}, p1 = p0;
                    if (u.kind > 0) { p0 = *(const f32x4*)(pb + (size_t)slot * 16384 + tl * 32u); p1 = *(const f32x4*)(pb + (size_t)slot * 16384 + tl * 32u + 16); }
                    const f32x4 f0 = (f32x4){__uint_as_float(a.x << 16), __uint_as_float(a.x & 0xffff0000u), __uint_as_float(a.y << 16), __uint_as_float(a.y & 0xffff0000u)};
                    const f32x4 f1 = (f32x4){__uint_as_float(a.z << 16), __uint_as_float(a.z & 0xffff0000u), __uint_as_float(a.w << 16), __uint_as_float(a.w & 0xffff0000u)};
                    p0 = p0 + acc[ai][bj][m][0] * f0; p1 = p1 + acc[ai][bj][m][1] * f1;
                    if (u.kind < 3) { *(f32x4*)(pb + (size_t)slot * 16384 + tl * 32u) = p0; *(f32x4*)(pb + (size_t)slot * 16384 + tl * 32u + 16) = p1; }
                    else { u32x4 w; w.x = cvt_pk_bf16(p0[0], p0[1]); w.y = cvt_pk_bf16(p0[2], p0[3]); w.z = cvt_pk_bf16(p1[0], p1[1]); w.w = cvt_pk_bf16(p1[2], p1[3]);
                        *(u32x4*)(O + (size_t)(row0 + ai * 128 + m * 16) * D + col0 + bj * 128) = w; }
                    asm volatile("" ::: "memory");
                }
        return false;
    }
};
struct EpiSoftmax {
    static constexpr bool CHAIN = false;
    bf16* P; LAS f32x2* xch; float scale_log2;
    __device__ __forceinline__ bool operator()(EPI_ARGS) const {
        EPI_LANE
        LAS f32x2* X = xch + (size_t)(u.kind & 1) * 1024;
#pragma unroll
        for (int ai = 0; ai < 2; ++ai)
#pragma unroll
            for (int m = 0; m < 4; ++m) {
                float v = -3.0e38f;
#pragma unroll
                for (int bj = 0; bj < 2; ++bj)
#pragma unroll
                    for (int n = 0; n < 2; ++n) { acc[ai][bj][m][n] = acc[ai][bj][m][n] * scale_log2; const f32x4 x = acc[ai][bj][m][n]; v = fmaxf(v, fmaxf(fmaxf(x[0], x[1]), fmaxf(x[2], x[3]))); }
                v = fmaxf(v, __shfl_xor(v, 16)); v = fmaxf(v, __shfl_xor(v, 32));
                float s = 0.f;
#pragma unroll
                for (int bj = 0; bj < 2; ++bj)
#pragma unroll
                    for (int n = 0; n < 2; ++n) { f32x4 x = acc[ai][bj][m][n];
#pragma unroll
                        for (int j = 0; j < 4; ++j) { x[j] = __builtin_amdgcn_exp2f(x[j] - v); s += x[j]; }
                        acc[ai][bj][m][n] = x; }
                s += __shfl_xor(s, 16); s += __shfl_xor(s, 32);
                if (fq == 0) X[(ai * 128 + wr * 64 + m * 16 + fr) * 4 + wc] = (f32x2){v, s};
            }
        asm volatile("s_waitcnt lgkmcnt(0)" ::: "memory"); __builtin_amdgcn_s_barrier(); asm volatile("" ::: "memory");
        const int row0 = u.pm * 256 + wr * 64 + fr, col0 = u.pn * 256 + wc * 32 + 8 * fq;
#pragma unroll
        for (int ai = 0; ai < 2; ++ai)
#pragma unroll
            for (int m = 0; m < 4; ++m) {
                const int rl = ai * 128 + wr * 64 + m * 16 + fr;
                const f32x2 p0 = X[rl * 4 + 0], p1 = X[rl * 4 + 1], p2 = X[rl * 4 + 2], p3 = X[rl * 4 + 3];
                const float gm = fmaxf(fmaxf(p0.x, p1.x), fmaxf(p2.x, p3.x));
                const float tot = p0.y * __builtin_amdgcn_exp2f(p0.x - gm) + p1.y * __builtin_amdgcn_exp2f(p1.x - gm) + p2.y * __builtin_amdgcn_exp2f(p2.x - gm) + p3.y * __builtin_amdgcn_exp2f(p3.x - gm);
                const float mine = (wc == 0) ? p0.x : (wc == 1) ? p1.x : (wc == 2) ? p2.x : p3.x;
                const float f = __builtin_amdgcn_exp2f(mine - gm) / tot;
                bf16* rowp = P + (size_t)(row0 + ai * 128 + m * 16) * D + col0;
#pragma unroll
                for (int bj = 0; bj < 2; ++bj) { const f32x4 v0 = acc[ai][bj][m][0] * f, v1 = acc[ai][bj][m][1] * f;
                    u32x4 w; w.x = cvt_pk_bf16(v0[0], v0[1]); w.y = cvt_pk_bf16(v0[2], v0[3]); w.z = cvt_pk_bf16(v1[0], v1[1]); w.w = cvt_pk_bf16(v1[2], v1[3]);
                    *(u32x4*)(rowp + bj * 128) = w; }
                asm volatile("" ::: "memory");
            }
        return false;
    }
};
struct EpiGU {
    static constexpr bool CHAIN = false;
    bf16* H;
    __device__ __forceinline__ bool operator()(EPI_ARGS) const {
        EPI_LANE
        const int row0 = u.pm * 256 + wr * 64 + fr, col0 = u.pn * 128 + wc * 32 + 8 * fq;
#pragma unroll
        for (int ai = 0; ai < 2; ++ai)
#pragma unroll
            for (int m = 0; m < 4; ++m) {
                f32x4 v[2];
#pragma unroll
                for (int n = 0; n < 2; ++n) { const f32x4 g = acc[ai][0][m][n], uu = acc[ai][1][m][n];
#pragma unroll
                    for (int j = 0; j < 4; ++j) v[n][j] = g[j] * __builtin_amdgcn_rcpf(1.f + __builtin_amdgcn_exp2f(-1.44269504f * g[j])) * uu[j]; }
                u32x4 w; w.x = cvt_pk_bf16(v[0][0], v[0][1]); w.y = cvt_pk_bf16(v[0][2], v[0][3]); w.z = cvt_pk_bf16(v[1][0], v[1][1]); w.w = cvt_pk_bf16(v[1][2], v[1][3]);
                *(u32x4*)(H + (size_t)(row0 + ai * 128 + m * 16) * DFF + col0) = w; asm volatile("" ::: "memory");
            }
        return false;
    }
};
struct EpiDownMoe {
    static constexpr bool CHAIN = false;
    const int* tokmap; const float* roww; float* x;
    __device__ __forceinline__ bool operator()(EPI_ARGS) const {
        EPI_LANE
        const int row0 = u.pm * 256 + wr * 64 + fr, col0 = u.pn * 256 + wc * 32 + 8 * fq;
#pragma unroll
        for (int ai = 0; ai < 2; ++ai)
#pragma unroll
            for (int m = 0; m < 4; ++m) { const int r = row0 + ai * 128 + m * 16; const int tk = tokmap[r];
                if (tk >= 0) { const float w = roww[r]; float* xp = x + (size_t)tk * D + col0;
#pragma unroll
                    for (int bj = 0; bj < 2; ++bj) {
                        const f32x4 a0 = *(const f32x4*)(xp + bj * 128), a1 = *(const f32x4*)(xp + bj * 128 + 4);
                        *(f32x4*)(xp + bj * 128) = a0 + acc[ai][bj][m][0] * w; *(f32x4*)(xp + bj * 128 + 4) = a1 + acc[ai][bj][m][1] * w; } }
                asm volatile("" ::: "memory"); }
        return false;
    }
};

template <int MODE> struct MergeSched {
    const char* A0; const char* A1; const char* W; int pm, pn;
    __device__ __forceinline__ bool next(int i, Unit& u) const {
        if (i >= 4) return false;
        u.pm = pm; u.pn = pn; u.kind = i;
        if (MODE == 0) { u.A = A0 + (size_t)pm * 256 * 2048; u.B = W + (size_t)(i * 1024 + pn * 256) * 2048; u.nt = 16; }
        else { u.A = ((i < 2) ? A0 : A1) + (size_t)pm * 256 * 2048 + (i & 1) * 1024; u.B = W + (size_t)(i >> 1) * (2 * MiB) + (size_t)pn * 256 * 2048 + (i & 1) * 1024; u.nt = 8; }
        return true;
    }
};
struct CrossSched {
    const char* A; const char* B; int mode, G, c;
    __device__ __forceinline__ bool next(int i, Unit& u) const {
        const long L0 = (long)i * G + c; if (L0 >= 512) return false;
        int L = (int)L0; { const int q = 512 / 8, xcd = L % 8, off = L / 8; L = xcd * q + off; }
        const int rt = L & 15, head = (L >> 4) & 3, b = L >> 6;
        u.pm = b * 16 + rt; u.pn = head; u.kind = i; u.nt = 4;
        u.A = A + (size_t)u.pm * 256 * 2048 + head * 512;
        u.B = (mode == 0) ? B + (size_t)(b * 256) * 2048 + head * 512 : B + (size_t)(head * 256) * 4096 + b * 512;
        return true;
    }
};
struct MoeSched {
    const char* A; const char* B; unsigned lda; size_t wstride; unsigned ldb; int t0, nT, nN, nt, G, c; const int* gt;
    __device__ __forceinline__ bool next(int i, Unit& u) const {
        const long L = (long)i * G + c; if (L >= (long)nT * nN) return false;
        int pm, pn; pg8::tile_of((int)L, nT, nN, pm, pn); pm += t0;
        int g = 0;
#pragma unroll
        for (int k = 1; k < 16; ++k) g += (pm >= gt[k]) ? 1 : 0;
        u.pm = pm; u.pn = pn; u.kind = 0; u.nt = nt;
        u.A = A + (size_t)pm * 256 * lda; u.B = B + (size_t)(g & 7) * wstride + (size_t)pn * 256 * ldb; return true;
    }
};

#define XB_TMO      128
#define XB_XCNT(j)  (256  + 64 * (j))
#define XB_XSUB(j)  (1280 + 64 * (j))
#define XB_XGEN(j)  (2304 + 64 * (j))
#define XB_TOP      3328
#define XB_TOPGEN   3392
#define XCD_BAR_WORDS 3456
#define XB_SPIN_CAP (1u << 22)
__device__ __forceinline__ unsigned xb_ld(unsigned* p)              { return __hip_atomic_load(p, __ATOMIC_RELAXED, __HIP_MEMORY_SCOPE_AGENT); }
__device__ __forceinline__ unsigned xb_add(unsigned* p, unsigned v) { return __hip_atomic_fetch_add(p, v, __ATOMIC_RELAXED, __HIP_MEMORY_SCOPE_AGENT); }
__device__ __forceinline__ unsigned xb_xcc_id() { return (unsigned)__builtin_amdgcn_s_getreg((3 << 11) | 20) & 0xFu; }
#define XB_SPIN(cond, bar) do { unsigned _sp = 0; while (cond) { __builtin_amdgcn_s_sleep(1); \
    if ((++_sp & 255u) == 0u) { if (xb_ld(&(bar)[XB_TMO])) break; if (_sp > XB_SPIN_CAP) { atomicAdd(&(bar)[XB_TMO], 1u); break; } } } } while (0)
struct XcdBarrier { unsigned* bar; unsigned x; volatile LAS unsigned* st; };
__device__ __forceinline__ XcdBarrier xcd_barrier_post(unsigned* bar, volatile LAS unsigned* st) {
    XcdBarrier b; b.bar = bar; b.x = xb_xcc_id(); b.st = st;
    if (threadIdx.x == 0) (void)xb_add(&bar[XB_XCNT(b.x)], 1u);
    return b;
}
__device__ __forceinline__ void xcd_barrier_complete(unsigned* bar, unsigned x, unsigned& nloc, unsigned& nx) {
    const unsigned G = gridDim.x * gridDim.y * gridDim.z;
    unsigned sum, cnt, mine, sp = 0u;
    for (;;) {
        sum = 0u; cnt = 0u; mine = 0u;
#pragma unroll
        for (unsigned j = 0; j < 16; ++j) { const unsigned c = xb_ld(&bar[XB_XCNT(j)]); sum += c; cnt += (c > 0u) ? 1u : 0u; mine = (j == x) ? c : mine; }
        if (sum == G) break;
        __builtin_amdgcn_s_sleep(1);
        if ((++sp & 255u) == 0u) { if (xb_ld(&bar[XB_TMO])) break; if (sp > XB_SPIN_CAP) { atomicAdd(&bar[XB_TMO], 1u); break; } }
    }
    nloc = mine > 0u ? mine : 1u; nx = cnt > 0u ? cnt : 1u;
}
__device__ __forceinline__ void xcd_barrier(const XcdBarrier& b) {
    asm volatile("s_waitcnt vmcnt(0)" ::: "memory");
    __syncthreads();
    if (threadIdx.x == 0) {
        unsigned* bar = b.bar;
        __builtin_amdgcn_s_waitcnt(0);
        unsigned nloc = b.st[0], nx = b.st[1];
        if (nloc == 0u) { xcd_barrier_complete(bar, b.x, nloc, nx); b.st[0] = nloc; b.st[1] = nx; }
        const unsigned old = xb_add(&bar[XB_XSUB(b.x)], 1u);
        const unsigned gen = old / nloc;
        if (old + 1u == (gen + 1u) * nloc) {
            __builtin_amdgcn_fence(__ATOMIC_RELEASE, "agent");
            asm volatile("s_waitcnt vmcnt(0)" ::: "memory");
            const unsigned og = xb_add(&bar[XB_TOP], 1u);
            const unsigned tg = og / nx;
            if (og + 1u == (tg + 1u) * nx) xb_add(&bar[XB_TOPGEN], 1u);
            else XB_SPIN(xb_ld(&bar[XB_TOPGEN]) == tg, bar);
            __builtin_amdgcn_fence(__ATOMIC_ACQUIRE, "agent");
            xb_add(&bar[XB_XGEN(b.x)], 1u);
            asm volatile("s_waitcnt vmcnt(0)" ::: "memory");
        } else {
            XB_SPIN(xb_ld(&bar[XB_XGEN(b.x)]) == gen, bar);
            __builtin_amdgcn_fence(__ATOMIC_ACQUIRE, "agent");
            asm volatile("s_waitcnt vmcnt(0)" ::: "memory");
        }
    }
    __syncthreads();
}

struct Args {
    const float* x; const float* mem; const int* positions; const float* norm_mix; const float* w_in; const float* attn_sink; const float* w_branch; const float* w_out;
    const float* pool_w; const float* pool_scale; const float* norm_cross; const float* norm_mem; const float* w_xq; const float* w_xkv; const float* w_xo; const float* norm_ffn;
    const float* dense_w_gu; const float* dense_w_down; const float* router_w; const float* moe_w_gu; const float* moe_w_down; const float* norm_final;
    float* out; unsigned char* ws; int ph_lo, ph_hi;
};

__device__ __forceinline__ void transpose_item(const float* W, int ldw, int k0, int src, int nv, bf16* WT, size_t dst_pitch, int dst_row0, int dst_k0, LAS float* scr, int lane) {
#pragma unroll 8
    for (int i = 0; i < 32; ++i) { const int kk = 2 * i + (lane >> 5), n = lane & 31; scr[kk * 33 + n] = (n < nv) ? W[(size_t)(k0 + kk) * ldw + src + n] : 0.f; }
    LDS_WAIT(); asm volatile("" ::: "memory");
    const int c = lane & 7;
#pragma unroll
    for (int j = 0; j < 4; ++j) { const int n = (lane >> 3) + 8 * j; const LAS float* s = scr + (8 * c) * 33 + n;
        u32x4 o; o.x = pk2(s[0 * 33], s[1 * 33]); o.y = pk2(s[2 * 33], s[3 * 33]); o.z = pk2(s[4 * 33], s[5 * 33]); o.w = pk2(s[6 * 33], s[7 * 33]);
        *(u32x4*)(WT + (size_t)(dst_row0 + n) * dst_pitch + dst_k0 + k0 + 8 * c) = o; }
    LDS_WAIT(); asm volatile("" ::: "memory");
}
template <int MAP>
__device__ __forceinline__ void conv_seg(const float* W, int K, int ldw, int src0, bf16* WT, size_t dst_pitch, int dst_k0, int nb, int item, LAS float* scr, int lane) {
    const int kb = item / nb, vb = item % nb;
    int src, nv = 32;
    if (MAP == 0) src = src0 + 32 * vb;
    else if (MAP == 1) { const int pn = vb >> 3, bj = (vb >> 2) & 1, wc = vb & 3, g = 4 * pn + wc;
        if (g < 29) src = 64 * g + 32 * bj; else if (g < 61) src = 64 * g + 4 + 32 * bj; else if (g == 61) { src = 1856; nv = bj == 0 ? 4 : 0; } else { src = 0; nv = 0; } }
    else { const int pn = vb >> 3, bj = (vb >> 2) & 1, pb = vb & 3; src = src0 + bj * DFF + 128 * pn + 32 * pb; }
    transpose_item(W, ldw, 64 * kb, src, nv, WT, dst_pitch, 32 * vb, dst_k0, scr, lane);
}
__device__ __forceinline__ void norm_row_bf16(const float* xrow, const float* g, bf16* orow, int lane) {
    const f32x4* xr = (const f32x4*)xrow + lane; const f32x4* gr = (const f32x4*)g + lane;
    f32x4 v[4]; float s = 0.f;
#pragma unroll
    for (int j = 0; j < 4; ++j) { v[j] = xr[64 * j]; s += (v[j].x * v[j].x + v[j].y * v[j].y) + (v[j].z * v[j].z + v[j].w * v[j].w); }
    const float rstd = 1.f / sqrtf(wave_sum(s) * (1.f / D) + EPS);
    unsigned long long* o8 = (unsigned long long*)orow + lane;
#pragma unroll
    for (int j = 0; j < 4; ++j) { const f32x4 gg = gr[64 * j];
        o8[64 * j] = (unsigned long long)pk2(v[j].x * rstd * gg.x, v[j].y * rstd * gg.y) | ((unsigned long long)pk2(v[j].z * rstd * gg.z, v[j].w * rstd * gg.w) << 32); }
}

__device__ __forceinline__ void pool_phase(const bf16* proj, const float* pw, const float* pscale, bf16* br23, char* lds, int G) {
    float* Wl = (float*)lds; float* Dl = (float*)(lds + 65536);
    int tid = threadIdx.x; asm volatile("" : "+v"(tid));
    for (int un = blockIdx.x; un < 2048; un += G) {
        const int g = un & 3, tb = (un >> 2) & 63, b = un >> 8;
        const float* wsrc = pw + (size_t)g * 16384;
        for (int i = tid; i < 16384; i += 512) Wl[i] = wsrc[i];
        const int win = 2 << g;
        for (int i = tid; i < 64 * 128; i += 512) { const int tt = i >> 7, c = i & 127, t = tb * 64 + tt;
            const bf16* up = proj + ((size_t)(b * T + t)) * NPROJ + C_PU + g * 128 + c;
            const int cnt = (t + 1 < win) ? t + 1 : win; float s = 0.f;
            for (int j = 0; j < cnt; ++j) s += bf2f(*(up - (size_t)j * NPROJ));
            Dl[i] = s / (float)cnt - bf2f(*up); }
        __syncthreads();
        const int cp = tid & 127, tg = tid >> 7;
        float acc[16];
#pragma unroll
        for (int k = 0; k < 16; ++k) acc[k] = 0.f;
        for (int c = 0; c < 128; c += 4) {
            const float w0 = Wl[(c + 0) * 128 + cp], w1 = Wl[(c + 1) * 128 + cp], w2 = Wl[(c + 2) * 128 + cp], w3 = Wl[(c + 3) * 128 + cp];
#pragma unroll
            for (int k = 0; k < 16; ++k) { const f32x4 d = *(const f32x4*)(Dl + (tg * 16 + k) * 128 + c); acc[k] += d.x * w0 + d.y * w1 + d.z * w2 + d.w * w3; }
        }
        const float sc = pscale[g * 128 + cp];
#pragma unroll
        for (int k = 0; k < 16; ++k) br23[((size_t)(b * T + tb * 64 + tg * 16 + k)) * D + 512 + g * 128 + cp] = (bf16)f2bf(acc[k] * sc);
        __syncthreads();
    }
}
__device__ __forceinline__ void swa_phase(const bf16* proj, const float* sink, bf16* br01, char* lds, int G) {
    int tid = threadIdx.x; asm volatile("" : "+v"(tid)); const int lane = tid & 63, wave = tid >> 6;
    char* wl = lds + wave * WAVE_LDS;
    unsigned* qls = (unsigned*)wl; float* pl = (float*)(wl + 512);
    for (int task = blockIdx.x * 8 + wave; task < 2 * M; task += G * 8) {
        const int kvh = task & 1, m = task >> 1, b = m >> 12, t = m & 4095;
        const bf16* prow = proj + (size_t)m * NPROJ;
        { const unsigned* qs = (const unsigned*)(prow + C_AQ + kvh * 256); qls[lane] = qs[lane]; qls[lane + 64] = qs[lane + 64]; }
        LDS_WAIT();
        float l[2][4];
#pragma unroll
        for (int kk = 0; kk < 2; ++kk) {
            const int s = t - 64 * kk - lane;
            if (s >= 0) {
                const u32x4* kp = (const u32x4*)(proj + ((size_t)(b * T + s)) * NPROJ + C_AK + kvh * 64);
                float a0 = 0.f, a1 = 0.f, a2 = 0.f, a3 = 0.f;
#pragma unroll
                for (int i = 0; i < 8; ++i) { const u32x4 kv = kp[i];
                    const u32x4 q0 = ((const u32x4*)qls)[i], q1 = ((const u32x4*)qls)[8 + i], q2 = ((const u32x4*)qls)[16 + i], q3 = ((const u32x4*)qls)[24 + i];
                    a0 = dot2(kv.x, q0.x, a0); a0 = dot2(kv.y, q0.y, a0); a0 = dot2(kv.z, q0.z, a0); a0 = dot2(kv.w, q0.w, a0);
                    a1 = dot2(kv.x, q1.x, a1); a1 = dot2(kv.y, q1.y, a1); a1 = dot2(kv.z, q1.z, a1); a1 = dot2(kv.w, q1.w, a1);
                    a2 = dot2(kv.x, q2.x, a2); a2 = dot2(kv.y, q2.y, a2); a2 = dot2(kv.z, q2.z, a2); a2 = dot2(kv.w, q2.w, a2);
                    a3 = dot2(kv.x, q3.x, a3); a3 = dot2(kv.y, q3.y, a3); a3 = dot2(kv.z, q3.z, a3); a3 = dot2(kv.w, q3.w, a3); }
                l[kk][0] = a0 * 0.125f; l[kk][1] = a1 * 0.125f; l[kk][2] = a2 * 0.125f; l[kk][3] = a3 * 0.125f;
            } else { l[kk][0] = -INFINITY; l[kk][1] = -INFINITY; l[kk][2] = -INFINITY; l[kk][3] = -INFINITY; }
        }
#pragma unroll
        for (int g = 0; g < 4; ++g) {
            const float sk = sink[kvh * 4 + g];
            const float mx = fmaxf(wave_max(fmaxf(l[0][g], l[1][g])), sk);
            const float p0 = __expf(l[0][g] - mx), p1 = __expf(l[1][g] - mx);
            const float den = wave_sum(p0 + p1) + __expf(sk - mx);
            pl[lane * 4 + g] = p0 / den; pl[(64 + lane) * 4 + g] = p1 / den;
        }
        LDS_WAIT();
        float o0 = 0.f, o1 = 0.f, o2 = 0.f, o3 = 0.f;
        const int ne = (t + 1 < 128) ? t + 1 : 128;
        const bf16* vp = proj + ((size_t)(b * T + t)) * NPROJ + C_AV + kvh * 64 + lane;
#pragma unroll 8
        for (int e = 0; e < ne; ++e) { const float v = bf2f(*(vp - (size_t)e * NPROJ)); const f32x4 p = *(const f32x4*)(pl + e * 4); o0 += p.x * v; o1 += p.y * v; o2 += p.z * v; o3 += p.w * v; }
        bf16* op = br01 + (size_t)m * D + kvh * 256 + lane;
        op[0] = (bf16)f2bf(o0); op[64] = (bf16)f2bf(o1); op[128] = (bf16)f2bf(o2); op[192] = (bf16)f2bf(o3);
        LDS_WAIT();
    }
}
__device__ __forceinline__ unsigned sortable(float f) { const unsigned u = __float_as_uint(f); return (u >> 31) ? ~u : (u | 0x80000000u); }
__device__ __forceinline__ void dsa_query(const bf16* proj, bf16* br01, int b, int t, char* wl, int lane) {
    float* sc = (float*)wl; unsigned* qls = (unsigned*)(wl + 16384); unsigned short* sel = (unsigned short*)(wl + 16384 + 512);
    const size_t m = (size_t)b * T + t;
    const bf16* prow = proj + m * NPROJ;
    const bf16* pb = proj + (size_t)b * T * NPROJ;
    { const unsigned* qs = (const unsigned*)(prow + C_IQ); qls[lane] = qs[lane]; qls[lane + 64] = qs[lane + 64]; }
    const float w0 = bf2f(prow[C_IW + 0]) * 0.5f, w1 = bf2f(prow[C_IW + 1]) * 0.5f, w2 = bf2f(prow[C_IW + 2]) * 0.5f, w3 = bf2f(prow[C_IW + 3]) * 0.5f;
    LDS_WAIT();
    const int nk = t + 1;
    for (int s = lane; s < nk; s += 64) {
        const u32x4* kp = (const u32x4*)(pb + (size_t)s * NPROJ + C_IK);
        float a0 = 0.f, a1 = 0.f, a2 = 0.f, a3 = 0.f;
#pragma unroll
        for (int i = 0; i < 8; ++i) { const u32x4 kv = kp[i];
            const u32x4 q0 = ((const u32x4*)qls)[i], q1 = ((const u32x4*)qls)[8 + i], q2 = ((const u32x4*)qls)[16 + i], q3 = ((const u32x4*)qls)[24 + i];
            a0 = dot2(kv.x, q0.x, a0); a0 = dot2(kv.y, q0.y, a0); a0 = dot2(kv.z, q0.z, a0); a0 = dot2(kv.w, q0.w, a0);
            a1 = dot2(kv.x, q1.x, a1); a1 = dot2(kv.y, q1.y, a1); a1 = dot2(kv.z, q1.z, a1); a1 = dot2(kv.w, q1.w, a1);
            a2 = dot2(kv.x, q2.x, a2); a2 = dot2(kv.y, q2.y, a2); a2 = dot2(kv.z, q2.z, a2); a2 = dot2(kv.w, q2.w, a2);
            a3 = dot2(kv.x, q3.x, a3); a3 = dot2(kv.y, q3.y, a3); a3 = dot2(kv.z, q3.z, a3); a3 = dot2(kv.w, q3.w, a3); }
        const float r0 = fmaxf(a0 * 0.125f, 0.f), r1 = fmaxf(a1 * 0.125f, 0.f), r2 = fmaxf(a2 * 0.125f, 0.f), r3 = fmaxf(a3 * 0.125f, 0.f);
        sc[s] = ((r0 * w0 + r1 * w1) + (r2 * w2 + r3 * w3)) + 0.f;
    }
    LDS_WAIT();
    const int K = nk < 256 ? nk : 256;
    const int nj = (nk + 63) >> 6;
    unsigned key[64];
#pragma unroll
    for (int j = 0; j < 64; ++j) { const int s = 64 * j + lane; key[j] = (j < nj && s < nk) ? sortable(sc[s]) : 0u; }
    unsigned Tk = 1u;
    if (nk > 256) {
        Tk = 0u;
        for (int bit = 31; bit >= 0; --bit) {
            const unsigned cand = Tk | (1u << bit); int cnt = 0;
#pragma unroll
            for (int j = 0; j < 64; ++j) if (j < nj) cnt += __popcll(__ballot(key[j] >= cand));
            if (cnt >= K) Tk = cand;
        }
    }
    int cgt = 0;
#pragma unroll
    for (int j = 0; j < 64; ++j) if (j < nj) cgt += __popcll(__ballot(key[j] > Tk));
    const int need = K - cgt;
    const unsigned long long lt = (1ull << lane) - 1ull;
    int pos = 0, ties = 0;
#pragma unroll
    for (int j = 0; j < 64; ++j) if (j < nj) {
        const bool gt = key[j] > Tk, eq = key[j] == Tk;
        const unsigned long long meq = __ballot(eq);
        const bool take = gt || (eq && (ties + __popcll(meq & lt)) < need);
        const unsigned long long mt = __ballot(take);
        if (take) sel[pos + __popcll(mt & lt)] = (unsigned short)(64 * j + lane);
        pos += __popcll(mt); ties += __popcll(meq);
    }
    LDS_WAIT();
    float* pl = sc;
#pragma unroll 1
    for (int kh = 0; kh < 2; ++kh) {
        { const unsigned* qs = (const unsigned*)(prow + C_BQ + kh * 256); qls[lane] = qs[lane]; qls[lane + 64] = qs[lane + 64]; }
        LDS_WAIT();
        float l[4][4];
#pragma unroll
        for (int i = 0; i < 4; ++i) {
            const int e = lane + 64 * i;
            if (e < K) {
                const int s = sel[e];
                const u32x4* kp = (const u32x4*)(pb + (size_t)s * NPROJ + C_BK + kh * 64);
                float a0 = 0.f, a1 = 0.f, a2 = 0.f, a3 = 0.f;
#pragma unroll
                for (int q = 0; q < 8; ++q) { const u32x4 kv = kp[q];
                    const u32x4 q0 = ((const u32x4*)qls)[q], q1 = ((const u32x4*)qls)[8 + q], q2 = ((const u32x4*)qls)[16 + q], q3 = ((const u32x4*)qls)[24 + q];
                    a0 = dot2(kv.x, q0.x, a0); a0 = dot2(kv.y, q0.y, a0); a0 = dot2(kv.z, q0.z, a0); a0 = dot2(kv.w, q0.w, a0);
                    a1 = dot2(kv.x, q1.x, a1); a1 = dot2(kv.y, q1.y, a1); a1 = dot2(kv.z, q1.z, a1); a1 = dot2(kv.w, q1.w, a1);
                    a2 = dot2(kv.x, q2.x, a2); a2 = dot2(kv.y, q2.y, a2); a2 = dot2(kv.z, q2.z, a2); a2 = dot2(kv.w, q2.w, a2);
                    a3 = dot2(kv.x, q3.x, a3); a3 = dot2(kv.y, q3.y, a3); a3 = dot2(kv.z, q3.z, a3); a3 = dot2(kv.w, q3.w, a3); }
                l[i][0] = a0 * 0.125f; l[i][1] = a1 * 0.125f; l[i][2] = a2 * 0.125f; l[i][3] = a3 * 0.125f;
            } else { l[i][0] = -INFINITY; l[i][1] = -INFINITY; l[i][2] = -INFINITY; l[i][3] = -INFINITY; }
        }
#pragma unroll
        for (int g = 0; g < 4; ++g) {
            const float mx = wave_max(fmaxf(fmaxf(l[0][g], l[1][g]), fmaxf(l[2][g], l[3][g])));
            float p[4]; float s = 0.f;
#pragma unroll
            for (int i = 0; i < 4; ++i) { p[i] = __expf(l[i][g] - mx); s += p[i]; }
            const float inv = 1.f / wave_sum(s);
#pragma unroll
            for (int i = 0; i < 4; ++i) pl[(lane + 64 * i) * 4 + g] = p[i] * inv;
        }
        LDS_WAIT();
        float o0 = 0.f, o1 = 0.f, o2 = 0.f, o3 = 0.f;
        const bf16* vb = pb + C_BV + kh * 64 + lane;
#pragma unroll 8
        for (int e = 0; e < K; ++e) { const int s = sel[e]; const float v = bf2f(vb[(size_t)s * NPROJ]); const f32x4 p = *(const f32x4*)(pl + e * 4); o0 += p.x * v; o1 += p.y * v; o2 += p.z * v; o3 += p.w * v; }
        bf16* op = br01 + m * D + 512 + kh * 256 + lane;
        op[0] = (bf16)f2bf(o0); op[64] = (bf16)f2bf(o1); op[128] = (bf16)f2bf(o2); op[192] = (bf16)f2bf(o3);
        LDS_WAIT();
    }
}
__device__ __forceinline__ void dsa_phase(const bf16* proj, bf16* br01, char* lds, int G) {
    int tid = threadIdx.x; asm volatile("" : "+v"(tid)); const int lane = tid & 63, wave = tid >> 6;
    char* wl = lds + wave * WAVE_LDS;
    const int c = blockIdx.x;
    const int per = (T + G - 1) / G;
    for (int k = 0; k < per; ++k) {
        const int t = (k & 1) ? (G - 1 - c) + G * k : c + G * k;
        if (t < T) dsa_query(proj, br01, wave, t, wl, lane);
    }
}
__device__ __forceinline__ void ret_u_phase(const bf16* proj, float* U, char* lds, int G) {
    float* Kl = (float*)lds;
    int tid = threadIdx.x; asm volatile("" : "+v"(tid));
    for (int un = blockIdx.x; un < 1024; un += G) {
        const int c = un & 31, bh = un >> 5, h = bh & 3, b = bh >> 2;
        const float lg2 = log2f(1.f - exp2f(-5.f - (float)h));
        const size_t m0 = (size_t)b * T + c * 128;
        for (int i = tid; i < 128 * 64; i += 512) { const int mm = i >> 6, d = i & 63; Kl[i] = bf2f(proj[(m0 + mm) * NPROJ + C_RK + 64 * h + d]) * 0.125f * exp2f(lg2 * (float)(127 - mm)); }
        __syncthreads();
        const int dv = tid & 127, dg = tid >> 7;
        float acc[16];
#pragma unroll
        for (int k = 0; k < 16; ++k) acc[k] = 0.f;
        for (int mm = 0; mm < 128; ++mm) { const float v = bf2f(proj[(m0 + mm) * NPROJ + C_RV + 128 * h + dv]);
#pragma unroll
            for (int k4 = 0; k4 < 4; ++k4) { const f32x4 kk = *(const f32x4*)(Kl + mm * 64 + dg * 16 + 4 * k4); acc[4 * k4] += kk.x * v; acc[4 * k4 + 1] += kk.y * v; acc[4 * k4 + 2] += kk.z * v; acc[4 * k4 + 3] += kk.w * v; } }
        float* up = U + (size_t)un * 8192;
#pragma unroll
        for (int k = 0; k < 16; ++k) up[(dg * 16 + k) * 128 + dv] = acc[k];
        __syncthreads();
    }
}
__device__ __forceinline__ void ret_out_phase(const bf16* proj, const float* U, bf16* br23, char* lds, int G) {
    float* Ql = (float*)lds; float* Sl = (float*)(lds + 32768); float* Al = (float*)(lds + 65536);
    int tid = threadIdx.x; asm volatile("" : "+v"(tid)); const int lane = tid & 63, wave = tid >> 6;
    for (int un = blockIdx.x; un < 1024; un += G) {
        const int c = un & 31, bh = un >> 5, h = bh & 3, b = bh >> 2;
        const float lg2 = log2f(1.f - exp2f(-5.f - (float)h));
        const size_t m0 = (size_t)b * T + c * 128;
        for (int i = tid; i < 128 * 64; i += 512) { const int n = i >> 6, d = i & 63; Ql[i] = bf2f(proj[(m0 + n) * NPROJ + C_RQ + 64 * h + d]); }
        {
            float s[16];
#pragma unroll
            for (int k = 0; k < 16; ++k) s[k] = 0.f;
            const float cd = exp2f(lg2 * 128.f);
#pragma unroll 1
            for (int j = 0; j < c; ++j) { const float* up = U + (size_t)(bh * 32 + j) * 8192;
#pragma unroll
                for (int k = 0; k < 16; ++k) s[k] = s[k] * cd + up[tid + 512 * k]; }
#pragma unroll
            for (int k = 0; k < 16; ++k) Sl[tid + 512 * k] = s[k];
        }
        __syncthreads();
#pragma unroll 1
        for (int k = 0; k < 32; ++k) { const int idx = tid + 512 * k, n = idx >> 7, mm = idx & 127; float a = 0.f;
            if (mm <= n) { const u32x4* kp = (const u32x4*)(proj + (m0 + mm) * NPROJ + C_RK + 64 * h);
#pragma unroll
                for (int q = 0; q < 8; ++q) { const u32x4 kv = kp[q]; const float* qq = Ql + n * 64 + 8 * q;
                    a += qq[0] * __uint_as_float(kv.x << 16) + qq[1] * __uint_as_float(kv.x & 0xffff0000u) + qq[2] * __uint_as_float(kv.y << 16) + qq[3] * __uint_as_float(kv.y & 0xffff0000u)
                       + qq[4] * __uint_as_float(kv.z << 16) + qq[5] * __uint_as_float(kv.z & 0xffff0000u) + qq[6] * __uint_as_float(kv.w << 16) + qq[7] * __uint_as_float(kv.w & 0xffff0000u); }
                a *= 0.125f * exp2f(lg2 * (float)(n - mm)); }
            Al[idx] = a; }
        __syncthreads();
        float a0[16], a1[16];
#pragma unroll
        for (int k = 0; k < 16; ++k) { a0[k] = 0.f; a1[k] = 0.f; }
#pragma unroll 1
        for (int d = 0; d < 64; d += 4) {
            const float s00 = Sl[(d + 0) * 128 + lane], s01 = Sl[(d + 0) * 128 + 64 + lane], s10 = Sl[(d + 1) * 128 + lane], s11 = Sl[(d + 1) * 128 + 64 + lane];
            const float s20 = Sl[(d + 2) * 128 + lane], s21 = Sl[(d + 2) * 128 + 64 + lane], s30 = Sl[(d + 3) * 128 + lane], s31 = Sl[(d + 3) * 128 + 64 + lane];
#pragma unroll
            for (int k = 0; k < 16; ++k) { const f32x4 q = *(const f32x4*)(Ql + (wave * 16 + k) * 64 + d);
                a0[k] += q.x * s00 + q.y * s10 + q.z * s20 + q.w * s30; a1[k] += q.x * s01 + q.y * s11 + q.z * s21 + q.w * s31;
                if ((k & 3) == 3) asm volatile("" ::: "memory"); }
        }
#pragma unroll
        for (int k = 0; k < 16; ++k) { const float qd = exp2f(lg2 * (float)(wave * 16 + k + 1)); a0[k] *= qd; a1[k] *= qd; }
#pragma unroll 1
        for (int mm = 0; mm < 128; mm += 4) {
            const bf16* vp = proj + (m0 + mm) * NPROJ + C_RV + 128 * h + lane;
            const float v00 = bf2f(vp[0]), v01 = bf2f(vp[64]), v10 = bf2f(vp[NPROJ]), v11 = bf2f(vp[NPROJ + 64]);
            const float v20 = bf2f(vp[2 * NPROJ]), v21 = bf2f(vp[2 * NPROJ + 64]), v30 = bf2f(vp[3 * NPROJ]), v31 = bf2f(vp[3 * NPROJ + 64]);
#pragma unroll
            for (int k = 0; k < 16; ++k) { const f32x4 a = *(const f32x4*)(Al + (wave * 16 + k) * 128 + mm);
                a0[k] += a.x * v00 + a.y * v10 + a.z * v20 + a.w * v30; a1[k] += a.x * v01 + a.y * v11 + a.z * v21 + a.w * v31;
                if ((k & 3) == 3) asm volatile("" ::: "memory"); }
        }
#pragma unroll
        for (int k = 0; k < 16; ++k) { const int n = wave * 16 + k;
            const float rs = 1.f / sqrtf(wave_sum(a0[k] * a0[k] + a1[k] * a1[k]) * (1.f / 128.f) + EPS);
            const bf16* gp = proj + (m0 + n) * NPROJ + C_RG + 128 * h + lane;
            const float g0 = bf2f(gp[0]), g1 = bf2f(gp[64]);
            bf16* op = br23 + (m0 + n) * D + h * 128 + lane;
            op[0] = (bf16)f2bf(g0 / (1.f + __expf(-g0)) * a0[k] * rs); op[64] = (bf16)f2bf(g1 / (1.f + __expf(-g1)) * a1[k] * rs); }
        __syncthreads();
    }
}

typedef const __attribute__((address_space(4))) Args* KArgs;
__device__ __forceinline__ KArgs kargs() { KArgs p = (KArgs)__builtin_amdgcn_kernarg_segment_ptr(); asm volatile("" : "+s"(p)); return p; }

__device__ __forceinline__ void ph0(LAS unsigned char* L, int layer, int slot) {
    int tid = threadIdx.x; asm volatile("" : "+v"(tid)); const int lane = tid & 63, wave = __builtin_amdgcn_readfirstlane(tid >> 6);
    const int G = gridDim.x, bx = blockIdx.x; const int gw = bx * 8 + wave, NGW = G * 8;
    unsigned char* lds = (unsigned char*)L; LAS int* lcnt = (LAS int*)(L + 0); LAS int* gt = (LAS int*)(L + LDS_MISC + 512);
    (void)lane; (void)gw; (void)NGW; (void)lds; (void)lcnt; (void)gt; (void)layer; (void)slot; (void)tid; (void)bx; (void)G;
    {
        KArgs A = kargs(); unsigned char* ws = A->ws;
        LAS float* scr = (LAS float*)(L + wave * 16384);
        constexpr int I_IN = 16 * 128, I_G = 16 * 128, I_B = 8 * 32, I_SQ = 16 * 32, I_L = I_IN + I_G + 4 * I_B + 5 * I_SQ;
        constexpr int I_GU = 16 * 224, I_DN = 56 * 32, NITEMS = 2 * I_L + I_GU + I_DN;
        for (int it = gw; it < NITEMS; it += NGW) {
            int r = it;
            if (r < 2 * I_L) {
                const int l = r / I_L; r -= l * I_L;
                unsigned char* wb = ws + WS_W + (size_t)l * W_LAYER;
                const float* win = A->w_in + (size_t)l * D * D_IN;
                if (r < I_IN) { conv_seg<1>(win, D, D_IN, 0, (bf16*)(wb + W_IN), D, 0, 128, r, scr, lane); continue; } r -= I_IN;
                if (r < I_G) { conv_seg<0>(win, D, D_IN, 3908, (bf16*)(wb + W_G), D, 0, 128, r, scr, lane); continue; } r -= I_G;
                if (r < 4 * I_B) { const int i = r / I_B; r -= i * I_B;
                    conv_seg<0>(A->w_branch + ((size_t)l * 4 + i) * 512 * D, 512, D, 0, (bf16*)(wb + W_B) + (size_t)(i >> 1) * D * D, D, (i & 1) * 512, 32, r, scr, lane); continue; } r -= 4 * I_B;
                if (r < I_SQ) { conv_seg<0>(A->w_out + (size_t)l * D * D, D, D, 0, (bf16*)(wb + W_OUT), D, 0, 32, r, scr, lane); continue; } r -= I_SQ;
                if (r < I_SQ) { conv_seg<0>(A->w_xq + (size_t)l * D * D, D, D, 0, (bf16*)(wb + W_XQ), D, 0, 32, r, scr, lane); continue; } r -= I_SQ;
                if (r < I_SQ) { conv_seg<0>(A->w_xkv + (size_t)l * D * 2 * D, D, 2 * D, 0, (bf16*)(wb + W_XK), D, 0, 32, r, scr, lane); continue; } r -= I_SQ;
                if (r < I_SQ) { conv_seg<0>(A->w_xkv + (size_t)l * D * 2 * D, D, 2 * D, D, (bf16*)(wb + W_XV), D, 0, 32, r, scr, lane); continue; } r -= I_SQ;
                conv_seg<0>(A->w_xo + (size_t)l * D * D, D, D, 0, (bf16*)(wb + W_XO), D, 0, 32, r, scr, lane); continue;
            }
            r -= 2 * I_L;
            if (r < I_GU) { conv_seg<2>(A->dense_w_gu, D, 2 * DFF, 0, (bf16*)(ws + WS_WGU), D, 0, 224, r, scr, lane); continue; } r -= I_GU;
            conv_seg<0>(A->dense_w_down, DFF, D, 0, (bf16*)(ws + WS_WDN), DFF, 0, 32, r, scr, lane);
        }
        {
            float* cosT = (float*)(ws + WS_ROPE); float* sinT = cosT + (size_t)M * 32; const int* pos = A->positions;
            for (int i = bx * 512 + tid; i < M * 32; i += G * 512) { const int m = i >> 5, j = i & 31;
                const float ang = (float)pos[m] * INV_FREQ[j];
                const double rev = (double)ang * 0.15915494309189533577; const float fr_ = (float)(rev - rint(rev));
                cosT[i] = __builtin_amdgcn_cosf(fr_); sinT[i] = __builtin_amdgcn_sinf(fr_); }
        }
        {
            const float* mem = A->mem; const float* nm = A->norm_mem; bf16* MN = (bf16*)(ws + WS_MN);
            for (int r = gw; r < 2 * MROWS; r += NGW) { const int l = r / MROWS, mr = r % MROWS; norm_row_bf16(mem + (size_t)mr * D, nm + (size_t)l * D, MN + (size_t)r * D, lane); }
            const float* x = A->x; const float* g = A->norm_mix; bf16* HB = (bf16*)(ws + WS_HB);
            for (int m = gw; m < M; m += NGW) norm_row_bf16(x + (size_t)m * D, g, HB + (size_t)m * D, lane);
        }
    }
}
__device__ __forceinline__ void ph1(LAS unsigned char* L, int layer, int slot) {
    int tid = threadIdx.x; asm volatile("" : "+v"(tid)); const int lane = tid & 63, wave = __builtin_amdgcn_readfirstlane(tid >> 6);
    const int G = gridDim.x, bx = blockIdx.x; const int gw = bx * 8 + wave, NGW = G * 8;
    unsigned char* lds = (unsigned char*)L; LAS int* lcnt = (LAS int*)(L + 0); LAS int* gt = (LAS int*)(L + LDS_MISC + 512);
    (void)lane; (void)gw; (void)NGW; (void)lds; (void)lcnt; (void)gt; (void)layer; (void)slot; (void)tid; (void)bx; (void)G;
    {
            unsigned char* ws = kargs()->ws; unsigned char* wb = ws + WS_W + (size_t)layer * W_LAYER;
            { pg8::GridSched S{(const char*)(ws + WS_HB), (const char*)(wb + W_IN), 2048u, 2048u, 128, 16, 16, G, bx};
              EpiProj E{(bf16*)(ws + WS_PROJ), (const float*)(ws + WS_ROPE), (const float*)(ws + WS_ROPE) + (size_t)M * 32};
              pg8::gemm_stream(L, S, E, 2048u, 2048u); }
            if (layer == 0) {
                for (int l = 0; l < 2; ++l) {
                    unsigned char* wl = ws + WS_W + (size_t)l * W_LAYER;
                    { pg8::GridSched S{(const char*)(ws + WS_MN) + (size_t)l * MROWS * D * 2, (const char*)(wl + W_XK), 2048u, 2048u, 8, 4, 16, G, bx};
                      EpiPlain E{(bf16*)(ws + WS_KX) + (size_t)l * MROWS * D, D, 1.f};
                      pg8::gemm_stream(L, S, E, 2048u, 2048u); }
                    { pg8::GridSched S{(const char*)(wl + W_XV), (const char*)(ws + WS_MN) + (size_t)l * MROWS * D * 2, 2048u, 2048u, 4, 8, 16, G, bx};
                      EpiPlain E{(bf16*)(ws + WS_VT) + (size_t)l * D * MROWS, MROWS, 1.f};
                      pg8::gemm_stream(L, S, E, 2048u, 2048u); }
                }
            }
        }
}
__device__ __forceinline__ void ph2(LAS unsigned char* L, int layer, int slot) {
    int tid = threadIdx.x; asm volatile("" : "+v"(tid)); const int lane = tid & 63, wave = __builtin_amdgcn_readfirstlane(tid >> 6);
    const int G = gridDim.x, bx = blockIdx.x; const int gw = bx * 8 + wave, NGW = G * 8;
    unsigned char* lds = (unsigned char*)L; LAS int* lcnt = (LAS int*)(L + 0); LAS int* gt = (LAS int*)(L + LDS_MISC + 512);
    (void)lane; (void)gw; (void)NGW; (void)lds; (void)lcnt; (void)gt; (void)layer; (void)slot; (void)tid; (void)bx; (void)G;
    {
            KArgs A = kargs(); unsigned char* ws = A->ws;
            const bf16* PROJ = (const bf16*)(ws + WS_PROJ);
            ret_u_phase(PROJ, (float*)(ws + WS_U), (char*)lds, G);
            pool_phase(PROJ, A->pool_w + (size_t)layer * 4 * 16384, A->pool_scale + (size_t)layer * 512, (bf16*)(ws + WS_BR23), (char*)lds, G);
            swa_phase(PROJ, A->attn_sink + layer * 8, (bf16*)(ws + WS_BR01), (char*)lds, G);
            dsa_phase(PROJ, (bf16*)(ws + WS_BR01), (char*)lds, G);
        }
}
__device__ __forceinline__ void ph3(LAS unsigned char* L, int layer, int slot) {
    int tid = threadIdx.x; asm volatile("" : "+v"(tid)); const int lane = tid & 63, wave = __builtin_amdgcn_readfirstlane(tid >> 6);
    const int G = gridDim.x, bx = blockIdx.x; const int gw = bx * 8 + wave, NGW = G * 8;
    unsigned char* lds = (unsigned char*)L; LAS int* lcnt = (LAS int*)(L + 0); LAS int* gt = (LAS int*)(L + LDS_MISC + 512);
    (void)lane; (void)gw; (void)NGW; (void)lds; (void)lcnt; (void)gt; (void)layer; (void)slot; (void)tid; (void)bx; (void)G;
    { unsigned char* ws = kargs()->ws; ret_out_phase((const bf16*)(ws + WS_PROJ), (const float*)(ws + WS_U), (bf16*)(ws + WS_BR23), (char*)lds, G); }
}
__device__ __forceinline__ void ph4(LAS unsigned char* L, int layer, int slot) {
    int tid = threadIdx.x; asm volatile("" : "+v"(tid)); const int lane = tid & 63, wave = __builtin_amdgcn_readfirstlane(tid >> 6);
    const int G = gridDim.x, bx = blockIdx.x; const int gw = bx * 8 + wave, NGW = G * 8;
    unsigned char* lds = (unsigned char*)L; LAS int* lcnt = (LAS int*)(L + 0); LAS int* gt = (LAS int*)(L + LDS_MISC + 512);
    (void)lane; (void)gw; (void)NGW; (void)lds; (void)lcnt; (void)gt; (void)layer; (void)slot; (void)tid; (void)bx; (void)G;
    {
            unsigned char* ws = kargs()->ws; unsigned char* wb = ws + WS_W + (size_t)layer * W_LAYER;
            unsigned* scr = (unsigned*)(ws + WS_MSCR + (size_t)bx * 786432);
            for (int ti = 0; ti * G + bx < 512; ++ti) {
                int pm, pn; pg8::tile_of(ti * G + bx, 128, 4, pm, pn);
                { MergeSched<0> S{(const char*)(ws + WS_HB), nullptr, (const char*)(wb + W_G), pm, pn};
                  EpiGate E{scr};
                  pg8::gemm_stream(L, S, E, 2048u, 2048u); }
                { MergeSched<1> S{(const char*)(ws + WS_BR01), (const char*)(ws + WS_BR23), (const char*)(wb + W_B), pm, pn};
                  EpiUp E{scr, (bf16*)(ws + WS_MERGED)};
                  pg8::gemm_stream(L, S, E, 2048u, 2048u); }
            }
        }
}
__device__ __forceinline__ void ph5(LAS unsigned char* L, int layer, int slot) {
    int tid = threadIdx.x; asm volatile("" : "+v"(tid)); const int lane = tid & 63, wave = __builtin_amdgcn_readfirstlane(tid >> 6);
    const int G = gridDim.x, bx = blockIdx.x; const int gw = bx * 8 + wave, NGW = G * 8;
    unsigned char* lds = (unsigned char*)L; LAS int* lcnt = (LAS int*)(L + 0); LAS int* gt = (LAS int*)(L + LDS_MISC + 512);
    (void)lane; (void)gw; (void)NGW; (void)lds; (void)lcnt; (void)gt; (void)layer; (void)slot; (void)tid; (void)bx; (void)G;
    {
            KArgs A = kargs(); unsigned char* ws = A->ws; unsigned char* wb = ws + WS_W + (size_t)layer * W_LAYER;
            pg8::GridSched S{(const char*)(ws + WS_MERGED), (const char*)(wb + W_OUT), 2048u, 2048u, 128, 4, 16, G, bx};
            EpiRes E{(layer == 0) ? A->x : (const float*)A->out, A->out};
            pg8::gemm_stream(L, S, E, 2048u, 2048u);
        }
}
__device__ __forceinline__ void ph6(LAS unsigned char* L, int layer, int slot) {
    int tid = threadIdx.x; asm volatile("" : "+v"(tid)); const int lane = tid & 63, wave = __builtin_amdgcn_readfirstlane(tid >> 6);
    const int G = gridDim.x, bx = blockIdx.x; const int gw = bx * 8 + wave, NGW = G * 8;
    unsigned char* lds = (unsigned char*)L; LAS int* lcnt = (LAS int*)(L + 0); LAS int* gt = (LAS int*)(L + LDS_MISC + 512);
    (void)lane; (void)gw; (void)NGW; (void)lds; (void)lcnt; (void)gt; (void)layer; (void)slot; (void)tid; (void)bx; (void)G;
    { KArgs A = kargs(); const float* x = A->out; const float* g = A->norm_cross + (size_t)layer * D; bf16* HB = (bf16*)(A->ws + WS_HB);
            for (int m = gw; m < M; m += NGW) norm_row_bf16(x + (size_t)m * D, g, HB + (size_t)m * D, lane); }
}
__device__ __forceinline__ void ph7(LAS unsigned char* L, int layer, int slot) {
    int tid = threadIdx.x; asm volatile("" : "+v"(tid)); const int lane = tid & 63, wave = __builtin_amdgcn_readfirstlane(tid >> 6);
    const int G = gridDim.x, bx = blockIdx.x; const int gw = bx * 8 + wave, NGW = G * 8;
    unsigned char* lds = (unsigned char*)L; LAS int* lcnt = (LAS int*)(L + 0); LAS int* gt = (LAS int*)(L + LDS_MISC + 512);
    (void)lane; (void)gw; (void)NGW; (void)lds; (void)lcnt; (void)gt; (void)layer; (void)slot; (void)tid; (void)bx; (void)G;
    {
            unsigned char* ws = kargs()->ws; unsigned char* wb = ws + WS_W + (size_t)layer * W_LAYER;
            pg8::GridSched S{(const char*)(ws + WS_HB), (const char*)(wb + W_XQ), 2048u, 2048u, 128, 4, 16, G, bx};
            EpiPlain E{(bf16*)(ws + WS_XQ), D, 1.f};
            pg8::gemm_stream(L, S, E, 2048u, 2048u);
        }
}
__device__ __forceinline__ void ph8(LAS unsigned char* L, int layer, int slot) {
    int tid = threadIdx.x; asm volatile("" : "+v"(tid)); const int lane = tid & 63, wave = __builtin_amdgcn_readfirstlane(tid >> 6);
    const int G = gridDim.x, bx = blockIdx.x; const int gw = bx * 8 + wave, NGW = G * 8;
    unsigned char* lds = (unsigned char*)L; LAS int* lcnt = (LAS int*)(L + 0); LAS int* gt = (LAS int*)(L + LDS_MISC + 512);
    (void)lane; (void)gw; (void)NGW; (void)lds; (void)lcnt; (void)gt; (void)layer; (void)slot; (void)tid; (void)bx; (void)G;
    {
            unsigned char* ws = kargs()->ws;
            CrossSched S{(const char*)(ws + WS_XQ), (const char*)(ws + WS_KX) + (size_t)layer * MROWS * D * 2, 0, G, bx};
            EpiSoftmax E{(bf16*)(ws + WS_XP), (LAS f32x2*)(L + LDS_XCH), 0.0625f * 1.44269504f};
            pg8::gemm_stream(L, S, E, 2048u, 2048u);
        }
}
__device__ __forceinline__ void ph9(LAS unsigned char* L, int layer, int slot) {
    int tid = threadIdx.x; asm volatile("" : "+v"(tid)); const int lane = tid & 63, wave = __builtin_amdgcn_readfirstlane(tid >> 6);
    const int G = gridDim.x, bx = blockIdx.x; const int gw = bx * 8 + wave, NGW = G * 8;
    unsigned char* lds = (unsigned char*)L; LAS int* lcnt = (LAS int*)(L + 0); LAS int* gt = (LAS int*)(L + LDS_MISC + 512);
    (void)lane; (void)gw; (void)NGW; (void)lds; (void)lcnt; (void)gt; (void)layer; (void)slot; (void)tid; (void)bx; (void)G;
    {
            unsigned char* ws = kargs()->ws;
            CrossSched S{(const char*)(ws + WS_XP), (const char*)(ws + WS_VT) + (size_t)layer * D * MROWS * 2, 1, G, bx};
            EpiPlain E{(bf16*)(ws + WS_XO), D, 1.f};
            pg8::gemm_stream(L, S, E, 2048u, 4096u);
        }
}
__device__ __forceinline__ void ph10(LAS unsigned char* L, int layer, int slot) {
    int tid = threadIdx.x; asm volatile("" : "+v"(tid)); const int lane = tid & 63, wave = __builtin_amdgcn_readfirstlane(tid >> 6);
    const int G = gridDim.x, bx = blockIdx.x; const int gw = bx * 8 + wave, NGW = G * 8;
    unsigned char* lds = (unsigned char*)L; LAS int* lcnt = (LAS int*)(L + 0); LAS int* gt = (LAS int*)(L + LDS_MISC + 512);
    (void)lane; (void)gw; (void)NGW; (void)lds; (void)lcnt; (void)gt; (void)layer; (void)slot; (void)tid; (void)bx; (void)G;
    {
            KArgs A = kargs(); unsigned char* ws = A->ws; unsigned char* wb = ws + WS_W + (size_t)layer * W_LAYER;
            pg8::GridSched S{(const char*)(ws + WS_XO), (const char*)(wb + W_XO), 2048u, 2048u, 128, 4, 16, G, bx};
            EpiRes E{(const float*)A->out, A->out};
            pg8::gemm_stream(L, S, E, 2048u, 2048u);
        }
}
__device__ __forceinline__ void ph11(LAS unsigned char* L, int layer, int slot) {
    int tid = threadIdx.x; asm volatile("" : "+v"(tid)); const int lane = tid & 63, wave = __builtin_amdgcn_readfirstlane(tid >> 6);
    const int G = gridDim.x, bx = blockIdx.x; const int gw = bx * 8 + wave, NGW = G * 8;
    unsigned char* lds = (unsigned char*)L; LAS int* lcnt = (LAS int*)(L + 0); LAS int* gt = (LAS int*)(L + LDS_MISC + 512);
    (void)lane; (void)gw; (void)NGW; (void)lds; (void)lcnt; (void)gt; (void)layer; (void)slot; (void)tid; (void)bx; (void)G;
    { KArgs A = kargs(); const float* x = A->out; const float* g = A->norm_ffn; bf16* HB = (bf16*)(A->ws + WS_HB);
                for (int m = gw; m < M; m += NGW) norm_row_bf16(x + (size_t)m * D, g, HB + (size_t)m * D, lane); }
}
__device__ __forceinline__ void ph12(LAS unsigned char* L, int layer, int slot) {
    int tid = threadIdx.x; asm volatile("" : "+v"(tid)); const int lane = tid & 63, wave = __builtin_amdgcn_readfirstlane(tid >> 6);
    const int G = gridDim.x, bx = blockIdx.x; const int gw = bx * 8 + wave, NGW = G * 8;
    unsigned char* lds = (unsigned char*)L; LAS int* lcnt = (LAS int*)(L + 0); LAS int* gt = (LAS int*)(L + LDS_MISC + 512);
    (void)lane; (void)gw; (void)NGW; (void)lds; (void)lcnt; (void)gt; (void)layer; (void)slot; (void)tid; (void)bx; (void)G;
    {
                unsigned char* ws = kargs()->ws;
                pg8::GridSched S{(const char*)(ws + WS_HB), (const char*)(ws + WS_WGU), 2048u, 2048u, 128, 28, 16, G, bx};
                EpiGU E{(bf16*)(ws + WS_HID)};
                pg8::gemm_stream(L, S, E, 2048u, 2048u);
            }
}
__device__ __forceinline__ void ph13(LAS unsigned char* L, int layer, int slot) {
    int tid = threadIdx.x; asm volatile("" : "+v"(tid)); const int lane = tid & 63, wave = __builtin_amdgcn_readfirstlane(tid >> 6);
    const int G = gridDim.x, bx = blockIdx.x; const int gw = bx * 8 + wave, NGW = G * 8;
    unsigned char* lds = (unsigned char*)L; LAS int* lcnt = (LAS int*)(L + 0); LAS int* gt = (LAS int*)(L + LDS_MISC + 512);
    (void)lane; (void)gw; (void)NGW; (void)lds; (void)lcnt; (void)gt; (void)layer; (void)slot; (void)tid; (void)bx; (void)G;
    {
                KArgs A = kargs(); unsigned char* ws = A->ws;
                pg8::GridSched S{(const char*)(ws + WS_HID), (const char*)(ws + WS_WDN), 7168u, 7168u, 128, 4, 56, G, bx};
                EpiRes E{(const float*)A->out, A->out};
                pg8::gemm_stream(L, S, E, 7168u, 7168u);
            }
}
__device__ __forceinline__ void ph14(LAS unsigned char* L, int layer, int slot) {
    int tid = threadIdx.x; asm volatile("" : "+v"(tid)); const int lane = tid & 63, wave = __builtin_amdgcn_readfirstlane(tid >> 6);
    const int G = gridDim.x, bx = blockIdx.x; const int gw = bx * 8 + wave, NGW = G * 8;
    unsigned char* lds = (unsigned char*)L; LAS int* lcnt = (LAS int*)(L + 0); LAS int* gt = (LAS int*)(L + LDS_MISC + 512);
    (void)lane; (void)gw; (void)NGW; (void)lds; (void)lcnt; (void)gt; (void)layer; (void)slot; (void)tid; (void)bx; (void)G;
    { KArgs A = kargs(); const float* x = A->out; const float* g = A->norm_mix + D; bf16* HB = (bf16*)(A->ws + WS_HB);
                for (int m = gw; m < M; m += NGW) norm_row_bf16(x + (size_t)m * D, g, HB + (size_t)m * D, lane); }
}
__device__ __forceinline__ void ph15(LAS unsigned char* L, int layer, int slot) {
    int tid = threadIdx.x; asm volatile("" : "+v"(tid)); const int lane = tid & 63, wave = __builtin_amdgcn_readfirstlane(tid >> 6);
    const int G = gridDim.x, bx = blockIdx.x; const int gw = bx * 8 + wave, NGW = G * 8;
    unsigned char* lds = (unsigned char*)L; LAS int* lcnt = (LAS int*)(L + 0); LAS int* gt = (LAS int*)(L + LDS_MISC + 512);
    (void)lane; (void)gw; (void)NGW; (void)lds; (void)lcnt; (void)gt; (void)layer; (void)slot; (void)tid; (void)bx; (void)G;
    {
                KArgs A = kargs(); unsigned char* ws = A->ws; unsigned* ctl = (unsigned*)(ws + WS_CTL);
                int* route = (int*)(ws + WS_ROUTE); bf16* HB = (bf16*)(ws + WS_HB);
                if (tid < 16) lcnt[tid] = 0;
                __syncthreads();
                const float* gn = A->norm_ffn + D; const float* xo = A->out; const float* rwt = A->router_w;
                for (int m = gw; m < M; m += NGW) {
                    const f32x4* xr = (const f32x4*)(xo + (size_t)m * D) + lane; const f32x4* gr = (const f32x4*)gn + lane;
                    f32x4 v[4]; float s = 0.f;
#pragma unroll
                    for (int j = 0; j < 4; ++j) { v[j] = xr[64 * j]; s += (v[j].x * v[j].x + v[j].y * v[j].y) + (v[j].z * v[j].z + v[j].w * v[j].w); }
                    const float rstd = 1.f / sqrtf(wave_sum(s) * (1.f / D) + EPS);
                    float lg[8];
#pragma unroll
                    for (int e = 0; e < 8; ++e) lg[e] = 0.f;
                    unsigned long long* o8 = (unsigned long long*)(HB + (size_t)m * D) + lane;
#pragma unroll
                    for (int j = 0; j < 4; ++j) { const f32x4 gg = gr[64 * j]; const f32x4 hv = v[j] * rstd * gg;
                        o8[64 * j] = (unsigned long long)pk2(hv.x, hv.y) | ((unsigned long long)pk2(hv.z, hv.w) << 32);
                        const float* rw = rwt + (size_t)(256 * j + 4 * lane) * 8;
#pragma unroll
                        for (int q = 0; q < 4; ++q) { const f32x4 r0 = *(const f32x4*)(rw + 8 * q), r1 = *(const f32x4*)(rw + 8 * q + 4); const float hq = hv[q];
                            lg[0] += hq * r0.x; lg[1] += hq * r0.y; lg[2] += hq * r0.z; lg[3] += hq * r0.w; lg[4] += hq * r1.x; lg[5] += hq * r1.y; lg[6] += hq * r1.z; lg[7] += hq * r1.w; } }
#pragma unroll
                    for (int e = 0; e < 8; ++e) lg[e] = wave_sum(lg[e]);
                    int e0 = 0; float v0 = lg[0];
#pragma unroll
                    for (int e = 1; e < 8; ++e) if (lg[e] > v0) { v0 = lg[e]; e0 = e; }
                    int e1 = -1; float v1 = -INFINITY;
#pragma unroll
                    for (int e = 0; e < 8; ++e) if (e != e0 && lg[e] > v1) { v1 = lg[e]; e1 = e; }
                    const float ww1 = 1.f / (1.f + __expf(v0 - v1)), ww0 = 1.f - ww1;
                    if (lane == 0) { route[4 * m] = e0; route[4 * m + 1] = e1; ((float*)route)[4 * m + 2] = ww0; ((float*)route)[4 * m + 3] = ww1; atomicAdd((int*)&lcnt[e0], 1); atomicAdd((int*)&lcnt[8 + e1], 1); }
                }
                __syncthreads();
                if (tid < 16) atomicAdd(ctl + CW_CNT + tid, (unsigned)lcnt[tid]);
                __syncthreads();
                LAS float* scr = (LAS float*)(L + wave * 16384);
                constexpr int I_GU = 16 * 224, I_DN = 56 * 32;
                const float* mgu = A->moe_w_gu; const float* mdn = A->moe_w_down;
                for (int it = gw; it < 8 * (I_GU + I_DN); it += NGW) {
                    const int e = it / (I_GU + I_DN); int r = it % (I_GU + I_DN);
                    if (r < I_GU) conv_seg<2>(mgu + (size_t)e * D * 2 * DFF, D, 2 * DFF, 0, (bf16*)(ws + WS_MWGU) + (size_t)e * 2 * DFF * D, D, 0, 224, r, scr, lane);
                    else conv_seg<0>(mdn + (size_t)e * DFF * D, DFF, D, 0, (bf16*)(ws + WS_MWDN) + (size_t)e * D * DFF, DFF, 0, 32, r - I_GU, scr, lane);
                }
            }
}
__device__ __forceinline__ void ph16(LAS unsigned char* L, int layer, int slot) {
    int tid = threadIdx.x; asm volatile("" : "+v"(tid)); const int lane = tid & 63, wave = __builtin_amdgcn_readfirstlane(tid >> 6);
    const int G = gridDim.x, bx = blockIdx.x; const int gw = bx * 8 + wave, NGW = G * 8;
    unsigned char* lds = (unsigned char*)L; LAS int* lcnt = (LAS int*)(L + 0); LAS int* gt = (LAS int*)(L + LDS_MISC + 512);
    (void)lane; (void)gw; (void)NGW; (void)lds; (void)lcnt; (void)gt; (void)layer; (void)slot; (void)tid; (void)bx; (void)G;
    {
                unsigned char* ws = kargs()->ws; unsigned* ctl = (unsigned*)(ws + WS_CTL);
                int* route = (int*)(ws + WS_ROUTE); int* tokmap = (int*)(ws + WS_TOKMAP); float* roww = (float*)(ws + WS_ROWW); bf16* HB = (bf16*)(ws + WS_HB);
                LAS int* lbase = (LAS int*)(L + 64); LAS int* lc2 = (LAS int*)(L + 128);
                for (int chunk = bx; chunk < M / 128; chunk += G) {
                    if (tid < 16) { lcnt[tid] = 0; lc2[tid] = 0; }
                    __syncthreads();
                    const int m = chunk * 128 + (tid >> 2);
                    const int e0 = route[4 * m], e1 = route[4 * m + 1];
                    if ((tid & 3) == 0) { atomicAdd((int*)&lcnt[e0], 1); atomicAdd((int*)&lcnt[8 + e1], 1); }
                    __syncthreads();
                    if (tid < 16) lbase[tid] = (int)atomicAdd(ctl + CW_CUR + tid, (unsigned)lcnt[tid]) + gt[tid] * 256;
                    __syncthreads();
                    int p0 = 0, p1 = 0;
                    if ((tid & 3) == 0) { p0 = lbase[e0] + atomicAdd((int*)&lc2[e0], 1); p1 = lbase[8 + e1] + atomicAdd((int*)&lc2[8 + e1], 1);
                        tokmap[p0] = m; tokmap[p1] = m; roww[p0] = ((const float*)route)[4 * m + 2]; roww[p1] = ((const float*)route)[4 * m + 3]; }
                    p0 = __shfl(p0, lane & ~3); p1 = __shfl(p1, lane & ~3);
                    const u32x4* src = (const u32x4*)(HB + (size_t)m * D) + (tid & 3) * 32;
                    u32x4* d0 = (u32x4*)((bf16*)(ws + WS_XS) + (size_t)p0 * D) + (tid & 3) * 32; u32x4* d1 = (u32x4*)((bf16*)(ws + WS_XS) + (size_t)p1 * D) + (tid & 3) * 32;
#pragma unroll 8
                    for (int q = 0; q < 32; ++q) { const u32x4 v = src[q]; d0[q] = v; d1[q] = v; }
                    __syncthreads();
                }
                if (bx < 16) { const int g = bx; const int cntg = (int)__hip_atomic_load(ctl + CW_CNT + g, __ATOMIC_RELAXED, __HIP_MEMORY_SCOPE_AGENT);
                    for (int r = gt[g] * 256 + cntg + tid; r < gt[g + 1] * 256; r += 512) { tokmap[r] = -1; roww[r] = 0.f; } }
            }
}
__device__ __forceinline__ void ph17(LAS unsigned char* L, int layer, int slot) {
    int tid = threadIdx.x; asm volatile("" : "+v"(tid)); const int lane = tid & 63, wave = __builtin_amdgcn_readfirstlane(tid >> 6);
    const int G = gridDim.x, bx = blockIdx.x; const int gw = bx * 8 + wave, NGW = G * 8;
    unsigned char* lds = (unsigned char*)L; LAS int* lcnt = (LAS int*)(L + 0); LAS int* gt = (LAS int*)(L + LDS_MISC + 512);
    (void)lane; (void)gw; (void)NGW; (void)lds; (void)lcnt; (void)gt; (void)layer; (void)slot; (void)tid; (void)bx; (void)G;
    {
                unsigned char* ws = kargs()->ws;
                MoeSched S{(const char*)(ws + WS_XS), (const char*)(ws + WS_MWGU), 2048u, (size_t)2 * DFF * D * 2, 2048u, 0, gt[16], 28, 16, G, bx, (const int*)gt};
                EpiGU E{(bf16*)(ws + WS_MHID)};
                pg8::gemm_stream(L, S, E, 2048u, 2048u);
            }
}
__device__ __forceinline__ void ph18(LAS unsigned char* L, int layer, int slot) {
    int tid = threadIdx.x; asm volatile("" : "+v"(tid)); const int lane = tid & 63, wave = __builtin_amdgcn_readfirstlane(tid >> 6);
    const int G = gridDim.x, bx = blockIdx.x; const int gw = bx * 8 + wave, NGW = G * 8;
    unsigned char* lds = (unsigned char*)L; LAS int* lcnt = (LAS int*)(L + 0); LAS int* gt = (LAS int*)(L + LDS_MISC + 512);
    (void)lane; (void)gw; (void)NGW; (void)lds; (void)lcnt; (void)gt; (void)layer; (void)slot; (void)tid; (void)bx; (void)G;
    {
                    KArgs A = kargs(); unsigned char* ws = A->ws;
                    const int t0 = slot == 0 ? 0 : gt[8], t1 = slot == 0 ? gt[8] : gt[16];
                    MoeSched S{(const char*)(ws + WS_MHID), (const char*)(ws + WS_MWDN), 7168u, (size_t)D * DFF * 2, 7168u, t0, t1 - t0, 4, 56, G, bx, (const int*)gt};
                    EpiDownMoe E{(const int*)(ws + WS_TOKMAP), (const float*)(ws + WS_ROWW), A->out};
                    pg8::gemm_stream(L, S, E, 7168u, 7168u);
                }
}
__device__ __forceinline__ void ph19(LAS unsigned char* L, int layer, int slot) {
    int tid = threadIdx.x; asm volatile("" : "+v"(tid)); const int lane = tid & 63, wave = __builtin_amdgcn_readfirstlane(tid >> 6);
    const int G = gridDim.x, bx = blockIdx.x; const int gw = bx * 8 + wave, NGW = G * 8;
    unsigned char* lds = (unsigned char*)L; LAS int* lcnt = (LAS int*)(L + 0); LAS int* gt = (LAS int*)(L + LDS_MISC + 512);
    (void)lane; (void)gw; (void)NGW; (void)lds; (void)lcnt; (void)gt; (void)layer; (void)slot; (void)tid; (void)bx; (void)G;
    { KArgs A = kargs(); float* xo = A->out; const float* gf = A->norm_final;
                for (int m = gw; m < M; m += NGW) {
                    f32x4* xr = (f32x4*)(xo + (size_t)m * D) + lane; const f32x4* gr = (const f32x4*)gf + lane;
                    f32x4 v[4]; float s = 0.f;
#pragma unroll
                    for (int j = 0; j < 4; ++j) { v[j] = xr[64 * j]; s += (v[j].x * v[j].x + v[j].y * v[j].y) + (v[j].z * v[j].z + v[j].w * v[j].w); }
                    const float rstd = 1.f / sqrtf(wave_sum(s) * (1.f / D) + EPS);
#pragma unroll
                    for (int j = 0; j < 4; ++j) xr[64 * j] = v[j] * rstd * gr[64 * j];
                } }
}
__global__ void __launch_bounds__(512, 2) fwd_kernel(Args a_unused) {
    extern __shared__ __attribute__((aligned(16))) unsigned char lds[];
    LAS unsigned char* L = (LAS unsigned char*)lds;
    volatile LAS unsigned* MISC = (volatile LAS unsigned*)(L + LDS_MISC);
    const int tid = threadIdx.x, lane = tid & 63, wave = __builtin_amdgcn_readfirstlane(tid >> 6);
    const int G = gridDim.x, bx = blockIdx.x;
    for (int u = tid; u < 64; u += 512) MISC[u] = 0u;
    __syncthreads();
    XcdBarrier bar; bar.bar = (unsigned*)(kargs()->ws + WS_CTL) + CW_BAR; bar.x = 0; bar.st = nullptr;
    if (!MK_PER_PHASE) bar = xcd_barrier_post(bar.bar, MISC + 8);
    int pid = 0;
    const int lo = kargs()->ph_lo, hi = kargs()->ph_hi;
#define RUN() (pid >= lo && pid < hi)
#define SEAM() do { if (!MK_PER_PHASE) xcd_barrier(bar); ++pid; } while (0)
    int slotv = 0; (void)lane;

    if (PON(0) && RUN()) ph0(L, 0, 0);
    SEAM();

    for (int layer = 0; layer < DEPTH; ++layer) {
        if (PON(1) && RUN()) ph1(L, layer, slotv);
        SEAM();
        if (PON(2) && RUN()) ph2(L, layer, slotv);
        SEAM();
        if (PON(3) && RUN()) ph3(L, layer, slotv);
        SEAM();
        if (PON(4) && RUN()) ph4(L, layer, slotv);
        SEAM();
        if (PON(5) && RUN()) ph5(L, layer, slotv);
        SEAM();
        if (PON(6) && RUN()) ph6(L, layer, slotv);
        SEAM();
        if (PON(7) && RUN()) ph7(L, layer, slotv);
        SEAM();
        if (PON(8) && RUN()) ph8(L, layer, slotv);
        SEAM();
        if (PON(9) && RUN()) ph9(L, layer, slotv);
        SEAM();
        if (PON(10) && RUN()) ph10(L, layer, slotv);
        SEAM();
        if (layer == 0) {
            if (PON(11) && RUN()) ph11(L, layer, slotv);
            SEAM();
            if (PON(12) && RUN()) ph12(L, layer, slotv);
            SEAM();
            if (PON(13) && RUN()) ph13(L, layer, slotv);
            SEAM();
            if (PON(14) && RUN()) ph14(L, layer, slotv);
            SEAM();
        } else {
            if (PON(15) && RUN()) ph15(L, layer, slotv);
            SEAM();
            LAS int* gt = (LAS int*)(L + LDS_MISC + 512);
            if (tid == 0) { unsigned* ctl = (unsigned*)(kargs()->ws + WS_CTL); int acc = 0; for (int g = 0; g < 16; ++g) { gt[g] = acc; acc += ((int)__hip_atomic_load(ctl + CW_CNT + g, __ATOMIC_RELAXED, __HIP_MEMORY_SCOPE_AGENT) + 255) >> 8; } gt[16] = acc; }
            __syncthreads();
            if (PON(16) && RUN()) ph16(L, layer, slotv);
            SEAM();
            if (PON(17) && RUN()) ph17(L, layer, slotv);
            SEAM();
            for (int slot = 0; slot < 2; ++slot) {
                if (PON(18) && RUN()) ph18(L, layer, slot);
                SEAM();
            }
            if (PON(19) && RUN()) ph19(L, layer, slotv);
            ++pid;
        }
    }
#undef RUN
#undef SEAM
}


constexpr int NPHASE = 1 + 14 + 16;
extern "C" void kernel_launch(void* const* d_in, const int* in_sizes, int n_in, void* d_out, int out_size, void* d_ws, size_t ws_size, hipStream_t stream) {
    static int grid = 0;
    if (grid == 0) {
        if (n_in != 22 || out_size != M * D || ws_size < WS_END) { fprintf(stderr, "kernel_launch: unexpected problem (n_in %d out %d ws %zu)\n", n_in, out_size, ws_size); grid = -1; return; }
        int dev = 0, cus = 0;
        if (hipGetDevice(&dev) != hipSuccess || hipDeviceGetAttribute(&cus, hipDeviceAttributeMultiprocessorCount, dev) != hipSuccess) { grid = -1; return; }
        if (hipFuncSetAttribute((const void*)fwd_kernel, hipFuncAttributeMaxDynamicSharedMemorySize, LDS_BYTES) != hipSuccess) { fprintf(stderr, "kernel_launch: hipFuncSetAttribute failed\n"); grid = -1; return; }
        int per_cu = 0;
        (void)hipOccupancyMaxActiveBlocksPerMultiprocessor(&per_cu, (const void*)fwd_kernel, 512, LDS_BYTES);
        (void)hipGetLastError();
        if (per_cu < 1) fprintf(stderr, "kernel_launch: occupancy query says %d\n", per_cu);
        grid = cus;
    }
    if (grid < 0) return;
    (void)hipMemsetAsync((char*)d_ws + WS_CTL, 0, CTL_ZERO_BYTES, stream);
    Args a{};
    a.x = (const float*)d_in[0]; a.mem = (const float*)d_in[1]; a.positions = (const int*)d_in[2]; a.norm_mix = (const float*)d_in[3]; a.w_in = (const float*)d_in[4];
    a.attn_sink = (const float*)d_in[5]; a.w_branch = (const float*)d_in[6]; a.w_out = (const float*)d_in[7]; a.pool_w = (const float*)d_in[8]; a.pool_scale = (const float*)d_in[9];
    a.norm_cross = (const float*)d_in[10]; a.norm_mem = (const float*)d_in[11]; a.w_xq = (const float*)d_in[12]; a.w_xkv = (const float*)d_in[13]; a.w_xo = (const float*)d_in[14];
    a.norm_ffn = (const float*)d_in[15]; a.dense_w_gu = (const float*)d_in[16]; a.dense_w_down = (const float*)d_in[17]; a.router_w = (const float*)d_in[18];
    a.moe_w_gu = (const float*)d_in[19]; a.moe_w_down = (const float*)d_in[20]; a.norm_final = (const float*)d_in[21];
    a.out = (float*)d_out; a.ws = (unsigned char*)d_ws;
#if MK_PER_PHASE
    for (int p = 0; p < NPHASE; ++p) { a.ph_lo = p; a.ph_hi = p + 1; hipLaunchKernelGGL(fwd_kernel, dim3(grid), dim3(512), LDS_BYTES, stream, a); }
#else
    a.ph_lo = 0; a.ph_hi = NPHASE;
    hipLaunchKernelGGL(fwd_kernel, dim3(grid), dim3(512), LDS_BYTES, stream, a);
#endif
}
```

```cpp
#include <hip/hip_runtime.h>
#include <cstdio>
#include <cstdint>

#ifndef MK_PER_PHASE
#define MK_PER_PHASE 0
#endif

#ifndef PHASE_MASK
#define PHASE_MASK 0xFFFFFFFFu
#endif
#define PON(k) ((PHASE_MASK >> (k)) & 1u)
#ifndef REP_MASK
#define REP_MASK 0u
#endif
#define REP(k) (1 + (int)((REP_MASK >> (k)) & 1u))
#define LAS __attribute__((address_space(3)))
#define GAS __attribute__((address_space(1)))
typedef unsigned short bf16;
typedef short bf16x8 __attribute__((ext_vector_type(8)));
typedef float f32x4 __attribute__((ext_vector_type(4)));
typedef float f32x2 __attribute__((ext_vector_type(2)));
typedef unsigned u32x4 __attribute__((ext_vector_type(4)));
typedef unsigned u32x2 __attribute__((ext_vector_type(2)));
typedef __bf16 bf16x2_t __attribute__((ext_vector_type(2)));

constexpr int BATCH = 8, T = 4096, D = 1024, M = BATCH * T, DEPTH = 2;
constexpr int D_IN = 8004, NPROJ = 4096, DFF = 3584, NEXP = 8, MEMLEN = 256, MROWS = BATCH * MEMLEN;
constexpr float EPS = 1e-6f;
constexpr int C_AQ = 0, C_AK = 512, C_AV = 640, C_BQ = 768, C_BK = 1280, C_BV = 1408, C_IQ = 1536, C_IK = 1792, C_RQ = 1856, C_RK = 2112, C_RV = 2368, C_RG = 2880, C_PU = 3392, C_IW = 3904;
constexpr unsigned long long ROPE_MASK = 0x3FFull | (0x3FFull << 12) | (0x1FFFull << 24);

constexpr size_t MiB = 1u << 20;
constexpr size_t WS_CTL = 0, CTL_ZERO_BYTES = 1 * MiB;
constexpr size_t WS_ROUTE = 1 * MiB;
constexpr size_t WS_TOKMAP = 2 * MiB;
constexpr size_t WS_ROWW = 3 * MiB;
constexpr size_t WS_HB = 4 * MiB;
constexpr size_t WS_ROPE = 68 * MiB;
constexpr size_t WS_MN = 76 * MiB;
constexpr size_t WS_KX = 84 * MiB;
constexpr size_t WS_VT = 92 * MiB;
constexpr size_t WS_W = 100 * MiB;
constexpr size_t W_IN = 0, W_G = 8 * MiB, W_B = 16 * MiB, W_OUT = 20 * MiB, W_XQ = 22 * MiB, W_XK = 24 * MiB, W_XV = 26 * MiB, W_XO = 28 * MiB, W_LAYER = 30 * MiB;
constexpr size_t WS_WGU = WS_W + 2 * W_LAYER;
constexpr size_t WS_WDN = WS_WGU + 14 * MiB;
constexpr size_t WS_R = 181 * MiB;
constexpr size_t WS_PROJ = WS_R;
constexpr size_t WS_BR01 = WS_R + 256 * MiB;
constexpr size_t WS_BR23 = WS_R + 320 * MiB;
constexpr size_t WS_U = WS_R + 384 * MiB;
constexpr size_t WS_R_END = WS_R + 416 * MiB;
constexpr size_t WS_AKV = 600 * MiB;
constexpr size_t WS_BKV = 616 * MiB;
constexpr size_t WS_IK = 632 * MiB;
constexpr size_t WS_MSCR = WS_PROJ;
constexpr size_t WS_MERGED = WS_PROJ + 192 * MiB;
constexpr size_t WS_XQ = WS_PROJ;
constexpr size_t WS_XP = WS_PROJ + 64 * MiB;
constexpr size_t WS_XO = WS_PROJ + 128 * MiB;
constexpr size_t WS_HID = WS_PROJ;
constexpr int MOE_ROWS = 2 * M + 16 * 256;
constexpr size_t WS_MWGU = 100 * MiB;
constexpr size_t WS_MWDN = 212 * MiB;
constexpr size_t WS_MHID = 268 * MiB;
constexpr size_t WS_XS = 744 * MiB;
constexpr size_t WS_END = 880 * MiB;
static_assert(WS_MHID + (size_t)MOE_ROWS * DFF * 2 <= WS_XS && WS_XS + (size_t)MOE_ROWS * D * 2 <= WS_END, "moe map");
static_assert(WS_WDN + 7 * MiB <= WS_R, "weights map");
constexpr int CW_BAR = 4096;
constexpr int CW_CNT = 16384;
constexpr int CW_CUR = 16384 + 64;

constexpr int LDS_STAGE = 131072;
constexpr int LDS_XCH = 131072;
constexpr int LDS_MISC = 131072 + 16384;
constexpr int LDS_BYTES = 131072 + 16384 + 8192;
constexpr int WAVE_LDS = 17408;

__device__ const float INV_FREQ[32] = {1.000000000e+00f, 7.498942018e-01f, 5.623413324e-01f, 4.216965139e-01f, 3.162277639e-01f, 2.371373922e-01f, 1.778279394e-01f, 1.333521456e-01f, 1.000000015e-01f, 7.498941571e-02f, 5.623412877e-02f, 4.216964915e-02f, 3.162277862e-02f, 2.371373586e-02f, 1.778279431e-02f, 1.333521493e-02f, 9.999999776e-03f, 7.498942316e-03f, 5.623413250e-03f, 4.216964822e-03f, 3.162277862e-03f, 2.371373819e-03f, 1.778279431e-03f, 1.333521446e-03f, 1.000000047e-03f, 7.498941850e-04f, 5.623413017e-04f, 4.216965463e-04f, 3.162277862e-04f, 2.371373848e-04f, 1.778279402e-04f, 1.333521504e-04f};
__device__ __forceinline__ float bf2f(unsigned short v) { return __uint_as_float(((unsigned)v) << 16); }
__device__ __forceinline__ unsigned f2bf(float f) { unsigned u = __float_as_uint(f); return (u + 0x7fffu + ((u >> 16) & 1u)) >> 16; }
__device__ __forceinline__ unsigned pk2(float lo, float hi) { return f2bf(lo) | (f2bf(hi) << 16); }
__device__ __forceinline__ unsigned cvt_pk_bf16(float lo, float hi) { unsigned r; asm volatile("v_cvt_pk_bf16_f32 %0, %1, %2" : "=v"(r) : "v"(lo), "v"(hi)); return r; }
__device__ __forceinline__ float dot2(unsigned a, unsigned b, float acc) { return __builtin_amdgcn_fdot2_f32_bf16(__builtin_bit_cast(bf16x2_t, a), __builtin_bit_cast(bf16x2_t, b), acc, false); }
__device__ __forceinline__ float wave_sum(float v) {
#pragma unroll
    for (int o = 1; o < 64; o <<= 1) v += __shfl_xor(v, o);
    return v;
}
__device__ __forceinline__ float wave_max(float v) {
#pragma unroll
    for (int o = 1; o < 64; o <<= 1) v = fmaxf(v, __shfl_xor(v, o));
    return v;
}
#define LDS_WAIT() asm volatile("s_waitcnt lgkmcnt(0)" ::: "memory")

namespace pg8 {
constexpr int BM = 256, BK = 64, HALF = 128, HTB = HALF * BK * 2, STAGE_BYTES = 8 * HTB, NXCD = 8, WGM = 8;
__host__ __device__ __forceinline__ int lds_byte(int r, int c) { const int st = (r >> 4) * 2 + (c >> 5), rr = r & 15, cc = c & 31, ob = rr * 64 + cc * 2; return st * 1024 + (ob ^ (((ob >> 9) & 1) << 5)); }
__host__ __device__ __forceinline__ void stage_rc(int b, int& R, int& C) { const int st = b / 1024, sb = b % 1024, swz = sb ^ (((sb >> 9) & 1) << 5); R = (st >> 1) * 16 + swz / 64; C = (st & 1) * 32 + (swz % 64) / 2; }
__host__ __device__ __forceinline__ int perm32(int rho) { const int n = rho >> 4, i = rho & 15; return 8 * (i >> 2) + 4 * n + (i & 3); }

struct Unit { const char* A; const char* B; int nt; int pm, pn, kind; };

__device__ __forceinline__ void tile_of(int wgid, int nM, int nN, int& pm, int& pn) {
    const int nwg = nM * nN;
    { const int q = nwg / NXCD, r = nwg % NXCD, xcd = wgid % NXCD, off = wgid / NXCD; wgid = (xcd < r ? xcd * (q + 1) : r * (q + 1) + (xcd - r) * q) + off; }
    const int nig = WGM * nN, gid = wgid / nig, fm = gid * WGM, gsz = (nM - fm) < WGM ? (nM - fm) : WGM;
    pm = fm + ((wgid % nig) % gsz); pn = (wgid % nig) / gsz;
}
struct GridSched {
    const char* A; const char* B; unsigned lda, ldb; int nM, nN, nt, G, c;
    __device__ __forceinline__ bool next(int i, Unit& u) const {
        const long L = (long)i * G + c; if (L >= (long)nM * nN) return false;
        tile_of((int)L, nM, nN, u.pm, u.pn);
        u.A = A + (size_t)u.pm * 256 * lda; u.B = B + (size_t)u.pn * 256 * ldb; u.nt = nt; u.kind = 0; return true;
    }
};

template <class Epi, class Sched>
__device__ __forceinline__ void gemm_stream(LAS unsigned char* lds, const Sched& S, const Epi& E, const unsigned lda, const unsigned ldb) {
    int tid = threadIdx.x; asm volatile("" : "+v"(tid));
    const int wid = __builtin_amdgcn_readfirstlane(tid >> 6), lane = tid & 63, wr = wid >> 2, wc = wid & 3, fr = lane & 15, fq = lane >> 4;
    unsigned voffA, voffB;
    { int R, C; stage_rc(tid * 16, R, C); const int Rb = (R & ~31) + perm32(R & 31); voffA = (unsigned)R * lda + (unsigned)C * 2u; voffB = (unsigned)Rb * ldb + (unsigned)C * 2u; }
    const size_t kstep = (size_t)(BK * 2);
    const size_t hA = (size_t)HALF * lda, hB = (size_t)HALF * ldb, qA = (size_t)64 * lda, qB = (size_t)64 * ldb;
    const unsigned ldsw = (unsigned)wid * 1024u;
    const int aoff = lds_byte(wr * 64 + fr, fq * 8), boff = lds_byte(wc * 32 + fr, fq * 8);
#define PG8_SA(b, h) (((b) * 2 + (h)) * HTB)
#define PG8_SB(b, h) ((4 + (b) * 2 + (h)) * HTB)
#define PG8_STAGE(bufoff, gbase, voff) do { \
        __builtin_amdgcn_global_load_lds((const unsigned*)((const char*)(gbase) + (voff)), (LAS unsigned*)(lds + (bufoff) + ldsw), 16, 0, 0); \
        __builtin_amdgcn_global_load_lds((const unsigned*)((const char*)(gbase) + ((&(voff) == &voffA) ? qA : qB) + (voff)), (LAS unsigned*)(lds + (bufoff) + ldsw + 8192), 16, 0, 0); } while (0)
#define PG8_LDA(dst, b, h) do { _Pragma("unroll") for (int m = 0; m < 4; ++m) _Pragma("unroll") for (int k = 0; k < 2; ++k) dst[m][k] = *(const LAS bf16x8*)(lds + PG8_SA(b, h) + aoff + m * 2048 + k * 1024); } while (0)
#define PG8_LDB(dst, b, h) do { _Pragma("unroll") for (int n = 0; n < 2; ++n) _Pragma("unroll") for (int k = 0; k < 2; ++k) dst[n][k] = *(const LAS bf16x8*)(lds + PG8_SB(b, h) + boff + n * 2048 + k * 1024); } while (0)
#define PG8_MMA(ai, bj, At, Bt) do { __builtin_amdgcn_s_setprio(1); _Pragma("unroll") for (int m = 0; m < 4; ++m) _Pragma("unroll") for (int n = 0; n < 2; ++n) _Pragma("unroll") for (int k = 0; k < 2; ++k) \
        acc[ai][bj][m][n] = __builtin_amdgcn_mfma_f32_16x16x32_bf16(Bt[n][k], At[m][k], acc[ai][bj][m][n], 0, 0, 0); __builtin_amdgcn_s_setprio(0); } while (0)
#define PG8_WAIT_V(n) asm volatile("s_waitcnt vmcnt(" #n ")" ::: "memory")
#define PG8_WAIT_L(n) asm volatile("s_waitcnt lgkmcnt(" #n ")" ::: "memory")
#define PG8_BAR __builtin_amdgcn_s_barrier()
#define PG8_SCHED __builtin_amdgcn_sched_barrier(0)
    Unit cur, nxt; int ui = 0;
    if (!S.next(0, cur)) return;
    f32x4 acc[2][2][4][2];
#pragma unroll
    for (int a = 0; a < 2; ++a)
#pragma unroll
        for (int b = 0; b < 2; ++b)
#pragma unroll
            for (int m = 0; m < 4; ++m)
#pragma unroll
                for (int n = 0; n < 2; ++n) acc[a][b][m][n] = (f32x4){0.f, 0.f, 0.f, 0.f};
    bf16x8 At[4][2], B0[2][2], B1[2][2];
    const char* cA = cur.A; const char* cB = cur.B;
    PG8_STAGE(PG8_SB(0, 0), cB, voffB); PG8_STAGE(PG8_SB(0, 1), cB + hB, voffB); PG8_STAGE(PG8_SA(0, 0), cA, voffA); PG8_STAGE(PG8_SA(0, 1), cA + hA, voffA);
    if (wr == 1) PG8_BAR;
    PG8_WAIT_V(2); PG8_BAR;
    PG8_STAGE(PG8_SB(1, 0), cB + kstep, voffB); PG8_STAGE(PG8_SA(1, 0), cA + kstep, voffA); PG8_STAGE(PG8_SB(1, 1), cB + hB + kstep, voffB);
    PG8_WAIT_V(6); PG8_BAR;
    for (;;) {
        const bool has_next = S.next(ui + 1, nxt);
        const char* nA = has_next ? nxt.A : cA; const char* nB = has_next ? nxt.B : cB;
        int nt = cur.nt; asm volatile("" : "+s"(nt));
#pragma unroll 1
        for (int t = 0; t < nt; t += 2) {
            const bool last = (t == nt - 2);
            const char* a1 = cA + (size_t)(t + 1) * kstep;
            const char* a2 = last ? nA : cA + (size_t)(t + 2) * kstep; const char* b2 = last ? nB : cB + (size_t)(t + 2) * kstep;
            const char* a3 = a2 + kstep; const char* b3 = b2 + kstep;
            PG8_LDB(B0, 0, 0); PG8_LDB(B1, 0, 1); PG8_SCHED; PG8_LDA(At, 0, 0); PG8_STAGE(PG8_SA(1, 1), a1 + hA, voffA);
            PG8_WAIT_V(8); PG8_WAIT_L(0); PG8_BAR; PG8_MMA(0, 0, At, B0); PG8_MMA(0, 1, At, B1); PG8_BAR; PG8_SCHED;
            PG8_LDA(At, 0, 1); PG8_STAGE(PG8_SB(0, 0), b2, voffB); PG8_STAGE(PG8_SB(0, 1), b2 + hB, voffB); PG8_STAGE(PG8_SA(0, 0), a2, voffA);
            PG8_WAIT_V(8); PG8_WAIT_L(0); PG8_BAR; PG8_MMA(1, 0, At, B0); PG8_MMA(1, 1, At, B1); PG8_BAR; PG8_SCHED;
            PG8_LDB(B0, 1, 0); PG8_LDB(B1, 1, 1); PG8_SCHED; PG8_LDA(At, 1, 0); PG8_STAGE(PG8_SA(0, 1), a2 + hA, voffA);
            PG8_WAIT_V(8); PG8_WAIT_L(0); PG8_BAR; PG8_MMA(0, 0, At, B0); PG8_MMA(0, 1, At, B1); PG8_BAR; PG8_SCHED;
            PG8_LDA(At, 1, 1); PG8_STAGE(PG8_SB(1, 0), b3, voffB); PG8_STAGE(PG8_SB(1, 1), b3 + hB, voffB); PG8_STAGE(PG8_SA(1, 0), a3, voffA);
            PG8_WAIT_V(8); PG8_WAIT_L(0); PG8_BAR; PG8_MMA(1, 0, At, B0); PG8_MMA(1, 1, At, B1); PG8_BAR; PG8_SCHED;
        }
        if (wr == 0) PG8_BAR;
        const bool keep = E(acc, cur, wr, wc, fr, fq);
        if (!has_next) break;
        if constexpr (Epi::CHAIN) {
            const float kf = keep ? 1.f : 0.f;
#pragma unroll
            for (int a = 0; a < 2; ++a)
#pragma unroll
                for (int b = 0; b < 2; ++b)
#pragma unroll
                    for (int m = 0; m < 4; ++m)
#pragma unroll
                        for (int n = 0; n < 2; ++n) acc[a][b][m][n] = acc[a][b][m][n] * kf;
        } else {
#pragma unroll
            for (int a = 0; a < 2; ++a)
#pragma unroll
                for (int b = 0; b < 2; ++b)
#pragma unroll
                    for (int m = 0; m < 4; ++m)
#pragma unroll
                        for (int n = 0; n < 2; ++n) acc[a][b][m][n] = (f32x4){0.f, 0.f, 0.f, 0.f};
        }
        cur = nxt; cA = nA; cB = nB; ++ui;
        if (wr == 1) PG8_BAR;
    }
    PG8_WAIT_V(0);
    PG8_BAR;
#undef PG8_SA
#undef PG8_SB
#undef PG8_STAGE
#undef PG8_LDA
#undef PG8_LDB
#undef PG8_MMA
#undef PG8_WAIT_V
#undef PG8_WAIT_L
#undef PG8_BAR
#undef PG8_SCHED
}
}
using pg8::Unit;

#define EPI_ARGS f32x4 (&acc)[2][2][4][2], const Unit& u, int wr, int wc, int fr_in, int fq_in
#define EPI_LANE int lane_l = threadIdx.x & 63; asm volatile("" : "+v"(lane_l)); const int fr = lane_l & 15, fq = lane_l >> 4; (void)fr_in; (void)fq_in;
struct EpiProj {
    static constexpr bool CHAIN = false;
    bf16* O; const float* cosT; const float* sinT; bf16* AKV; bf16* BKV; bf16* IK;
    __device__ __forceinline__ bool operator()(EPI_ARGS) const {
        EPI_LANE
        const int g = 4 * u.pn + wc; const bool rope = (ROPE_MASK >> g) & 1ull;
        const int row0 = u.pm * 256 + wr * 64 + fr;
#pragma unroll
        for (int ai = 0; ai < 2; ++ai)
#pragma unroll
            for (int m = 0; m < 4; ++m) {
                const int r = row0 + ai * 128 + m * 16;
                f32x4 x1a = acc[ai][0][m][0], x1b = acc[ai][0][m][1], x2a = acc[ai][1][m][0], x2b = acc[ai][1][m][1];
                if (rope) {
                    const f32x4 ca = *(const f32x4*)(cosT + (size_t)r * 32 + 8 * fq), cb = *(const f32x4*)(cosT + (size_t)r * 32 + 8 * fq + 4);
                    const f32x4 sa = *(const f32x4*)(sinT + (size_t)r * 32 + 8 * fq), sb = *(const f32x4*)(sinT + (size_t)r * 32 + 8 * fq + 4);
                    const f32x4 o1a = x1a * ca - x2a * sa, o1b = x1b * cb - x2b * sb, o2a = x2a * ca + x1a * sa, o2b = x2b * cb + x1b * sb;
                    x1a = o1a; x1b = o1b; x2a = o2a; x2b = o2b;
                }
                bf16* rowp = (g >= 8 && g < 12) ? AKV + (size_t)r * 256 + 64 * (g - 8) + 8 * fq : (g >= 20 && g < 24) ? BKV + (size_t)r * 256 + 64 * (g - 20) + 8 * fq
                           : (g == 28) ? IK + (size_t)r * 64 + 8 * fq : O + (size_t)r * NPROJ + 64 * g + 8 * fq;
                u32x4 w1, w2;
                w1.x = cvt_pk_bf16(x1a[0], x1a[1]); w1.y = cvt_pk_bf16(x1a[2], x1a[3]); w1.z = cvt_pk_bf16(x1b[0], x1b[1]); w1.w = cvt_pk_bf16(x1b[2], x1b[3]);
                w2.x = cvt_pk_bf16(x2a[0], x2a[1]); w2.y = cvt_pk_bf16(x2a[2], x2a[3]); w2.z = cvt_pk_bf16(x2b[0], x2b[1]); w2.w = cvt_pk_bf16(x2b[2], x2b[3]);
                *(u32x4*)(rowp) = w1; *(u32x4*)(rowp + 32) = w2;
            }
        return false;
    }
};
struct EpiPlain {
    static constexpr bool CHAIN = false;
    bf16* O; int ldc; float scale;
    __device__ __forceinline__ bool operator()(EPI_ARGS) const {
        EPI_LANE
        const int row0 = u.pm * 256 + wr * 64 + fr, col0 = u.pn * 256 + wc * 32 + 8 * fq;
#pragma unroll
        for (int ai = 0; ai < 2; ++ai)
#pragma unroll
            for (int m = 0; m < 4; ++m) { bf16* rowp = O + (size_t)(row0 + ai * 128 + m * 16) * ldc + col0;
#pragma unroll
                for (int bj = 0; bj < 2; ++bj) { const f32x4 v0 = acc[ai][bj][m][0] * scale, v1 = acc[ai][bj][m][1] * scale;
                    u32x4 w; w.x = cvt_pk_bf16(v0[0], v0[1]); w.y = cvt_pk_bf16(v0[2], v0[3]); w.z = cvt_pk_bf16(v1[0], v1[1]); w.w = cvt_pk_bf16(v1[2], v1[3]);
                    *(u32x4*)(rowp + bj * 128) = w; } }
        return false;
    }
};
struct EpiRes {
    static constexpr bool CHAIN = false;
    const float* in; float* out;
    __device__ __forceinline__ bool operator()(EPI_ARGS) const {
        EPI_LANE
        const int row0 = u.pm * 256 + wr * 64 + fr, col0 = u.pn * 256 + wc * 32 + 8 * fq;
#pragma unroll
        for (int ai = 0; ai < 2; ++ai)
#pragma unroll
            for (int m = 0; m < 4; ++m) { const size_t off = (size_t)(row0 + ai * 128 + m * 16) * D + col0;
#pragma unroll
                for (int bj = 0; bj < 2; ++bj) {
                    const f32x4 a0 = *(const f32x4*)(in + off + bj * 128), a1 = *(const f32x4*)(in + off + bj * 128 + 4);
                    *(f32x4*)(out + off + bj * 128) = a0 + acc[ai][bj][m][0]; *(f32x4*)(out + off + bj * 128 + 4) = a1 + acc[ai][bj][m][1]; }
                asm volatile("" ::: "memory"); }
        return false;
    }
};
struct EpiGate {
    static constexpr bool CHAIN = false;
    unsigned* scr;
    __device__ __forceinline__ bool operator()(EPI_ARGS) const {
        EPI_LANE
        const unsigned voff = (unsigned)(((unsigned)__builtin_amdgcn_readfirstlane(threadIdx.x >> 6) * 64u + (unsigned)lane_l) * 16u);
        char* sb = (char*)scr + (size_t)u.kind * 131072;
#pragma unroll
        for (int ai = 0; ai < 2; ++ai)
#pragma unroll
            for (int m = 0; m < 4; ++m)
#pragma unroll
                for (int bj = 0; bj < 2; ++bj) {
                    f32x4 v0 = acc[ai][bj][m][0], v1 = acc[ai][bj][m][1]; u32x4 w;
#pragma unroll
                    for (int j = 0; j < 4; ++j) { v0[j] = fmaxf(__builtin_amdgcn_rcpf(1.f + __builtin_amdgcn_exp2f(-1.44269504f * v0[j])), 1e-6f); v1[j] = fmaxf(__builtin_amdgcn_rcpf(1.f + __builtin_amdgcn_exp2f(-1.44269504f * v1[j])), 1e-6f); }
                    w.x = cvt_pk_bf16(v0[0], v0[1]); w.y = cvt_pk_bf16(v0[2], v0[3]); w.z = cvt_pk_bf16(v1[0], v1[1]); w.w = cvt_pk_bf16(v1[2], v1[3]);
                    *(u32x4*)(sb + (size_t)((ai * 4 + m) * 2 + bj) * 8192 + voff) = w; asm volatile("" ::: "memory"); }
        return false;
    }
};
struct EpiUp {
    static constexpr bool CHAIN = false;
    unsigned* scr; bf16* O;
    __device__ __forceinline__ bool operator()(EPI_ARGS) const {
        EPI_LANE
        const unsigned tl = (unsigned)__builtin_amdgcn_readfirstlane(threadIdx.x >> 6) * 64u + (unsigned)lane_l;
        const char* s0 = (const char*)scr + (size_t)u.kind * 131072;
        char* pb = (char*)scr + 4 * 131072;
        const int row0 = u.pm * 256 + wr * 64 + fr, col0 = u.pn * 256 + wc * 32 + 8 * fq;
#pragma unroll
        for (int ai = 0; ai < 2; ++ai)
#pragma unroll
            for (int m = 0; m < 4; ++m)
#pragma unroll
                for (int bj = 0; bj < 2; ++bj) {
                    const int slot = (ai * 4 + m) * 2 + bj;
                    const u32x4 a = *(const u32x4*)(s0 + (size_t)slot * 8192 + tl * 16u);
                    f32x4 p0 = (f32x4){0.f, 0.f, 0.f, 0.f}, p1 = p0;
                    if (u.kind > 0) { p0 = *(const f32x4*)(pb + (size_t)slot * 16384 + tl * 32u); p1 = *(const f32x4*)(pb + (size_t)slot * 16384 + tl * 32u + 16); }
                    const f32x4 f0 = (f32x4){__uint_as_float(a.x << 16), __uint_as_float(a.x & 0xffff0000u), __uint_as_float(a.y << 16), __uint_as_float(a.y & 0xffff0000u)};
                    const f32x4 f1 = (f32x4){__uint_as_float(a.z << 16), __uint_as_float(a.z & 0xffff0000u), __uint_as_float(a.w << 16), __uint_as_float(a.w & 0xffff0000u)};
                    p0 = p0 + acc[ai][bj][m][0] * f0; p1 = p1 + acc[ai][bj][m][1] * f1;
                    if (u.kind < 3) { *(f32x4*)(pb + (size_t)slot * 16384 + tl * 32u) = p0; *(f32x4*)(pb + (size_t)slot * 16384 + tl * 32u + 16) = p1; }
                    else { u32x4 w; w.x = cvt_pk_bf16(p0[0], p0[1]); w.y = cvt_pk_bf16(p0[2], p0[3]); w.z = cvt_pk_bf16(p1[0], p1[1]); w.w = cvt_pk_bf16(p1[2], p1[3]);
                        *(u32x4*)(O + (size_t)(row0 + ai * 128 + m * 16) * D + col0 + bj * 128) = w; }
                    asm volatile("" ::: "memory");
                }
        return false;
    }
};
struct EpiSoftmax {
    static constexpr bool CHAIN = false;
    bf16* P; LAS f32x2* xch; float scale_log2;
    __device__ __forceinline__ bool operator()(EPI_ARGS) const {
        EPI_LANE
        LAS f32x2* X = xch + (size_t)(u.kind & 1) * 1024;
#pragma unroll
        for (int ai = 0; ai < 2; ++ai)
#pragma unroll
            for (int m = 0; m < 4; ++m) {
                float v = -3.0e38f;
#pragma unroll
                for (int bj = 0; bj < 2; ++bj)
#pragma unroll
                    for (int n = 0; n < 2; ++n) { acc[ai][bj][m][n] = acc[ai][bj][m][n] * scale_log2; const f32x4 x = acc[ai][bj][m][n]; v = fmaxf(v, fmaxf(fmaxf(x[0], x[1]), fmaxf(x[2], x[3]))); }
                v = fmaxf(v, __shfl_xor(v, 16)); v = fmaxf(v, __shfl_xor(v, 32));
                float s = 0.f;
#pragma unroll
                for (int bj = 0; bj < 2; ++bj)
#pragma unroll
                    for (int n = 0; n < 2; ++n) { f32x4 x = acc[ai][bj][m][n];
#pragma unroll
                        for (int j = 0; j < 4; ++j) { x[j] = __builtin_amdgcn_exp2f(x[j] - v); s += x[j]; }
                        acc[ai][bj][m][n] = x; }
                s += __shfl_xor(s, 16); s += __shfl_xor(s, 32);
                if (fq == 0) X[(ai * 128 + wr * 64 + m * 16 + fr) * 4 + wc] = (f32x2){v, s};
            }
        asm volatile("s_waitcnt lgkmcnt(0)" ::: "memory"); __builtin_amdgcn_s_barrier(); asm volatile("" ::: "memory");
        const int row0 = u.pm * 256 + wr * 64 + fr, col0 = u.pn * 256 + wc * 32 + 8 * fq;
#pragma unroll
        for (int ai = 0; ai < 2; ++ai)
#pragma unroll
            for (int m = 0; m < 4; ++m) {
                const int rl = ai * 128 + wr * 64 + m * 16 + fr;
                const f32x2 p0 = X[rl * 4 + 0], p1 = X[rl * 4 + 1], p2 = X[rl * 4 + 2], p3 = X[rl * 4 + 3];
                const float gm = fmaxf(fmaxf(p0.x, p1.x), fmaxf(p2.x, p3.x));
                const float tot = p0.y * __builtin_amdgcn_exp2f(p0.x - gm) + p1.y * __builtin_amdgcn_exp2f(p1.x - gm) + p2.y * __builtin_amdgcn_exp2f(p2.x - gm) + p3.y * __builtin_amdgcn_exp2f(p3.x - gm);
                const float mine = (wc == 0) ? p0.x : (wc == 1) ? p1.x : (wc == 2) ? p2.x : p3.x;
                const float f = __builtin_amdgcn_exp2f(mine - gm) / tot;
                bf16* rowp = P + (size_t)(row0 + ai * 128 + m * 16) * D + col0;
#pragma unroll
                for (int bj = 0; bj < 2; ++bj) { const f32x4 v0 = acc[ai][bj][m][0] * f, v1 = acc[ai][bj][m][1] * f;
                    u32x4 w; w.x = cvt_pk_bf16(v0[0], v0[1]); w.y = cvt_pk_bf16(v0[2], v0[3]); w.z = cvt_pk_bf16(v1[0], v1[1]); w.w = cvt_pk_bf16(v1[2], v1[3]);
                    *(u32x4*)(rowp + bj * 128) = w; }
                asm volatile("" ::: "memory");
            }
        return false;
    }
};
struct EpiGU {
    static constexpr bool CHAIN = false;
    bf16* H;
    __device__ __forceinline__ bool operator()(EPI_ARGS) const {
        EPI_LANE
        const int row0 = u.pm * 256 + wr * 64 + fr, col0 = u.pn * 128 + wc * 32 + 8 * fq;
#pragma unroll
        for (int ai = 0; ai < 2; ++ai)
#pragma unroll
            for (int m = 0; m < 4; ++m) {
                f32x4 v[2];
#pragma unroll
                for (int n = 0; n < 2; ++n) { const f32x4 g = acc[ai][0][m][n], uu = acc[ai][1][m][n];
#pragma unroll
                    for (int j = 0; j < 4; ++j) v[n][j] = g[j] * __builtin_amdgcn_rcpf(1.f + __builtin_amdgcn_exp2f(-1.44269504f * g[j])) * uu[j]; }
                u32x4 w; w.x = cvt_pk_bf16(v[0][0], v[0][1]); w.y = cvt_pk_bf16(v[0][2], v[0][3]); w.z = cvt_pk_bf16(v[1][0], v[1][1]); w.w = cvt_pk_bf16(v[1][2], v[1][3]);
                *(u32x4*)(H + (size_t)(row0 + ai * 128 + m * 16) * DFF + col0) = w; asm volatile("" ::: "memory");
            }
        return false;
    }
};
struct EpiDownMoe {
    static constexpr bool CHAIN = false;
    const int* tokmap; const float* roww; float* x;
    __device__ __forceinline__ bool operator()(EPI_ARGS) const {
        EPI_LANE
        const int row0 = u.pm * 256 + wr * 64 + fr, col0 = u.pn * 256 + wc * 32 + 8 * fq;
#pragma unroll
        for (int ai = 0; ai < 2; ++ai)
#pragma unroll
            for (int m = 0; m < 4; ++m) { const int r = row0 + ai * 128 + m * 16; const int tk = tokmap[r];
                if (tk >= 0) { const float w = roww[r]; float* xp = x + (size_t)tk * D + col0;
#pragma unroll
                    for (int bj = 0; bj < 2; ++bj) {
                        const f32x4 a0 = *(const f32x4*)(xp + bj * 128), a1 = *(const f32x4*)(xp + bj * 128 + 4);
                        *(f32x4*)(xp + bj * 128) = a0 + acc[ai][bj][m][0] * w; *(f32x4*)(xp + bj * 128 + 4) = a1 + acc[ai][bj][m][1] * w; } }
                asm volatile("" ::: "memory"); }
        return false;
    }
};

template <int MODE> struct MergeSched {
    const char* A0; const char* A1; const char* W; int pm, pn;
    __device__ __forceinline__ bool next(int i, Unit& u) const {
        if (i >= 4) return false;
        u.pm = pm; u.pn = pn; u.kind = i;
        if (MODE == 0) { u.A = A0 + (size_t)pm * 256 * 2048; u.B = W + (size_t)(i * 1024 + pn * 256) * 2048; u.nt = 16; }
        else { u.A = ((i < 2) ? A0 : A1) + (size_t)pm * 256 * 2048 + (i & 1) * 1024; u.B = W + (size_t)(i >> 1) * (2 * MiB) + (size_t)pn * 256 * 2048 + (i & 1) * 1024; u.nt = 8; }
        return true;
    }
};
struct CrossSched {
    const char* A; const char* B; int mode, G, c;
    __device__ __forceinline__ bool next(int i, Unit& u) const {
        const long L0 = (long)i * G + c; if (L0 >= 512) return false;
        int L = (int)L0; { const int q = 512 / 8, xcd = L % 8, off = L / 8; L = xcd * q + off; }
        const int rt = L & 15, head = (L >> 4) & 3, b = L >> 6;
        u.pm = b * 16 + rt; u.pn = head; u.kind = i; u.nt = 4;
        u.A = A + (size_t)u.pm * 256 * 2048 + head * 512;
        u.B = (mode == 0) ? B + (size_t)(b * 256) * 2048 + head * 512 : B + (size_t)(head * 256) * 4096 + b * 512;
        return true;
    }
};
struct MoeSched {
    const char* A; const char* B; unsigned lda; size_t wstride; unsigned ldb; int t0, nT, nN, nt, G, c; const int* gt;
    __device__ __forceinline__ bool next(int i, Unit& u) const {
        const long L = (long)i * G + c; if (L >= (long)nT * nN) return false;
        int pm, pn; pg8::tile_of((int)L, nT, nN, pm, pn); pm += t0;
        int g = 0;
#pragma unroll
        for (int k = 1; k < 16; ++k) g += (pm >= gt[k]) ? 1 : 0;
        u.pm = pm; u.pn = pn; u.kind = 0; u.nt = nt;
        u.A = A + (size_t)pm * 256 * lda; u.B = B + (size_t)(g & 7) * wstride + (size_t)pn * 256 * ldb; return true;
    }
};

#define XB_TMO      128
#define XB_XCNT(j)  (256  + 64 * (j))
#define XB_XSUB(j)  (1280 + 64 * (j))
#define XB_XGEN(j)  (2304 + 64 * (j))
#define XB_TOP      3328
#define XB_TOPGEN   3392
#define XCD_BAR_WORDS 3456
#define XB_SPIN_CAP (1u << 22)
__device__ __forceinline__ unsigned xb_ld(unsigned* p)              { return __hip_atomic_load(p, __ATOMIC_RELAXED, __HIP_MEMORY_SCOPE_AGENT); }
__device__ __forceinline__ unsigned xb_add(unsigned* p, unsigned v) { return __hip_atomic_fetch_add(p, v, __ATOMIC_RELAXED, __HIP_MEMORY_SCOPE_AGENT); }
__device__ __forceinline__ unsigned xb_xcc_id() { return (unsigned)__builtin_amdgcn_s_getreg((3 << 11) | 20) & 0xFu; }
#define XB_SPIN(cond, bar) do { unsigned _sp = 0; while (cond) { __builtin_amdgcn_s_sleep(1); \
    if ((++_sp & 255u) == 0u) { if (xb_ld(&(bar)[XB_TMO])) break; if (_sp > XB_SPIN_CAP) { atomicAdd(&(bar)[XB_TMO], 1u); break; } } } } while (0)
struct XcdBarrier { unsigned* bar; unsigned x; volatile LAS unsigned* st; };
__device__ __forceinline__ XcdBarrier xcd_barrier_post(unsigned* bar, volatile LAS unsigned* st) {
    XcdBarrier b; b.bar = bar; b.x = xb_xcc_id(); b.st = st;
    if (threadIdx.x == 0) (void)xb_add(&bar[XB_XCNT(b.x)], 1u);
    return b;
}
__device__ __forceinline__ void xcd_barrier_complete(unsigned* bar, unsigned x, unsigned& nloc, unsigned& nx) {
    const unsigned G = gridDim.x * gridDim.y * gridDim.z;
    unsigned sum, cnt, mine, sp = 0u;
    for (;;) {
        sum = 0u; cnt = 0u; mine = 0u;
#pragma unroll
        for (unsigned j = 0; j < 16; ++j) { const unsigned c = xb_ld(&bar[XB_XCNT(j)]); sum += c; cnt += (c > 0u) ? 1u : 0u; mine = (j == x) ? c : mine; }
        if (sum == G) break;
        __builtin_amdgcn_s_sleep(1);
        if ((++sp & 255u) == 0u) { if (xb_ld(&bar[XB_TMO])) break; if (sp > XB_SPIN_CAP) { atomicAdd(&bar[XB_TMO], 1u); break; } }
    }
    nloc = mine > 0u ? mine : 1u; nx = cnt > 0u ? cnt : 1u;
}
__device__ __forceinline__ void xcd_barrier(const XcdBarrier& b) {
    asm volatile("s_waitcnt vmcnt(0)" ::: "memory");
    __syncthreads();
    if (threadIdx.x == 0) {
        unsigned* bar = b.bar;
        __builtin_amdgcn_s_waitcnt(0);
        unsigned nloc = b.st[0], nx = b.st[1];
        if (nloc == 0u) { xcd_barrier_complete(bar, b.x, nloc, nx); b.st[0] = nloc; b.st[1] = nx; }
        const unsigned old = xb_add(&bar[XB_XSUB(b.x)], 1u);
        const unsigned gen = old / nloc;
        if (old + 1u == (gen + 1u) * nloc) {
            __builtin_amdgcn_fence(__ATOMIC_RELEASE, "agent");
            asm volatile("s_waitcnt vmcnt(0)" ::: "memory");
            const unsigned og = xb_add(&bar[XB_TOP], 1u);
            const unsigned tg = og / nx;
            if (og + 1u == (tg + 1u) * nx) xb_add(&bar[XB_TOPGEN], 1u);
            else XB_SPIN(xb_ld(&bar[XB_TOPGEN]) == tg, bar);
            __builtin_amdgcn_fence(__ATOMIC_ACQUIRE, "agent");
            xb_add(&bar[XB_XGEN(b.x)], 1u);
            asm volatile("s_waitcnt vmcnt(0)" ::: "memory");
        } else {
            XB_SPIN(xb_ld(&bar[XB_XGEN(b.x)]) == gen, bar);
            __builtin_amdgcn_fence(__ATOMIC_ACQUIRE, "agent");
            asm volatile("s_waitcnt vmcnt(0)" ::: "memory");
        }
    }
    __syncthreads();
}

struct Args {
    const float* x; const float* mem; const int* positions; const float* norm_mix; const float* w_in; const float* attn_sink; const float* w_branch; const float* w_out;
    const float* pool_w; const float* pool_scale; const float* norm_cross; const float* norm_mem; const float* w_xq; const float* w_xkv; const float* w_xo; const float* norm_ffn;
    const float* dense_w_gu; const float* dense_w_down; const float* router_w; const float* moe_w_gu; const float* moe_w_down; const float* norm_final;
    float* out; unsigned char* ws; int ph_lo, ph_hi;
};

__device__ __forceinline__ void transpose_item(const float* W, int ldw, int k0, int src, int nv, bf16* WT, size_t dst_pitch, int dst_row0, int dst_k0, LAS float* scr, int lane) {
#pragma unroll 8
    for (int i = 0; i < 32; ++i) { const int kk = 2 * i + (lane >> 5), n = lane & 31; scr[kk * 33 + n] = (n < nv) ? W[(size_t)(k0 + kk) * ldw + src + n] : 0.f; }
    LDS_WAIT(); asm volatile("" ::: "memory");
    const int c = lane & 7;
#pragma unroll
    for (int j = 0; j < 4; ++j) { const int n = (lane >> 3) + 8 * j; const LAS float* s = scr + (8 * c) * 33 + n;
        u32x4 o; o.x = pk2(s[0 * 33], s[1 * 33]); o.y = pk2(s[2 * 33], s[3 * 33]); o.z = pk2(s[4 * 33], s[5 * 33]); o.w = pk2(s[6 * 33], s[7 * 33]);
        *(u32x4*)(WT + (size_t)(dst_row0 + n) * dst_pitch + dst_k0 + k0 + 8 * c) = o; }
    LDS_WAIT(); asm volatile("" ::: "memory");
}
template <int MAP>
__device__ __forceinline__ void conv_seg(const float* W, int K, int ldw, int src0, bf16* WT, size_t dst_pitch, int dst_k0, int nb, int item, LAS float* scr, int lane) {
    const int kb = item / nb, vb = item % nb;
    int src, nv = 32;
    if (MAP == 0) src = src0 + 32 * vb;
    else if (MAP == 1) { const int pn = vb >> 3, bj = (vb >> 2) & 1, wc = vb & 3, g = 4 * pn + wc;
        if (g < 29) src = 64 * g + 32 * bj; else if (g < 61) src = 64 * g + 4 + 32 * bj; else if (g == 61) { src = 1856; nv = bj == 0 ? 4 : 0; } else { src = 0; nv = 0; } }
    else { const int pn = vb >> 3, bj = (vb >> 2) & 1, pb = vb & 3; src = src0 + bj * DFF + 128 * pn + 32 * pb; }
    transpose_item(W, ldw, 64 * kb, src, nv, WT, dst_pitch, 32 * vb, dst_k0, scr, lane);
}
__device__ __forceinline__ void norm_row_bf16(const float* xrow, const float* g, bf16* orow, int lane) {
    const f32x4* xr = (const f32x4*)xrow + lane; const f32x4* gr = (const f32x4*)g + lane;
    f32x4 v[4]; float s = 0.f;
#pragma unroll
    for (int j = 0; j < 4; ++j) { v[j] = xr[64 * j]; s += (v[j].x * v[j].x + v[j].y * v[j].y) + (v[j].z * v[j].z + v[j].w * v[j].w); }
    const float rstd = 1.f / sqrtf(wave_sum(s) * (1.f / D) + EPS);
    unsigned long long* o8 = (unsigned long long*)orow + lane;
#pragma unroll
    for (int j = 0; j < 4; ++j) { const f32x4 gg = gr[64 * j];
        o8[64 * j] = (unsigned long long)pk2(v[j].x * rstd * gg.x, v[j].y * rstd * gg.y) | ((unsigned long long)pk2(v[j].z * rstd * gg.z, v[j].w * rstd * gg.w) << 32); }
}

__device__ __forceinline__ void pool_phase(const bf16* proj, const float* pw, const float* pscale, bf16* br23, char* lds, int G) {
    float* Wl = (float*)lds; float* Dl = (float*)(lds + 65536);
    int tid = threadIdx.x; asm volatile("" : "+v"(tid));
    for (int un = blockIdx.x; un < 2048; un += G) {
        const int g = un & 3, tb = (un >> 2) & 63, b = un >> 8;
        const float* wsrc = pw + (size_t)g * 16384;
        for (int i = tid; i < 16384; i += 512) Wl[i] = wsrc[i];
        const int win = 2 << g;
        for (int i = tid; i < 64 * 128; i += 512) { const int tt = i >> 7, c = i & 127, t = tb * 64 + tt;
            const bf16* up = proj + ((size_t)(b * T + t)) * NPROJ + C_PU + g * 128 + c;
            const int cnt = (t + 1 < win) ? t + 1 : win; float s = 0.f;
            for (int j = 0; j < cnt; ++j) s += bf2f(*(up - (size_t)j * NPROJ));
            Dl[i] = s / (float)cnt - bf2f(*up); }
        __syncthreads();
        const int cp = tid & 127, tg = tid >> 7;
        float acc[16];
#pragma unroll
        for (int k = 0; k < 16; ++k) acc[k] = 0.f;
        for (int c = 0; c < 128; c += 4) {
            const float w0 = Wl[(c + 0) * 128 + cp], w1 = Wl[(c + 1) * 128 + cp], w2 = Wl[(c + 2) * 128 + cp], w3 = Wl[(c + 3) * 128 + cp];
#pragma unroll
            for (int k = 0; k < 16; ++k) { const f32x4 d = *(const f32x4*)(Dl + (tg * 16 + k) * 128 + c); acc[k] += d.x * w0 + d.y * w1 + d.z * w2 + d.w * w3; }
        }
        const float sc = pscale[g * 128 + cp];
#pragma unroll
        for (int k = 0; k < 16; ++k) br23[((size_t)(b * T + tb * 64 + tg * 16 + k)) * D + 512 + g * 128 + cp] = (bf16)f2bf(acc[k] * sc);
        __syncthreads();
    }
}
__device__ __forceinline__ void swa_phase(const bf16* proj, const bf16* akv, const float* sink, bf16* br01, char* lds, int G) {
    int tid = threadIdx.x; asm volatile("" : "+v"(tid)); const int lane = tid & 63, wave = tid >> 6;
    char* wl = lds + wave * WAVE_LDS;
    unsigned* qls = (unsigned*)wl; float* pl = (float*)(wl + 512);
    for (int task = blockIdx.x * 8 + wave; task < 2 * M; task += G * 8) {
        const int kvh = task & 1, m = task >> 1, b = m >> 12, t = m & 4095;
        const bf16* prow = proj + (size_t)m * NPROJ;
        { const unsigned* qs = (const unsigned*)(prow + C_AQ + kvh * 256); qls[lane] = qs[lane]; qls[lane + 64] = qs[lane + 64]; }
        LDS_WAIT();
        float l[2][4];
#pragma unroll
        for (int kk = 0; kk < 2; ++kk) {
            const int s = t - 64 * kk - lane;
            if (s >= 0) {
                const u32x4* kp = (const u32x4*)(akv + ((size_t)(b * T + s)) * 256 + kvh * 64);
                float a0 = 0.f, a1 = 0.f, a2 = 0.f, a3 = 0.f;
#pragma unroll
                for (int i = 0; i < 8; ++i) { const u32x4 kv = kp[i];
                    const u32x4 q0 = ((const u32x4*)qls)[i], q1 = ((const u32x4*)qls)[8 + i], q2 = ((const u32x4*)qls)[16 + i], q3 = ((const u32x4*)qls)[24 + i];
                    a0 = dot2(kv.x, q0.x, a0); a0 = dot2(kv.y, q0.y, a0); a0 = dot2(kv.z, q0.z, a0); a0 = dot2(kv.w, q0.w, a0);
                    a1 = dot2(kv.x, q1.x, a1); a1 = dot2(kv.y, q1.y, a1); a1 = dot2(kv.z, q1.z, a1); a1 = dot2(kv.w, q1.w, a1);
                    a2 = dot2(kv.x, q2.x, a2); a2 = dot2(kv.y, q2.y, a2); a2 = dot2(kv.z, q2.z, a2); a2 = dot2(kv.w, q2.w, a2);
                    a3 = dot2(kv.x, q3.x, a3); a3 = dot2(kv.y, q3.y, a3); a3 = dot2(kv.z, q3.z, a3); a3 = dot2(kv.w, q3.w, a3); }
                l[kk][0] = a0 * 0.125f; l[kk][1] = a1 * 0.125f; l[kk][2] = a2 * 0.125f; l[kk][3] = a3 * 0.125f;
            } else { l[kk][0] = -INFINITY; l[kk][1] = -INFINITY; l[kk][2] = -INFINITY; l[kk][3] = -INFINITY; }
        }
#pragma unroll
        for (int g = 0; g < 4; ++g) {
            const float sk = sink[kvh * 4 + g];
            const float mx = fmaxf(wave_max(fmaxf(l[0][g], l[1][g])), sk);
            const float p0 = __expf(l[0][g] - mx), p1 = __expf(l[1][g] - mx);
            const float den = wave_sum(p0 + p1) + __expf(sk - mx);
            pl[lane * 4 + g] = p0 / den; pl[(64 + lane) * 4 + g] = p1 / den;
        }
        LDS_WAIT();
        float o0 = 0.f, o1 = 0.f, o2 = 0.f, o3 = 0.f;
        const int ne = (t + 1 < 128) ? t + 1 : 128;
        const bf16* vp = akv + ((size_t)(b * T + t)) * 256 + 128 + kvh * 64 + lane;
#pragma unroll 8
        for (int e = 0; e < ne; ++e) { const float v = bf2f(*(vp - (size_t)e * 256)); const f32x4 p = *(const f32x4*)(pl + e * 4); o0 += p.x * v; o1 += p.y * v; o2 += p.z * v; o3 += p.w * v; }
        bf16* op = br01 + (size_t)m * D + kvh * 256 + lane;
        op[0] = (bf16)f2bf(o0); op[64] = (bf16)f2bf(o1); op[128] = (bf16)f2bf(o2); op[192] = (bf16)f2bf(o3);
        LDS_WAIT();
    }
}
typedef float f32x16 __attribute__((ext_vector_type(16)));
constexpr int DSA_S = 4100;
constexpr int DSA_WOFF = 8 * DSA_S * 4;
__device__ __forceinline__ float dpp_x1(float x) { return __builtin_bit_cast(float, __builtin_amdgcn_mov_dpp(__builtin_bit_cast(int, x), 0xB1, 0xf, 0xf, true)); }
__device__ __forceinline__ float dpp_x2(float x) { return __builtin_bit_cast(float, __builtin_amdgcn_mov_dpp(__builtin_bit_cast(int, x), 0x4E, 0xf, 0xf, true)); }
__device__ __forceinline__ int wave_sum_i(int v) {
    v += __builtin_amdgcn_mov_dpp(v, 0xB1, 0xf, 0xf, true);
    v += __builtin_amdgcn_mov_dpp(v, 0x4E, 0xf, 0xf, true);
    v += __builtin_amdgcn_mov_dpp(v, 0x141, 0xf, 0xf, true);
    v += __builtin_amdgcn_mov_dpp(v, 0x140, 0xf, 0xf, true);
    v += __builtin_amdgcn_update_dpp(0, v, 0x142, 0xa, 0xf, false);
    v += __builtin_amdgcn_update_dpp(0, v, 0x143, 0xc, 0xf, false);
    return __builtin_amdgcn_readlane(v, 63);
}
__device__ __forceinline__ unsigned sortable(float f) { const unsigned u = __float_as_uint(f); return (u >> 31) ? ~u : (u | 0x80000000u); }
__device__ __forceinline__ void dsa_scores(const bf16* pb, const bf16* ikb, int t0, float* scl, int wave, int lane) {
    const int n = lane & 31, kh = lane >> 5, q = n >> 2, h = n & 3;
    const bf16* qrow = pb + (size_t)(t0 + q) * NPROJ;
    bf16x8 Bq[4];
#pragma unroll
    for (int ks = 0; ks < 4; ++ks) Bq[ks] = *(const bf16x8*)(qrow + C_IQ + h * 64 + 16 * ks + 8 * kh);
    const float wq = bf2f(qrow[C_IW + h]) * 0.0625f;
    const int ntile = (t0 + 8 + 31) >> 5;
    float* dst = scl + q * DSA_S + h + 4 * kh;
#pragma unroll 1
    for (int tile0 = wave; tile0 < ntile; tile0 += 32) {
        bf16x8 a[4][4];
#pragma unroll
        for (int u = 0; u < 4; ++u) { const int tile = tile0 + 8 * u; const int row = (tile < ntile) ? tile * 32 + n : n;
            const bf16* krow = ikb + (size_t)row * 64 + 8 * kh;
#pragma unroll
            for (int ks = 0; ks < 4; ++ks) a[u][ks] = *(const bf16x8*)(krow + 16 * ks); }
#pragma unroll
        for (int u = 0; u < 4; ++u) { const int tile = tile0 + 8 * u;
            if (tile < ntile) {
                f32x16 d;
#pragma unroll
                for (int r = 0; r < 16; ++r) d[r] = 0.f;
#pragma unroll
                for (int ks = 0; ks < 4; ++ks) d = __builtin_amdgcn_mfma_f32_32x32x16_bf16(a[u][ks], Bq[ks], d, 0, 0, 0);
                float v[16];
#pragma unroll
                for (int r = 0; r < 16; ++r) { float x = fmaxf(d[r], 0.f) * wq; x += dpp_x1(x); x += dpp_x2(x); v[r] = x; }
#pragma unroll
                for (int k = 0; k < 4; ++k) { const float val = (h == 0) ? v[4 * k] : (h == 1) ? v[4 * k + 1] : (h == 2) ? v[4 * k + 2] : v[4 * k + 3]; dst[tile * 32 + 8 * k] = val + 0.f; }
            } }
    }
}
__device__ __forceinline__ void dsa_select(int t, const float* sc, char* wl, int lane) {
    unsigned short* sel = (unsigned short*)(wl + 512);
    const int nk = t + 1;
    const int K = nk < 256 ? nk : 256;
    const int nj = (nk + 63) >> 6;
    unsigned key[64];
#pragma unroll
    for (int j = 0; j < 64; ++j) { const int s = 64 * j + lane; key[j] = (j < nj && s < nk) ? sortable(sc[s]) : 0u; }
    unsigned Tk = 1u;
    if (nk > 256) {
        Tk = 0u;
        for (int bit = 31; bit >= 0; --bit) {
            const unsigned cand = Tk | (1u << bit); int c = 0;
#pragma unroll
            for (int jg = 0; jg < 4; ++jg) if (16 * jg < nj) {
#pragma unroll
                for (int j = 16 * jg; j < 16 * jg + 16; ++j) c += (key[j] >= cand) ? 1 : 0; }
            if (wave_sum_i(c) >= K) Tk = cand;
        }
    }
    int cgt_l = 0;
#pragma unroll
    for (int j = 0; j < 64; ++j) cgt_l += (key[j] > Tk) ? 1 : 0;
    const int need = K - wave_sum_i(cgt_l);
    const unsigned long long lt = (1ull << lane) - 1ull;
    int pos = 0, ties = 0;
#pragma unroll
    for (int jg = 0; jg < 4; ++jg) if (16 * jg < nj) {
#pragma unroll
        for (int j = 16 * jg; j < 16 * jg + 16; ++j) {
            const bool gt = key[j] > Tk, eq = key[j] == Tk;
            const unsigned long long meq = __ballot(eq);
            const bool take = gt || (eq && (ties + __popcll(meq & lt)) < need);
            const unsigned long long mt = __ballot(take);
            if (take) sel[pos + __popcll(mt & lt)] = (unsigned short)(64 * j + lane);
            pos += __popcll(mt); ties += __popcll(meq);
        }
    }
    LDS_WAIT();
}
__device__ __forceinline__ void dsa_attend(const bf16* proj, const bf16* kvb, bf16* br01, int b, int t, float* sc, char* wl, int lane) {
    unsigned* qls = (unsigned*)wl; const unsigned short* sel = (const unsigned short*)(wl + 512);
    const size_t m = (size_t)b * T + t;
    const bf16* prow = proj + m * NPROJ;
    const bf16* pb = proj + (size_t)b * T * NPROJ;
    const int K = (t + 1) < 256 ? (t + 1) : 256;
    float* pl = sc;
#pragma unroll 1
    for (int kh = 0; kh < 2; ++kh) {
        { const unsigned* qs = (const unsigned*)(prow + C_BQ + kh * 256); qls[lane] = qs[lane]; qls[lane + 64] = qs[lane + 64]; }
        LDS_WAIT();
        float l[4][4];
#pragma unroll
        for (int i = 0; i < 4; ++i) {
            const int e = lane + 64 * i;
            if (e < K) {
                const int s = sel[e];
                const u32x4* kp = (const u32x4*)(kvb + (size_t)s * 256 + kh * 64);
                float a0 = 0.f, a1 = 0.f, a2 = 0.f, a3 = 0.f;
#pragma unroll
                for (int q = 0; q < 8; ++q) { const u32x4 kv = kp[q];
                    const u32x4 q0 = ((const u32x4*)qls)[q], q1 = ((const u32x4*)qls)[8 + q], q2 = ((const u32x4*)qls)[16 + q], q3 = ((const u32x4*)qls)[24 + q];
                    a0 = dot2(kv.x, q0.x, a0); a0 = dot2(kv.y, q0.y, a0); a0 = dot2(kv.z, q0.z, a0); a0 = dot2(kv.w, q0.w, a0);
                    a1 = dot2(kv.x, q1.x, a1); a1 = dot2(kv.y, q1.y, a1); a1 = dot2(kv.z, q1.z, a1); a1 = dot2(kv.w, q1.w, a1);
                    a2 = dot2(kv.x, q2.x, a2); a2 = dot2(kv.y, q2.y, a2); a2 = dot2(kv.z, q2.z, a2); a2 = dot2(kv.w, q2.w, a2);
                    a3 = dot2(kv.x, q3.x, a3); a3 = dot2(kv.y, q3.y, a3); a3 = dot2(kv.z, q3.z, a3); a3 = dot2(kv.w, q3.w, a3); }
                l[i][0] = a0 * 0.125f; l[i][1] = a1 * 0.125f; l[i][2] = a2 * 0.125f; l[i][3] = a3 * 0.125f;
            } else { l[i][0] = -INFINITY; l[i][1] = -INFINITY; l[i][2] = -INFINITY; l[i][3] = -INFINITY; }
            if (i == 1) asm volatile("" ::: "memory");
        }
#pragma unroll
        for (int g = 0; g < 4; ++g) {
            const float mx = wave_max(fmaxf(fmaxf(l[0][g], l[1][g]), fmaxf(l[2][g], l[3][g])));
            float p[4]; float s = 0.f;
#pragma unroll
            for (int i = 0; i < 4; ++i) { p[i] = __expf(l[i][g] - mx); s += p[i]; }
            const float inv = 1.f / wave_sum(s);
#pragma unroll
            for (int i = 0; i < 4; ++i) pl[kh * 1024 + (lane + 64 * i) * 4 + g] = p[i] * inv;
        }
    }
    LDS_WAIT();
    {
        const int p8 = lane & 7, kvh = (lane >> 3) & 1, es = lane >> 4;
        float o[4][8];
#pragma unroll
        for (int g = 0; g < 4; ++g)
#pragma unroll
            for (int j = 0; j < 8; ++j) o[g][j] = 0.f;
        const bf16* vb = kvb + 128 + kvh * 64 + 8 * p8;
        const float* plk = pl + kvh * 1024;
        const int nit = (K + 3) >> 2;
#pragma unroll 1
        for (int it0 = 0; it0 < nit; it0 += 16) {
            u32x4 vv[16];
#pragma unroll
            for (int i = 0; i < 16; ++i) { const int e = 4 * (it0 + i) + es; const int s = (e < K) ? (int)sel[e] : 0; vv[i] = *(const u32x4*)(vb + (size_t)s * 256); }
#pragma unroll
            for (int i = 0; i < 16; ++i) {
                const int e = 4 * (it0 + i) + es;
                f32x4 p = *(const f32x4*)(plk + (e & 255) * 4); if (e >= K) p = (f32x4){0.f, 0.f, 0.f, 0.f};
                const float v0 = __uint_as_float(vv[i].x << 16), v1 = __uint_as_float(vv[i].x & 0xffff0000u), v2 = __uint_as_float(vv[i].y << 16), v3 = __uint_as_float(vv[i].y & 0xffff0000u);
                const float v4 = __uint_as_float(vv[i].z << 16), v5 = __uint_as_float(vv[i].z & 0xffff0000u), v6 = __uint_as_float(vv[i].w << 16), v7 = __uint_as_float(vv[i].w & 0xffff0000u);
#pragma unroll
                for (int g = 0; g < 4; ++g) { o[g][0] += p[g] * v0; o[g][1] += p[g] * v1; o[g][2] += p[g] * v2; o[g][3] += p[g] * v3; o[g][4] += p[g] * v4; o[g][5] += p[g] * v5; o[g][6] += p[g] * v6; o[g][7] += p[g] * v7; }
                if ((i & 1) == 1) asm volatile("" ::: "memory");
            }
        }
#pragma unroll
        for (int g = 0; g < 4; ++g)
#pragma unroll
            for (int j = 0; j < 8; ++j) { float x = o[g][j]; x += __shfl_xor(x, 16); x += __shfl_xor(x, 32); o[g][j] = x; }
        if (es == 0) {
            bf16* op = br01 + m * D + 512 + kvh * 256 + 8 * p8;
#pragma unroll
            for (int g = 0; g < 4; ++g) { u32x4 w; w.x = pk2(o[g][0], o[g][1]); w.y = pk2(o[g][2], o[g][3]); w.z = pk2(o[g][4], o[g][5]); w.w = pk2(o[g][6], o[g][7]); *(u32x4*)(op + g * 64) = w; }
        }
    }
    LDS_WAIT();
}
__device__ __forceinline__ void dsa_phase(const bf16* proj, const bf16* bkv, const bf16* ik, bf16* br01, char* lds, int G) {
    int tid = threadIdx.x; asm volatile("" : "+v"(tid)); const int lane = tid & 63, wave = tid >> 6;
    float* scl = (float*)lds;
    char* wl = lds + DSA_WOFF + wave * 1024;
    const int c = blockIdx.x, b = c & 7, j = c >> 3, R = G >> 3;
    const bf16* pb = proj + (size_t)b * T * NPROJ; const bf16* kvb = bkv + (size_t)b * T * 256; const bf16* ikb = ik + (size_t)b * T * 64;
    for (int k = 0; ; ++k) {
        const int u = (k & 1) ? (R - 1 - j) + R * k : j + R * k;
        if (u >= T / 8) break;
        const int t0 = 8 * u;
        int l1 = lane; asm volatile("" : "+v"(l1));
        for (int r_ = 0; r_ < REP(4); ++r_) dsa_scores(pb, ikb, t0, scl, wave, l1);
        __syncthreads();
        int l2 = lane; asm volatile("" : "+v"(l2));
        for (int r_ = 0; r_ < REP(5); ++r_) dsa_select(t0 + wave, scl + wave * DSA_S, wl, l2);
        int l3 = lane; asm volatile("" : "+v"(l3));
        for (int r_ = 0; r_ < REP(6); ++r_) dsa_attend(proj, kvb, br01, b, t0 + wave, scl + wave * DSA_S, wl, l3);
        __syncthreads();
    }
}
__device__ __forceinline__ void ret_u_phase(const bf16* proj, float* U, char* lds, int G) {
    float* Kl = (float*)lds;
    int tid = threadIdx.x; asm volatile("" : "+v"(tid));
    for (int un = blockIdx.x; un < 1024; un += G) {
        const int c = un & 31, bh = un >> 5, h = bh & 3, b = bh >> 2;
        const float lg2 = log2f(1.f - exp2f(-5.f - (float)h));
        const size_t m0 = (size_t)b * T + c * 128;
        for (int i = tid; i < 128 * 64; i += 512) { const int mm = i >> 6, d = i & 63; Kl[i] = bf2f(proj[(m0 + mm) * NPROJ + C_RK + 64 * h + d]) * 0.125f * exp2f(lg2 * (float)(127 - mm)); }
        __syncthreads();
        const int dv = tid & 127, dg = tid >> 7;
        float acc[16];
#pragma unroll
        for (int k = 0; k < 16; ++k) acc[k] = 0.f;
        for (int mm = 0; mm < 128; ++mm) { const float v = bf2f(proj[(m0 + mm) * NPROJ + C_RV + 128 * h + dv]);
#pragma unroll
            for (int k4 = 0; k4 < 4; ++k4) { const f32x4 kk = *(const f32x4*)(Kl + mm * 64 + dg * 16 + 4 * k4); acc[4 * k4] += kk.x * v; acc[4 * k4 + 1] += kk.y * v; acc[4 * k4 + 2] += kk.z * v; acc[4 * k4 + 3] += kk.w * v; } }
        float* up = U + (size_t)un * 8192;
#pragma unroll
        for (int k = 0; k < 16; ++k) up[(dg * 16 + k) * 128 + dv] = acc[k];
        __syncthreads();
    }
}
__device__ __forceinline__ void ret_out_phase(const bf16* proj, const float* U, bf16* br23, char* lds, int G) {
    float* Ql = (float*)lds; float* Sl = (float*)(lds + 32768); float* Al = (float*)(lds + 65536);
    int tid = threadIdx.x; asm volatile("" : "+v"(tid)); const int lane = tid & 63, wave = tid >> 6;
    for (int un = blockIdx.x; un < 1024; un += G) {
        const int c = un & 31, bh = un >> 5, h = bh & 3, b = bh >> 2;
        const float lg2 = log2f(1.f - exp2f(-5.f - (float)h));
        const size_t m0 = (size_t)b * T + c * 128;
        for (int i = tid; i < 128 * 64; i += 512) { const int n = i >> 6, d = i & 63; Ql[i] = bf2f(proj[(m0 + n) * NPROJ + C_RQ + 64 * h + d]); }
        {
            float s[16];
#pragma unroll
            for (int k = 0; k < 16; ++k) s[k] = 0.f;
            const float cd = exp2f(lg2 * 128.f);
#pragma unroll 1
            for (int j = 0; j < c; ++j) { const float* up = U + (size_t)(bh * 32 + j) * 8192;
#pragma unroll
                for (int k = 0; k < 16; ++k) s[k] = s[k] * cd + up[tid + 512 * k]; }
#pragma unroll
            for (int k = 0; k < 16; ++k) Sl[tid + 512 * k] = s[k];
        }
        __syncthreads();
#pragma unroll 1
        for (int k = 0; k < 32; ++k) { const int idx = tid + 512 * k, n = idx >> 7, mm = idx & 127; float a = 0.f;
            if (mm <= n) { const u32x4* kp = (const u32x4*)(proj + (m0 + mm) * NPROJ + C_RK + 64 * h);
#pragma unroll
                for (int q = 0; q < 8; ++q) { const u32x4 kv = kp[q]; const float* qq = Ql + n * 64 + 8 * q;
                    a += qq[0] * __uint_as_float(kv.x << 16) + qq[1] * __uint_as_float(kv.x & 0xffff0000u) + qq[2] * __uint_as_float(kv.y << 16) + qq[3] * __uint_as_float(kv.y & 0xffff0000u)
                       + qq[4] * __uint_as_float(kv.z << 16) + qq[5] * __uint_as_float(kv.z & 0xffff0000u) + qq[6] * __uint_as_float(kv.w << 16) + qq[7] * __uint_as_float(kv.w & 0xffff0000u); }
                a *= 0.125f * exp2f(lg2 * (float)(n - mm)); }
            Al[idx] = a; }
        __syncthreads();
        float a0[16], a1[16];
#pragma unroll
        for (int k = 0; k < 16; ++k) { a0[k] = 0.f; a1[k] = 0.f; }
#pragma unroll 1
        for (int d = 0; d < 64; d += 4) {
            const float s00 = Sl[(d + 0) * 128 + lane], s01 = Sl[(d + 0) * 128 + 64 + lane], s10 = Sl[(d + 1) * 128 + lane], s11 = Sl[(d + 1) * 128 + 64 + lane];
            const float s20 = Sl[(d + 2) * 128 + lane], s21 = Sl[(d + 2) * 128 + 64 + lane], s30 = Sl[(d + 3) * 128 + lane], s31 = Sl[(d + 3) * 128 + 64 + lane];
#pragma unroll
            for (int k = 0; k < 16; ++k) { const f32x4 q = *(const f32x4*)(Ql + (wave * 16 + k) * 64 + d);
                a0[k] += q.x * s00 + q.y * s10 + q.z * s20 + q.w * s30; a1[k] += q.x * s01 + q.y * s11 + q.z * s21 + q.w * s31;
                if ((k & 3) == 3) asm volatile("" ::: "memory"); }
        }
#pragma unroll
        for (int k = 0; k < 16; ++k) { const float qd = exp2f(lg2 * (float)(wave * 16 + k + 1)); a0[k] *= qd; a1[k] *= qd; }
#pragma unroll 1
        for (int mm = 0; mm < 128; mm += 4) {
            const bf16* vp = proj + (m0 + mm) * NPROJ + C_RV + 128 * h + lane;
            const float v00 = bf2f(vp[0]), v01 = bf2f(vp[64]), v10 = bf2f(vp[NPROJ]), v11 = bf2f(vp[NPROJ + 64]);
            const float v20 = bf2f(vp[2 * NPROJ]), v21 = bf2f(vp[2 * NPROJ + 64]), v30 = bf2f(vp[3 * NPROJ]), v31 = bf2f(vp[3 * NPROJ + 64]);
#pragma unroll
            for (int k = 0; k < 16; ++k) { const f32x4 a = *(const f32x4*)(Al + (wave * 16 + k) * 128 + mm);
                a0[k] += a.x * v00 + a.y * v10 + a.z * v20 + a.w * v30; a1[k] += a.x * v01 + a.y * v11 + a.z * v21 + a.w * v31;
                if ((k & 3) == 3) asm volatile("" ::: "memory"); }
        }
#pragma unroll
        for (int k = 0; k < 16; ++k) { const int n = wave * 16 + k;
            const float rs = 1.f / sqrtf(wave_sum(a0[k] * a0[k] + a1[k] * a1[k]) * (1.f / 128.f) + EPS);
            const bf16* gp = proj + (m0 + n) * NPROJ + C_RG + 128 * h + lane;
            const float g0 = bf2f(gp[0]), g1 = bf2f(gp[64]);
            bf16* op = br23 + (m0 + n) * D + h * 128 + lane;
            op[0] = (bf16)f2bf(g0 / (1.f + __expf(-g0)) * a0[k] * rs); op[64] = (bf16)f2bf(g1 / (1.f + __expf(-g1)) * a1[k] * rs); }
        __syncthreads();
    }
}

typedef const __attribute__((address_space(4))) Args* KArgs;
__device__ __forceinline__ KArgs kargs() { KArgs p = (KArgs)__builtin_amdgcn_kernarg_segment_ptr(); asm volatile("" : "+s"(p)); return p; }

__device__ __forceinline__ void ph0(LAS unsigned char* L, int layer, int slot) {
    int tid = threadIdx.x; asm volatile("" : "+v"(tid)); const int lane = tid & 63, wave = __builtin_amdgcn_readfirstlane(tid >> 6);
    int G = gridDim.x, bx = blockIdx.x; asm volatile("" : "+s"(G), "+s"(bx)); const int gw = bx * 8 + wave, NGW = G * 8;
    unsigned char* lds = (unsigned char*)L; LAS int* lcnt = (LAS int*)(L + 0); LAS int* gt = (LAS int*)(L + LDS_MISC + 512);
    (void)lane; (void)gw; (void)NGW; (void)lds; (void)lcnt; (void)gt; (void)layer; (void)slot; (void)tid; (void)bx; (void)G;
    {
        KArgs A = kargs(); unsigned char* ws = A->ws;
        LAS float* scr = (LAS float*)(L + wave * 16384);
        constexpr int I_IN = 16 * 128, I_G = 16 * 128, I_B = 8 * 32, I_SQ = 16 * 32, I_L = I_IN + I_G + 4 * I_B + 5 * I_SQ;
        constexpr int I_GU = 16 * 224, I_DN = 56 * 32, NITEMS = 2 * I_L + I_GU + I_DN;
        for (int it = gw; it < NITEMS; it += NGW) {
            int r = it;
            if (r < 2 * I_L) {
                const int l = r / I_L; r -= l * I_L;
                unsigned char* wb = ws + WS_W + (size_t)l * W_LAYER;
                const float* win = A->w_in + (size_t)l * D * D_IN;
                if (r < I_IN) { conv_seg<1>(win, D, D_IN, 0, (bf16*)(wb + W_IN), D, 0, 128, r, scr, lane); continue; } r -= I_IN;
                if (r < I_G) { conv_seg<0>(win, D, D_IN, 3908, (bf16*)(wb + W_G), D, 0, 128, r, scr, lane); continue; } r -= I_G;
                if (r < 4 * I_B) { const int i = r / I_B; r -= i * I_B;
                    conv_seg<0>(A->w_branch + ((size_t)l * 4 + i) * 512 * D, 512, D, 0, (bf16*)(wb + W_B) + (size_t)(i >> 1) * D * D, D, (i & 1) * 512, 32, r, scr, lane); continue; } r -= 4 * I_B;
                if (r < I_SQ) { conv_seg<0>(A->w_out + (size_t)l * D * D, D, D, 0, (bf16*)(wb + W_OUT), D, 0, 32, r, scr, lane); continue; } r -= I_SQ;
                if (r < I_SQ) { conv_seg<0>(A->w_xq + (size_t)l * D * D, D, D, 0, (bf16*)(wb + W_XQ), D, 0, 32, r, scr, lane); continue; } r -= I_SQ;
                if (r < I_SQ) { conv_seg<0>(A->w_xkv + (size_t)l * D * 2 * D, D, 2 * D, 0, (bf16*)(wb + W_XK), D, 0, 32, r, scr, lane); continue; } r -= I_SQ;
                if (r < I_SQ) { conv_seg<0>(A->w_xkv + (size_t)l * D * 2 * D, D, 2 * D, D, (bf16*)(wb + W_XV), D, 0, 32, r, scr, lane); continue; } r -= I_SQ;
                conv_seg<0>(A->w_xo + (size_t)l * D * D, D, D, 0, (bf16*)(wb + W_XO), D, 0, 32, r, scr, lane); continue;
            }
            r -= 2 * I_L;
            if (r < I_GU) { conv_seg<2>(A->dense_w_gu, D, 2 * DFF, 0, (bf16*)(ws + WS_WGU), D, 0, 224, r, scr, lane); continue; } r -= I_GU;
            conv_seg<0>(A->dense_w_down, DFF, D, 0, (bf16*)(ws + WS_WDN), DFF, 0, 32, r, scr, lane);
        }
        {
            float* cosT = (float*)(ws + WS_ROPE); float* sinT = cosT + (size_t)M * 32; const int* pos = A->positions;
            for (int i = bx * 512 + tid; i < M * 32; i += G * 512) { const int m = i >> 5, j = i & 31;
                const float ang = (float)pos[m] * INV_FREQ[j];
                const double rev = (double)ang * 0.15915494309189533577; const float fr_ = (float)(rev - rint(rev));
                cosT[i] = __builtin_amdgcn_cosf(fr_); sinT[i] = __builtin_amdgcn_sinf(fr_); }
        }
        {
            const float* mem = A->mem; const float* nm = A->norm_mem; bf16* MN = (bf16*)(ws + WS_MN);
            for (int r = gw; r < 2 * MROWS; r += NGW) { const int l = r / MROWS, mr = r % MROWS; norm_row_bf16(mem + (size_t)mr * D, nm + (size_t)l * D, MN + (size_t)r * D, lane); }
            const float* x = A->x; const float* g = A->norm_mix; bf16* HB = (bf16*)(ws + WS_HB);
            for (int m = gw; m < M; m += NGW) norm_row_bf16(x + (size_t)m * D, g, HB + (size_t)m * D, lane);
        }
    }
}
__device__ __forceinline__ void ph1(LAS unsigned char* L, int layer, int slot) {
    int tid = threadIdx.x; asm volatile("" : "+v"(tid)); const int lane = tid & 63, wave = __builtin_amdgcn_readfirstlane(tid >> 6);
    int G = gridDim.x, bx = blockIdx.x; asm volatile("" : "+s"(G), "+s"(bx)); const int gw = bx * 8 + wave, NGW = G * 8;
    unsigned char* lds = (unsigned char*)L; LAS int* lcnt = (LAS int*)(L + 0); LAS int* gt = (LAS int*)(L + LDS_MISC + 512);
    (void)lane; (void)gw; (void)NGW; (void)lds; (void)lcnt; (void)gt; (void)layer; (void)slot; (void)tid; (void)bx; (void)G;
    {
            unsigned char* ws = kargs()->ws; unsigned char* wb = ws + WS_W + (size_t)layer * W_LAYER;
            { pg8::GridSched S{(const char*)(ws + WS_HB), (const char*)(wb + W_IN), 2048u, 2048u, 128, 16, 16, G, bx};
              EpiProj E{(bf16*)(ws + WS_PROJ), (const float*)(ws + WS_ROPE), (const float*)(ws + WS_ROPE) + (size_t)M * 32, (bf16*)(ws + WS_AKV), (bf16*)(ws + WS_BKV), (bf16*)(ws + WS_IK)};
              pg8::gemm_stream(L, S, E, 2048u, 2048u); }
            if (layer == 0) {
                for (int l = 0; l < 2; ++l) {
                    unsigned char* wl = ws + WS_W + (size_t)l * W_LAYER;
                    { pg8::GridSched S{(const char*)(ws + WS_MN) + (size_t)l * MROWS * D * 2, (const char*)(wl + W_XK), 2048u, 2048u, 8, 4, 16, G, bx};
                      EpiPlain E{(bf16*)(ws + WS_KX) + (size_t)l * MROWS * D, D, 1.f};
                      pg8::gemm_stream(L, S, E, 2048u, 2048u); }
                    { pg8::GridSched S{(const char*)(wl + W_XV), (const char*)(ws + WS_MN) + (size_t)l * MROWS * D * 2, 2048u, 2048u, 4, 8, 16, G, bx};
                      EpiPlain E{(bf16*)(ws + WS_VT) + (size_t)l * D * MROWS, MROWS, 1.f};
                      pg8::gemm_stream(L, S, E, 2048u, 2048u); }
                }
            }
        }
}
__device__ __forceinline__ void ph2(LAS unsigned char* L, int layer, int slot) {
    int tid = threadIdx.x; asm volatile("" : "+v"(tid)); const int lane = tid & 63, wave = __builtin_amdgcn_readfirstlane(tid >> 6);
    int G = gridDim.x, bx = blockIdx.x; asm volatile("" : "+s"(G), "+s"(bx)); const int gw = bx * 8 + wave, NGW = G * 8;
    unsigned char* lds = (unsigned char*)L; LAS int* lcnt = (LAS int*)(L + 0); LAS int* gt = (LAS int*)(L + LDS_MISC + 512);
    (void)lane; (void)gw; (void)NGW; (void)lds; (void)lcnt; (void)gt; (void)layer; (void)slot; (void)tid; (void)bx; (void)G;
    {
            KArgs A = kargs(); unsigned char* ws = A->ws;
            const bf16* PROJ = (const bf16*)(ws + WS_PROJ);
            for (int r_ = 0; r_ < REP(0); ++r_) ret_u_phase(PROJ, (float*)(ws + WS_U), (char*)lds, G);
            for (int r_ = 0; r_ < REP(1); ++r_) pool_phase(PROJ, A->pool_w + (size_t)layer * 4 * 16384, A->pool_scale + (size_t)layer * 512, (bf16*)(ws + WS_BR23), (char*)lds, G);
            for (int r_ = 0; r_ < REP(2); ++r_) swa_phase(PROJ, (const bf16*)(ws + WS_AKV), A->attn_sink + layer * 8, (bf16*)(ws + WS_BR01), (char*)lds, G);
            for (int r_ = 0; r_ < REP(3); ++r_) dsa_phase(PROJ, (const bf16*)(ws + WS_BKV), (const bf16*)(ws + WS_IK), (bf16*)(ws + WS_BR01), (char*)lds, G);
        }
}
__device__ __forceinline__ void ph3(LAS unsigned char* L, int layer, int slot) {
    int tid = threadIdx.x; asm volatile("" : "+v"(tid)); const int lane = tid & 63, wave = __builtin_amdgcn_readfirstlane(tid >> 6);
    int G = gridDim.x, bx = blockIdx.x; asm volatile("" : "+s"(G), "+s"(bx)); const int gw = bx * 8 + wave, NGW = G * 8;
    unsigned char* lds = (unsigned char*)L; LAS int* lcnt = (LAS int*)(L + 0); LAS int* gt = (LAS int*)(L + LDS_MISC + 512);
    (void)lane; (void)gw; (void)NGW; (void)lds; (void)lcnt; (void)gt; (void)layer; (void)slot; (void)tid; (void)bx; (void)G;
    { unsigned char* ws = kargs()->ws; ret_out_phase((const bf16*)(ws + WS_PROJ), (const float*)(ws + WS_U), (bf16*)(ws + WS_BR23), (char*)lds, G); }
}
__device__ __forceinline__ void ph4(LAS unsigned char* L, int layer, int slot) {
    int tid = threadIdx.x; asm volatile("" : "+v"(tid)); const int lane = tid & 63, wave = __builtin_amdgcn_readfirstlane(tid >> 6);
    int G = gridDim.x, bx = blockIdx.x; asm volatile("" : "+s"(G), "+s"(bx)); const int gw = bx * 8 + wave, NGW = G * 8;
    unsigned char* lds = (unsigned char*)L; LAS int* lcnt = (LAS int*)(L + 0); LAS int* gt = (LAS int*)(L + LDS_MISC + 512);
    (void)lane; (void)gw; (void)NGW; (void)lds; (void)lcnt; (void)gt; (void)layer; (void)slot; (void)tid; (void)bx; (void)G;
    {
            unsigned char* ws = kargs()->ws; unsigned char* wb = ws + WS_W + (size_t)layer * W_LAYER;
            unsigned* scr = (unsigned*)(ws + WS_MSCR + (size_t)bx * 786432);
            for (int ti = 0; ti * G + bx < 512; ++ti) {
                int pm, pn; pg8::tile_of(ti * G + bx, 128, 4, pm, pn);
                { MergeSched<0> S{(const char*)(ws + WS_HB), nullptr, (const char*)(wb + W_G), pm, pn};
                  EpiGate E{scr};
                  pg8::gemm_stream(L, S, E, 2048u, 2048u); }
                { MergeSched<1> S{(const char*)(ws + WS_BR01), (const char*)(ws + WS_BR23), (const char*)(wb + W_B), pm, pn};
                  EpiUp E{scr, (bf16*)(ws + WS_MERGED)};
                  pg8::gemm_stream(L, S, E, 2048u, 2048u); }
            }
        }
}
__device__ __forceinline__ void ph5(LAS unsigned char* L, int layer, int slot) {
    int tid = threadIdx.x; asm volatile("" : "+v"(tid)); const int lane = tid & 63, wave = __builtin_amdgcn_readfirstlane(tid >> 6);
    int G = gridDim.x, bx = blockIdx.x; asm volatile("" : "+s"(G), "+s"(bx)); const int gw = bx * 8 + wave, NGW = G * 8;
    unsigned char* lds = (unsigned char*)L; LAS int* lcnt = (LAS int*)(L + 0); LAS int* gt = (LAS int*)(L + LDS_MISC + 512);
    (void)lane; (void)gw; (void)NGW; (void)lds; (void)lcnt; (void)gt; (void)layer; (void)slot; (void)tid; (void)bx; (void)G;
    {
            KArgs A = kargs(); unsigned char* ws = A->ws; unsigned char* wb = ws + WS_W + (size_t)layer * W_LAYER;
            pg8::GridSched S{(const char*)(ws + WS_MERGED), (const char*)(wb + W_OUT), 2048u, 2048u, 128, 4, 16, G, bx};
            EpiRes E{(layer == 0) ? A->x : (const float*)A->out, A->out};
            pg8::gemm_stream(L, S, E, 2048u, 2048u);
        }
}
__device__ __forceinline__ void ph6(LAS unsigned char* L, int layer, int slot) {
    int tid = threadIdx.x; asm volatile("" : "+v"(tid)); const int lane = tid & 63, wave = __builtin_amdgcn_readfirstlane(tid >> 6);
    int G = gridDim.x, bx = blockIdx.x; asm volatile("" : "+s"(G), "+s"(bx)); const int gw = bx * 8 + wave, NGW = G * 8;
    unsigned char* lds = (unsigned char*)L; LAS int* lcnt = (LAS int*)(L + 0); LAS int* gt = (LAS int*)(L + LDS_MISC + 512);
    (void)lane; (void)gw; (void)NGW; (void)lds; (void)lcnt; (void)gt; (void)layer; (void)slot; (void)tid; (void)bx; (void)G;
    { KArgs A = kargs(); const float* x = A->out; const float* g = A->norm_cross + (size_t)layer * D; bf16* HB = (bf16*)(A->ws + WS_HB);
            for (int m = gw; m < M; m += NGW) norm_row_bf16(x + (size_t)m * D, g, HB + (size_t)m * D, lane); }
}
__device__ __forceinline__ void ph7(LAS unsigned char* L, int layer, int slot) {
    int tid = threadIdx.x; asm volatile("" : "+v"(tid)); const int lane = tid & 63, wave = __builtin_amdgcn_readfirstlane(tid >> 6);
    int G = gridDim.x, bx = blockIdx.x; asm volatile("" : "+s"(G), "+s"(bx)); const int gw = bx * 8 + wave, NGW = G * 8;
    unsigned char* lds = (unsigned char*)L; LAS int* lcnt = (LAS int*)(L + 0); LAS int* gt = (LAS int*)(L + LDS_MISC + 512);
    (void)lane; (void)gw; (void)NGW; (void)lds; (void)lcnt; (void)gt; (void)layer; (void)slot; (void)tid; (void)bx; (void)G;
    {
            unsigned char* ws = kargs()->ws; unsigned char* wb = ws + WS_W + (size_t)layer * W_LAYER;
            pg8::GridSched S{(const char*)(ws + WS_HB), (const char*)(wb + W_XQ), 2048u, 2048u, 128, 4, 16, G, bx};
            EpiPlain E{(bf16*)(ws + WS_XQ), D, 1.f};
            pg8::gemm_stream(L, S, E, 2048u, 2048u);
        }
}
__device__ __forceinline__ void ph8(LAS unsigned char* L, int layer, int slot) {
    int tid = threadIdx.x; asm volatile("" : "+v"(tid)); const int lane = tid & 63, wave = __builtin_amdgcn_readfirstlane(tid >> 6);
    int G = gridDim.x, bx = blockIdx.x; asm volatile("" : "+s"(G), "+s"(bx)); const int gw = bx * 8 + wave, NGW = G * 8;
    unsigned char* lds = (unsigned char*)L; LAS int* lcnt = (LAS int*)(L + 0); LAS int* gt = (LAS int*)(L + LDS_MISC + 512);
    (void)lane; (void)gw; (void)NGW; (void)lds; (void)lcnt; (void)gt; (void)layer; (void)slot; (void)tid; (void)bx; (void)G;
    {
            unsigned char* ws = kargs()->ws;
            CrossSched S{(const char*)(ws + WS_XQ), (const char*)(ws + WS_KX) + (size_t)layer * MROWS * D * 2, 0, G, bx};
            EpiSoftmax E{(bf16*)(ws + WS_XP), (LAS f32x2*)(L + LDS_XCH), 0.0625f * 1.44269504f};
            pg8::gemm_stream(L, S, E, 2048u, 2048u);
        }
}
__device__ __forceinline__ void ph9(LAS unsigned char* L, int layer, int slot) {
    int tid = threadIdx.x; asm volatile("" : "+v"(tid)); const int lane = tid & 63, wave = __builtin_amdgcn_readfirstlane(tid >> 6);
    int G = gridDim.x, bx = blockIdx.x; asm volatile("" : "+s"(G), "+s"(bx)); const int gw = bx * 8 + wave, NGW = G * 8;
    unsigned char* lds = (unsigned char*)L; LAS int* lcnt = (LAS int*)(L + 0); LAS int* gt = (LAS int*)(L + LDS_MISC + 512);
    (void)lane; (void)gw; (void)NGW; (void)lds; (void)lcnt; (void)gt; (void)layer; (void)slot; (void)tid; (void)bx; (void)G;
    {
            unsigned char* ws = kargs()->ws;
            CrossSched S{(const char*)(ws + WS_XP), (const char*)(ws + WS_VT) + (size_t)layer * D * MROWS * 2, 1, G, bx};
            EpiPlain E{(bf16*)(ws + WS_XO), D, 1.f};
            pg8::gemm_stream(L, S, E, 2048u, 4096u);
        }
}
__device__ __forceinline__ void ph10(LAS unsigned char* L, int layer, int slot) {
    int tid = threadIdx.x; asm volatile("" : "+v"(tid)); const int lane = tid & 63, wave = __builtin_amdgcn_readfirstlane(tid >> 6);
    int G = gridDim.x, bx = blockIdx.x; asm volatile("" : "+s"(G), "+s"(bx)); const int gw = bx * 8 + wave, NGW = G * 8;
    unsigned char* lds = (unsigned char*)L; LAS int* lcnt = (LAS int*)(L + 0); LAS int* gt = (LAS int*)(L + LDS_MISC + 512);
    (void)lane; (void)gw; (void)NGW; (void)lds; (void)lcnt; (void)gt; (void)layer; (void)slot; (void)tid; (void)bx; (void)G;
    {
            KArgs A = kargs(); unsigned char* ws = A->ws; unsigned char* wb = ws + WS_W + (size_t)layer * W_LAYER;
            pg8::GridSched S{(const char*)(ws + WS_XO), (const char*)(wb + W_XO), 2048u, 2048u, 128, 4, 16, G, bx};
            EpiRes E{(const float*)A->out, A->out};
            pg8::gemm_stream(L, S, E, 2048u, 2048u);
        }
}
__device__ __forceinline__ void ph11(LAS unsigned char* L, int layer, int slot) {
    int tid = threadIdx.x; asm volatile("" : "+v"(tid)); const int lane = tid & 63, wave = __builtin_amdgcn_readfirstlane(tid >> 6);
    int G = gridDim.x, bx = blockIdx.x; asm volatile("" : "+s"(G), "+s"(bx)); const int gw = bx * 8 + wave, NGW = G * 8;
    unsigned char* lds = (unsigned char*)L; LAS int* lcnt = (LAS int*)(L + 0); LAS int* gt = (LAS int*)(L + LDS_MISC + 512);
    (void)lane; (void)gw; (void)NGW; (void)lds; (void)lcnt; (void)gt; (void)layer; (void)slot; (void)tid; (void)bx; (void)G;
    { KArgs A = kargs(); const float* x = A->out; const float* g = A->norm_ffn; bf16* HB = (bf16*)(A->ws + WS_HB);
                for (int m = gw; m < M; m += NGW) norm_row_bf16(x + (size_t)m * D, g, HB + (size_t)m * D, lane); }
}
__device__ __forceinline__ void ph12(LAS unsigned char* L, int layer, int slot) {
    int tid = threadIdx.x; asm volatile("" : "+v"(tid)); const int lane = tid & 63, wave = __builtin_amdgcn_readfirstlane(tid >> 6);
    int G = gridDim.x, bx = blockIdx.x; asm volatile("" : "+s"(G), "+s"(bx)); const int gw = bx * 8 + wave, NGW = G * 8;
    unsigned char* lds = (unsigned char*)L; LAS int* lcnt = (LAS int*)(L + 0); LAS int* gt = (LAS int*)(L + LDS_MISC + 512);
    (void)lane; (void)gw; (void)NGW; (void)lds; (void)lcnt; (void)gt; (void)layer; (void)slot; (void)tid; (void)bx; (void)G;
    {
                unsigned char* ws = kargs()->ws;
                pg8::GridSched S{(const char*)(ws + WS_HB), (const char*)(ws + WS_WGU), 2048u, 2048u, 128, 28, 16, G, bx};
                EpiGU E{(bf16*)(ws + WS_HID)};
                pg8::gemm_stream(L, S, E, 2048u, 2048u);
            }
}
__device__ __forceinline__ void ph13(LAS unsigned char* L, int layer, int slot) {
    int tid = threadIdx.x; asm volatile("" : "+v"(tid)); const int lane = tid & 63, wave = __builtin_amdgcn_readfirstlane(tid >> 6);
    int G = gridDim.x, bx = blockIdx.x; asm volatile("" : "+s"(G), "+s"(bx)); const int gw = bx * 8 + wave, NGW = G * 8;
    unsigned char* lds = (unsigned char*)L; LAS int* lcnt = (LAS int*)(L + 0); LAS int* gt = (LAS int*)(L + LDS_MISC + 512);
    (void)lane; (void)gw; (void)NGW; (void)lds; (void)lcnt; (void)gt; (void)layer; (void)slot; (void)tid; (void)bx; (void)G;
    {
                KArgs A = kargs(); unsigned char* ws = A->ws;
                pg8::GridSched S{(const char*)(ws + WS_HID), (const char*)(ws + WS_WDN), 7168u, 7168u, 128, 4, 56, G, bx};
                EpiRes E{(const float*)A->out, A->out};
                pg8::gemm_stream(L, S, E, 7168u, 7168u);
            }
}
__device__ __forceinline__ void ph14(LAS unsigned char* L, int layer, int slot) {
    int tid = threadIdx.x; asm volatile("" : "+v"(tid)); const int lane = tid & 63, wave = __builtin_amdgcn_readfirstlane(tid >> 6);
    int G = gridDim.x, bx = blockIdx.x; asm volatile("" : "+s"(G), "+s"(bx)); const int gw = bx * 8 + wave, NGW = G * 8;
    unsigned char* lds = (unsigned char*)L; LAS int* lcnt = (LAS int*)(L + 0); LAS int* gt = (LAS int*)(L + LDS_MISC + 512);
    (void)lane; (void)gw; (void)NGW; (void)lds; (void)lcnt; (void)gt; (void)layer; (void)slot; (void)tid; (void)bx; (void)G;
    { KArgs A = kargs(); const float* x = A->out; const float* g = A->norm_mix + D; bf16* HB = (bf16*)(A->ws + WS_HB);
                for (int m = gw; m < M; m += NGW) norm_row_bf16(x + (size_t)m * D, g, HB + (size_t)m * D, lane); }
}
__device__ __forceinline__ void ph15(LAS unsigned char* L, int layer, int slot) {
    int tid = threadIdx.x; asm volatile("" : "+v"(tid)); const int lane = tid & 63, wave = __builtin_amdgcn_readfirstlane(tid >> 6);
    int G = gridDim.x, bx = blockIdx.x; asm volatile("" : "+s"(G), "+s"(bx)); const int gw = bx * 8 + wave, NGW = G * 8;
    unsigned char* lds = (unsigned char*)L; LAS int* lcnt = (LAS int*)(L + 0); LAS int* gt = (LAS int*)(L + LDS_MISC + 512);
    (void)lane; (void)gw; (void)NGW; (void)lds; (void)lcnt; (void)gt; (void)layer; (void)slot; (void)tid; (void)bx; (void)G;
    {
                KArgs A = kargs(); unsigned char* ws = A->ws; unsigned* ctl = (unsigned*)(ws + WS_CTL);
                int* route = (int*)(ws + WS_ROUTE); bf16* HB = (bf16*)(ws + WS_HB);
                if (tid < 16) lcnt[tid] = 0;
                __syncthreads();
                const float* gn = A->norm_ffn + D; const float* xo = A->out; const float* rwt = A->router_w;
                for (int m = gw; m < M; m += NGW) {
                    const f32x4* xr = (const f32x4*)(xo + (size_t)m * D) + lane; const f32x4* gr = (const f32x4*)gn + lane;
                    f32x4 v[4]; float s = 0.f;
#pragma unroll
                    for (int j = 0; j < 4; ++j) { v[j] = xr[64 * j]; s += (v[j].x * v[j].x + v[j].y * v[j].y) + (v[j].z * v[j].z + v[j].w * v[j].w); }
                    const float rstd = 1.f / sqrtf(wave_sum(s) * (1.f / D) + EPS);
                    float lg[8];
#pragma unroll
                    for (int e = 0; e < 8; ++e) lg[e] = 0.f;
                    unsigned long long* o8 = (unsigned long long*)(HB + (size_t)m * D) + lane;
#pragma unroll
                    for (int j = 0; j < 4; ++j) { const f32x4 gg = gr[64 * j]; const f32x4 hv = v[j] * rstd * gg;
                        o8[64 * j] = (unsigned long long)pk2(hv.x, hv.y) | ((unsigned long long)pk2(hv.z, hv.w) << 32);
                        const float* rw = rwt + (size_t)(256 * j + 4 * lane) * 8;
#pragma unroll
                        for (int q = 0; q < 4; ++q) { const f32x4 r0 = *(const f32x4*)(rw + 8 * q), r1 = *(const f32x4*)(rw + 8 * q + 4); const float hq = hv[q];
                            lg[0] += hq * r0.x; lg[1] += hq * r0.y; lg[2] += hq * r0.z; lg[3] += hq * r0.w; lg[4] += hq * r1.x; lg[5] += hq * r1.y; lg[6] += hq * r1.z; lg[7] += hq * r1.w; } }
#pragma unroll
                    for (int e = 0; e < 8; ++e) lg[e] = wave_sum(lg[e]);
                    int e0 = 0; float v0 = lg[0];
#pragma unroll
                    for (int e = 1; e < 8; ++e) if (lg[e] > v0) { v0 = lg[e]; e0 = e; }
                    int e1 = -1; float v1 = -INFINITY;
#pragma unroll
                    for (int e = 0; e < 8; ++e) if (e != e0 && lg[e] > v1) { v1 = lg[e]; e1 = e; }
                    const float ww1 = 1.f / (1.f + __expf(v0 - v1)), ww0 = 1.f - ww1;
                    if (lane == 0) { route[4 * m] = e0; route[4 * m + 1] = e1; ((float*)route)[4 * m + 2] = ww0; ((float*)route)[4 * m + 3] = ww1; atomicAdd((int*)&lcnt[e0], 1); atomicAdd((int*)&lcnt[8 + e1], 1); }
                }
                __syncthreads();
                if (tid < 16) atomicAdd(ctl + CW_CNT + tid, (unsigned)lcnt[tid]);
                __syncthreads();
                LAS float* scr = (LAS float*)(L + wave * 16384);
                constexpr int I_GU = 16 * 224, I_DN = 56 * 32;
                const float* mgu = A->moe_w_gu; const float* mdn = A->moe_w_down;
                for (int it = gw; it < 8 * (I_GU + I_DN); it += NGW) {
                    const int e = it / (I_GU + I_DN); int r = it % (I_GU + I_DN);
                    if (r < I_GU) conv_seg<2>(mgu + (size_t)e * D * 2 * DFF, D, 2 * DFF, 0, (bf16*)(ws + WS_MWGU) + (size_t)e * 2 * DFF * D, D, 0, 224, r, scr, lane);
                    else conv_seg<0>(mdn + (size_t)e * DFF * D, DFF, D, 0, (bf16*)(ws + WS_MWDN) + (size_t)e * D * DFF, DFF, 0, 32, r - I_GU, scr, lane);
                }
            }
}
__device__ __forceinline__ void ph16(LAS unsigned char* L, int layer, int slot) {
    int tid = threadIdx.x; asm volatile("" : "+v"(tid)); const int lane = tid & 63, wave = __builtin_amdgcn_readfirstlane(tid >> 6);
    int G = gridDim.x, bx = blockIdx.x; asm volatile("" : "+s"(G), "+s"(bx)); const int gw = bx * 8 + wave, NGW = G * 8;
    unsigned char* lds = (unsigned char*)L; LAS int* lcnt = (LAS int*)(L + 0); LAS int* gt = (LAS int*)(L + LDS_MISC + 512);
    (void)lane; (void)gw; (void)NGW; (void)lds; (void)lcnt; (void)gt; (void)layer; (void)slot; (void)tid; (void)bx; (void)G;
    {
                unsigned char* ws = kargs()->ws; unsigned* ctl = (unsigned*)(ws + WS_CTL);
                int* route = (int*)(ws + WS_ROUTE); int* tokmap = (int*)(ws + WS_TOKMAP); float* roww = (float*)(ws + WS_ROWW); bf16* HB = (bf16*)(ws + WS_HB);
                LAS int* lbase = (LAS int*)(L + 64); LAS int* lc2 = (LAS int*)(L + 128);
                for (int chunk = bx; chunk < M / 128; chunk += G) {
                    if (tid < 16) { lcnt[tid] = 0; lc2[tid] = 0; }
                    __syncthreads();
                    const int m = chunk * 128 + (tid >> 2);
                    const int e0 = route[4 * m], e1 = route[4 * m + 1];
                    if ((tid & 3) == 0) { atomicAdd((int*)&lcnt[e0], 1); atomicAdd((int*)&lcnt[8 + e1], 1); }
                    __syncthreads();
                    if (tid < 16) lbase[tid] = (int)atomicAdd(ctl + CW_CUR + tid, (unsigned)lcnt[tid]) + gt[tid] * 256;
                    __syncthreads();
                    int p0 = 0, p1 = 0;
                    if ((tid & 3) == 0) { p0 = lbase[e0] + atomicAdd((int*)&lc2[e0], 1); p1 = lbase[8 + e1] + atomicAdd((int*)&lc2[8 + e1], 1);
                        tokmap[p0] = m; tokmap[p1] = m; roww[p0] = ((const float*)route)[4 * m + 2]; roww[p1] = ((const float*)route)[4 * m + 3]; }
                    p0 = __shfl(p0, lane & ~3); p1 = __shfl(p1, lane & ~3);
                    const u32x4* src = (const u32x4*)(HB + (size_t)m * D) + (tid & 3) * 32;
                    u32x4* d0 = (u32x4*)((bf16*)(ws + WS_XS) + (size_t)p0 * D) + (tid & 3) * 32; u32x4* d1 = (u32x4*)((bf16*)(ws + WS_XS) + (size_t)p1 * D) + (tid & 3) * 32;
#pragma unroll 8
                    for (int q = 0; q < 32; ++q) { const u32x4 v = src[q]; d0[q] = v; d1[q] = v; }
                    __syncthreads();
                }
                if (bx < 16) { const int g = bx; const int cntg = (int)__hip_atomic_load(ctl + CW_CNT + g, __ATOMIC_RELAXED, __HIP_MEMORY_SCOPE_AGENT);
                    for (int r = gt[g] * 256 + cntg + tid; r < gt[g + 1] * 256; r += 512) { tokmap[r] = -1; roww[r] = 0.f; } }
            }
}
__device__ __forceinline__ void ph17(LAS unsigned char* L, int layer, int slot) {
    int tid = threadIdx.x; asm volatile("" : "+v"(tid)); const int lane = tid & 63, wave = __builtin_amdgcn_readfirstlane(tid >> 6);
    int G = gridDim.x, bx = blockIdx.x; asm volatile("" : "+s"(G), "+s"(bx)); const int gw = bx * 8 + wave, NGW = G * 8;
    unsigned char* lds = (unsigned char*)L; LAS int* lcnt = (LAS int*)(L + 0); LAS int* gt = (LAS int*)(L + LDS_MISC + 512);
    (void)lane; (void)gw; (void)NGW; (void)lds; (void)lcnt; (void)gt; (void)layer; (void)slot; (void)tid; (void)bx; (void)G;
    {
                unsigned char* ws = kargs()->ws;
                MoeSched S{(const char*)(ws + WS_XS), (const char*)(ws + WS_MWGU), 2048u, (size_t)2 * DFF * D * 2, 2048u, 0, gt[16], 28, 16, G, bx, (const int*)gt};
                EpiGU E{(bf16*)(ws + WS_MHID)};
                pg8::gemm_stream(L, S, E, 2048u, 2048u);
            }
}
__device__ __forceinline__ void ph18(LAS unsigned char* L, int layer, int slot) {
    int tid = threadIdx.x; asm volatile("" : "+v"(tid)); const int lane = tid & 63, wave = __builtin_amdgcn_readfirstlane(tid >> 6);
    int G = gridDim.x, bx = blockIdx.x; asm volatile("" : "+s"(G), "+s"(bx)); const int gw = bx * 8 + wave, NGW = G * 8;
    unsigned char* lds = (unsigned char*)L; LAS int* lcnt = (LAS int*)(L + 0); LAS int* gt = (LAS int*)(L + LDS_MISC + 512);
    (void)lane; (void)gw; (void)NGW; (void)lds; (void)lcnt; (void)gt; (void)layer; (void)slot; (void)tid; (void)bx; (void)G;
    {
                    KArgs A = kargs(); unsigned char* ws = A->ws;
                    const int t0 = slot == 0 ? 0 : gt[8], t1 = slot == 0 ? gt[8] : gt[16];
                    MoeSched S{(const char*)(ws + WS_MHID), (const char*)(ws + WS_MWDN), 7168u, (size_t)D * DFF * 2, 7168u, t0, t1 - t0, 4, 56, G, bx, (const int*)gt};
                    EpiDownMoe E{(const int*)(ws + WS_TOKMAP), (const float*)(ws + WS_ROWW), A->out};
                    pg8::gemm_stream(L, S, E, 7168u, 7168u);
                }
}
__device__ __forceinline__ void ph19(LAS unsigned char* L, int layer, int slot) {
    int tid = threadIdx.x; asm volatile("" : "+v"(tid)); const int lane = tid & 63, wave = __builtin_amdgcn_readfirstlane(tid >> 6);
    int G = gridDim.x, bx = blockIdx.x; asm volatile("" : "+s"(G), "+s"(bx)); const int gw = bx * 8 + wave, NGW = G * 8;
    unsigned char* lds = (unsigned char*)L; LAS int* lcnt = (LAS int*)(L + 0); LAS int* gt = (LAS int*)(L + LDS_MISC + 512);
    (void)lane; (void)gw; (void)NGW; (void)lds; (void)lcnt; (void)gt; (void)layer; (void)slot; (void)tid; (void)bx; (void)G;
    { KArgs A = kargs(); float* xo = A->out; const float* gf = A->norm_final;
                for (int m = gw; m < M; m += NGW) {
                    f32x4* xr = (f32x4*)(xo + (size_t)m * D) + lane; const f32x4* gr = (const f32x4*)gf + lane;
                    f32x4 v[4]; float s = 0.f;
#pragma unroll
                    for (int j = 0; j < 4; ++j) { v[j] = xr[64 * j]; s += (v[j].x * v[j].x + v[j].y * v[j].y) + (v[j].z * v[j].z + v[j].w * v[j].w); }
                    const float rstd = 1.f / sqrtf(wave_sum(s) * (1.f / D) + EPS);
#pragma unroll
                    for (int j = 0; j < 4; ++j) xr[64 * j] = v[j] * rstd * gr[64 * j];
                } }
}
__global__ void __launch_bounds__(512, 2) fwd_kernel(Args a_unused) {
    extern __shared__ __attribute__((aligned(16))) unsigned char lds[];
    LAS unsigned char* L = (LAS unsigned char*)lds;
    volatile LAS unsigned* MISC = (volatile LAS unsigned*)(L + LDS_MISC);
    const int tid = threadIdx.x, lane = tid & 63, wave = __builtin_amdgcn_readfirstlane(tid >> 6);
    const int G = gridDim.x, bx = blockIdx.x;
    for (int u = tid; u < 64; u += 512) MISC[u] = 0u;
    __syncthreads();
    XcdBarrier bar; bar.bar = (unsigned*)(kargs()->ws + WS_CTL) + CW_BAR; bar.x = 0; bar.st = nullptr;
    if (!MK_PER_PHASE) bar = xcd_barrier_post(bar.bar, MISC + 8);
    int pid = 0;
    const int lo = kargs()->ph_lo, hi = kargs()->ph_hi;
#define RUN() (pid >= lo && pid < hi)
#define SEAM() do { if (!MK_PER_PHASE) xcd_barrier(bar); ++pid; } while (0)
    int slotv = 0; (void)lane;

    if (PON(0) && RUN()) for (int r_ = 0; r_ < REP(8); ++r_) ph0(L, 0, 0);
    SEAM();

    for (int layer = 0; layer < DEPTH; ++layer) {
        if (PON(1) && RUN()) for (int r_ = 0; r_ < REP(9); ++r_) ph1(L, layer, slotv);
        SEAM();
        if (PON(2) && RUN()) for (int r_ = 0; r_ < REP(10); ++r_) ph2(L, layer, slotv);
        SEAM();
        if (PON(3) && RUN()) for (int r_ = 0; r_ < REP(11); ++r_) ph3(L, layer, slotv);
        SEAM();
        if (PON(4) && RUN()) for (int r_ = 0; r_ < REP(12); ++r_) ph4(L, layer, slotv);
        SEAM();
        if (PON(5) && RUN()) for (int r_ = 0; r_ < REP(13); ++r_) ph5(L, layer, slotv);
        SEAM();
        if (PON(6) && RUN()) for (int r_ = 0; r_ < REP(14); ++r_) ph6(L, layer, slotv);
        SEAM();
        if (PON(7) && RUN()) for (int r_ = 0; r_ < REP(15); ++r_) ph7(L, layer, slotv);
        SEAM();
        if (PON(8) && RUN()) for (int r_ = 0; r_ < REP(16); ++r_) ph8(L, layer, slotv);
        SEAM();
        if (PON(9) && RUN()) for (int r_ = 0; r_ < REP(17); ++r_) ph9(L, layer, slotv);
        SEAM();
        if (PON(10) && RUN()) for (int r_ = 0; r_ < REP(18); ++r_) ph10(L, layer, slotv);
        SEAM();
        if (layer == 0) {
            if (PON(11) && RUN()) for (int r_ = 0; r_ < REP(19); ++r_) ph11(L, layer, slotv);
            SEAM();
            if (PON(12) && RUN()) for (int r_ = 0; r_ < REP(20); ++r_) ph12(L, layer, slotv);
            SEAM();
            if (PON(13) && RUN()) for (int r_ = 0; r_ < REP(21); ++r_) ph13(L, layer, slotv);
            SEAM();
            if (PON(14) && RUN()) for (int r_ = 0; r_ < REP(22); ++r_) ph14(L, layer, slotv);
            SEAM();
        } else {
            if (PON(15) && RUN()) for (int r_ = 0; r_ < REP(23); ++r_) ph15(L, layer, slotv);
            SEAM();
            LAS int* gt = (LAS int*)(L + LDS_MISC + 512);
            if (tid == 0) { unsigned* ctl = (unsigned*)(kargs()->ws + WS_CTL); int acc = 0; for (int g = 0; g < 16; ++g) { gt[g] = acc; acc += ((int)__hip_atomic_load(ctl + CW_CNT + g, __ATOMIC_RELAXED, __HIP_MEMORY_SCOPE_AGENT) + 255) >> 8; } gt[16] = acc; }
            __syncthreads();
            if (PON(16) && RUN()) for (int r_ = 0; r_ < REP(24); ++r_) ph16(L, layer, slotv);
            SEAM();
            if (PON(17) && RUN()) for (int r_ = 0; r_ < REP(25); ++r_) ph17(L, layer, slotv);
            SEAM();
            for (int slot = 0; slot < 2; ++slot) {
                if (PON(18) && RUN()) for (int r_ = 0; r_ < REP(26); ++r_) ph18(L, layer, slot);
                SEAM();
            }
            if (PON(19) && RUN()) for (int r_ = 0; r_ < REP(27); ++r_) ph19(L, layer, slotv);
            ++pid;
        }
    }
#undef RUN
#undef SEAM
}


constexpr int NPHASE = 1 + 14 + 16;
extern "C" void kernel_launch(void* const* d_in, const int* in_sizes, int n_in, void* d_out, int out_size, void* d_ws, size_t ws_size, hipStream_t stream) {
    static int grid = 0;
    if (grid == 0) {
        if (n_in != 22 || out_size != M * D || ws_size < WS_END) { fprintf(stderr, "kernel_launch: unexpected problem (n_in %d out %d ws %zu)\n", n_in, out_size, ws_size); grid = -1; return; }
        int dev = 0, cus = 0;
        if (hipGetDevice(&dev) != hipSuccess || hipDeviceGetAttribute(&cus, hipDeviceAttributeMultiprocessorCount, dev) != hipSuccess) { grid = -1; return; }
        if (hipFuncSetAttribute((const void*)fwd_kernel, hipFuncAttributeMaxDynamicSharedMemorySize, LDS_BYTES) != hipSuccess) { fprintf(stderr, "kernel_launch: hipFuncSetAttribute failed\n"); grid = -1; return; }
        int per_cu = 0;
        (void)hipOccupancyMaxActiveBlocksPerMultiprocessor(&per_cu, (const void*)fwd_kernel, 512, LDS_BYTES);
        (void)hipGetLastError();
        if (per_cu < 1) fprintf(stderr, "kernel_launch: occupancy query says %d\n", per_cu);
        grid = cus;
    }
    if (grid < 0) return;
    (void)hipMemsetAsync((char*)d_ws + WS_CTL, 0, CTL_ZERO_BYTES, stream);
    Args a{};
    a.x = (const float*)d_in[0]; a.mem = (const float*)d_in[1]; a.positions = (const int*)d_in[2]; a.norm_mix = (const float*)d_in[3]; a.w_in = (const float*)d_in[4];
    a.attn_sink = (const float*)d_in[5]; a.w_branch = (const float*)d_in[6]; a.w_out = (const float*)d_in[7]; a.pool_w = (const float*)d_in[8]; a.pool_scale = (const float*)d_in[9];
    a.norm_cross = (const float*)d_in[10]; a.norm_mem = (const float*)d_in[11]; a.w_xq = (const float*)d_in[12]; a.w_xkv = (const float*)d_in[13]; a.w_xo = (const float*)d_in[14];
    a.norm_ffn = (const float*)d_in[15]; a.dense_w_gu = (const float*)d_in[16]; a.dense_w_down = (const float*)d_in[17]; a.router_w = (const float*)d_in[18];
    a.moe_w_gu = (const float*)d_in[19]; a.moe_w_down = (const float*)d_in[20]; a.norm_final = (const float*)d_in[21];
    a.out = (float*)d_out; a.ws = (unsigned char*)d_ws;
#if MK_PER_PHASE
    for (int p = 0; p < NPHASE; ++p) { a.ph_lo = p; a.ph_hi = p + 1; hipLaunchKernelGGL(fwd_kernel, dim3(grid), dim3(512), LDS_BYTES, stream, a); }
#else
    a.ph_lo = 0; a.ph_hi = NPHASE;
    hipLaunchKernelGGL(fwd_kernel, dim3(grid), dim3(512), LDS_BYTES, stream, a);
#endif
}
```

```cpp
#include <hip/hip_runtime.h>
#include <cstdio>
#include <cstdint>

#ifndef MK_PER_PHASE
#define MK_PER_PHASE 0
#endif

#ifndef PHASE_MASK
#define PHASE_MASK 0xFFFFFFFFu
#endif
#define PON(k) ((PHASE_MASK >> (k)) & 1u)
#ifndef REP_MASK
#define REP_MASK 0u
#endif
#define REP(k) (1 + (int)((REP_MASK >> (k)) & 1u))
#define LAS __attribute__((address_space(3)))
#define GAS __attribute__((address_space(1)))
typedef unsigned short bf16;
typedef short bf16x8 __attribute__((ext_vector_type(8)));
typedef float f32x4 __attribute__((ext_vector_type(4)));
typedef float f32x2 __attribute__((ext_vector_type(2)));
typedef unsigned u32x4 __attribute__((ext_vector_type(4)));
typedef unsigned u32x2 __attribute__((ext_vector_type(2)));
typedef __bf16 bf16x2_t __attribute__((ext_vector_type(2)));

constexpr int BATCH = 8, T = 4096, D = 1024, M = BATCH * T, DEPTH = 2;
constexpr int D_IN = 8004, NPROJ = 4096, DFF = 3584, NEXP = 8, MEMLEN = 256, MROWS = BATCH * MEMLEN;
constexpr float EPS = 1e-6f;
constexpr int C_AQ = 0, C_AK = 512, C_AV = 640, C_BQ = 768, C_BK = 1280, C_BV = 1408, C_IQ = 1536, C_IK = 1792, C_RQ = 1856, C_RK = 2112, C_RV = 2368, C_RG = 2880, C_PU = 3392, C_IW = 3904;
constexpr unsigned long long ROPE_MASK = 0x3FFull | (0x3FFull << 12) | (0x1FFFull << 24);

constexpr size_t MiB = 1u << 20;
constexpr size_t WS_CTL = 0, CTL_ZERO_BYTES = 1 * MiB;
constexpr size_t WS_ROUTE = 1 * MiB;
constexpr size_t WS_TOKMAP = 2 * MiB;
constexpr size_t WS_ROWW = 3 * MiB;
constexpr size_t WS_HB = 4 * MiB;
constexpr size_t WS_ROPE = 68 * MiB;
constexpr size_t WS_MN = 76 * MiB;
constexpr size_t WS_KX = 84 * MiB;
constexpr size_t WS_VT = 92 * MiB;
constexpr size_t WS_W = 100 * MiB;
constexpr size_t W_IN = 0, W_G = 8 * MiB, W_B = 16 * MiB, W_OUT = 20 * MiB, W_XQ = 22 * MiB, W_XK = 24 * MiB, W_XV = 26 * MiB, W_XO = 28 * MiB, W_LAYER = 30 * MiB;
constexpr size_t WS_WGU = WS_W + 2 * W_LAYER;
constexpr size_t WS_WDN = WS_WGU + 14 * MiB;
constexpr size_t WS_R = 181 * MiB;
constexpr size_t WS_PROJ = WS_R;
constexpr size_t WS_BR01 = WS_R + 256 * MiB;
constexpr size_t WS_BR23 = WS_R + 320 * MiB;
constexpr size_t WS_U = WS_R + 384 * MiB;
constexpr size_t WS_R_END = WS_R + 416 * MiB;
constexpr size_t WS_AKV = 600 * MiB;
constexpr size_t WS_BKV = 616 * MiB;
constexpr size_t WS_IK = 632 * MiB;
constexpr size_t WS_WPOOL = 652 * MiB;
constexpr size_t WS_ST = 636 * MiB;
constexpr size_t WS_MSCR = WS_PROJ;
constexpr size_t WS_MERGED = WS_PROJ + 192 * MiB;
constexpr size_t WS_XQ = WS_PROJ;
constexpr size_t WS_XP = WS_PROJ + 64 * MiB;
constexpr size_t WS_XO = WS_PROJ + 128 * MiB;
constexpr size_t WS_HID = WS_PROJ;
constexpr int MOE_ROWS = 2 * M + 16 * 256;
constexpr size_t WS_MWGU = 100 * MiB;
constexpr size_t WS_MWDN = 212 * MiB;
constexpr size_t WS_MHID = 268 * MiB;
constexpr size_t WS_XS = 744 * MiB;
constexpr size_t WS_END = 880 * MiB;
static_assert(WS_MHID + (size_t)MOE_ROWS * DFF * 2 <= WS_XS && WS_XS + (size_t)MOE_ROWS * D * 2 <= WS_END, "moe map");
static_assert(WS_WDN + 7 * MiB <= WS_R, "weights map");
constexpr int CW_BAR = 4096;
constexpr int CW_CNT = 16384;
constexpr int CW_CUR = 16384 + 64;

constexpr int LDS_STAGE = 131072;
constexpr int LDS_XCH = 131072;
constexpr int LDS_MISC = 131072 + 16384;
constexpr int LDS_BYTES = 131072 + 16384 + 8192;
constexpr int WAVE_LDS = 17408;

__device__ const float INV_FREQ[32] = {1.000000000e+00f, 7.498942018e-01f, 5.623413324e-01f, 4.216965139e-01f, 3.162277639e-01f, 2.371373922e-01f, 1.778279394e-01f, 1.333521456e-01f, 1.000000015e-01f, 7.498941571e-02f, 5.623412877e-02f, 4.216964915e-02f, 3.162277862e-02f, 2.371373586e-02f, 1.778279431e-02f, 1.333521493e-02f, 9.999999776e-03f, 7.498942316e-03f, 5.623413250e-03f, 4.216964822e-03f, 3.162277862e-03f, 2.371373819e-03f, 1.778279431e-03f, 1.333521446e-03f, 1.000000047e-03f, 7.498941850e-04f, 5.623413017e-04f, 4.216965463e-04f, 3.162277862e-04f, 2.371373848e-04f, 1.778279402e-04f, 1.333521504e-04f};
__device__ __forceinline__ float bf2f(unsigned short v) { return __uint_as_float(((unsigned)v) << 16); }
__device__ __forceinline__ unsigned f2bf(float f) { unsigned u = __float_as_uint(f); return (u + 0x7fffu + ((u >> 16) & 1u)) >> 16; }
__device__ __forceinline__ unsigned pk2(float lo, float hi) { return f2bf(lo) | (f2bf(hi) << 16); }
__device__ __forceinline__ unsigned cvt_pk_bf16(float lo, float hi) { unsigned r; asm volatile("v_cvt_pk_bf16_f32 %0, %1, %2" : "=v"(r) : "v"(lo), "v"(hi)); return r; }
__device__ __forceinline__ float dot2(unsigned a, unsigned b, float acc) { return __builtin_amdgcn_fdot2_f32_bf16(__builtin_bit_cast(bf16x2_t, a), __builtin_bit_cast(bf16x2_t, b), acc, false); }
__device__ __forceinline__ float wave_sum(float v) {
#pragma unroll
    for (int o = 1; o < 64; o <<= 1) v += __shfl_xor(v, o);
    return v;
}
__device__ __forceinline__ float wave_max(float v) {
#pragma unroll
    for (int o = 1; o < 64; o <<= 1) v = fmaxf(v, __shfl_xor(v, o));
    return v;
}
#define LDS_WAIT() asm volatile("s_waitcnt lgkmcnt(0)" ::: "memory")

namespace pg8 {
constexpr int BM = 256, BK = 64, HALF = 128, HTB = HALF * BK * 2, STAGE_BYTES = 8 * HTB, NXCD = 8, WGM = 8;
__host__ __device__ __forceinline__ int lds_byte(int r, int c) { const int st = (r >> 4) * 2 + (c >> 5), rr = r & 15, cc = c & 31, ob = rr * 64 + cc * 2; return st * 1024 + (ob ^ (((ob >> 9) & 1) << 5)); }
__host__ __device__ __forceinline__ void stage_rc(int b, int& R, int& C) { const int st = b / 1024, sb = b % 1024, swz = sb ^ (((sb >> 9) & 1) << 5); R = (st >> 1) * 16 + swz / 64; C = (st & 1) * 32 + (swz % 64) / 2; }
__host__ __device__ __forceinline__ int perm32(int rho) { const int n = rho >> 4, i = rho & 15; return 8 * (i >> 2) + 4 * n + (i & 3); }

struct Unit { const char* A; const char* B; int nt; int pm, pn, kind; };

__device__ __forceinline__ void tile_of(int wgid, int nM, int nN, int& pm, int& pn) {
    const int nwg = nM * nN;
    { const int q = nwg / NXCD, r = nwg % NXCD, xcd = wgid % NXCD, off = wgid / NXCD; wgid = (xcd < r ? xcd * (q + 1) : r * (q + 1) + (xcd - r) * q) + off; }
    const int nig = WGM * nN, gid = wgid / nig, fm = gid * WGM, gsz = (nM - fm) < WGM ? (nM - fm) : WGM;
    pm = fm + ((wgid % nig) % gsz); pn = (wgid % nig) / gsz;
}
struct GridSched {
    const char* A; const char* B; unsigned lda, ldb; int nM, nN, nt, G, c;
    __device__ __forceinline__ bool next(int i, Unit& u) const {
        const long L = (long)i * G + c; if (L >= (long)nM * nN) return false;
        tile_of((int)L, nM, nN, u.pm, u.pn);
        u.A = A + (size_t)u.pm * 256 * lda; u.B = B + (size_t)u.pn * 256 * ldb; u.nt = nt; u.kind = 0; return true;
    }
};

template <class Epi, class Sched>
__device__ __forceinline__ void gemm_stream(LAS unsigned char* lds, const Sched& S, const Epi& E, const unsigned lda, const unsigned ldb) {
    int tid = threadIdx.x; asm volatile("" : "+v"(tid));
    const int wid = __builtin_amdgcn_readfirstlane(tid >> 6), lane = tid & 63, wr = wid >> 2, wc = wid & 3, fr = lane & 15, fq = lane >> 4;
    unsigned voffA, voffB;
    { int R, C; stage_rc(tid * 16, R, C); const int Rb = (R & ~31) + perm32(R & 31); voffA = (unsigned)R * lda + (unsigned)C * 2u; voffB = (unsigned)Rb * ldb + (unsigned)C * 2u; }
    const size_t kstep = (size_t)(BK * 2);
    const size_t hA = (size_t)HALF * lda, hB = (size_t)HALF * ldb, qA = (size_t)64 * lda, qB = (size_t)64 * ldb;
    const unsigned ldsw = (unsigned)wid * 1024u;
    const int aoff = lds_byte(wr * 64 + fr, fq * 8), boff = lds_byte(wc * 32 + fr, fq * 8);
#define PG8_SA(b, h) (((b) * 2 + (h)) * HTB)
#define PG8_SB(b, h) ((4 + (b) * 2 + (h)) * HTB)
#define PG8_STAGE(bufoff, gbase, voff) do { \
        __builtin_amdgcn_global_load_lds((const unsigned*)((const char*)(gbase) + (voff)), (LAS unsigned*)(lds + (bufoff) + ldsw), 16, 0, 0); \
        __builtin_amdgcn_global_load_lds((const unsigned*)((const char*)(gbase) + ((&(voff) == &voffA) ? qA : qB) + (voff)), (LAS unsigned*)(lds + (bufoff) + ldsw + 8192), 16, 0, 0); } while (0)
#define PG8_LDA(dst, b, h) do { _Pragma("unroll") for (int m = 0; m < 4; ++m) _Pragma("unroll") for (int k = 0; k < 2; ++k) dst[m][k] = *(const LAS bf16x8*)(lds + PG8_SA(b, h) + aoff + m * 2048 + k * 1024); } while (0)
#define PG8_LDB(dst, b, h) do { _Pragma("unroll") for (int n = 0; n < 2; ++n) _Pragma("unroll") for (int k = 0; k < 2; ++k) dst[n][k] = *(const LAS bf16x8*)(lds + PG8_SB(b, h) + boff + n * 2048 + k * 1024); } while (0)
#define PG8_MMA(ai, bj, At, Bt) do { __builtin_amdgcn_s_setprio(1); _Pragma("unroll") for (int m = 0; m < 4; ++m) _Pragma("unroll") for (int n = 0; n < 2; ++n) _Pragma("unroll") for (int k = 0; k < 2; ++k) \
        acc[ai][bj][m][n] = __builtin_amdgcn_mfma_f32_16x16x32_bf16(Bt[n][k], At[m][k], acc[ai][bj][m][n], 0, 0, 0); __builtin_amdgcn_s_setprio(0); } while (0)
#define PG8_WAIT_V(n) asm volatile("s_waitcnt vmcnt(" #n ")" ::: "memory")
#define PG8_WAIT_L(n) asm volatile("s_waitcnt lgkmcnt(" #n ")" ::: "memory")
#define PG8_BAR __builtin_amdgcn_s_barrier()
#define PG8_SCHED __builtin_amdgcn_sched_barrier(0)
    Unit cur, nxt; int ui = 0;
    if (!S.next(0, cur)) return;
    f32x4 acc[2][2][4][2];
#pragma unroll
    for (int a = 0; a < 2; ++a)
#pragma unroll
        for (int b = 0; b < 2; ++b)
#pragma unroll
            for (int m = 0; m < 4; ++m)
#pragma unroll
                for (int n = 0; n < 2; ++n) acc[a][b][m][n] = (f32x4){0.f, 0.f, 0.f, 0.f};
    bf16x8 At[4][2], B0[2][2], B1[2][2];
    const char* cA = cur.A; const char* cB = cur.B;
    PG8_STAGE(PG8_SB(0, 0), cB, voffB); PG8_STAGE(PG8_SB(0, 1), cB + hB, voffB); PG8_STAGE(PG8_SA(0, 0), cA, voffA); PG8_STAGE(PG8_SA(0, 1), cA + hA, voffA);
    if (wr == 1) PG8_BAR;
    PG8_WAIT_V(2); PG8_BAR;
    PG8_STAGE(PG8_SB(1, 0), cB + kstep, voffB); PG8_STAGE(PG8_SA(1, 0), cA + kstep, voffA); PG8_STAGE(PG8_SB(1, 1), cB + hB + kstep, voffB);
    PG8_WAIT_V(6); PG8_BAR;
    for (;;) {
        const bool has_next = S.next(ui + 1, nxt);
        const char* nA = has_next ? nxt.A : cA; const char* nB = has_next ? nxt.B : cB;
        int nt = cur.nt; asm volatile("" : "+s"(nt));
#pragma unroll 1
        for (int t = 0; t < nt; t += 2) {
            const bool last = (t == nt - 2);
            const char* a1 = cA + (size_t)(t + 1) * kstep;
            const char* a2 = last ? nA : cA + (size_t)(t + 2) * kstep; const char* b2 = last ? nB : cB + (size_t)(t + 2) * kstep;
            const char* a3 = a2 + kstep; const char* b3 = b2 + kstep;
            PG8_LDB(B0, 0, 0); PG8_LDB(B1, 0, 1); PG8_SCHED; PG8_LDA(At, 0, 0); PG8_STAGE(PG8_SA(1, 1), a1 + hA, voffA);
            PG8_WAIT_V(8); PG8_WAIT_L(0); PG8_BAR; PG8_MMA(0, 0, At, B0); PG8_MMA(0, 1, At, B1); PG8_BAR; PG8_SCHED;
            PG8_LDA(At, 0, 1); PG8_STAGE(PG8_SB(0, 0), b2, voffB); PG8_STAGE(PG8_SB(0, 1), b2 + hB, voffB); PG8_STAGE(PG8_SA(0, 0), a2, voffA);
            PG8_WAIT_V(8); PG8_WAIT_L(0); PG8_BAR; PG8_MMA(1, 0, At, B0); PG8_MMA(1, 1, At, B1); PG8_BAR; PG8_SCHED;
            PG8_LDB(B0, 1, 0); PG8_LDB(B1, 1, 1); PG8_SCHED; PG8_LDA(At, 1, 0); PG8_STAGE(PG8_SA(0, 1), a2 + hA, voffA);
            PG8_WAIT_V(8); PG8_WAIT_L(0); PG8_BAR; PG8_MMA(0, 0, At, B0); PG8_MMA(0, 1, At, B1); PG8_BAR; PG8_SCHED;
            PG8_LDA(At, 1, 1); PG8_STAGE(PG8_SB(1, 0), b3, voffB); PG8_STAGE(PG8_SB(1, 1), b3 + hB, voffB); PG8_STAGE(PG8_SA(1, 0), a3, voffA);
            PG8_WAIT_V(8); PG8_WAIT_L(0); PG8_BAR; PG8_MMA(1, 0, At, B0); PG8_MMA(1, 1, At, B1); PG8_BAR; PG8_SCHED;
        }
        if (wr == 0) PG8_BAR;
        const bool keep = E(acc, cur, wr, wc, fr, fq);
        if (!has_next) break;
        if constexpr (Epi::CHAIN) {
            const float kf = keep ? 1.f : 0.f;
#pragma unroll
            for (int a = 0; a < 2; ++a)
#pragma unroll
                for (int b = 0; b < 2; ++b)
#pragma unroll
                    for (int m = 0; m < 4; ++m)
#pragma unroll
                        for (int n = 0; n < 2; ++n) acc[a][b][m][n] = acc[a][b][m][n] * kf;
        } else {
#pragma unroll
            for (int a = 0; a < 2; ++a)
#pragma unroll
                for (int b = 0; b < 2; ++b)
#pragma unroll
                    for (int m = 0; m < 4; ++m)
#pragma unroll
                        for (int n = 0; n < 2; ++n) acc[a][b][m][n] = (f32x4){0.f, 0.f, 0.f, 0.f};
        }
        cur = nxt; cA = nA; cB = nB; ++ui;
        if (wr == 1) PG8_BAR;
    }
    PG8_WAIT_V(0);
    PG8_BAR;
#undef PG8_SA
#undef PG8_SB
#undef PG8_STAGE
#undef PG8_LDA
#undef PG8_LDB
#undef PG8_MMA
#undef PG8_WAIT_V
#undef PG8_WAIT_L
#undef PG8_BAR
#undef PG8_SCHED
}
}
using pg8::Unit;

#define EPI_ARGS f32x4 (&acc)[2][2][4][2], const Unit& u, int wr, int wc, int fr_in, int fq_in
#define EPI_LANE int lane_l = threadIdx.x & 63; asm volatile("" : "+v"(lane_l)); const int fr = lane_l & 15, fq = lane_l >> 4; (void)fr_in; (void)fq_in;
struct EpiProj {
    static constexpr bool CHAIN = false;
    bf16* O; const float* cosT; const float* sinT; bf16* AKV; bf16* BKV; bf16* IK;
    __device__ __forceinline__ bool operator()(EPI_ARGS) const {
        EPI_LANE
        const int g = 4 * u.pn + wc; const bool rope = (ROPE_MASK >> g) & 1ull;
        const int row0 = u.pm * 256 + wr * 64 + fr;
#pragma unroll
        for (int ai = 0; ai < 2; ++ai)
#pragma unroll
            for (int m = 0; m < 4; ++m) {
                const int r = row0 + ai * 128 + m * 16;
                f32x4 x1a = acc[ai][0][m][0], x1b = acc[ai][0][m][1], x2a = acc[ai][1][m][0], x2b = acc[ai][1][m][1];
                if (rope) {
                    const f32x4 ca = *(const f32x4*)(cosT + (size_t)r * 32 + 8 * fq), cb = *(const f32x4*)(cosT + (size_t)r * 32 + 8 * fq + 4);
                    const f32x4 sa = *(const f32x4*)(sinT + (size_t)r * 32 + 8 * fq), sb = *(const f32x4*)(sinT + (size_t)r * 32 + 8 * fq + 4);
                    const f32x4 o1a = x1a * ca - x2a * sa, o1b = x1b * cb - x2b * sb, o2a = x2a * ca + x1a * sa, o2b = x2b * cb + x1b * sb;
                    x1a = o1a; x1b = o1b; x2a = o2a; x2b = o2b;
                }
                bf16* rowp = (g >= 8 && g < 12) ? AKV + (size_t)r * 256 + 64 * (g - 8) + 8 * fq : (g >= 20 && g < 24) ? BKV + (size_t)r * 256 + 64 * (g - 20) + 8 * fq
                           : (g == 28) ? IK + (size_t)r * 64 + 8 * fq : O + (size_t)r * NPROJ + 64 * g + 8 * fq;
                u32x4 w1, w2;
                w1.x = cvt_pk_bf16(x1a[0], x1a[1]); w1.y = cvt_pk_bf16(x1a[2], x1a[3]); w1.z = cvt_pk_bf16(x1b[0], x1b[1]); w1.w = cvt_pk_bf16(x1b[2], x1b[3]);
                w2.x = cvt_pk_bf16(x2a[0], x2a[1]); w2.y = cvt_pk_bf16(x2a[2], x2a[3]); w2.z = cvt_pk_bf16(x2b[0], x2b[1]); w2.w = cvt_pk_bf16(x2b[2], x2b[3]);
                *(u32x4*)(rowp) = w1; *(u32x4*)(rowp + 32) = w2;
            }
        return false;
    }
};
struct EpiPlain {
    static constexpr bool CHAIN = false;
    bf16* O; int ldc; float scale;
    __device__ __forceinline__ bool operator()(EPI_ARGS) const {
        EPI_LANE
        const int row0 = u.pm * 256 + wr * 64 + fr, col0 = u.pn * 256 + wc * 32 + 8 * fq;
#pragma unroll
        for (int ai = 0; ai < 2; ++ai)
#pragma unroll
            for (int m = 0; m < 4; ++m) { bf16* rowp = O + (size_t)(row0 + ai * 128 + m * 16) * ldc + col0;
#pragma unroll
                for (int bj = 0; bj < 2; ++bj) { const f32x4 v0 = acc[ai][bj][m][0] * scale, v1 = acc[ai][bj][m][1] * scale;
                    u32x4 w; w.x = cvt_pk_bf16(v0[0], v0[1]); w.y = cvt_pk_bf16(v0[2], v0[3]); w.z = cvt_pk_bf16(v1[0], v1[1]); w.w = cvt_pk_bf16(v1[2], v1[3]);
                    *(u32x4*)(rowp + bj * 128) = w; } }
        return false;
    }
};
struct EpiRes {
    static constexpr bool CHAIN = false;
    const float* in; float* out;
    __device__ __forceinline__ bool operator()(EPI_ARGS) const {
        EPI_LANE
        const int row0 = u.pm * 256 + wr * 64 + fr, col0 = u.pn * 256 + wc * 32 + 8 * fq;
#pragma unroll
        for (int ai = 0; ai < 2; ++ai)
#pragma unroll
            for (int m = 0; m < 4; ++m) { const size_t off = (size_t)(row0 + ai * 128 + m * 16) * D + col0;
#pragma unroll
                for (int bj = 0; bj < 2; ++bj) {
                    const f32x4 a0 = *(const f32x4*)(in + off + bj * 128), a1 = *(const f32x4*)(in + off + bj * 128 + 4);
                    *(f32x4*)(out + off + bj * 128) = a0 + acc[ai][bj][m][0]; *(f32x4*)(out + off + bj * 128 + 4) = a1 + acc[ai][bj][m][1]; }
                asm volatile("" ::: "memory"); }
        return false;
    }
};
struct EpiGate {
    static constexpr bool CHAIN = false;
    unsigned* scr;
    __device__ __forceinline__ bool operator()(EPI_ARGS) const {
        EPI_LANE
        const unsigned voff = (unsigned)(((unsigned)__builtin_amdgcn_readfirstlane(threadIdx.x >> 6) * 64u + (unsigned)lane_l) * 16u);
        char* sb = (char*)scr + (size_t)u.kind * 131072;
#pragma unroll
        for (int ai = 0; ai < 2; ++ai)
#pragma unroll
            for (int m = 0; m < 4; ++m)
#pragma unroll
                for (int bj = 0; bj < 2; ++bj) {
                    f32x4 v0 = acc[ai][bj][m][0], v1 = acc[ai][bj][m][1]; u32x4 w;
#pragma unroll
                    for (int j = 0; j < 4; ++j) { v0[j] = fmaxf(__builtin_amdgcn_rcpf(1.f + __builtin_amdgcn_exp2f(-1.44269504f * v0[j])), 1e-6f); v1[j] = fmaxf(__builtin_amdgcn_rcpf(1.f + __builtin_amdgcn_exp2f(-1.44269504f * v1[j])), 1e-6f); }
                    w.x = cvt_pk_bf16(v0[0], v0[1]); w.y = cvt_pk_bf16(v0[2], v0[3]); w.z = cvt_pk_bf16(v1[0], v1[1]); w.w = cvt_pk_bf16(v1[2], v1[3]);
                    *(u32x4*)(sb + (size_t)((ai * 4 + m) * 2 + bj) * 8192 + voff) = w; asm volatile("" ::: "memory"); }
        return false;
    }
};
struct EpiUp {
    static constexpr bool CHAIN = false;
    unsigned* scr; bf16* O;
    __device__ __forceinline__ bool operator()(EPI_ARGS) const {
        EPI_LANE
        const unsigned tl = (unsigned)__builtin_amdgcn_readfirstlane(threadIdx.x >> 6) * 64u + (unsigned)lane_l;
        const char* s0 = (const char*)scr + (size_t)u.kind * 131072;
        char* pb = (char*)scr + 4 * 131072;
        const int row0 = u.pm * 256 + wr * 64 + fr, col0 = u.pn * 256 + wc * 32 + 8 * fq;
#pragma unroll
        for (int ai = 0; ai < 2; ++ai)
#pragma unroll
            for (int m = 0; m < 4; ++m)
#pragma unroll
                for (int bj = 0; bj < 2; ++bj) {
                    const int slot = (ai * 4 + m) * 2 + bj;
                    const u32x4 a = *(const u32x4*)(s0 + (size_t)slot * 8192 + tl * 16u);
                    f32x4 p0 = (f32x4){0.f, 0.f, 0.f, 0.f}, p1 = p0;
                    if (u.kind > 0) { p0 = *(const f32x4*)(pb + (size_t)slot * 16384 + tl * 32u); p1 = *(const f32x4*)(pb + (size_t)slot * 16384 + tl * 32u + 16); }
                    const f32x4 f0 = (f32x4){__uint_as_float(a.x << 16), __uint_as_float(a.x & 0xffff0000u), __uint_as_float(a.y << 16), __uint_as_float(a.y & 0xffff0000u)};
                    const f32x4 f1 = (f32x4){__uint_as_float(a.z << 16), __uint_as_float(a.z & 0xffff0000u), __uint_as_float(a.w << 16), __uint_as_float(a.w & 0xffff0000u)};
                    p0 = p0 + acc[ai][bj][m][0] * f0; p1 = p1 + acc[ai][bj][m][1] * f1;
                    if (u.kind < 3) { *(f32x4*)(pb + (size_t)slot * 16384 + tl * 32u) = p0; *(f32x4*)(pb + (size_t)slot * 16384 + tl * 32u + 16) = p1; }
                    else { u32x4 w; w.x = cvt_pk_bf16(p0[0], p0[1]); w.y = cvt_pk_bf16(p0[2], p0[3]); w.z = cvt_pk_bf16(p1[0], p1[1]); w.w = cvt_pk_bf16(p1[2], p1[3]);
                        *(u32x4*)(O + (size_t)(row0 + ai * 128 + m * 16) * D + col0 + bj * 128) = w; }
                    asm volatile("" ::: "memory");
                }
        return false;
    }
};
struct EpiSoftmax {
    static constexpr bool CHAIN = false;
    bf16* P; LAS f32x2* xch; float scale_log2;
    __device__ __forceinline__ bool operator()(EPI_ARGS) const {
        EPI_LANE
        LAS f32x2* X = xch + (size_t)(u.kind & 1) * 1024;
#pragma unroll
        for (int ai = 0; ai < 2; ++ai)
#pragma unroll
            for (int m = 0; m < 4; ++m) {
                float v = -3.0e38f;
#pragma unroll
                for (int bj = 0; bj < 2; ++bj)
#pragma unroll
                    for (int n = 0; n < 2; ++n) { acc[ai][bj][m][n] = acc[ai][bj][m][n] * scale_log2; const f32x4 x = acc[ai][bj][m][n]; v = fmaxf(v, fmaxf(fmaxf(x[0], x[1]), fmaxf(x[2], x[3]))); }
                v = fmaxf(v, __shfl_xor(v, 16)); v = fmaxf(v, __shfl_xor(v, 32));
                float s = 0.f;
#pragma unroll
                for (int bj = 0; bj < 2; ++bj)
#pragma unroll
                    for (int n = 0; n < 2; ++n) { f32x4 x = acc[ai][bj][m][n];
#pragma unroll
                        for (int j = 0; j < 4; ++j) { x[j] = __builtin_amdgcn_exp2f(x[j] - v); s += x[j]; }
                        acc[ai][bj][m][n] = x; }
                s += __shfl_xor(s, 16); s += __shfl_xor(s, 32);
                if (fq == 0) X[(ai * 128 + wr * 64 + m * 16 + fr) * 4 + wc] = (f32x2){v, s};
            }
        asm volatile("s_waitcnt lgkmcnt(0)" ::: "memory"); __builtin_amdgcn_s_barrier(); asm volatile("" ::: "memory");
        const int row0 = u.pm * 256 + wr * 64 + fr, col0 = u.pn * 256 + wc * 32 + 8 * fq;
#pragma unroll
        for (int ai = 0; ai < 2; ++ai)
#pragma unroll
            for (int m = 0; m < 4; ++m) {
                const int rl = ai * 128 + wr * 64 + m * 16 + fr;
                const f32x2 p0 = X[rl * 4 + 0], p1 = X[rl * 4 + 1], p2 = X[rl * 4 + 2], p3 = X[rl * 4 + 3];
                const float gm = fmaxf(fmaxf(p0.x, p1.x), fmaxf(p2.x, p3.x));
                const float tot = p0.y * __builtin_amdgcn_exp2f(p0.x - gm) + p1.y * __builtin_amdgcn_exp2f(p1.x - gm) + p2.y * __builtin_amdgcn_exp2f(p2.x - gm) + p3.y * __builtin_amdgcn_exp2f(p3.x - gm);
                const float mine = (wc == 0) ? p0.x : (wc == 1) ? p1.x : (wc == 2) ? p2.x : p3.x;
                const float f = __builtin_amdgcn_exp2f(mine - gm) / tot;
                bf16* rowp = P + (size_t)(row0 + ai * 128 + m * 16) * D + col0;
#pragma unroll
                for (int bj = 0; bj < 2; ++bj) { const f32x4 v0 = acc[ai][bj][m][0] * f, v1 = acc[ai][bj][m][1] * f;
                    u32x4 w; w.x = cvt_pk_bf16(v0[0], v0[1]); w.y = cvt_pk_bf16(v0[2], v0[3]); w.z = cvt_pk_bf16(v1[0], v1[1]); w.w = cvt_pk_bf16(v1[2], v1[3]);
                    *(u32x4*)(rowp + bj * 128) = w; }
                asm volatile("" ::: "memory");
            }
        return false;
    }
};
struct EpiGU {
    static constexpr bool CHAIN = false;
    bf16* H;
    __device__ __forceinline__ bool operator()(EPI_ARGS) const {
        EPI_LANE
        const int row0 = u.pm * 256 + wr * 64 + fr, col0 = u.pn * 128 + wc * 32 + 8 * fq;
#pragma unroll
        for (int ai = 0; ai < 2; ++ai)
#pragma unroll
            for (int m = 0; m < 4; ++m) {
                f32x4 v[2];
#pragma unroll
                for (int n = 0; n < 2; ++n) { const f32x4 g = acc[ai][0][m][n], uu = acc[ai][1][m][n];
#pragma unroll
                    for (int j = 0; j < 4; ++j) v[n][j] = g[j] * __builtin_amdgcn_rcpf(1.f + __builtin_amdgcn_exp2f(-1.44269504f * g[j])) * uu[j]; }
                u32x4 w; w.x = cvt_pk_bf16(v[0][0], v[0][1]); w.y = cvt_pk_bf16(v[0][2], v[0][3]); w.z = cvt_pk_bf16(v[1][0], v[1][1]); w.w = cvt_pk_bf16(v[1][2], v[1][3]);
                *(u32x4*)(H + (size_t)(row0 + ai * 128 + m * 16) * DFF + col0) = w; asm volatile("" ::: "memory");
            }
        return false;
    }
};
struct EpiDownMoe {
    static constexpr bool CHAIN = false;
    const int* tokmap; const float* roww; float* x;
    __device__ __forceinline__ bool operator()(EPI_ARGS) const {
        EPI_LANE
        const int row0 = u.pm * 256 + wr * 64 + fr, col0 = u.pn * 256 + wc * 32 + 8 * fq;
#pragma unroll
        for (int ai = 0; ai < 2; ++ai)
#pragma unroll
            for (int m = 0; m < 4; ++m) { const int r = row0 + ai * 128 + m * 16; const int tk = tokmap[r];
                if (tk >= 0) { const float w = roww[r]; float* xp = x + (size_t)tk * D + col0;
#pragma unroll
                    for (int bj = 0; bj < 2; ++bj) {
                        const f32x4 a0 = *(const f32x4*)(xp + bj * 128), a1 = *(const f32x4*)(xp + bj * 128 + 4);
                        *(f32x4*)(xp + bj * 128) = a0 + acc[ai][bj][m][0] * w; *(f32x4*)(xp + bj * 128 + 4) = a1 + acc[ai][bj][m][1] * w; } }
                asm volatile("" ::: "memory"); }
        return false;
    }
};

template <int MODE> struct MergeSched {
    const char* A0; const char* A1; const char* W; int pm, pn;
    __device__ __forceinline__ bool next(int i, Unit& u) const {
        if (i >= 4) return false;
        u.pm = pm; u.pn = pn; u.kind = i;
        if (MODE == 0) { u.A = A0 + (size_t)pm * 256 * 2048; u.B = W + (size_t)(i * 1024 + pn * 256) * 2048; u.nt = 16; }
        else { u.A = ((i < 2) ? A0 : A1) + (size_t)pm * 256 * 2048 + (i & 1) * 1024; u.B = W + (size_t)(i >> 1) * (2 * MiB) + (size_t)pn * 256 * 2048 + (i & 1) * 1024; u.nt = 8; }
        return true;
    }
};
struct CrossSched {
    const char* A; const char* B; int mode, G, c;
    __device__ __forceinline__ bool next(int i, Unit& u) const {
        const long L0 = (long)i * G + c; if (L0 >= 512) return false;
        int L = (int)L0; { const int q = 512 / 8, xcd = L % 8, off = L / 8; L = xcd * q + off; }
        const int rt = L & 15, head = (L >> 4) & 3, b = L >> 6;
        u.pm = b * 16 + rt; u.pn = head; u.kind = i; u.nt = 4;
        u.A = A + (size_t)u.pm * 256 * 2048 + head * 512;
        u.B = (mode == 0) ? B + (size_t)(b * 256) * 2048 + head * 512 : B + (size_t)(head * 256) * 4096 + b * 512;
        return true;
    }
};
struct MoeSched {
    const char* A; const char* B; unsigned lda; size_t wstride; unsigned ldb; int t0, nT, nN, nt, G, c; const int* gt;
    __device__ __forceinline__ bool next(int i, Unit& u) const {
        const long L = (long)i * G + c; if (L >= (long)nT * nN) return false;
        int pm, pn; pg8::tile_of((int)L, nT, nN, pm, pn); pm += t0;
        int g = 0;
#pragma unroll
        for (int k = 1; k < 16; ++k) g += (pm >= gt[k]) ? 1 : 0;
        u.pm = pm; u.pn = pn; u.kind = 0; u.nt = nt;
        u.A = A + (size_t)pm * 256 * lda; u.B = B + (size_t)(g & 7) * wstride + (size_t)pn * 256 * ldb; return true;
    }
};

#define XB_TMO      128
#define XB_XCNT(j)  (256  + 64 * (j))
#define XB_XSUB(j)  (1280 + 64 * (j))
#define XB_XGEN(j)  (2304 + 64 * (j))
#define XB_TOP      3328
#define XB_TOPGEN   3392
#define XCD_BAR_WORDS 3456
#define XB_SPIN_CAP (1u << 22)
__device__ __forceinline__ unsigned xb_ld(unsigned* p)              { return __hip_atomic_load(p, __ATOMIC_RELAXED, __HIP_MEMORY_SCOPE_AGENT); }
__device__ __forceinline__ unsigned xb_add(unsigned* p, unsigned v) { return __hip_atomic_fetch_add(p, v, __ATOMIC_RELAXED, __HIP_MEMORY_SCOPE_AGENT); }
__device__ __forceinline__ unsigned xb_xcc_id() { return (unsigned)__builtin_amdgcn_s_getreg((3 << 11) | 20) & 0xFu; }
#define XB_SPIN(cond, bar) do { unsigned _sp = 0; while (cond) { __builtin_amdgcn_s_sleep(1); \
    if ((++_sp & 255u) == 0u) { if (xb_ld(&(bar)[XB_TMO])) break; if (_sp > XB_SPIN_CAP) { atomicAdd(&(bar)[XB_TMO], 1u); break; } } } } while (0)
struct XcdBarrier { unsigned* bar; unsigned x; volatile LAS unsigned* st; };
__device__ __forceinline__ XcdBarrier xcd_barrier_post(unsigned* bar, volatile LAS unsigned* st) {
    XcdBarrier b; b.bar = bar; b.x = xb_xcc_id(); b.st = st;
    if (threadIdx.x == 0) (void)xb_add(&bar[XB_XCNT(b.x)], 1u);
    return b;
}
__device__ __forceinline__ void xcd_barrier_complete(unsigned* bar, unsigned x, unsigned& nloc, unsigned& nx) {
    const unsigned G = gridDim.x * gridDim.y * gridDim.z;
    unsigned sum, cnt, mine, sp = 0u;
    for (;;) {
        sum = 0u; cnt = 0u; mine = 0u;
#pragma unroll
        for (unsigned j = 0; j < 16; ++j) { const unsigned c = xb_ld(&bar[XB_XCNT(j)]); sum += c; cnt += (c > 0u) ? 1u : 0u; mine = (j == x) ? c : mine; }
        if (sum == G) break;
        __builtin_amdgcn_s_sleep(1);
        if ((++sp & 255u) == 0u) { if (xb_ld(&bar[XB_TMO])) break; if (sp > XB_SPIN_CAP) { atomicAdd(&bar[XB_TMO], 1u); break; } }
    }
    nloc = mine > 0u ? mine : 1u; nx = cnt > 0u ? cnt : 1u;
}
__device__ __forceinline__ void xcd_barrier(const XcdBarrier& b) {
    asm volatile("s_waitcnt vmcnt(0)" ::: "memory");
    __syncthreads();
    if (threadIdx.x == 0) {
        unsigned* bar = b.bar;
        __builtin_amdgcn_s_waitcnt(0);
        unsigned nloc = b.st[0], nx = b.st[1];
        if (nloc == 0u) { xcd_barrier_complete(bar, b.x, nloc, nx); b.st[0] = nloc; b.st[1] = nx; }
        const unsigned old = xb_add(&bar[XB_XSUB(b.x)], 1u);
        const unsigned gen = old / nloc;
        if (old + 1u == (gen + 1u) * nloc) {
            __builtin_amdgcn_fence(__ATOMIC_RELEASE, "agent");
            asm volatile("s_waitcnt vmcnt(0)" ::: "memory");
            const unsigned og = xb_add(&bar[XB_TOP], 1u);
            const unsigned tg = og / nx;
            if (og + 1u == (tg + 1u) * nx) xb_add(&bar[XB_TOPGEN], 1u);
            else XB_SPIN(xb_ld(&bar[XB_TOPGEN]) == tg, bar);
            __builtin_amdgcn_fence(__ATOMIC_ACQUIRE, "agent");
            xb_add(&bar[XB_XGEN(b.x)], 1u);
            asm volatile("s_waitcnt vmcnt(0)" ::: "memory");
        } else {
            XB_SPIN(xb_ld(&bar[XB_XGEN(b.x)]) == gen, bar);
            __builtin_amdgcn_fence(__ATOMIC_ACQUIRE, "agent");
            asm volatile("s_waitcnt vmcnt(0)" ::: "memory");
        }
    }
    __syncthreads();
}

struct Args {
    const float* x; const float* mem; const int* positions; const float* norm_mix; const float* w_in; const float* attn_sink; const float* w_branch; const float* w_out;
    const float* pool_w; const float* pool_scale; const float* norm_cross; const float* norm_mem; const float* w_xq; const float* w_xkv; const float* w_xo; const float* norm_ffn;
    const float* dense_w_gu; const float* dense_w_down; const float* router_w; const float* moe_w_gu; const float* moe_w_down; const float* norm_final;
    float* out; unsigned char* ws; int ph_lo, ph_hi;
};

__device__ __forceinline__ void transpose_item(const float* W, int ldw, int k0, int src, int nv, bf16* WT, size_t dst_pitch, int dst_row0, int dst_k0, LAS float* scr, int lane) {
#pragma unroll 8
    for (int i = 0; i < 32; ++i) { const int kk = 2 * i + (lane >> 5), n = lane & 31; scr[kk * 33 + n] = (n < nv) ? W[(size_t)(k0 + kk) * ldw + src + n] : 0.f; }
    LDS_WAIT(); asm volatile("" ::: "memory");
    const int c = lane & 7;
#pragma unroll
    for (int j = 0; j < 4; ++j) { const int n = (lane >> 3) + 8 * j; const LAS float* s = scr + (8 * c) * 33 + n;
        u32x4 o; o.x = pk2(s[0 * 33], s[1 * 33]); o.y = pk2(s[2 * 33], s[3 * 33]); o.z = pk2(s[4 * 33], s[5 * 33]); o.w = pk2(s[6 * 33], s[7 * 33]);
        *(u32x4*)(WT + (size_t)(dst_row0 + n) * dst_pitch + dst_k0 + k0 + 8 * c) = o; }
    LDS_WAIT(); asm volatile("" ::: "memory");
}
template <int MAP>
__device__ __forceinline__ void conv_seg(const float* W, int K, int ldw, int src0, bf16* WT, size_t dst_pitch, int dst_k0, int nb, int item, LAS float* scr, int lane) {
    const int kb = item / nb, vb = item % nb;
    int src, nv = 32;
    if (MAP == 0) src = src0 + 32 * vb;
    else if (MAP == 1) { const int pn = vb >> 3, bj = (vb >> 2) & 1, wc = vb & 3, g = 4 * pn + wc;
        if (g < 29) src = 64 * g + 32 * bj; else if (g < 61) src = 64 * g + 4 + 32 * bj; else if (g == 61) { src = 1856; nv = bj == 0 ? 4 : 0; } else { src = 0; nv = 0; } }
    else { const int pn = vb >> 3, bj = (vb >> 2) & 1, pb = vb & 3; src = src0 + bj * DFF + 128 * pn + 32 * pb; }
    transpose_item(W, ldw, 64 * kb, src, nv, WT, dst_pitch, 32 * vb, dst_k0, scr, lane);
}
__device__ __forceinline__ void norm_row_bf16(const float* xrow, const float* g, bf16* orow, int lane) {
    const f32x4* xr = (const f32x4*)xrow + lane; const f32x4* gr = (const f32x4*)g + lane;
    f32x4 v[4]; float s = 0.f;
#pragma unroll
    for (int j = 0; j < 4; ++j) { v[j] = xr[64 * j]; s += (v[j].x * v[j].x + v[j].y * v[j].y) + (v[j].z * v[j].z + v[j].w * v[j].w); }
    const float rstd = 1.f / sqrtf(wave_sum(s) * (1.f / D) + EPS);
    unsigned long long* o8 = (unsigned long long*)orow + lane;
#pragma unroll
    for (int j = 0; j < 4; ++j) { const f32x4 gg = gr[64 * j];
        o8[64 * j] = (unsigned long long)pk2(v[j].x * rstd * gg.x, v[j].y * rstd * gg.y) | ((unsigned long long)pk2(v[j].z * rstd * gg.z, v[j].w * rstd * gg.w) << 32); }
}

constexpr int RT_P = 136;
typedef float f32x4v __attribute__((ext_vector_type(4)));
__device__ __forceinline__ void pool_phase(const bf16* proj, const bf16* wpt, const float* pscale, bf16* br23, char* lds, int G) {
    int tid = threadIdx.x; asm volatile("" : "+v"(tid)); const int lane = tid & 63, wave = tid >> 6, fr = lane & 15, fq = lane >> 4;
    bf16* Dl = (bf16*)lds;
    for (int un = blockIdx.x; un < 2048; un += G) {
        const int g = un & 3, tb = (un >> 2) & 63, b = un >> 8;
        const int win = 2 << g;
#pragma unroll
        for (int i = 0; i < 2; ++i) { const int idx = tid + 512 * i, tt = idx >> 4, pc = idx & 15, t = tb * 64 + tt;
            const bf16* up = proj + ((size_t)(b * T + t)) * NPROJ + C_PU + g * 128 + 8 * pc;
            const int cnt = (t + 1 < win) ? t + 1 : win;
            float sm[8];
#pragma unroll
            for (int q = 0; q < 8; ++q) sm[q] = 0.f;
            u32x4 u0 = (u32x4){0u, 0u, 0u, 0u};
            for (int j = 0; j < cnt; ++j) { const u32x4 v = *(const u32x4*)(up - (size_t)j * NPROJ); if (j == 0) u0 = v;
                sm[0] += __uint_as_float(v.x << 16); sm[1] += __uint_as_float(v.x & 0xffff0000u); sm[2] += __uint_as_float(v.y << 16); sm[3] += __uint_as_float(v.y & 0xffff0000u);
                sm[4] += __uint_as_float(v.z << 16); sm[5] += __uint_as_float(v.z & 0xffff0000u); sm[6] += __uint_as_float(v.w << 16); sm[7] += __uint_as_float(v.w & 0xffff0000u); }
            const float ic = 1.f / (float)cnt;
            u32x4 o;
            o.x = pk2(sm[0] * ic - __uint_as_float(u0.x << 16), sm[1] * ic - __uint_as_float(u0.x & 0xffff0000u)); o.y = pk2(sm[2] * ic - __uint_as_float(u0.y << 16), sm[3] * ic - __uint_as_float(u0.y & 0xffff0000u));
            o.z = pk2(sm[4] * ic - __uint_as_float(u0.z << 16), sm[5] * ic - __uint_as_float(u0.z & 0xffff0000u)); o.w = pk2(sm[6] * ic - __uint_as_float(u0.w << 16), sm[7] * ic - __uint_as_float(u0.w & 0xffff0000u));
            *(u32x4*)(Dl + tt * RT_P + 8 * pc) = o; }
        __syncthreads();
        const bf16* wp = wpt + (size_t)g * 16384 + (16 * wave + fr) * 128 + 8 * fq;
        bf16x8 bw[4];
#pragma unroll
        for (int ks = 0; ks < 4; ++ks) bw[ks] = *(const bf16x8*)(wp + 32 * ks);
        const float sc = pscale[g * 128 + 16 * wave + fr];
#pragma unroll
        for (int tt = 0; tt < 4; ++tt) { f32x4v d = (f32x4v){0.f, 0.f, 0.f, 0.f};
#pragma unroll
            for (int ks = 0; ks < 4; ++ks) d = __builtin_amdgcn_mfma_f32_16x16x32_bf16(*(const bf16x8*)(Dl + (16 * tt + fr) * RT_P + 32 * ks + 8 * fq), bw[ks], d, 0, 0, 0);
#pragma unroll
            for (int r = 0; r < 4; ++r) br23[((size_t)(b * T + tb * 64 + 16 * tt + 4 * fq + r)) * D + 512 + g * 128 + 16 * wave + fr] = (bf16)f2bf(d[r] * sc); }
        __syncthreads();
    }
}
__device__ __forceinline__ float row16_max(float v) {
    v = fmaxf(v, __builtin_bit_cast(float, __builtin_amdgcn_mov_dpp(__builtin_bit_cast(int, v), 0xB1, 0xf, 0xf, true)));
    v = fmaxf(v, __builtin_bit_cast(float, __builtin_amdgcn_mov_dpp(__builtin_bit_cast(int, v), 0x4E, 0xf, 0xf, true)));
    v = fmaxf(v, __builtin_bit_cast(float, __builtin_amdgcn_mov_dpp(__builtin_bit_cast(int, v), 0x141, 0xf, 0xf, true)));
    v = fmaxf(v, __builtin_bit_cast(float, __builtin_amdgcn_mov_dpp(__builtin_bit_cast(int, v), 0x140, 0xf, 0xf, true)));
    return v;
}
__device__ __forceinline__ float row16_sum(float v) {
    v += __builtin_bit_cast(float, __builtin_amdgcn_mov_dpp(__builtin_bit_cast(int, v), 0xB1, 0xf, 0xf, true));
    v += __builtin_bit_cast(float, __builtin_amdgcn_mov_dpp(__builtin_bit_cast(int, v), 0x4E, 0xf, 0xf, true));
    v += __builtin_bit_cast(float, __builtin_amdgcn_mov_dpp(__builtin_bit_cast(int, v), 0x141, 0xf, 0xf, true));
    v += __builtin_bit_cast(float, __builtin_amdgcn_mov_dpp(__builtin_bit_cast(int, v), 0x140, 0xf, 0xf, true));
    return v;
}
constexpr int SWA_KP = 72, SWA_VP = 264, SWA_PP = 168;
__device__ __forceinline__ void swa_phase(const bf16* proj, const bf16* akv, const float* sink, bf16* br01, char* lds, int G) {
    int tid = threadIdx.x; asm volatile("" : "+v"(tid)); const int lane = tid & 63, wave = tid >> 6;
    bf16* Kl = (bf16*)lds; bf16* Vt = (bf16*)(lds + 36864); bf16* Pw = (bf16*)(lds + 36864 + 33792) + wave * 16 * SWA_PP;
    for (int un = blockIdx.x; un < 512; un += G) {
        const int nb = un & 31, kvh = (un >> 5) & 1, b = un >> 6;
        const size_t m0 = (size_t)b * T + nb * 128;
#pragma unroll
        for (int i = 0; i < 4; ++i) { const int idx = tid + 512 * i, key = idx >> 3, pc = idx & 7;
            u32x4 kv = (u32x4){0u, 0u, 0u, 0u}, vv = kv;
            if (nb > 0 || key >= 128) { const bf16* src = akv + (m0 - 128 + key) * 256 + kvh * 64 + pc * 8; kv = *(const u32x4*)src; vv = *(const u32x4*)(src + 128); }
            *(u32x4*)(Kl + key * SWA_KP + pc * 8) = kv;
            bf16* vd = Vt + (pc * 8) * SWA_VP + key;
            vd[0] = (bf16)(vv.x & 0xffffu); vd[SWA_VP] = (bf16)(vv.x >> 16); vd[2 * SWA_VP] = (bf16)(vv.y & 0xffffu); vd[3 * SWA_VP] = (bf16)(vv.y >> 16);
            vd[4 * SWA_VP] = (bf16)(vv.z & 0xffffu); vd[5 * SWA_VP] = (bf16)(vv.z >> 16); vd[6 * SWA_VP] = (bf16)(vv.w & 0xffffu); vd[7 * SWA_VP] = (bf16)(vv.w >> 16); }
        __syncthreads();
        const int g = wave >> 1, head = kvh * 4 + g, fr = lane & 15, fq = lane >> 4;
        const float sk = sink[head];
#pragma unroll 1
        for (int j = 0; j < 4; ++j) {
            const int a = (wave & 1) * 4 + j, i0 = 16 * a, ap = a & ~1;
            const bf16* qp = proj + (m0 + i0 + fr) * NPROJ + C_AQ + head * 64 + 8 * fq;
            const bf16x8 q0 = *(const bf16x8*)qp, q1 = *(const bf16x8*)(qp + 32);
            f32x4v sv[10];
#pragma unroll
            for (int kt = 0; kt < 10; ++kt) {
                const bf16* kp = Kl + (16 * (ap + kt) + fr) * SWA_KP + 8 * fq;
                f32x4v d = (f32x4v){0.f, 0.f, 0.f, 0.f};
                d = __builtin_amdgcn_mfma_f32_16x16x32_bf16(q0, *(const bf16x8*)kp, d, 0, 0, 0);
                d = __builtin_amdgcn_mfma_f32_16x16x32_bf16(q1, *(const bf16x8*)(kp + 32), d, 0, 0, 0);
                sv[kt] = d;
            }
            float mx[4] = {-INFINITY, -INFINITY, -INFINITY, -INFINITY};
#pragma unroll
            for (int kt = 0; kt < 10; ++kt) { const int kabs = 16 * (ap + kt) + fr;
#pragma unroll
                for (int r = 0; r < 4; ++r) { const int i = i0 + 4 * fq + r; const bool ok = (kabs >= i + 1) && (kabs <= i + 128) && (nb > 0 || kabs >= 128);
                    const float x = ok ? sv[kt][r] * 0.125f : -INFINITY; sv[kt][r] = x; mx[r] = fmaxf(mx[r], x); } }
            float den[4];
#pragma unroll
            for (int r = 0; r < 4; ++r) { mx[r] = fmaxf(row16_max(mx[r]), sk); den[r] = 0.f; }
#pragma unroll
            for (int kt = 0; kt < 10; ++kt)
#pragma unroll
                for (int r = 0; r < 4; ++r) { const float pv = __expf(sv[kt][r] - mx[r]); den[r] += pv; Pw[(4 * fq + r) * SWA_PP + 16 * kt + fr] = (bf16)f2bf(pv); }
#pragma unroll
            for (int r = 0; r < 4; ++r) den[r] = 1.f / (row16_sum(den[r]) + __expf(sk - mx[r]));
            LDS_WAIT();
            f32x4v o[4];
#pragma unroll
            for (int dt = 0; dt < 4; ++dt) o[dt] = (f32x4v){0.f, 0.f, 0.f, 0.f};
#pragma unroll
            for (int ks = 0; ks < 5; ++ks) { const bf16x8 pa = *(const bf16x8*)(Pw + fr * SWA_PP + 32 * ks + 8 * fq);
#pragma unroll
                for (int dt = 0; dt < 4; ++dt) o[dt] = __builtin_amdgcn_mfma_f32_16x16x32_bf16(pa, *(const bf16x8*)(Vt + (16 * dt + fr) * SWA_VP + 16 * ap + 32 * ks + 8 * fq), o[dt], 0, 0, 0); }
#pragma unroll
            for (int r = 0; r < 4; ++r) { bf16* op = br01 + (m0 + i0 + 4 * fq + r) * D + head * 64 + fr;
#pragma unroll
                for (int dt = 0; dt < 4; ++dt) op[16 * dt] = (bf16)f2bf(o[dt][r] * den[r]); }
            LDS_WAIT();
        }
        __syncthreads();
    }
}
typedef float f32x16 __attribute__((ext_vector_type(16)));
constexpr int DSA_S = 4100;
constexpr int DSA_WOFF = 8 * DSA_S * 4;
__device__ __forceinline__ float dpp_x1(float x) { return __builtin_bit_cast(float, __builtin_amdgcn_mov_dpp(__builtin_bit_cast(int, x), 0xB1, 0xf, 0xf, true)); }
__device__ __forceinline__ float dpp_x2(float x) { return __builtin_bit_cast(float, __builtin_amdgcn_mov_dpp(__builtin_bit_cast(int, x), 0x4E, 0xf, 0xf, true)); }
__device__ __forceinline__ int wave_sum_i(int v) {
    v += __builtin_amdgcn_mov_dpp(v, 0xB1, 0xf, 0xf, true);
    v += __builtin_amdgcn_mov_dpp(v, 0x4E, 0xf, 0xf, true);
    v += __builtin_amdgcn_mov_dpp(v, 0x141, 0xf, 0xf, true);
    v += __builtin_amdgcn_mov_dpp(v, 0x140, 0xf, 0xf, true);
    v += __builtin_amdgcn_update_dpp(0, v, 0x142, 0xa, 0xf, false);
    v += __builtin_amdgcn_update_dpp(0, v, 0x143, 0xc, 0xf, false);
    return __builtin_amdgcn_readlane(v, 63);
}
__device__ __forceinline__ unsigned sortable(float f) { const unsigned u = __float_as_uint(f); return (u >> 31) ? ~u : (u | 0x80000000u); }
__device__ __forceinline__ void dsa_scores(const bf16* pb, const bf16* ikb, int t0, float* scl, int wave, int lane) {
    const int n = lane & 31, kh = lane >> 5, q = n >> 2, h = n & 3;
    const bf16* qrow = pb + (size_t)(t0 + q) * NPROJ;
    bf16x8 Bq[4];
#pragma unroll
    for (int ks = 0; ks < 4; ++ks) Bq[ks] = *(const bf16x8*)(qrow + C_IQ + h * 64 + 16 * ks + 8 * kh);
    const float wq = bf2f(qrow[C_IW + h]) * 0.0625f;
    const int ntile = (t0 + 8 + 31) >> 5;
    float* dst = scl + q * DSA_S + h + 4 * kh;
#pragma unroll 1
    for (int tile0 = wave; tile0 < ntile; tile0 += 32) {
        bf16x8 a[4][4];
#pragma unroll
        for (int u = 0; u < 4; ++u) { const int tile = tile0 + 8 * u; const int row = (tile < ntile) ? tile * 32 + n : n;
            const bf16* krow = ikb + (size_t)row * 64 + 8 * kh;
#pragma unroll
            for (int ks = 0; ks < 4; ++ks) a[u][ks] = *(const bf16x8*)(krow + 16 * ks); }
#pragma unroll
        for (int u = 0; u < 4; ++u) { const int tile = tile0 + 8 * u;
            if (tile < ntile) {
                f32x16 d;
#pragma unroll
                for (int r = 0; r < 16; ++r) d[r] = 0.f;
#pragma unroll
                for (int ks = 0; ks < 4; ++ks) d = __builtin_amdgcn_mfma_f32_32x32x16_bf16(a[u][ks], Bq[ks], d, 0, 0, 0);
                float v[16];
#pragma unroll
                for (int r = 0; r < 16; ++r) { float x = fmaxf(d[r], 0.f) * wq; x += dpp_x1(x); x += dpp_x2(x); v[r] = x; }
#pragma unroll
                for (int k = 0; k < 4; ++k) { const float val = (h == 0) ? v[4 * k] : (h == 1) ? v[4 * k + 1] : (h == 2) ? v[4 * k + 2] : v[4 * k + 3]; dst[tile * 32 + 8 * k] = val + 0.f; }
            } }
    }
}
__device__ __forceinline__ void dsa_select(int t, const float* sc, char* wl, int lane) {
    unsigned short* sel = (unsigned short*)(wl + 512);
    const int nk = t + 1;
    const int K = nk < 256 ? nk : 256;
    const int nj = (nk + 63) >> 6;
    unsigned key[64];
#pragma unroll
    for (int j = 0; j < 64; ++j) { const int s = 64 * j + lane; key[j] = (j < nj && s < nk) ? sortable(sc[s]) : 0u; }
    unsigned Tk = 1u;
    if (nk > 256) {
        Tk = 0u;
        for (int bit = 31; bit >= 0; --bit) {
            const unsigned cand = Tk | (1u << bit); int c = 0;
#pragma unroll
            for (int jg = 0; jg < 4; ++jg) if (16 * jg < nj) {
#pragma unroll
                for (int j = 16 * jg; j < 16 * jg + 16; ++j) c += (key[j] >= cand) ? 1 : 0; }
            const int tot = wave_sum_i(c);
            if (tot >= K) Tk = cand;
            if (tot == K) break;
        }
    }
    int cgt_l = 0;
#pragma unroll
    for (int j = 0; j < 64; ++j) cgt_l += (key[j] > Tk) ? 1 : 0;
    const int need = K - wave_sum_i(cgt_l);
    const unsigned long long lt = (1ull << lane) - 1ull;
    int pos = 0, ties = 0;
#pragma unroll
    for (int jg = 0; jg < 4; ++jg) if (16 * jg < nj) {
#pragma unroll
        for (int j = 16 * jg; j < 16 * jg + 16; ++j) {
            const bool gt = key[j] > Tk, eq = key[j] == Tk;
            const unsigned long long meq = __ballot(eq);
            const bool take = gt || (eq && (ties + __popcll(meq & lt)) < need);
            const unsigned long long mt = __ballot(take);
            if (take) sel[pos + __popcll(mt & lt)] = (unsigned short)(64 * j + lane);
            pos += __popcll(mt); ties += __popcll(meq);
        }
    }
    LDS_WAIT();
}
typedef short v4i16_t __attribute__((ext_vector_type(4)));
constexpr int DSA_VP = 72, DSA_PP = 264;
template <int MODE> __device__ __forceinline__ void dsa_attend(const bf16* proj, const bf16* kvb, bf16* br01, int b, int t, float* sc, char* wl, int lane) {
    const unsigned short* sel = (const unsigned short*)(wl + 512);
    const size_t m = (size_t)b * T + t;
    const bf16* prow = proj + m * NPROJ;
    const int K = (t + 1) < 256 ? (t + 1) : 256;
    const int fr = lane & 15, fq = lane >> 4;
    bf16* Vst = (bf16*)sc; bf16* Pl = (bf16*)sc + 64 * DSA_VP;
    LAS const char* vst3 = (LAS const char*)Vst;
    const int nch = (MODE & 1) ? 0 : ((K + 63) >> 6);
    bf16x8 qa[2][2];
#pragma unroll
    for (int kvh = 0; kvh < 2; ++kvh) { const bf16* qp = prow + C_BQ + (kvh * 4 + (fr & 3)) * 64 + 8 * fq; qa[kvh][0] = *(const bf16x8*)qp; qa[kvh][1] = *(const bf16x8*)(qp + 32); }
#pragma unroll
    for (int kvh = 0; kvh < 2; ++kvh) {
        f32x4v lg[16];
        {
            bf16x8 kb[16][2];
#pragma unroll
            for (int i = 0; i < 16; ++i) { const int s_ = (int)sel[16 * i + fr]; const bf16* kp = kvb + (size_t)s_ * 256 + kvh * 64 + 8 * fq;
                kb[i][0] = *(const bf16x8*)kp; kb[i][1] = *(const bf16x8*)(kp + 32); }
#pragma unroll
            for (int et = 0; et < 16; ++et) {
                f32x4v d = (f32x4v){0.f, 0.f, 0.f, 0.f};
                d = __builtin_amdgcn_mfma_f32_16x16x32_bf16(qa[kvh][0], kb[et][0], d, 0, 0, 0);
                d = __builtin_amdgcn_mfma_f32_16x16x32_bf16(qa[kvh][1], kb[et][1], d, 0, 0, 0);
                if (16 * et + fr >= K) d = (f32x4v){-INFINITY, -INFINITY, -INFINITY, -INFINITY};
                lg[et] = d; }
        }
        u32x4 va[8], vb[8];
#pragma unroll
        for (int i = 0; i < 8; ++i) va[i] = *(const u32x4*)(kvb + (size_t)sel[8 * i + (lane >> 3)] * 256 + 128 + kvh * 64 + 8 * (lane & 7));
#pragma unroll
        for (int i = 0; i < 8; ++i) vb[i] = *(const u32x4*)(kvb + (size_t)sel[64 + 8 * i + (lane >> 3)] * 256 + 128 + kvh * 64 + 8 * (lane & 7));
#pragma unroll
        for (int r = 0; r < 4; ++r) {
            float mx = lg[0][r];
#pragma unroll
            for (int et = 1; et < 16; ++et) mx = fmaxf(mx, lg[et][r]);
            mx = row16_max(mx);
            float sm = 0.f;
#pragma unroll
            for (int et = 0; et < 16; ++et) { const float pv = __builtin_amdgcn_exp2f((lg[et][r] - mx) * (0.125f * 1.44269504f)); lg[et][r] = pv; sm += pv; }
            const float inv = 1.f / row16_sum(sm);
            if (fq == 0) {
#pragma unroll
                for (int et = 0; et < 16; ++et) Pl[r * DSA_PP + 16 * et + fr] = (bf16)f2bf(lg[et][r] * inv); }
        }
        f32x4v o[4];
#pragma unroll
        for (int dt = 0; dt < 4; ++dt) o[dt] = (f32x4v){0.f, 0.f, 0.f, 0.f};
#define DSA_PV_CHUNK(c, buf, nextc) do { \
            LDS_WAIT(); \
            _Pragma("unroll") for (int i = 0; i < 8; ++i) *(u32x4*)(Vst + (8 * i + (lane >> 3)) * DSA_VP + 8 * (lane & 7)) = buf[i]; \
            if ((nextc) < nch) { \
                _Pragma("unroll") for (int i = 0; i < 8; ++i) buf[i] = *(const u32x4*)(kvb + (size_t)sel[64 * (nextc) + 8 * i + (lane >> 3)] * 256 + 128 + kvh * 64 + 8 * (lane & 7)); } \
            LDS_WAIT(); \
            _Pragma("unroll") for (int ks = 0; ks < 2; ++ks) { \
                const bf16x8 pa = *(const bf16x8*)(Pl + (fr & 3) * DSA_PP + 64 * (c) + 32 * ks + 8 * fq); \
                _Pragma("unroll") for (int dt = 0; dt < 4; ++dt) { \
                    LAS const char* a0 = vst3 + ((32 * ks + 8 * fq + (fr >> 2)) * DSA_VP + 16 * dt + 4 * (fr & 3)) * 2; \
                    const v4i16_t lo = __builtin_amdgcn_ds_read_tr16_b64_v4i16((LAS v4i16_t*)a0); \
                    const v4i16_t hi = __builtin_amdgcn_ds_read_tr16_b64_v4i16((LAS v4i16_t*)(a0 + 4 * DSA_VP * 2)); \
                    bf16x8 bv; bv[0] = lo[0]; bv[1] = lo[1]; bv[2] = lo[2]; bv[3] = lo[3]; bv[4] = hi[0]; bv[5] = hi[1]; bv[6] = hi[2]; bv[7] = hi[3]; \
                    o[dt] = __builtin_amdgcn_mfma_f32_16x16x32_bf16(pa, bv, o[dt], 0, 0, 0); } } } while (0)
        if (nch > 0) DSA_PV_CHUNK(0, va, 2);
        if (nch > 1) DSA_PV_CHUNK(1, vb, 3);
        if (nch > 2) DSA_PV_CHUNK(2, va, 4);
        if (nch > 3) DSA_PV_CHUNK(3, vb, 5);
#undef DSA_PV_CHUNK
        const f32x4v ov = (fq == 0) ? o[0] : (fq == 1) ? o[1] : (fq == 2) ? o[2] : o[3];
        bf16* op = br01 + m * D + 512 + kvh * 256 + 16 * fq + fr;
#pragma unroll
        for (int r = 0; r < 4; ++r) op[r * 64] = (bf16)f2bf(ov[r]);
        LDS_WAIT();
    }
}
__device__ __forceinline__ void dsa_phase(const bf16* proj, const bf16* bkv, const bf16* ik, bf16* br01, char* lds, int G) {
    int tid = threadIdx.x; asm volatile("" : "+v"(tid)); const int lane = tid & 63, wave = tid >> 6;
    float* scl = (float*)lds;
    char* wl = lds + DSA_WOFF + wave * 1024;
    const int c = blockIdx.x, b = c & 7, j = c >> 3, R = G >> 3;
    const bf16* pb = proj + (size_t)b * T * NPROJ; const bf16* kvb = bkv + (size_t)b * T * 256; const bf16* ikb = ik + (size_t)b * T * 64;
    ((unsigned*)(wl + 512))[lane] = 0u; ((unsigned*)(wl + 512))[lane + 64] = 0u;
    for (int k = 0; ; ++k) {
        const int u = (k & 1) ? (R - 1 - j) + R * k : j + R * k;
        if (u >= T / 8) break;
        const int t0 = 8 * u;
        int l1 = lane; asm volatile("" : "+v"(l1));
        for (int r_ = 0; r_ < REP(4); ++r_) dsa_scores(pb, ikb, t0, scl, wave, l1);
        __syncthreads();
        int l2 = lane; asm volatile("" : "+v"(l2));
        for (int r_ = 0; r_ < REP(5); ++r_) dsa_select(t0 + wave, scl + wave * DSA_S, wl, l2);
        int l3 = lane; asm volatile("" : "+v"(l3));
        if (REP(6) > 1) dsa_attend<1>(proj, kvb, br01, b, t0 + wave, scl + wave * DSA_S, wl, l3);
        dsa_attend<0>(proj, kvb, br01, b, t0 + wave, scl + wave * DSA_S, wl, l3);
        __syncthreads();
    }
}
__device__ __forceinline__ void ret_u_phase(const bf16* proj, float* U, char* lds, int G) {
    int tid = threadIdx.x; asm volatile("" : "+v"(tid)); const int lane = tid & 63, wave = tid >> 6, fr = lane & 15, fq = lane >> 4;
    bf16* KdT = (bf16*)lds; bf16* VT = (bf16*)(lds + 17408);
    for (int un = blockIdx.x; un < 1024; un += G) {
        const int c = un & 31, bh = un >> 5, h = bh & 3, b = bh >> 2;
        const float lg2 = log2f(1.f - exp2f(-5.f - (float)h));
        const size_t m0 = (size_t)b * T + c * 128;
#pragma unroll
        for (int i = 0; i < 2; ++i) { const int idx = tid + 512 * i, mm = idx >> 3, pc = idx & 7;
            const u32x4 kv = *(const u32x4*)(proj + (m0 + mm) * NPROJ + C_RK + 64 * h + 8 * pc);
            const float dc = 0.125f * exp2f(lg2 * (float)(127 - mm));
            bf16* kd = KdT + (8 * pc) * RT_P + mm;
            kd[0] = (bf16)f2bf(__uint_as_float(kv.x << 16) * dc); kd[RT_P] = (bf16)f2bf(__uint_as_float(kv.x & 0xffff0000u) * dc);
            kd[2 * RT_P] = (bf16)f2bf(__uint_as_float(kv.y << 16) * dc); kd[3 * RT_P] = (bf16)f2bf(__uint_as_float(kv.y & 0xffff0000u) * dc);
            kd[4 * RT_P] = (bf16)f2bf(__uint_as_float(kv.z << 16) * dc); kd[5 * RT_P] = (bf16)f2bf(__uint_as_float(kv.z & 0xffff0000u) * dc);
            kd[6 * RT_P] = (bf16)f2bf(__uint_as_float(kv.w << 16) * dc); kd[7 * RT_P] = (bf16)f2bf(__uint_as_float(kv.w & 0xffff0000u) * dc); }
#pragma unroll
        for (int i = 0; i < 4; ++i) { const int idx = tid + 512 * i, mm = idx >> 4, pc = idx & 15;
            const u32x4 vv = *(const u32x4*)(proj + (m0 + mm) * NPROJ + C_RV + 128 * h + 8 * pc);
            bf16* vd = VT + (8 * pc) * RT_P + mm;
            vd[0] = (bf16)(vv.x & 0xffffu); vd[RT_P] = (bf16)(vv.x >> 16); vd[2 * RT_P] = (bf16)(vv.y & 0xffffu); vd[3 * RT_P] = (bf16)(vv.y >> 16);
            vd[4 * RT_P] = (bf16)(vv.z & 0xffffu); vd[5 * RT_P] = (bf16)(vv.z >> 16); vd[6 * RT_P] = (bf16)(vv.w & 0xffffu); vd[7 * RT_P] = (bf16)(vv.w >> 16); }
        __syncthreads();
        f32x4v acc[4];
#pragma unroll
        for (int dt = 0; dt < 4; ++dt) acc[dt] = (f32x4v){0.f, 0.f, 0.f, 0.f};
#pragma unroll
        for (int ks = 0; ks < 4; ++ks) { const bf16x8 bv = *(const bf16x8*)(VT + (16 * wave + fr) * RT_P + 32 * ks + 8 * fq);
#pragma unroll
            for (int dt = 0; dt < 4; ++dt) acc[dt] = __builtin_amdgcn_mfma_f32_16x16x32_bf16(*(const bf16x8*)(KdT + (16 * dt + fr) * RT_P + 32 * ks + 8 * fq), bv, acc[dt], 0, 0, 0); }
        float* up = U + (size_t)un * 8192;
#pragma unroll
        for (int dt = 0; dt < 4; ++dt)
#pragma unroll
            for (int r = 0; r < 4; ++r) up[(16 * dt + 4 * fq + r) * 128 + 16 * wave + fr] = acc[dt][r];
        __syncthreads();
    }
}
__device__ __forceinline__ void ret_scan_phase(const float* U, bf16* ST, int G) {
    int tid = threadIdx.x; asm volatile("" : "+v"(tid));
    for (int w = blockIdx.x; w < 256; w += G) {
        const int bh = w >> 3, part = w & 7, h = bh & 3;
        const float cd = exp2f(128.f * log2f(1.f - exp2f(-5.f - (float)h)));
        const int e2 = part * 512 + tid, dv = e2 & 127, dp = e2 >> 7;
        const float* up = U + (size_t)bh * 32 * 8192 + (2 * dp) * 128 + dv;
        unsigned* sp = (unsigned*)(ST + (size_t)bh * 32 * 8192 + dv * 64 + 2 * dp);
        float u0[32], u1[32];
#pragma unroll
        for (int j = 0; j < 31; ++j) { u0[j] = up[(size_t)j * 8192]; u1[j] = up[(size_t)j * 8192 + 128]; }
        float s0 = 0.f, s1 = 0.f;
        sp[0] = 0u;
#pragma unroll
        for (int c = 1; c < 32; ++c) { s0 = s0 * cd + u0[c - 1]; s1 = s1 * cd + u1[c - 1]; sp[(size_t)c * 4096] = pk2(s0, s1); }
    }
}
__device__ __forceinline__ void ret_out_phase(const bf16* proj, const bf16* ST, bf16* br23, char* lds, int G) {
    int tid = threadIdx.x; asm volatile("" : "+v"(tid)); const int lane = tid & 63, wave = tid >> 6, fr = lane & 15, fq = lane >> 4;
    bf16* Kl = (bf16*)lds; bf16* VT = (bf16*)(lds + 18432); bf16* Pw = (bf16*)(lds + 18432 + 34816) + wave * 16 * RT_P;
    for (int un = blockIdx.x; un < 1024; un += G) {
        const int c = un & 31, bh = un >> 5, h = bh & 3, b = bh >> 2;
        const float lg2 = log2f(1.f - exp2f(-5.f - (float)h));
        const size_t m0 = (size_t)b * T + c * 128;
#pragma unroll
        for (int i = 0; i < 2; ++i) { const int idx = tid + 512 * i, mm = idx >> 3, pc = idx & 7;
            *(u32x4*)(Kl + mm * 72 + 8 * pc) = *(const u32x4*)(proj + (m0 + mm) * NPROJ + C_RK + 64 * h + 8 * pc); }
#pragma unroll
        for (int i = 0; i < 4; ++i) { const int idx = tid + 512 * i, mm = idx >> 4, pc = idx & 15;
            const u32x4 vv = *(const u32x4*)(proj + (m0 + mm) * NPROJ + C_RV + 128 * h + 8 * pc);
            bf16* vd = VT + (8 * pc) * RT_P + mm;
            vd[0] = (bf16)(vv.x & 0xffffu); vd[RT_P] = (bf16)(vv.x >> 16); vd[2 * RT_P] = (bf16)(vv.y & 0xffffu); vd[3 * RT_P] = (bf16)(vv.y >> 16);
            vd[4 * RT_P] = (bf16)(vv.z & 0xffffu); vd[5 * RT_P] = (bf16)(vv.z >> 16); vd[6 * RT_P] = (bf16)(vv.w & 0xffffu); vd[7 * RT_P] = (bf16)(vv.w >> 16); }
        __syncthreads();
        const bf16* qp = proj + (m0 + 16 * wave + fr) * NPROJ + C_RQ + 64 * h + 8 * fq;
        const bf16x8 q0 = *(const bf16x8*)qp, q1 = *(const bf16x8*)(qp + 32);
        const bf16* stp = ST + (size_t)un * 8192;
        f32x4v acc[8];
#pragma unroll
        for (int dt = 0; dt < 8; ++dt) { f32x4v d = (f32x4v){0.f, 0.f, 0.f, 0.f};
            const bf16* sp = stp + (16 * dt + fr) * 64 + 8 * fq;
            d = __builtin_amdgcn_mfma_f32_16x16x32_bf16(q0, *(const bf16x8*)sp, d, 0, 0, 0);
            d = __builtin_amdgcn_mfma_f32_16x16x32_bf16(q1, *(const bf16x8*)(sp + 32), d, 0, 0, 0);
            acc[dt] = d; }
#pragma unroll
        for (int r = 0; r < 4; ++r) { const float qd = exp2f(lg2 * (float)(16 * wave + 4 * fq + r + 1));
#pragma unroll
            for (int dt = 0; dt < 8; ++dt) acc[dt][r] *= qd; }
#pragma unroll
        for (int mt = 0; mt < 8; ++mt) {
            f32x4v d = (f32x4v){0.f, 0.f, 0.f, 0.f};
            if (mt <= wave) { const bf16* kp = Kl + (16 * mt + fr) * 72 + 8 * fq;
                d = __builtin_amdgcn_mfma_f32_16x16x32_bf16(q0, *(const bf16x8*)kp, d, 0, 0, 0);
                d = __builtin_amdgcn_mfma_f32_16x16x32_bf16(q1, *(const bf16x8*)(kp + 32), d, 0, 0, 0); }
            const int mm = 16 * mt + fr;
#pragma unroll
            for (int r = 0; r < 4; ++r) { const int n = 16 * wave + 4 * fq + r;
                const float pv = (mm <= n) ? d[r] * 0.125f * exp2f(lg2 * (float)(n - mm)) : 0.f;
                Pw[(4 * fq + r) * RT_P + mm] = (bf16)f2bf(pv); }
        }
        LDS_WAIT();
#pragma unroll
        for (int ks = 0; ks < 4; ++ks) { const bf16x8 pa = *(const bf16x8*)(Pw + fr * RT_P + 32 * ks + 8 * fq);
#pragma unroll
            for (int dt = 0; dt < 8; ++dt) acc[dt] = __builtin_amdgcn_mfma_f32_16x16x32_bf16(pa, *(const bf16x8*)(VT + (16 * dt + fr) * RT_P + 32 * ks + 8 * fq), acc[dt], 0, 0, 0); }
#pragma unroll
        for (int r = 0; r < 4; ++r) { float q = 0.f;
#pragma unroll
            for (int dt = 0; dt < 8; ++dt) q += acc[dt][r] * acc[dt][r];
            const float rs = 1.f / sqrtf(row16_sum(q) * (1.f / 128.f) + EPS);
            const size_t row = m0 + 16 * wave + 4 * fq + r;
            const bf16* gp = proj + row * NPROJ + C_RG + 128 * h + fr; bf16* op = br23 + row * D + h * 128 + fr;
#pragma unroll
            for (int dt = 0; dt < 8; ++dt) { const float gv = bf2f(gp[16 * dt]); op[16 * dt] = (bf16)f2bf(gv / (1.f + __expf(-gv)) * acc[dt][r] * rs); } }
        __syncthreads();
    }
}

typedef const __attribute__((address_space(4))) Args* KArgs;
__device__ __forceinline__ KArgs kargs() { KArgs p = (KArgs)__builtin_amdgcn_kernarg_segment_ptr(); asm volatile("" : "+s"(p)); return p; }

__device__ __forceinline__ void ph0(LAS unsigned char* L, int layer, int slot) {
    int tid = threadIdx.x; asm volatile("" : "+v"(tid)); const int lane = tid & 63, wave = __builtin_amdgcn_readfirstlane(tid >> 6);
    int G = gridDim.x, bx = blockIdx.x; asm volatile("" : "+s"(G), "+s"(bx)); const int gw = bx * 8 + wave, NGW = G * 8;
    unsigned char* lds = (unsigned char*)L; LAS int* lcnt = (LAS int*)(L + 0); LAS int* gt = (LAS int*)(L + LDS_MISC + 512);
    (void)lane; (void)gw; (void)NGW; (void)lds; (void)lcnt; (void)gt; (void)layer; (void)slot; (void)tid; (void)bx; (void)G;
    {
        KArgs A = kargs(); unsigned char* ws = A->ws;
        LAS float* scr = (LAS float*)(L + wave * 16384);
        constexpr int I_IN = 16 * 128, I_G = 16 * 128, I_B = 8 * 32, I_SQ = 16 * 32, I_L = I_IN + I_G + 4 * I_B + 5 * I_SQ;
        constexpr int I_GU = 16 * 224, I_DN = 56 * 32, NITEMS = 2 * I_L + I_GU + I_DN;
        for (int it = gw; it < NITEMS; it += NGW) {
            int r = it;
            if (r < 2 * I_L) {
                const int l = r / I_L; r -= l * I_L;
                unsigned char* wb = ws + WS_W + (size_t)l * W_LAYER;
                const float* win = A->w_in + (size_t)l * D * D_IN;
                if (r < I_IN) { conv_seg<1>(win, D, D_IN, 0, (bf16*)(wb + W_IN), D, 0, 128, r, scr, lane); continue; } r -= I_IN;
                if (r < I_G) { conv_seg<0>(win, D, D_IN, 3908, (bf16*)(wb + W_G), D, 0, 128, r, scr, lane); continue; } r -= I_G;
                if (r < 4 * I_B) { const int i = r / I_B; r -= i * I_B;
                    conv_seg<0>(A->w_branch + ((size_t)l * 4 + i) * 512 * D, 512, D, 0, (bf16*)(wb + W_B) + (size_t)(i >> 1) * D * D, D, (i & 1) * 512, 32, r, scr, lane); continue; } r -= 4 * I_B;
                if (r < I_SQ) { conv_seg<0>(A->w_out + (size_t)l * D * D, D, D, 0, (bf16*)(wb + W_OUT), D, 0, 32, r, scr, lane); continue; } r -= I_SQ;
                if (r < I_SQ) { conv_seg<0>(A->w_xq + (size_t)l * D * D, D, D, 0, (bf16*)(wb + W_XQ), D, 0, 32, r, scr, lane); continue; } r -= I_SQ;
                if (r < I_SQ) { conv_seg<0>(A->w_xkv + (size_t)l * D * 2 * D, D, 2 * D, 0, (bf16*)(wb + W_XK), D, 0, 32, r, scr, lane); continue; } r -= I_SQ;
                if (r < I_SQ) { conv_seg<0>(A->w_xkv + (size_t)l * D * 2 * D, D, 2 * D, D, (bf16*)(wb + W_XV), D, 0, 32, r, scr, lane); continue; } r -= I_SQ;
                conv_seg<0>(A->w_xo + (size_t)l * D * D, D, D, 0, (bf16*)(wb + W_XO), D, 0, 32, r, scr, lane); continue;
            }
            r -= 2 * I_L;
            if (r < I_GU) { conv_seg<2>(A->dense_w_gu, D, 2 * DFF, 0, (bf16*)(ws + WS_WGU), D, 0, 224, r, scr, lane); continue; } r -= I_GU;
            conv_seg<0>(A->dense_w_down, DFF, D, 0, (bf16*)(ws + WS_WDN), DFF, 0, 32, r, scr, lane);
        }
        for (int it = gw; it < 64; it += NGW) { const int lg = it >> 3;
            conv_seg<0>(A->pool_w + (size_t)lg * 16384, 128, 128, 0, (bf16*)(ws + WS_WPOOL) + (size_t)lg * 16384, 128, 0, 4, it & 7, scr, lane); }
        {
            float* cosT = (float*)(ws + WS_ROPE); float* sinT = cosT + (size_t)M * 32; const int* pos = A->positions;
            for (int i = bx * 512 + tid; i < M * 32; i += G * 512) { const int m = i >> 5, j = i & 31;
                const float ang = (float)pos[m] * INV_FREQ[j];
                const double rev = (double)ang * 0.15915494309189533577; const float fr_ = (float)(rev - rint(rev));
                cosT[i] = __builtin_amdgcn_cosf(fr_); sinT[i] = __builtin_amdgcn_sinf(fr_); }
        }
        {
            const float* mem = A->mem; const float* nm = A->norm_mem; bf16* MN = (bf16*)(ws + WS_MN);
            for (int r = gw; r < 2 * MROWS; r += NGW) { const int l = r / MROWS, mr = r % MROWS; norm_row_bf16(mem + (size_t)mr * D, nm + (size_t)l * D, MN + (size_t)r * D, lane); }
            const float* x = A->x; const float* g = A->norm_mix; bf16* HB = (bf16*)(ws + WS_HB);
            for (int m = gw; m < M; m += NGW) norm_row_bf16(x + (size_t)m * D, g, HB + (size_t)m * D, lane);
        }
    }
}
__device__ __forceinline__ void ph1(LAS unsigned char* L, int layer, int slot) {
    int tid = threadIdx.x; asm volatile("" : "+v"(tid)); const int lane = tid & 63, wave = __builtin_amdgcn_readfirstlane(tid >> 6);
    int G = gridDim.x, bx = blockIdx.x; asm volatile("" : "+s"(G), "+s"(bx)); const int gw = bx * 8 + wave, NGW = G * 8;
    unsigned char* lds = (unsigned char*)L; LAS int* lcnt = (LAS int*)(L + 0); LAS int* gt = (LAS int*)(L + LDS_MISC + 512);
    (void)lane; (void)gw; (void)NGW; (void)lds; (void)lcnt; (void)gt; (void)layer; (void)slot; (void)tid; (void)bx; (void)G;
    {
            unsigned char* ws = kargs()->ws; unsigned char* wb = ws + WS_W + (size_t)layer * W_LAYER;
            { pg8::GridSched S{(const char*)(ws + WS_HB), (const char*)(wb + W_IN), 2048u, 2048u, 128, 16, 16, G, bx};
              EpiProj E{(bf16*)(ws + WS_PROJ), (const float*)(ws + WS_ROPE), (const float*)(ws + WS_ROPE) + (size_t)M * 32, (bf16*)(ws + WS_AKV), (bf16*)(ws + WS_BKV), (bf16*)(ws + WS_IK)};
              pg8::gemm_stream(L, S, E, 2048u, 2048u); }
            if (layer == 0) {
                for (int l = 0; l < 2; ++l) {
                    unsigned char* wl = ws + WS_W + (size_t)l * W_LAYER;
                    { pg8::GridSched S{(const char*)(ws + WS_MN) + (size_t)l * MROWS * D * 2, (const char*)(wl + W_XK), 2048u, 2048u, 8, 4, 16, G, bx};
                      EpiPlain E{(bf16*)(ws + WS_KX) + (size_t)l * MROWS * D, D, 1.f};
                      pg8::gemm_stream(L, S, E, 2048u, 2048u); }
                    { pg8::GridSched S{(const char*)(wl + W_XV), (const char*)(ws + WS_MN) + (size_t)l * MROWS * D * 2, 2048u, 2048u, 4, 8, 16, G, bx};
                      EpiPlain E{(bf16*)(ws + WS_VT) + (size_t)l * D * MROWS, MROWS, 1.f};
                      pg8::gemm_stream(L, S, E, 2048u, 2048u); }
                }
            }
        }
}
__device__ __forceinline__ void ph2(LAS unsigned char* L, int layer, int slot) {
    int tid = threadIdx.x; asm volatile("" : "+v"(tid)); const int lane = tid & 63, wave = __builtin_amdgcn_readfirstlane(tid >> 6);
    int G = gridDim.x, bx = blockIdx.x; asm volatile("" : "+s"(G), "+s"(bx)); const int gw = bx * 8 + wave, NGW = G * 8;
    unsigned char* lds = (unsigned char*)L; LAS int* lcnt = (LAS int*)(L + 0); LAS int* gt = (LAS int*)(L + LDS_MISC + 512);
    (void)lane; (void)gw; (void)NGW; (void)lds; (void)lcnt; (void)gt; (void)layer; (void)slot; (void)tid; (void)bx; (void)G;
    {
            KArgs A = kargs(); unsigned char* ws = A->ws;
            const bf16* PROJ = (const bf16*)(ws + WS_PROJ);
            for (int r_ = 0; r_ < REP(0); ++r_) ret_u_phase(PROJ, (float*)(ws + WS_U), (char*)lds, G);
            for (int r_ = 0; r_ < REP(1); ++r_) pool_phase(PROJ, (const bf16*)(ws + WS_WPOOL) + (size_t)layer * 4 * 16384, A->pool_scale + (size_t)layer * 512, (bf16*)(ws + WS_BR23), (char*)lds, G);
            for (int r_ = 0; r_ < REP(2); ++r_) swa_phase(PROJ, (const bf16*)(ws + WS_AKV), A->attn_sink + layer * 8, (bf16*)(ws + WS_BR01), (char*)lds, G);
            for (int r_ = 0; r_ < REP(3); ++r_) dsa_phase(PROJ, (const bf16*)(ws + WS_BKV), (const bf16*)(ws + WS_IK), (bf16*)(ws + WS_BR01), (char*)lds, G);
        }
}
__device__ __forceinline__ void ph3(LAS unsigned char* L, int layer, int slot) {
    int tid = threadIdx.x; asm volatile("" : "+v"(tid)); const int lane = tid & 63, wave = __builtin_amdgcn_readfirstlane(tid >> 6);
    int G = gridDim.x, bx = blockIdx.x; asm volatile("" : "+s"(G), "+s"(bx)); const int gw = bx * 8 + wave, NGW = G * 8;
    unsigned char* lds = (unsigned char*)L; LAS int* lcnt = (LAS int*)(L + 0); LAS int* gt = (LAS int*)(L + LDS_MISC + 512);
    (void)lane; (void)gw; (void)NGW; (void)lds; (void)lcnt; (void)gt; (void)layer; (void)slot; (void)tid; (void)bx; (void)G;
    { unsigned char* ws = kargs()->ws; ret_out_phase((const bf16*)(ws + WS_PROJ), (const bf16*)(ws + WS_ST), (bf16*)(ws + WS_BR23), (char*)lds, G); }
}
__device__ __forceinline__ void ph20(LAS unsigned char* L, int layer, int slot) {
    int tid = threadIdx.x; asm volatile("" : "+v"(tid)); const int lane = tid & 63, wave = __builtin_amdgcn_readfirstlane(tid >> 6);
    int G = gridDim.x, bx = blockIdx.x; asm volatile("" : "+s"(G), "+s"(bx)); const int gw = bx * 8 + wave, NGW = G * 8;
    unsigned char* lds = (unsigned char*)L; LAS int* lcnt = (LAS int*)(L + 0); LAS int* gt = (LAS int*)(L + LDS_MISC + 512);
    (void)lane; (void)gw; (void)NGW; (void)lds; (void)lcnt; (void)gt; (void)layer; (void)slot; (void)tid; (void)bx; (void)G;
    { unsigned char* ws = kargs()->ws; ret_scan_phase((const float*)(ws + WS_U), (bf16*)(ws + WS_ST), G); }
}
__device__ __forceinline__ void ph4(LAS unsigned char* L, int layer, int slot) {
    int tid = threadIdx.x; asm volatile("" : "+v"(tid)); const int lane = tid & 63, wave = __builtin_amdgcn_readfirstlane(tid >> 6);
    int G = gridDim.x, bx = blockIdx.x; asm volatile("" : "+s"(G), "+s"(bx)); const int gw = bx * 8 + wave, NGW = G * 8;
    unsigned char* lds = (unsigned char*)L; LAS int* lcnt = (LAS int*)(L + 0); LAS int* gt = (LAS int*)(L + LDS_MISC + 512);
    (void)lane; (void)gw; (void)NGW; (void)lds; (void)lcnt; (void)gt; (void)layer; (void)slot; (void)tid; (void)bx; (void)G;
    {
            unsigned char* ws = kargs()->ws; unsigned char* wb = ws + WS_W + (size_t)layer * W_LAYER;
            unsigned* scr = (unsigned*)(ws + WS_MSCR + (size_t)bx * 786432);
            for (int ti = 0; ti * G + bx < 512; ++ti) {
                int pm, pn; pg8::tile_of(ti * G + bx, 128, 4, pm, pn);
                { MergeSched<0> S{(const char*)(ws + WS_HB), nullptr, (const char*)(wb + W_G), pm, pn};
                  EpiGate E{scr};
                  pg8::gemm_stream(L, S, E, 2048u, 2048u); }
                { MergeSched<1> S{(const char*)(ws + WS_BR01), (const char*)(ws + WS_BR23), (const char*)(wb + W_B), pm, pn};
                  EpiUp E{scr, (bf16*)(ws + WS_MERGED)};
                  pg8::gemm_stream(L, S, E, 2048u, 2048u); }
            }
        }
}
__device__ __forceinline__ void ph5(LAS unsigned char* L, int layer, int slot) {
    int tid = threadIdx.x; asm volatile("" : "+v"(tid)); const int lane = tid & 63, wave = __builtin_amdgcn_readfirstlane(tid >> 6);
    int G = gridDim.x, bx = blockIdx.x; asm volatile("" : "+s"(G), "+s"(bx)); const int gw = bx * 8 + wave, NGW = G * 8;
    unsigned char* lds = (unsigned char*)L; LAS int* lcnt = (LAS int*)(L + 0); LAS int* gt = (LAS int*)(L + LDS_MISC + 512);
    (void)lane; (void)gw; (void)NGW; (void)lds; (void)lcnt; (void)gt; (void)layer; (void)slot; (void)tid; (void)bx; (void)G;
    {
            KArgs A = kargs(); unsigned char* ws = A->ws; unsigned char* wb = ws + WS_W + (size_t)layer * W_LAYER;
            pg8::GridSched S{(const char*)(ws + WS_MERGED), (const char*)(wb + W_OUT), 2048u, 2048u, 128, 4, 16, G, bx};
            EpiRes E{(layer == 0) ? A->x : (const float*)A->out, A->out};
            pg8::gemm_stream(L, S, E, 2048u, 2048u);
        }
}
__device__ __forceinline__ void ph6(LAS unsigned char* L, int layer, int slot) {
    int tid = threadIdx.x; asm volatile("" : "+v"(tid)); const int lane = tid & 63, wave = __builtin_amdgcn_readfirstlane(tid >> 6);
    int G = gridDim.x, bx = blockIdx.x; asm volatile("" : "+s"(G), "+s"(bx)); const int gw = bx * 8 + wave, NGW = G * 8;
    unsigned char* lds = (unsigned char*)L; LAS int* lcnt = (LAS int*)(L + 0); LAS int* gt = (LAS int*)(L + LDS_MISC + 512);
    (void)lane; (void)gw; (void)NGW; (void)lds; (void)lcnt; (void)gt; (void)layer; (void)slot; (void)tid; (void)bx; (void)G;
    { KArgs A = kargs(); const float* x = A->out; const float* g = A->norm_cross + (size_t)layer * D; bf16* HB = (bf16*)(A->ws + WS_HB);
            for (int m = gw; m < M; m += NGW) norm_row_bf16(x + (size_t)m * D, g, HB + (size_t)m * D, lane); }
}
__device__ __forceinline__ void ph7(LAS unsigned char* L, int layer, int slot) {
    int tid = threadIdx.x; asm volatile("" : "+v"(tid)); const int lane = tid & 63, wave = __builtin_amdgcn_readfirstlane(tid >> 6);
    int G = gridDim.x, bx = blockIdx.x; asm volatile("" : "+s"(G), "+s"(bx)); const int gw = bx * 8 + wave, NGW = G * 8;
    unsigned char* lds = (unsigned char*)L; LAS int* lcnt = (LAS int*)(L + 0); LAS int* gt = (LAS int*)(L + LDS_MISC + 512);
    (void)lane; (void)gw; (void)NGW; (void)lds; (void)lcnt; (void)gt; (void)layer; (void)slot; (void)tid; (void)bx; (void)G;
    {
            unsigned char* ws = kargs()->ws; unsigned char* wb = ws + WS_W + (size_t)layer * W_LAYER;
            pg8::GridSched S{(const char*)(ws + WS_HB), (const char*)(wb + W_XQ), 2048u, 2048u, 128, 4, 16, G, bx};
            EpiPlain E{(bf16*)(ws + WS_XQ), D, 1.f};
            pg8::gemm_stream(L, S, E, 2048u, 2048u);
        }
}
__device__ __forceinline__ void ph8(LAS unsigned char* L, int layer, int slot) {
    int tid = threadIdx.x; asm volatile("" : "+v"(tid)); const int lane = tid & 63, wave = __builtin_amdgcn_readfirstlane(tid >> 6);
    int G = gridDim.x, bx = blockIdx.x; asm volatile("" : "+s"(G), "+s"(bx)); const int gw = bx * 8 + wave, NGW = G * 8;
    unsigned char* lds = (unsigned char*)L; LAS int* lcnt = (LAS int*)(L + 0); LAS int* gt = (LAS int*)(L + LDS_MISC + 512);
    (void)lane; (void)gw; (void)NGW; (void)lds; (void)lcnt; (void)gt; (void)layer; (void)slot; (void)tid; (void)bx; (void)G;
    {
            unsigned char* ws = kargs()->ws;
            CrossSched S{(const char*)(ws + WS_XQ), (const char*)(ws + WS_KX) + (size_t)layer * MROWS * D * 2, 0, G, bx};
            EpiSoftmax E{(bf16*)(ws + WS_XP), (LAS f32x2*)(L + LDS_XCH), 0.0625f * 1.44269504f};
            pg8::gemm_stream(L, S, E, 2048u, 2048u);
        }
}
__device__ __forceinline__ void ph9(LAS unsigned char* L, int layer, int slot) {
    int tid = threadIdx.x; asm volatile("" : "+v"(tid)); const int lane = tid & 63, wave = __builtin_amdgcn_readfirstlane(tid >> 6);
    int G = gridDim.x, bx = blockIdx.x; asm volatile("" : "+s"(G), "+s"(bx)); const int gw = bx * 8 + wave, NGW = G * 8;
    unsigned char* lds = (unsigned char*)L; LAS int* lcnt = (LAS int*)(L + 0); LAS int* gt = (LAS int*)(L + LDS_MISC + 512);
    (void)lane; (void)gw; (void)NGW; (void)lds; (void)lcnt; (void)gt; (void)layer; (void)slot; (void)tid; (void)bx; (void)G;
    {
            unsigned char* ws = kargs()->ws;
            CrossSched S{(const char*)(ws + WS_XP), (const char*)(ws + WS_VT) + (size_t)layer * D * MROWS * 2, 1, G, bx};
            EpiPlain E{(bf16*)(ws + WS_XO), D, 1.f};
            pg8::gemm_stream(L, S, E, 2048u, 4096u);
        }
}
__device__ __forceinline__ void ph10(LAS unsigned char* L, int layer, int slot) {
    int tid = threadIdx.x; asm volatile("" : "+v"(tid)); const int lane = tid & 63, wave = __builtin_amdgcn_readfirstlane(tid >> 6);
    int G = gridDim.x, bx = blockIdx.x; asm volatile("" : "+s"(G), "+s"(bx)); const int gw = bx * 8 + wave, NGW = G * 8;
    unsigned char* lds = (unsigned char*)L; LAS int* lcnt = (LAS int*)(L + 0); LAS int* gt = (LAS int*)(L + LDS_MISC + 512);
    (void)lane; (void)gw; (void)NGW; (void)lds; (void)lcnt; (void)gt; (void)layer; (void)slot; (void)tid; (void)bx; (void)G;
    {
            KArgs A = kargs(); unsigned char* ws = A->ws; unsigned char* wb = ws + WS_W + (size_t)layer * W_LAYER;
            pg8::GridSched S{(const char*)(ws + WS_XO), (const char*)(wb + W_XO), 2048u, 2048u, 128, 4, 16, G, bx};
            EpiRes E{(const float*)A->out, A->out};
            pg8::gemm_stream(L, S, E, 2048u, 2048u);
        }
}
__device__ __forceinline__ void ph11(LAS unsigned char* L, int layer, int slot) {
    int tid = threadIdx.x; asm volatile("" : "+v"(tid)); const int lane = tid & 63, wave = __builtin_amdgcn_readfirstlane(tid >> 6);
    int G = gridDim.x, bx = blockIdx.x; asm volatile("" : "+s"(G), "+s"(bx)); const int gw = bx * 8 + wave, NGW = G * 8;
    unsigned char* lds = (unsigned char*)L; LAS int* lcnt = (LAS int*)(L + 0); LAS int* gt = (LAS int*)(L + LDS_MISC + 512);
    (void)lane; (void)gw; (void)NGW; (void)lds; (void)lcnt; (void)gt; (void)layer; (void)slot; (void)tid; (void)bx; (void)G;
    { KArgs A = kargs(); const float* x = A->out; const float* g = A->norm_ffn; bf16* HB = (bf16*)(A->ws + WS_HB);
                for (int m = gw; m < M; m += NGW) norm_row_bf16(x + (size_t)m * D, g, HB + (size_t)m * D, lane); }
}
__device__ __forceinline__ void ph12(LAS unsigned char* L, int layer, int slot) {
    int tid = threadIdx.x; asm volatile("" : "+v"(tid)); const int lane = tid & 63, wave = __builtin_amdgcn_readfirstlane(tid >> 6);
    int G = gridDim.x, bx = blockIdx.x; asm volatile("" : "+s"(G), "+s"(bx)); const int gw = bx * 8 + wave, NGW = G * 8;
    unsigned char* lds = (unsigned char*)L; LAS int* lcnt = (LAS int*)(L + 0); LAS int* gt = (LAS int*)(L + LDS_MISC + 512);
    (void)lane; (void)gw; (void)NGW; (void)lds; (void)lcnt; (void)gt; (void)layer; (void)slot; (void)tid; (void)bx; (void)G;
    {
                unsigned char* ws = kargs()->ws;
                pg8::GridSched S{(const char*)(ws + WS_HB), (const char*)(ws + WS_WGU), 2048u, 2048u, 128, 28, 16, G, bx};
                EpiGU E{(bf16*)(ws + WS_HID)};
                pg8::gemm_stream(L, S, E, 2048u, 2048u);
            }
}
__device__ __forceinline__ void ph13(LAS unsigned char* L, int layer, int slot) {
    int tid = threadIdx.x; asm volatile("" : "+v"(tid)); const int lane = tid & 63, wave = __builtin_amdgcn_readfirstlane(tid >> 6);
    int G = gridDim.x, bx = blockIdx.x; asm volatile("" : "+s"(G), "+s"(bx)); const int gw = bx * 8 + wave, NGW = G * 8;
    unsigned char* lds = (unsigned char*)L; LAS int* lcnt = (LAS int*)(L + 0); LAS int* gt = (LAS int*)(L + LDS_MISC + 512);
    (void)lane; (void)gw; (void)NGW; (void)lds; (void)lcnt; (void)gt; (void)layer; (void)slot; (void)tid; (void)bx; (void)G;
    {
                KArgs A = kargs(); unsigned char* ws = A->ws;
                pg8::GridSched S{(const char*)(ws + WS_HID), (const char*)(ws + WS_WDN), 7168u, 7168u, 128, 4, 56, G, bx};
                EpiRes E{(const float*)A->out, A->out};
                pg8::gemm_stream(L, S, E, 7168u, 7168u);
            }
}
__device__ __forceinline__ void ph14(LAS unsigned char* L, int layer, int slot) {
    int tid = threadIdx.x; asm volatile("" : "+v"(tid)); const int lane = tid & 63, wave = __builtin_amdgcn_readfirstlane(tid >> 6);
    int G = gridDim.x, bx = blockIdx.x; asm volatile("" : "+s"(G), "+s"(bx)); const int gw = bx * 8 + wave, NGW = G * 8;
    unsigned char* lds = (unsigned char*)L; LAS int* lcnt = (LAS int*)(L + 0); LAS int* gt = (LAS int*)(L + LDS_MISC + 512);
    (void)lane; (void)gw; (void)NGW; (void)lds; (void)lcnt; (void)gt; (void)layer; (void)slot; (void)tid; (void)bx; (void)G;
    { KArgs A = kargs(); const float* x = A->out; const float* g = A->norm_mix + D; bf16* HB = (bf16*)(A->ws + WS_HB);
                for (int m = gw; m < M; m += NGW) norm_row_bf16(x + (size_t)m * D, g, HB + (size_t)m * D, lane); }
}
__device__ __forceinline__ void ph15(LAS unsigned char* L, int layer, int slot) {
    int tid = threadIdx.x; asm volatile("" : "+v"(tid)); const int lane = tid & 63, wave = __builtin_amdgcn_readfirstlane(tid >> 6);
    int G = gridDim.x, bx = blockIdx.x; asm volatile("" : "+s"(G), "+s"(bx)); const int gw = bx * 8 + wave, NGW = G * 8;
    unsigned char* lds = (unsigned char*)L; LAS int* lcnt = (LAS int*)(L + 0); LAS int* gt = (LAS int*)(L + LDS_MISC + 512);
    (void)lane; (void)gw; (void)NGW; (void)lds; (void)lcnt; (void)gt; (void)layer; (void)slot; (void)tid; (void)bx; (void)G;
    {
                KArgs A = kargs(); unsigned char* ws = A->ws; unsigned* ctl = (unsigned*)(ws + WS_CTL);
                int* route = (int*)(ws + WS_ROUTE); bf16* HB = (bf16*)(ws + WS_HB);
                if (tid < 16) lcnt[tid] = 0;
                __syncthreads();
                const float* gn = A->norm_ffn + D; const float* xo = A->out; const float* rwt = A->router_w;
                for (int m = gw; m < M; m += NGW) {
                    const f32x4* xr = (const f32x4*)(xo + (size_t)m * D) + lane; const f32x4* gr = (const f32x4*)gn + lane;
                    f32x4 v[4]; float s = 0.f;
#pragma unroll
                    for (int j = 0; j < 4; ++j) { v[j] = xr[64 * j]; s += (v[j].x * v[j].x + v[j].y * v[j].y) + (v[j].z * v[j].z + v[j].w * v[j].w); }
                    const float rstd = 1.f / sqrtf(wave_sum(s) * (1.f / D) + EPS);
                    float lg[8];
#pragma unroll
                    for (int e = 0; e < 8; ++e) lg[e] = 0.f;
                    unsigned long long* o8 = (unsigned long long*)(HB + (size_t)m * D) + lane;
#pragma unroll
                    for (int j = 0; j < 4; ++j) { const f32x4 gg = gr[64 * j]; const f32x4 hv = v[j] * rstd * gg;
                        o8[64 * j] = (unsigned long long)pk2(hv.x, hv.y) | ((unsigned long long)pk2(hv.z, hv.w) << 32);
                        const float* rw = rwt + (size_t)(256 * j + 4 * lane) * 8;
#pragma unroll
                        for (int q = 0; q < 4; ++q) { const f32x4 r0 = *(const f32x4*)(rw + 8 * q), r1 = *(const f32x4*)(rw + 8 * q + 4); const float hq = hv[q];
                            lg[0] += hq * r0.x; lg[1] += hq * r0.y; lg[2] += hq * r0.z; lg[3] += hq * r0.w; lg[4] += hq * r1.x; lg[5] += hq * r1.y; lg[6] += hq * r1.z; lg[7] += hq * r1.w; } }
#pragma unroll
                    for (int e = 0; e < 8; ++e) lg[e] = wave_sum(lg[e]);
                    int e0 = 0; float v0 = lg[0];
#pragma unroll
                    for (int e = 1; e < 8; ++e) if (lg[e] > v0) { v0 = lg[e]; e0 = e; }
                    int e1 = -1; float v1 = -INFINITY;
#pragma unroll
                    for (int e = 0; e < 8; ++e) if (e != e0 && lg[e] > v1) { v1 = lg[e]; e1 = e; }
                    const float ww1 = 1.f / (1.f + __expf(v0 - v1)), ww0 = 1.f - ww1;
                    if (lane == 0) { route[4 * m] = e0; route[4 * m + 1] = e1; ((float*)route)[4 * m + 2] = ww0; ((float*)route)[4 * m + 3] = ww1; atomicAdd((int*)&lcnt[e0], 1); atomicAdd((int*)&lcnt[8 + e1], 1); }
                }
                __syncthreads();
                if (tid < 16) atomicAdd(ctl + CW_CNT + tid, (unsigned)lcnt[tid]);
                __syncthreads();
                LAS float* scr = (LAS float*)(L + wave * 16384);
                constexpr int I_GU = 16 * 224, I_DN = 56 * 32;
                const float* mgu = A->moe_w_gu; const float* mdn = A->moe_w_down;
                for (int r_ = 0; r_ < REP(7); ++r_) for (int it = gw; it < 8 * (I_GU + I_DN); it += NGW) {
                    const int e = it / (I_GU + I_DN); int r = it % (I_GU + I_DN);
                    if (r < I_GU) conv_seg<2>(mgu + (size_t)e * D * 2 * DFF, D, 2 * DFF, 0, (bf16*)(ws + WS_MWGU) + (size_t)e * 2 * DFF * D, D, 0, 224, r, scr, lane);
                    else conv_seg<0>(mdn + (size_t)e * DFF * D, DFF, D, 0, (bf16*)(ws + WS_MWDN) + (size_t)e * D * DFF, DFF, 0, 32, r - I_GU, scr, lane);
                }
            }
}
__device__ __forceinline__ void ph16(LAS unsigned char* L, int layer, int slot) {
    int tid = threadIdx.x; asm volatile("" : "+v"(tid)); const int lane = tid & 63, wave = __builtin_amdgcn_readfirstlane(tid >> 6);
    int G = gridDim.x, bx = blockIdx.x; asm volatile("" : "+s"(G), "+s"(bx)); const int gw = bx * 8 + wave, NGW = G * 8;
    unsigned char* lds = (unsigned char*)L; LAS int* lcnt = (LAS int*)(L + 0); LAS int* gt = (LAS int*)(L + LDS_MISC + 512);
    (void)lane; (void)gw; (void)NGW; (void)lds; (void)lcnt; (void)gt; (void)layer; (void)slot; (void)tid; (void)bx; (void)G;
    {
                unsigned char* ws = kargs()->ws; unsigned* ctl = (unsigned*)(ws + WS_CTL);
                int* route = (int*)(ws + WS_ROUTE); int* tokmap = (int*)(ws + WS_TOKMAP); float* roww = (float*)(ws + WS_ROWW); bf16* HB = (bf16*)(ws + WS_HB);
                LAS int* lbase = (LAS int*)(L + 64); LAS int* lc2 = (LAS int*)(L + 128);
                for (int chunk = bx; chunk < M / 128; chunk += G) {
                    if (tid < 16) { lcnt[tid] = 0; lc2[tid] = 0; }
                    __syncthreads();
                    const int m = chunk * 128 + (tid >> 2);
                    const int e0 = route[4 * m], e1 = route[4 * m + 1];
                    if ((tid & 3) == 0) { atomicAdd((int*)&lcnt[e0], 1); atomicAdd((int*)&lcnt[8 + e1], 1); }
                    __syncthreads();
                    if (tid < 16) lbase[tid] = (int)atomicAdd(ctl + CW_CUR + tid, (unsigned)lcnt[tid]) + gt[tid] * 256;
                    __syncthreads();
                    int p0 = 0, p1 = 0;
                    if ((tid & 3) == 0) { p0 = lbase[e0] + atomicAdd((int*)&lc2[e0], 1); p1 = lbase[8 + e1] + atomicAdd((int*)&lc2[8 + e1], 1);
                        tokmap[p0] = m; tokmap[p1] = m; roww[p0] = ((const float*)route)[4 * m + 2]; roww[p1] = ((const float*)route)[4 * m + 3]; }
                    p0 = __shfl(p0, lane & ~3); p1 = __shfl(p1, lane & ~3);
                    const u32x4* src = (const u32x4*)(HB + (size_t)m * D) + (tid & 3) * 32;
                    u32x4* d0 = (u32x4*)((bf16*)(ws + WS_XS) + (size_t)p0 * D) + (tid & 3) * 32; u32x4* d1 = (u32x4*)((bf16*)(ws + WS_XS) + (size_t)p1 * D) + (tid & 3) * 32;
#pragma unroll 8
                    for (int q = 0; q < 32; ++q) { const u32x4 v = src[q]; d0[q] = v; d1[q] = v; }
                    __syncthreads();
                }
                if (bx < 16) { const int g = bx; const int cntg = (int)__hip_atomic_load(ctl + CW_CNT + g, __ATOMIC_RELAXED, __HIP_MEMORY_SCOPE_AGENT);
                    for (int r = gt[g] * 256 + cntg + tid; r < gt[g + 1] * 256; r += 512) { tokmap[r] = -1; roww[r] = 0.f; } }
            }
}
__device__ __forceinline__ void ph17(LAS unsigned char* L, int layer, int slot) {
    int tid = threadIdx.x; asm volatile("" : "+v"(tid)); const int lane = tid & 63, wave = __builtin_amdgcn_readfirstlane(tid >> 6);
    int G = gridDim.x, bx = blockIdx.x; asm volatile("" : "+s"(G), "+s"(bx)); const int gw = bx * 8 + wave, NGW = G * 8;
    unsigned char* lds = (unsigned char*)L; LAS int* lcnt = (LAS int*)(L + 0); LAS int* gt = (LAS int*)(L + LDS_MISC + 512);
    (void)lane; (void)gw; (void)NGW; (void)lds; (void)lcnt; (void)gt; (void)layer; (void)slot; (void)tid; (void)bx; (void)G;
    {
                unsigned char* ws = kargs()->ws;
                MoeSched S{(const char*)(ws + WS_XS), (const char*)(ws + WS_MWGU), 2048u, (size_t)2 * DFF * D * 2, 2048u, 0, gt[16], 28, 16, G, bx, (const int*)gt};
                EpiGU E{(bf16*)(ws + WS_MHID)};
                pg8::gemm_stream(L, S, E, 2048u, 2048u);
            }
}
__device__ __forceinline__ void ph18(LAS unsigned char* L, int layer, int slot) {
    int tid = threadIdx.x; asm volatile("" : "+v"(tid)); const int lane = tid & 63, wave = __builtin_amdgcn_readfirstlane(tid >> 6);
    int G = gridDim.x, bx = blockIdx.x; asm volatile("" : "+s"(G), "+s"(bx)); const int gw = bx * 8 + wave, NGW = G * 8;
    unsigned char* lds = (unsigned char*)L; LAS int* lcnt = (LAS int*)(L + 0); LAS int* gt = (LAS int*)(L + LDS_MISC + 512);
    (void)lane; (void)gw; (void)NGW; (void)lds; (void)lcnt; (void)gt; (void)layer; (void)slot; (void)tid; (void)bx; (void)G;
    {
                    KArgs A = kargs(); unsigned char* ws = A->ws;
                    const int t0 = slot == 0 ? 0 : gt[8], t1 = slot == 0 ? gt[8] : gt[16];
                    MoeSched S{(const char*)(ws + WS_MHID), (const char*)(ws + WS_MWDN), 7168u, (size_t)D * DFF * 2, 7168u, t0, t1 - t0, 4, 56, G, bx, (const int*)gt};
                    EpiDownMoe E{(const int*)(ws + WS_TOKMAP), (const float*)(ws + WS_ROWW), A->out};
                    pg8::gemm_stream(L, S, E, 7168u, 7168u);
                }
}
__device__ __forceinline__ void ph19(LAS unsigned char* L, int layer, int slot) {
    int tid = threadIdx.x; asm volatile("" : "+v"(tid)); const int lane = tid & 63, wave = __builtin_amdgcn_readfirstlane(tid >> 6);
    int G = gridDim.x, bx = blockIdx.x; asm volatile("" : "+s"(G), "+s"(bx)); const int gw = bx * 8 + wave, NGW = G * 8;
    unsigned char* lds = (unsigned char*)L; LAS int* lcnt = (LAS int*)(L + 0); LAS int* gt = (LAS int*)(L + LDS_MISC + 512);
    (void)lane; (void)gw; (void)NGW; (void)lds; (void)lcnt; (void)gt; (void)layer; (void)slot; (void)tid; (void)bx; (void)G;
    { KArgs A = kargs(); float* xo = A->out; const float* gf = A->norm_final;
                for (int m = gw; m < M; m += NGW) {
                    f32x4* xr = (f32x4*)(xo + (size_t)m * D) + lane; const f32x4* gr = (const f32x4*)gf + lane;
                    f32x4 v[4]; float s = 0.f;
#pragma unroll
                    for (int j = 0; j < 4; ++j) { v[j] = xr[64 * j]; s += (v[j].x * v[j].x + v[j].y * v[j].y) + (v[j].z * v[j].z + v[j].w * v[j].w); }
                    const float rstd = 1.f / sqrtf(wave_sum(s) * (1.f / D) + EPS);
#pragma unroll
                    for (int j = 0; j < 4; ++j) xr[64 * j] = v[j] * rstd * gr[64 * j];
                } }
}
__global__ void __launch_bounds__(512, 2) fwd_kernel(Args a_unused) {
    extern __shared__ __attribute__((aligned(16))) unsigned char lds[];
    LAS unsigned char* L = (LAS unsigned char*)lds;
    volatile LAS unsigned* MISC = (volatile LAS unsigned*)(L + LDS_MISC);
    const int tid = threadIdx.x, lane = tid & 63, wave = __builtin_amdgcn_readfirstlane(tid >> 6);
    const int G = gridDim.x, bx = blockIdx.x;
    for (int u = tid; u < 64; u += 512) MISC[u] = 0u;
    __syncthreads();
    XcdBarrier bar; bar.bar = (unsigned*)(kargs()->ws + WS_CTL) + CW_BAR; bar.x = 0; bar.st = nullptr;
    if (!MK_PER_PHASE) bar = xcd_barrier_post(bar.bar, MISC + 8);
    int pid = 0;
    const int lo = kargs()->ph_lo, hi = kargs()->ph_hi;
#define RUN() (pid >= lo && pid < hi)
#define SEAM() do { if (!MK_PER_PHASE) { xcd_barrier(bar); if (REP(30) > 1) xcd_barrier(bar); } ++pid; } while (0)
    int slotv = 0; (void)lane;

    if (PON(0) && RUN()) for (int r_ = 0; r_ < REP(8); ++r_) ph0(L, 0, 0);
    SEAM();

    for (int layer = 0; layer < DEPTH; ++layer) {
        if (PON(1) && RUN()) for (int r_ = 0; r_ < REP(9); ++r_) ph1(L, layer, slotv);
        SEAM();
        if (PON(2) && RUN()) for (int r_ = 0; r_ < REP(10); ++r_) ph2(L, layer, slotv);
        SEAM();
        if (PON(20) && RUN()) for (int r_ = 0; r_ < REP(28); ++r_) ph20(L, layer, slotv);
        SEAM();
        if (PON(3) && RUN()) for (int r_ = 0; r_ < REP(11); ++r_) ph3(L, layer, slotv);
        SEAM();
        if (PON(4) && RUN()) for (int r_ = 0; r_ < REP(12); ++r_) ph4(L, layer, slotv);
        SEAM();
        if (PON(5) && RUN()) for (int r_ = 0; r_ < REP(13); ++r_) ph5(L, layer, slotv);
        SEAM();
        if (PON(6) && RUN()) for (int r_ = 0; r_ < REP(14); ++r_) ph6(L, layer, slotv);
        SEAM();
        if (PON(7) && RUN()) for (int r_ = 0; r_ < REP(15); ++r_) ph7(L, layer, slotv);
        SEAM();
        if (PON(8) && RUN()) for (int r_ = 0; r_ < REP(16); ++r_) ph8(L, layer, slotv);
        SEAM();
        if (PON(9) && RUN()) for (int r_ = 0; r_ < REP(17); ++r_) ph9(L, layer, slotv);
        SEAM();
        if (PON(10) && RUN()) for (int r_ = 0; r_ < REP(18); ++r_) ph10(L, layer, slotv);
        SEAM();
        if (layer == 0) {
            if (PON(11) && RUN()) for (int r_ = 0; r_ < REP(19); ++r_) ph11(L, layer, slotv);
            SEAM();
            if (PON(12) && RUN()) for (int r_ = 0; r_ < REP(20); ++r_) ph12(L, layer, slotv);
            SEAM();
            if (PON(13) && RUN()) for (int r_ = 0; r_ < REP(21); ++r_) ph13(L, layer, slotv);
            SEAM();
            if (PON(14) && RUN()) for (int r_ = 0; r_ < REP(22); ++r_) ph14(L, layer, slotv);
            SEAM();
        } else {
            if (PON(15) && RUN()) for (int r_ = 0; r_ < REP(23); ++r_) ph15(L, layer, slotv);
            SEAM();
            LAS int* gt = (LAS int*)(L + LDS_MISC + 512);
            if (tid == 0) { unsigned* ctl = (unsigned*)(kargs()->ws + WS_CTL); int acc = 0; for (int g = 0; g < 16; ++g) { gt[g] = acc; acc += ((int)__hip_atomic_load(ctl + CW_CNT + g, __ATOMIC_RELAXED, __HIP_MEMORY_SCOPE_AGENT) + 255) >> 8; } gt[16] = acc; }
            __syncthreads();
            if (PON(16) && RUN()) for (int r_ = 0; r_ < REP(24); ++r_) ph16(L, layer, slotv);
            SEAM();
            if (PON(17) && RUN()) for (int r_ = 0; r_ < REP(25); ++r_) ph17(L, layer, slotv);
            SEAM();
            for (int slot = 0; slot < 2; ++slot) {
                if (PON(18) && RUN()) for (int r_ = 0; r_ < REP(26); ++r_) ph18(L, layer, slot);
                SEAM();
            }
            if (PON(19) && RUN()) for (int r_ = 0; r_ < REP(27); ++r_) ph19(L, layer, slotv);
            ++pid;
        }
    }
#undef RUN
#undef SEAM
}


constexpr int NPHASE = 1 + 15 + 17;
extern "C" void kernel_launch(void* const* d_in, const int* in_sizes, int n_in, void* d_out, int out_size, void* d_ws, size_t ws_size, hipStream_t stream) {
    static int grid = 0;
    if (grid == 0) {
        if (n_in != 22 || out_size != M * D || ws_size < WS_END) { fprintf(stderr, "kernel_launch: unexpected problem (n_in %d out %d ws %zu)\n", n_in, out_size, ws_size); grid = -1; return; }
        int dev = 0, cus = 0;
        if (hipGetDevice(&dev) != hipSuccess || hipDeviceGetAttribute(&cus, hipDeviceAttributeMultiprocessorCount, dev) != hipSuccess) { grid = -1; return; }
        if (hipFuncSetAttribute((const void*)fwd_kernel, hipFuncAttributeMaxDynamicSharedMemorySize, LDS_BYTES) != hipSuccess) { fprintf(stderr, "kernel_launch: hipFuncSetAttribute failed\n"); grid = -1; return; }
        int per_cu = 0;
        (void)hipOccupancyMaxActiveBlocksPerMultiprocessor(&per_cu, (const void*)fwd_kernel, 512, LDS_BYTES);
        (void)hipGetLastError();
        if (per_cu < 1) fprintf(stderr, "kernel_launch: occupancy query says %d\n", per_cu);
        grid = cus;
    }
    if (grid < 0) return;
    (void)hipMemsetAsync((char*)d_ws + WS_CTL, 0, CTL_ZERO_BYTES, stream);
    Args a{};
    a.x = (const float*)d_in[0]; a.mem = (const float*)d_in[1]; a.positions = (const int*)d_in[2]; a.norm_mix = (const float*)d_in[3]; a.w_in = (const float*)d_in[4];
    a.attn_sink = (const float*)d_in[5]; a.w_branch = (const float*)d_in[6]; a.w_out = (const float*)d_in[7]; a.pool_w = (const float*)d_in[8]; a.pool_scale = (const float*)d_in[9];
    a.norm_cross = (const float*)d_in[10]; a.norm_mem = (const float*)d_in[11]; a.w_xq = (const float*)d_in[12]; a.w_xkv = (const float*)d_in[13]; a.w_xo = (const float*)d_in[14];
    a.norm_ffn = (const float*)d_in[15]; a.dense_w_gu = (const float*)d_in[16]; a.dense_w_down = (const float*)d_in[17]; a.router_w = (const float*)d_in[18];
    a.moe_w_gu = (const float*)d_in[19]; a.moe_w_down = (const float*)d_in[20]; a.norm_final = (const float*)d_in[21];
    a.out = (float*)d_out; a.ws = (unsigned char*)d_ws;
#if MK_PER_PHASE
    for (int p = 0; p < NPHASE; ++p) { a.ph_lo = p; a.ph_hi = p + 1; hipLaunchKernelGGL(fwd_kernel, dim3(grid), dim3(512), LDS_BYTES, stream, a); }
#else
    a.ph_lo = 0; a.ph_hi = NPHASE;
    hipLaunchKernelGGL(fwd_kernel, dim3(grid), dim3(512), LDS_BYTES, stream, a);
#endif
}
```

```cpp
#include <hip/hip_runtime.h>
#include <cstdio>
#include <cstdint>

#ifndef MK_PER_PHASE
#define MK_PER_PHASE 0
#endif

#ifndef PHASE_MASK
#define PHASE_MASK 0xFFFFFFFFu
#endif
#define PON(k) ((PHASE_MASK >> (k)) & 1u)
#ifndef REP_MASK
#define REP_MASK 0u
#endif
#define REP(k) (1 + (int)((REP_MASK >> (k)) & 1u))
#define LAS __attribute__((address_space(3)))
#define GAS __attribute__((address_space(1)))
typedef unsigned short bf16;
typedef short bf16x8 __attribute__((ext_vector_type(8)));
typedef float f32x4 __attribute__((ext_vector_type(4)));
typedef float f32x2 __attribute__((ext_vector_type(2)));
typedef unsigned u32x4 __attribute__((ext_vector_type(4)));
typedef int i32x4 __attribute__((ext_vector_type(4)));
typedef unsigned u32x2 __attribute__((ext_vector_type(2)));
typedef __bf16 bf16x2_t __attribute__((ext_vector_type(2)));
typedef _Float16 h16x8 __attribute__((ext_vector_type(8)));

constexpr int BATCH = 8, T = 4096, D = 1024, M = BATCH * T, DEPTH = 2;
constexpr int D_IN = 8004, NPROJ = 4096, DFF = 3584, NEXP = 8, MEMLEN = 256, MROWS = BATCH * MEMLEN;
constexpr float EPS = 1e-6f;
constexpr int C_AQ = 0, C_AK = 512, C_AV = 640, C_BQ = 768, C_BK = 1280, C_BV = 1408, C_IQ = 1536, C_IK = 1792, C_RQ = 1856, C_RK = 2112, C_RV = 2368, C_RG = 2880, C_PU = 3392, C_IW = 3904;
constexpr unsigned long long ROPE_MASK = 0x3FFull | (0x3FFull << 12) | (0x1FFFull << 24);

constexpr size_t MiB = 1u << 20;
constexpr size_t WS_CTL = 0, CTL_ZERO_BYTES = 2 * MiB;
constexpr size_t WS_SS = 128 * 1024;
constexpr size_t WS_ROUTE = 2 * MiB;
constexpr size_t WS_TOKMAP = 2 * MiB + 512 * 1024;
constexpr size_t WS_ROWW = 3 * MiB;
constexpr size_t WS_ROWSS = 3 * MiB + 384 * 1024;
constexpr size_t WS_HB = 4 * MiB;
constexpr size_t WS_ROPE = 68 * MiB;
constexpr size_t WS_MN = 76 * MiB;
constexpr size_t WS_KX = 84 * MiB;
constexpr size_t WS_VT = 92 * MiB;
constexpr size_t WS_W = 100 * MiB;
constexpr size_t W_IN = 0, W_G = 8 * MiB, W_B = 16 * MiB, W_OUT = 20 * MiB, W_XQ = 22 * MiB, W_XK = 24 * MiB, W_XV = 26 * MiB, W_XO = 28 * MiB, W_LAYER = 30 * MiB;
constexpr size_t WS_WGU = WS_W + 2 * W_LAYER;
constexpr size_t WS_WDN = WS_WGU + 14 * MiB;
constexpr size_t WS_R = 181 * MiB;
constexpr size_t WS_PROJ = WS_R;
constexpr size_t WS_BR01 = WS_R + 256 * MiB;
constexpr size_t WS_BR23 = WS_R + 320 * MiB;
constexpr size_t WS_U = WS_R + 384 * MiB;
constexpr size_t WS_R_END = WS_R + 416 * MiB;
constexpr size_t WS_AKV = 600 * MiB;
constexpr size_t WS_BKV = 616 * MiB;
constexpr size_t WS_IK = 632 * MiB;
constexpr size_t WS_VTB = 656 * MiB;
constexpr size_t WS_WPOOL = 652 * MiB;
constexpr size_t WS_ST = 636 * MiB;
constexpr size_t WS_MSCR = WS_PROJ;
constexpr size_t WS_MERGED = WS_PROJ + 192 * MiB;
constexpr size_t WS_XQ = WS_PROJ;
constexpr size_t WS_XP = WS_PROJ + 64 * MiB;
constexpr size_t WS_XO = WS_PROJ + 128 * MiB;
constexpr size_t WS_HID = WS_PROJ;
constexpr int MOE_ROWS = 2 * M + 16 * 256;
constexpr size_t WS_MWGU = 100 * MiB;
constexpr size_t WS_MWDN = 212 * MiB;
constexpr size_t WS_MHID = 268 * MiB;
constexpr size_t WS_XS = 744 * MiB;
constexpr size_t WS_XF8 = 812 * MiB;
constexpr size_t WS_END = 880 * MiB;
static_assert(WS_MHID + (size_t)MOE_ROWS * DFF * 2 <= WS_XS && WS_XS + (size_t)MOE_ROWS * D * 2 <= WS_END, "moe map");
static_assert(WS_WDN + 7 * MiB <= WS_R, "weights map");
constexpr int CW_BAR = 4096;
constexpr int CW_CNT = 16384;
constexpr int CW_CUR = 16384 + 64;

constexpr int LDS_STAGE = 131072;
constexpr int LDS_XCH = 131072;
constexpr int LDS_MISC = 131072 + 16384;
constexpr int LDS_BYTES = 131072 + 16384 + 8192;
constexpr int WAVE_LDS = 17408;

__device__ const float INV_FREQ[32] = {1.000000000e+00f, 7.498942018e-01f, 5.623413324e-01f, 4.216965139e-01f, 3.162277639e-01f, 2.371373922e-01f, 1.778279394e-01f, 1.333521456e-01f, 1.000000015e-01f, 7.498941571e-02f, 5.623412877e-02f, 4.216964915e-02f, 3.162277862e-02f, 2.371373586e-02f, 1.778279431e-02f, 1.333521493e-02f, 9.999999776e-03f, 7.498942316e-03f, 5.623413250e-03f, 4.216964822e-03f, 3.162277862e-03f, 2.371373819e-03f, 1.778279431e-03f, 1.333521446e-03f, 1.000000047e-03f, 7.498941850e-04f, 5.623413017e-04f, 4.216965463e-04f, 3.162277862e-04f, 2.371373848e-04f, 1.778279402e-04f, 1.333521504e-04f};
__device__ __forceinline__ float bf2f(unsigned short v) { return __uint_as_float(((unsigned)v) << 16); }
__device__ __forceinline__ unsigned f2bf(float f) { unsigned u = __float_as_uint(f); return (u + 0x7fffu + ((u >> 16) & 1u)) >> 16; }
__device__ __forceinline__ unsigned pk2(float lo, float hi) { return f2bf(lo) | (f2bf(hi) << 16); }
__device__ __forceinline__ unsigned f2bf1(float f) { return (unsigned)__builtin_bit_cast(unsigned short, (__bf16)f); }
__device__ __forceinline__ unsigned cvt_pk_bf16(float lo, float hi) { unsigned r; asm volatile("v_cvt_pk_bf16_f32 %0, %1, %2" : "=v"(r) : "v"(lo), "v"(hi)); return r; }
__device__ __forceinline__ float dot2(unsigned a, unsigned b, float acc) { return __builtin_amdgcn_fdot2_f32_bf16(__builtin_bit_cast(bf16x2_t, a), __builtin_bit_cast(bf16x2_t, b), acc, false); }
__device__ __forceinline__ float wave_sum(float v) {
#pragma unroll
    for (int o = 1; o < 64; o <<= 1) v += __shfl_xor(v, o);
    return v;
}
__device__ __forceinline__ float wave_max(float v) {
#pragma unroll
    for (int o = 1; o < 64; o <<= 1) v = fmaxf(v, __shfl_xor(v, o));
    return v;
}
#define LDS_WAIT() asm volatile("s_waitcnt lgkmcnt(0)" ::: "memory")
typedef unsigned long long u64;
__device__ __forceinline__ float rstd_of(u64 ssfix) { return 1.f / sqrtf((float)ssfix * (5.9604645e-8f / 1024.f) + 1e-6f); }
__device__ __forceinline__ u64 ss_fix(float q) { return (u64)(q * 16777216.f); }
__device__ __forceinline__ unsigned pk4_f8(float a, float b, float c, float d) {
    int w = 0;
    w = __builtin_amdgcn_cvt_pk_fp8_f32(__builtin_amdgcn_fmed3f(a, -448.f, 448.f), __builtin_amdgcn_fmed3f(b, -448.f, 448.f), w, false);
    w = __builtin_amdgcn_cvt_pk_fp8_f32(__builtin_amdgcn_fmed3f(c, -448.f, 448.f), __builtin_amdgcn_fmed3f(d, -448.f, 448.f), w, true);
    return (unsigned)w; }
constexpr float F8_MSCALE = 8.f, F8_OSCALE = 16.f;
constexpr float F8_HSCALE = 4.f;
constexpr float F8_WSCALE = 64.f;

namespace pg8 {
constexpr int BM = 256, BK = 64, HALF = 128, HTB = HALF * BK * 2, STAGE_BYTES = 8 * HTB, NXCD = 8, WGM = 8;
__host__ __device__ __forceinline__ int lds_byte(int r, int c) { const int st = (r >> 4) * 2 + (c >> 5), rr = r & 15, cc = c & 31, ob = rr * 64 + cc * 2; return st * 1024 + (ob ^ (((ob >> 9) & 1) << 5)); }
__host__ __device__ __forceinline__ void stage_rc(int b, int& R, int& C) { const int st = b / 1024, sb = b % 1024, swz = sb ^ (((sb >> 9) & 1) << 5); R = (st >> 1) * 16 + swz / 64; C = (st & 1) * 32 + (swz % 64) / 2; }
__host__ __device__ __forceinline__ int perm32(int rho) { const int n = rho >> 4, i = rho & 15; return 8 * (i >> 2) + 4 * n + (i & 3); }

struct Unit { const char* A; const char* B; int nt; int pm, pn, kind; };

__device__ __forceinline__ void tile_of(int wgid, int nM, int nN, int& pm, int& pn) {
    const int nwg = nM * nN;
    { const int q = nwg / NXCD, r = nwg % NXCD, xcd = wgid % NXCD, off = wgid / NXCD; wgid = (xcd < r ? xcd * (q + 1) : r * (q + 1) + (xcd - r) * q) + off; }
    const int nig = WGM * nN, gid = wgid / nig, fm = gid * WGM, gsz = (nM - fm) < WGM ? (nM - fm) : WGM;
    pm = fm + ((wgid % nig) % gsz); pn = (wgid % nig) / gsz;
}
struct GridSched {
    const char* A; const char* B; unsigned lda, ldb; int nM, nN, nt, G, c;
    __device__ __forceinline__ bool next(int i, Unit& u) const {
        const long L = (long)i * G + c; if (L >= (long)nM * nN) return false;
        tile_of((int)L, nM, nN, u.pm, u.pn);
        u.A = A + (size_t)u.pm * 256 * lda; u.B = B + (size_t)u.pn * 256 * ldb; u.nt = nt; u.kind = 0; return true;
    }
};

template <class Epi, class Sched, int F8 = 0>
__device__ __forceinline__ void gemm_stream(LAS unsigned char* lds, const Sched& S, const Epi& E, const unsigned lda, const unsigned ldb) {
    int tid = threadIdx.x; asm volatile("" : "+v"(tid));
    const int wid = __builtin_amdgcn_readfirstlane(tid >> 6), lane = tid & 63, wr = wid >> 2, wc = wid & 3, fr = lane & 15, fq = lane >> 4;
    unsigned voffA, voffB;
    { int R, C; stage_rc(tid * 16, R, C); const int Rb = (R & ~31) + perm32(R & 31); voffA = (unsigned)R * lda + (unsigned)C * 2u; voffB = (unsigned)Rb * ldb + (unsigned)C * 2u; }
    const size_t kstep = (size_t)(BK * 2);
    const size_t hA = (size_t)HALF * lda, hB = (size_t)HALF * ldb, qA = (size_t)64 * lda, qB = (size_t)64 * ldb;
    const unsigned ldsw = (unsigned)wid * 1024u;
    const int aoff = lds_byte(wr * 64 + fr, fq * 8), boff = lds_byte(wc * 32 + fr, fq * 8);
#define PG8_SA(b, h) (((b) * 2 + (h)) * HTB)
#define PG8_SB(b, h) ((4 + (b) * 2 + (h)) * HTB)
#define PG8_STAGE(bufoff, gbase, voff) do { \
        __builtin_amdgcn_global_load_lds((const unsigned*)((const char*)(gbase) + (voff)), (LAS unsigned*)(lds + (bufoff) + ldsw), 16, 0, 0); \
        __builtin_amdgcn_global_load_lds((const unsigned*)((const char*)(gbase) + ((&(voff) == &voffA) ? qA : qB) + (voff)), (LAS unsigned*)(lds + (bufoff) + ldsw + 8192), 16, 0, 0); } while (0)
#define PG8_LDA(dst, b, h) do { _Pragma("unroll") for (int m = 0; m < 4; ++m) _Pragma("unroll") for (int k = 0; k < 2; ++k) dst[m][k] = *(const LAS bf16x8*)(lds + PG8_SA(b, h) + aoff + m * 2048 + k * 1024); } while (0)
#define PG8_LDB(dst, b, h) do { _Pragma("unroll") for (int n = 0; n < 2; ++n) _Pragma("unroll") for (int k = 0; k < 2; ++k) dst[n][k] = *(const LAS bf16x8*)(lds + PG8_SB(b, h) + boff + n * 2048 + k * 1024); } while (0)
#define PG8_MMA(ai, bj, At, Bt) do { __builtin_amdgcn_s_setprio(1); _Pragma("unroll") for (int m = 0; m < 4; ++m) _Pragma("unroll") for (int n = 0; n < 2; ++n) _Pragma("unroll") for (int k = 0; k < 2; ++k) \
        acc[ai][bj][m][n] = __builtin_amdgcn_mfma_f32_16x16x32_bf16(Bt[n][k], At[m][k], acc[ai][bj][m][n], 0, 0, 0); __builtin_amdgcn_s_setprio(0); } while (0)
#define PG8_CAT(x) __builtin_shufflevector(__builtin_bit_cast(i32x4, x[0]), __builtin_bit_cast(i32x4, x[1]), 0, 1, 2, 3, 4, 5, 6, 7)
#define PG8_MMA8(ai, bj, At, Bt) do { __builtin_amdgcn_s_setprio(1); _Pragma("unroll") for (int m = 0; m < 4; ++m) _Pragma("unroll") for (int n = 0; n < 2; ++n) \
        asm volatile("v_mfma_f32_16x16x128_f8f6f4 %0, %1, %2, %0" : "+v"(acc[ai][bj][m][n]) : "v"(PG8_CAT(Bt[n])), "v"(PG8_CAT(At[m]))); __builtin_amdgcn_s_setprio(0); } while (0)
#define PG8_MM(ai, bj, At, Bt) do { if constexpr (F8) PG8_MMA8(ai, bj, At, Bt); else PG8_MMA(ai, bj, At, Bt); } while (0)
#define PG8_WAIT_V(n) asm volatile("s_waitcnt vmcnt(" #n ")" ::: "memory")
#define PG8_WAIT_L(n) asm volatile("s_waitcnt lgkmcnt(" #n ")" ::: "memory")
#define PG8_BAR __builtin_amdgcn_s_barrier()
#define PG8_SCHED __builtin_amdgcn_sched_barrier(0)
    Unit cur, nxt; int ui = 0;
    if (!S.next(0, cur)) return;
    f32x4 acc[2][2][4][2];
#pragma unroll
    for (int a = 0; a < 2; ++a)
#pragma unroll
        for (int b = 0; b < 2; ++b)
#pragma unroll
            for (int m = 0; m < 4; ++m)
#pragma unroll
                for (int n = 0; n < 2; ++n) acc[a][b][m][n] = (f32x4){0.f, 0.f, 0.f, 0.f};
    bf16x8 At[4][2], B0[2][2], B1[2][2];
    const char* cA = cur.A; const char* cB = cur.B;
    PG8_STAGE(PG8_SB(0, 0), cB, voffB); PG8_STAGE(PG8_SB(0, 1), cB + hB, voffB); PG8_STAGE(PG8_SA(0, 0), cA, voffA); PG8_STAGE(PG8_SA(0, 1), cA + hA, voffA);
    if (wr == 1) PG8_BAR;
    PG8_WAIT_V(2); PG8_BAR;
    PG8_STAGE(PG8_SB(1, 0), cB + kstep, voffB); PG8_STAGE(PG8_SA(1, 0), cA + kstep, voffA); PG8_STAGE(PG8_SB(1, 1), cB + hB + kstep, voffB);
    PG8_WAIT_V(6); PG8_BAR;
    for (;;) {
        const bool has_next = S.next(ui + 1, nxt);
        const char* nA = has_next ? nxt.A : cA; const char* nB = has_next ? nxt.B : cB;
        int nt = cur.nt; asm volatile("" : "+s"(nt));
        asm volatile(".p2align 8" ::: "memory");
#pragma unroll 1
        for (int t = 0; t < nt; t += 2) {
            const bool last = (t == nt - 2);
            const char* a1 = cA + (size_t)(t + 1) * kstep;
            const char* a2 = last ? nA : cA + (size_t)(t + 2) * kstep; const char* b2 = last ? nB : cB + (size_t)(t + 2) * kstep;
            const char* a3 = a2 + kstep; const char* b3 = b2 + kstep;
            if constexpr (Epi::HOOK) {
                if (last && has_next && nxt.kind >= 2) { asm volatile("s_waitcnt vmcnt(0)" ::: "memory"); PG8_BAR; PG8_BAR; asm volatile("" ::: "memory"); } }
            PG8_LDB(B0, 0, 0); PG8_LDB(B1, 0, 1); PG8_SCHED; PG8_LDA(At, 0, 0); PG8_STAGE(PG8_SA(1, 1), a1 + hA, voffA);
            PG8_WAIT_V(8); PG8_WAIT_L(0); PG8_BAR; PG8_MM(0, 0, At, B0); PG8_MM(0, 1, At, B1); PG8_BAR; PG8_SCHED;
            PG8_LDA(At, 0, 1); PG8_STAGE(PG8_SB(0, 0), b2, voffB); PG8_STAGE(PG8_SB(0, 1), b2 + hB, voffB); PG8_STAGE(PG8_SA(0, 0), a2, voffA);
            PG8_WAIT_V(8); PG8_WAIT_L(0); PG8_BAR; PG8_MM(1, 0, At, B0); PG8_MM(1, 1, At, B1); PG8_BAR; PG8_SCHED;
            PG8_LDB(B0, 1, 0); PG8_LDB(B1, 1, 1); PG8_SCHED; PG8_LDA(At, 1, 0); PG8_STAGE(PG8_SA(0, 1), a2 + hA, voffA);
            PG8_WAIT_V(8); PG8_WAIT_L(0); PG8_BAR; PG8_MM(0, 0, At, B0); PG8_MM(0, 1, At, B1); PG8_BAR; PG8_SCHED;
            PG8_LDA(At, 1, 1); PG8_STAGE(PG8_SB(1, 0), b3, voffB); PG8_STAGE(PG8_SB(1, 1), b3 + hB, voffB); PG8_STAGE(PG8_SA(1, 0), a3, voffA);
            PG8_WAIT_V(8); PG8_WAIT_L(0); PG8_BAR; PG8_MM(1, 0, At, B0); PG8_MM(1, 1, At, B1); PG8_BAR; PG8_SCHED;
        }
        if constexpr (F8) asm volatile("s_nop 7\n\ts_nop 7\n\ts_nop 7" ::: "memory");
        if constexpr (Epi::ALIGN) { if (wr == 0) PG8_BAR; }
        if constexpr (Epi::TWICE) { if (REP(26) > 1) (void)E(acc, cur, wr, wc, fr, fq); }
        const bool keep = E(acc, cur, wr, wc, fr, fq);
        if (!has_next) break;
        if constexpr (Epi::CHAIN) {
            const float kf = keep ? 1.f : 0.f;
#pragma unroll
            for (int a = 0; a < 2; ++a)
#pragma unroll
                for (int b = 0; b < 2; ++b)
#pragma unroll
                    for (int m = 0; m < 4; ++m)
#pragma unroll
                        for (int n = 0; n < 2; ++n) acc[a][b][m][n] = acc[a][b][m][n] * kf;
        } else {
#pragma unroll
            for (int a = 0; a < 2; ++a)
#pragma unroll
                for (int b = 0; b < 2; ++b)
#pragma unroll
                    for (int m = 0; m < 4; ++m)
#pragma unroll
                        for (int n = 0; n < 2; ++n) acc[a][b][m][n] = (f32x4){0.f, 0.f, 0.f, 0.f};
        }
        cur = nxt; cA = nA; cB = nB; ++ui;
        if constexpr (Epi::ALIGN) { if (wr == 1) PG8_BAR; }
    }
    PG8_WAIT_V(0);
    if constexpr (!Epi::ALIGN) { if (wr == 0) PG8_BAR; }
    PG8_BAR;
#undef PG8_SA
#undef PG8_SB
#undef PG8_STAGE
#undef PG8_LDA
#undef PG8_LDB
#undef PG8_MMA
#undef PG8_MMA8
#undef PG8_MM
#undef PG8_CAT
#undef PG8_WAIT_V
#undef PG8_WAIT_L
#undef PG8_BAR
#undef PG8_SCHED
}
}
using pg8::Unit;

#define EPI_ARGS f32x4 (&acc)[2][2][4][2], const Unit& u, int wr, int wc, int fr_in, int fq_in
#define EPI_LANE int lane_l = threadIdx.x & 63; asm volatile("" : "+v"(lane_l)); const int fr = lane_l & 15, fq = lane_l >> 4; (void)fr_in; (void)fq_in;
#ifndef EPI_ALIGN
#define EPI_ALIGN true
#endif
struct EpiProj {
    static constexpr bool CHAIN = false, TWICE = true;
    static constexpr bool HOOK = false;
    static constexpr bool ALIGN = true;
    bf16* O; const _Float16* cosT; const _Float16* sinT; bf16* AKV; bf16* BKV; bf16* IK; const u64* ss;
    __device__ __forceinline__ bool operator()(EPI_ARGS) const {
        EPI_LANE
        const int g = 4 * u.pn + wc; const bool rope = (ROPE_MASK >> g) & 1ull;
        const int row0 = u.pm * 256 + wr * 64 + fr;
        u64 sq[8];
#pragma unroll
        for (int k = 0; k < 8; ++k) sq[k] = ss[row0 + (k >> 2) * 128 + (k & 3) * 16];
#pragma unroll
        for (int ai = 0; ai < 2; ++ai) {
            h16x8 ct[4], st[4];
            if (rope) {
#pragma unroll
                for (int k = 0; k < 4; ++k) { const int rr = row0 + ai * 128 + k * 16; const size_t ro = ((size_t)((rr >> 4) * 4 + fq) * 16 + (rr & 15)) * 8;
                    ct[k] = *(const h16x8*)(cosT + ro); st[k] = *(const h16x8*)(sinT + ro); }
            }
#pragma unroll
            for (int m = 0; m < 4; ++m) {
                const int r = row0 + ai * 128 + m * 16;
                const float rs = rstd_of(sq[ai * 4 + m]);
                f32x4 x1a = acc[ai][0][m][0] * rs, x1b = acc[ai][0][m][1] * rs, x2a = acc[ai][1][m][0] * rs, x2b = acc[ai][1][m][1] * rs;
                if (rope) {
                    const h16x8 c8 = ct[m], s8 = st[m];
                    const f32x4 ca = (f32x4){(float)c8[0], (float)c8[1], (float)c8[2], (float)c8[3]}, cb = (f32x4){(float)c8[4], (float)c8[5], (float)c8[6], (float)c8[7]};
                    const f32x4 sa = (f32x4){(float)s8[0], (float)s8[1], (float)s8[2], (float)s8[3]}, sb = (f32x4){(float)s8[4], (float)s8[5], (float)s8[6], (float)s8[7]};
                    const f32x4 o1a = x1a * ca - x2a * sa, o1b = x1b * cb - x2b * sb, o2a = x2a * ca + x1a * sa, o2b = x2b * cb + x1b * sb;
                    x1a = o1a; x1b = o1b; x2a = o2a; x2b = o2b;
                }
                bf16* rowp = (g >= 8 && g < 12) ? AKV + (size_t)r * 256 + 64 * (g - 8) + 8 * fq : (g >= 20 && g < 24) ? BKV + (size_t)r * 256 + 64 * (g - 20) + 8 * fq
                           : (g == 28) ? IK + ((size_t)((r >> 5) * 4 + (fq >> 1)) * 64 + (fq & 1) * 32 + (r & 31)) * 8 : O + (size_t)r * NPROJ + 64 * g + 8 * fq;
                u32x4 w1, w2;
                w1.x = cvt_pk_bf16(x1a[0], x1a[1]); w1.y = cvt_pk_bf16(x1a[2], x1a[3]); w1.z = cvt_pk_bf16(x1b[0], x1b[1]); w1.w = cvt_pk_bf16(x1b[2], x1b[3]);
                w2.x = cvt_pk_bf16(x2a[0], x2a[1]); w2.y = cvt_pk_bf16(x2a[2], x2a[3]); w2.z = cvt_pk_bf16(x2b[0], x2b[1]); w2.w = cvt_pk_bf16(x2b[2], x2b[3]);
                *(u32x4*)(rowp) = w1; *(u32x4*)(rowp + ((g == 28) ? 1024 : 32)) = w2;
            }
        }
        return false;
    }
};
template <bool F8O> struct EpiPlainT {
    static constexpr bool CHAIN = false, TWICE = true;
    static constexpr bool HOOK = false;
#ifndef EPI_ALIGN
#define EPI_ALIGN true
#endif
    static constexpr bool ALIGN = EPI_ALIGN;
    bf16* O; int ldc; float scale; const u64* ss; size_t pn_stride = 0;
    __device__ __forceinline__ bool operator()(EPI_ARGS) const {
        EPI_LANE
        const int row0 = u.pm * 256 + wr * 64 + fr, col0 = (pn_stride ? 0 : u.pn * 256) + wc * 32 + 8 * fq;
        bf16* Ob = O + (size_t)u.pn * pn_stride;
        u64 sq[8];
#pragma unroll
        for (int k = 0; k < 8; ++k) sq[k] = ss ? ss[row0 + (k >> 2) * 128 + (k & 3) * 16] : 0ull;
#pragma unroll
        for (int ai = 0; ai < 2; ++ai)
#pragma unroll
            for (int m = 0; m < 4; ++m) { bf16* rowp = Ob + (size_t)(row0 + ai * 128 + m * 16) * ldc + col0;
                const float sc_ = ss ? rstd_of(sq[ai * 4 + m]) : scale;
#pragma unroll
                for (int bj = 0; bj < 2; ++bj) { const f32x4 v0 = acc[ai][bj][m][0] * sc_, v1 = acc[ai][bj][m][1] * sc_;
                    if constexpr (F8O) {
                        u32x2 w8; w8.x = pk4_f8(v0[0], v0[1], v0[2], v0[3]); w8.y = pk4_f8(v1[0], v1[1], v1[2], v1[3]);
                        *(u32x2*)((unsigned char*)Ob + (size_t)(row0 + ai * 128 + m * 16) * ldc + col0 + bj * 128) = w8;
                    } else {
                    u32x4 w; w.x = cvt_pk_bf16(v0[0], v0[1]); w.y = cvt_pk_bf16(v0[2], v0[3]); w.z = cvt_pk_bf16(v1[0], v1[1]); w.w = cvt_pk_bf16(v1[2], v1[3]);
                    *(u32x4*)(rowp + bj * 128) = w; } } }
        return false;
    }
};
typedef EpiPlainT<false> EpiPlain;
template <bool F8OUT> struct EpiResT {
    static constexpr bool CHAIN = false, TWICE = false;
    static constexpr bool HOOK = false;
#ifndef EPI_ALIGN
#define EPI_ALIGN true
#endif
    static constexpr bool ALIGN = EPI_ALIGN;
    bf16* X; u64* ssn; unsigned char* X8 = nullptr; float sc = 1.f;
    __device__ __forceinline__ bool operator()(EPI_ARGS) const {
        EPI_LANE
        const int row0 = u.pm * 256 + wr * 64 + fr, col0 = u.pn * 256 + wc * 32 + 8 * fq;
#pragma unroll
        for (int ai = 0; ai < 2; ++ai) {
            u32x4 xv[4][2];
#pragma unroll
            for (int m = 0; m < 4; ++m)
#pragma unroll
                for (int bj = 0; bj < 2; ++bj) xv[m][bj] = *(const u32x4*)(X + (size_t)(row0 + ai * 128 + m * 16) * D + col0 + bj * 128);
#pragma unroll
            for (int m = 0; m < 4; ++m) { const int r = row0 + ai * 128 + m * 16; bf16* rowp = X + (size_t)r * D + col0; float q = 0.f;
#pragma unroll
                for (int bj = 0; bj < 2; ++bj) {
                    const u32x4 xq = xv[m][bj];
                    f32x4 v0 = acc[ai][bj][m][0] * sc, v1 = acc[ai][bj][m][1] * sc;
                    v0[0] += __uint_as_float(xq.x << 16); v0[1] += __uint_as_float(xq.x & 0xffff0000u); v0[2] += __uint_as_float(xq.y << 16); v0[3] += __uint_as_float(xq.y & 0xffff0000u);
                    v1[0] += __uint_as_float(xq.z << 16); v1[1] += __uint_as_float(xq.z & 0xffff0000u); v1[2] += __uint_as_float(xq.w << 16); v1[3] += __uint_as_float(xq.w & 0xffff0000u);
                    q += (v0[0] * v0[0] + v0[1] * v0[1]) + (v0[2] * v0[2] + v0[3] * v0[3]) + (v1[0] * v1[0] + v1[1] * v1[1]) + (v1[2] * v1[2] + v1[3] * v1[3]);
                    u32x4 w; w.x = cvt_pk_bf16(v0[0], v0[1]); w.y = cvt_pk_bf16(v0[2], v0[3]); w.z = cvt_pk_bf16(v1[0], v1[1]); w.w = cvt_pk_bf16(v1[2], v1[3]);
                    *(u32x4*)(rowp + bj * 128) = w;
                    if constexpr (F8OUT) { u32x2 w8; w8.x = pk4_f8(v0[0], v0[1], v0[2], v0[3]); w8.y = pk4_f8(v1[0], v1[1], v1[2], v1[3]); *(u32x2*)(X8 + (size_t)r * D + col0 + bj * 128) = w8; } }
                q += __shfl_xor(q, 16); q += __shfl_xor(q, 32);
                if (fq == 0) atomicAdd(ssn + r, ss_fix(q)); }
            asm volatile("" ::: "memory"); }
        return false;
    }
};
typedef EpiResT<false> EpiRes;
struct EpiGate {
    static constexpr bool CHAIN = false, TWICE = true;
    static constexpr bool HOOK = false;
#ifndef EPI_ALIGN
#define EPI_ALIGN true
#endif
    static constexpr bool ALIGN = EPI_ALIGN;
    unsigned* scr; const u64* ss; float wsc;
    __device__ __forceinline__ bool operator()(EPI_ARGS) const {
        EPI_LANE
        const unsigned voff = (unsigned)(((unsigned)__builtin_amdgcn_readfirstlane(threadIdx.x >> 6) * 64u + (unsigned)lane_l) * 16u);
        char* sb = (char*)scr + (size_t)u.kind * 131072;
        u64 sq[8];
#pragma unroll
        for (int k = 0; k < 8; ++k) sq[k] = ss[u.pm * 256 + (k >> 2) * 128 + wr * 64 + (k & 3) * 16 + fr];
#pragma unroll
        for (int ai = 0; ai < 2; ++ai)
#pragma unroll
            for (int m = 0; m < 4; ++m)
#pragma unroll
                for (int bj = 0; bj < 2; ++bj) {
                    const float ns = -1.44269504f * wsc * rstd_of(sq[ai * 4 + m]);
                    f32x4 v0 = acc[ai][bj][m][0], v1 = acc[ai][bj][m][1]; u32x4 w;
#pragma unroll
                    for (int j = 0; j < 4; ++j) { v0[j] = fmaxf(__builtin_amdgcn_rcpf(1.f + __builtin_amdgcn_exp2f(ns * v0[j])), 1e-6f); v1[j] = fmaxf(__builtin_amdgcn_rcpf(1.f + __builtin_amdgcn_exp2f(ns * v1[j])), 1e-6f); }
                    w.x = cvt_pk_bf16(v0[0], v0[1]); w.y = cvt_pk_bf16(v0[2], v0[3]); w.z = cvt_pk_bf16(v1[0], v1[1]); w.w = cvt_pk_bf16(v1[2], v1[3]);
                    *(u32x4*)(sb + (size_t)((ai * 4 + m) * 2 + bj) * 8192 + voff) = w; asm volatile("" ::: "memory"); }
        return false;
    }
};
struct EpiUp {
    static constexpr bool CHAIN = false, TWICE = false;
    static constexpr bool HOOK = false;
#ifndef EPI_ALIGN
#define EPI_ALIGN true
#endif
    static constexpr bool ALIGN = EPI_ALIGN;
    unsigned* scr; bf16* O;
    __device__ __forceinline__ bool operator()(EPI_ARGS) const {
        EPI_LANE
        const unsigned tl = (unsigned)__builtin_amdgcn_readfirstlane(threadIdx.x >> 6) * 64u + (unsigned)lane_l;
        const char* s0 = (const char*)scr + (size_t)u.kind * 131072;
        char* pb = (char*)scr + 4 * 131072;
        const int row0 = u.pm * 256 + wr * 64 + fr, col0 = u.pn * 256 + wc * 32 + 8 * fq;
#pragma unroll
        for (int ai = 0; ai < 2; ++ai) {
            u32x4 av[8], pv[8];
#pragma unroll
            for (int k = 0; k < 8; ++k) { const int slot = ai * 8 + k; av[k] = *(const u32x4*)(s0 + (size_t)slot * 8192 + tl * 16u);
                pv[k] = (u.kind > 0) ? *(const u32x4*)(pb + (size_t)slot * 8192 + tl * 16u) : (u32x4){0u, 0u, 0u, 0u}; }
#pragma unroll
            for (int m = 0; m < 4; ++m)
#pragma unroll
                for (int bj = 0; bj < 2; ++bj) {
                    const int k = m * 2 + bj, slot = ai * 8 + k; const u32x4 a = av[k], q = pv[k];
                    f32x4 p0 = (f32x4){__uint_as_float(q.x << 16), __uint_as_float(q.x & 0xffff0000u), __uint_as_float(q.y << 16), __uint_as_float(q.y & 0xffff0000u)};
                    f32x4 p1 = (f32x4){__uint_as_float(q.z << 16), __uint_as_float(q.z & 0xffff0000u), __uint_as_float(q.w << 16), __uint_as_float(q.w & 0xffff0000u)};
                    const f32x4 f0 = (f32x4){__uint_as_float(a.x << 16), __uint_as_float(a.x & 0xffff0000u), __uint_as_float(a.y << 16), __uint_as_float(a.y & 0xffff0000u)};
                    const f32x4 f1 = (f32x4){__uint_as_float(a.z << 16), __uint_as_float(a.z & 0xffff0000u), __uint_as_float(a.w << 16), __uint_as_float(a.w & 0xffff0000u)};
                    p0 = p0 + acc[ai][bj][m][0] * f0; p1 = p1 + acc[ai][bj][m][1] * f1;
                    u32x4 w; w.x = cvt_pk_bf16(p0[0], p0[1]); w.y = cvt_pk_bf16(p0[2], p0[3]); w.z = cvt_pk_bf16(p1[0], p1[1]); w.w = cvt_pk_bf16(p1[2], p1[3]);
                    if (u.kind < 3) *(u32x4*)(pb + (size_t)slot * 8192 + tl * 16u) = w;
                    else *(u32x4*)(O + (size_t)(row0 + ai * 128 + m * 16) * D + col0 + bj * 128) = w;
                }
            asm volatile("" ::: "memory"); }
        return false;
    }
};
struct EpiSoftmax {
    static constexpr bool CHAIN = false, TWICE = false;
    static constexpr bool HOOK = false;
#ifndef EPI_ALIGN
#define EPI_ALIGN true
#endif
    static constexpr bool ALIGN = true;
    bf16* P; LAS f32x2* xch; float scale_log2;
    __device__ __forceinline__ bool operator()(EPI_ARGS) const {
        EPI_LANE
        LAS f32x2* X = xch + (size_t)(u.kind & 1) * 1024;
#pragma unroll
        for (int ai = 0; ai < 2; ++ai)
#pragma unroll
            for (int m = 0; m < 4; ++m) {
                float v = -3.0e38f;
#pragma unroll
                for (int bj = 0; bj < 2; ++bj)
#pragma unroll
                    for (int n = 0; n < 2; ++n) { const f32x4 x = acc[ai][bj][m][n]; v = fmaxf(v, fmaxf(fmaxf(x[0], x[1]), fmaxf(x[2], x[3]))); }
                v *= scale_log2;
                v = fmaxf(v, __shfl_xor(v, 16)); v = fmaxf(v, __shfl_xor(v, 32));
                float s = 0.f;
#pragma unroll
                for (int bj = 0; bj < 2; ++bj)
#pragma unroll
                    for (int n = 0; n < 2; ++n) { const f32x4 x = acc[ai][bj][m][n];
#pragma unroll
                        for (int j = 0; j < 4; ++j) s += __builtin_amdgcn_exp2f(x[j] * scale_log2 - v); }
                s += __shfl_xor(s, 16); s += __shfl_xor(s, 32);
                if (fq == 0) X[(ai * 128 + wr * 64 + m * 16 + fr) * 4 + wc] = (f32x2){v, s};
            }
        asm volatile("s_waitcnt lgkmcnt(0)" ::: "memory"); __builtin_amdgcn_s_barrier(); asm volatile("" ::: "memory");
        const int row0 = u.pm * 256 + wr * 64 + fr, col0 = u.pn * 256 + wc * 32 + 8 * fq;
#pragma unroll
        for (int ai = 0; ai < 2; ++ai)
#pragma unroll
            for (int m = 0; m < 4; ++m) {
                const int rl = ai * 128 + wr * 64 + m * 16 + fr;
                const f32x2 p0 = X[rl * 4 + 0], p1 = X[rl * 4 + 1], p2 = X[rl * 4 + 2], p3 = X[rl * 4 + 3];
                const float gm = fmaxf(fmaxf(p0.x, p1.x), fmaxf(p2.x, p3.x));
                const float tot = p0.y * __builtin_amdgcn_exp2f(p0.x - gm) + p1.y * __builtin_amdgcn_exp2f(p1.x - gm) + p2.y * __builtin_amdgcn_exp2f(p2.x - gm) + p3.y * __builtin_amdgcn_exp2f(p3.x - gm);
                const float inv = 1.f / tot;
                bf16* rowp = P + (size_t)(row0 + ai * 128 + m * 16) * D + col0;
#pragma unroll
                for (int bj = 0; bj < 2; ++bj) { f32x4 v0 = acc[ai][bj][m][0], v1 = acc[ai][bj][m][1];
#pragma unroll
                    for (int j = 0; j < 4; ++j) { v0[j] = __builtin_amdgcn_exp2f(v0[j] * scale_log2 - gm) * inv; v1[j] = __builtin_amdgcn_exp2f(v1[j] * scale_log2 - gm) * inv; }
                    u32x4 w; w.x = cvt_pk_bf16(v0[0], v0[1]); w.y = cvt_pk_bf16(v0[2], v0[3]); w.z = cvt_pk_bf16(v1[0], v1[1]); w.w = cvt_pk_bf16(v1[2], v1[3]);
                    *(u32x4*)(rowp + bj * 128) = w; }
                asm volatile("" ::: "memory");
            }
        return false;
    }
};
struct EpiCross {
    static constexpr bool CHAIN = false, TWICE = false;
    static constexpr bool ALIGN = true, HOOK = true;
    EpiPlain q; EpiSoftmax sm; EpiPlainT<true> o;
    __device__ __forceinline__ bool operator()(EPI_ARGS) const {
        if (u.kind < 2) return q(acc, u, wr, wc, fr_in, fq_in);
        if (u.kind < 4) return sm(acc, u, wr, wc, fr_in, fq_in);
        return o(acc, u, wr, wc, fr_in, fq_in);
    }
};
struct EpiGU {
    static constexpr bool CHAIN = false, TWICE = true;
    static constexpr bool HOOK = false;
#ifndef EPI_ALIGN
#define EPI_ALIGN true
#endif
    static constexpr bool ALIGN = EPI_ALIGN;
    bf16* H; const u64* ss; float wsc;
    __device__ __forceinline__ bool operator()(EPI_ARGS) const {
        EPI_LANE
        const int row0 = u.pm * 256 + wr * 64 + fr, col0 = u.pn * 128 + wc * 32 + 8 * fq;
        u64 sq[8];
#pragma unroll
        for (int k = 0; k < 8; ++k) sq[k] = ss[row0 + (k >> 2) * 128 + (k & 3) * 16];
#pragma unroll
        for (int ai = 0; ai < 2; ++ai)
#pragma unroll
            for (int m = 0; m < 4; ++m) {
                const float rs = rstd_of(sq[ai * 4 + m]) * wsc, ns = -1.44269504f * rs;
                f32x4 v[2];
#pragma unroll
                for (int n = 0; n < 2; ++n) { const f32x4 g = acc[ai][0][m][n], uu = acc[ai][1][m][n];
#pragma unroll
                    for (int j = 0; j < 4; ++j) v[n][j] = (g[j] * rs) * __builtin_amdgcn_rcpf(1.f + __builtin_amdgcn_exp2f(ns * g[j])) * (uu[j] * (rs * F8_HSCALE)); }
                u32x2 w; w.x = pk4_f8(v[0][0], v[0][1], v[0][2], v[0][3]); w.y = pk4_f8(v[1][0], v[1][1], v[1][2], v[1][3]);
                *(u32x2*)((unsigned char*)H + (size_t)(row0 + ai * 128 + m * 16) * DFF + col0) = w; asm volatile("" ::: "memory");
            }
        return false;
    }
};
struct EpiDownMoe {
    static constexpr bool CHAIN = false, TWICE = false;
    static constexpr bool HOOK = false;
    static constexpr bool ALIGN = true;
    const int* tokmap; const float* roww; bf16* Y; int t_slot1;
    __device__ __forceinline__ bool operator()(EPI_ARGS) const {
        EPI_LANE
        const int row0 = u.pm * 256 + wr * 64 + fr, col0 = u.pn * 256 + wc * 32 + 8 * fq;
        bf16* Ys = Y + ((u.pm >= t_slot1) ? (size_t)M * D : (size_t)0);
        int tk[8]; float wg[8];
#pragma unroll
        for (int k = 0; k < 8; ++k) { const int r = row0 + (k >> 2) * 128 + (k & 3) * 16; tk[k] = tokmap[r]; wg[k] = roww[r] * (1.f / (F8_HSCALE * F8_WSCALE)); }
#pragma unroll
        for (int ai = 0; ai < 2; ++ai)
#pragma unroll
            for (int m = 0; m < 4; ++m) { const int t_ = tk[ai * 4 + m];
                if (t_ >= 0) { const float wgt = wg[ai * 4 + m]; bf16* rowp = Ys + (size_t)t_ * D + col0;
#pragma unroll
                    for (int bj = 0; bj < 2; ++bj) { const f32x4 v0 = acc[ai][bj][m][0] * wgt, v1 = acc[ai][bj][m][1] * wgt;
                        u32x4 w; w.x = cvt_pk_bf16(v0[0], v0[1]); w.y = cvt_pk_bf16(v0[2], v0[3]); w.z = cvt_pk_bf16(v1[0], v1[1]); w.w = cvt_pk_bf16(v1[2], v1[3]);
                        *(u32x4*)(rowp + bj * 128) = w; } } }
        return false;
    }
};

template <int MODE> struct MergeSched {
    const char* A0; const char* A1; const char* W; int pm, pn;
    __device__ __forceinline__ bool next(int i, Unit& u) const {
        if (i >= 4) return false;
        u.pm = pm; u.pn = pn; u.kind = i;
        if (MODE == 0) { u.A = A0 + (size_t)pm * 256 * 1024; u.B = W + (size_t)(i * 1024 + pn * 256) * 1024; u.nt = 8; }
        else { u.A = ((i < 2) ? A0 : A1) + (size_t)pm * 256 * 2048 + (i & 1) * 1024; u.B = W + (size_t)(i >> 1) * (2 * MiB) + (size_t)pn * 256 * 2048 + (i & 1) * 1024; u.nt = 8; }
        return true;
    }
};
struct CrossFusedSched {
    const char* XB; const char* Wq; const char* XQ; const char* Kx; const char* XP; const char* VTb; int G, c;
    __device__ __forceinline__ bool next(int i, Unit& u) const {
        if (i >= 6) return false;
        const int ti = i & 1, stage = i >> 1;
        int L = ti * G + c; if (L >= 512) return false;
        { const int q = 512 / 8, xcd = L % 8, off = L / 8; L = xcd * q + off; }
        const int rt = L & 15, head = (L >> 4) & 3, b = L >> 6;
        u.pm = b * 16 + rt; u.pn = head; u.kind = 2 * stage + ti;
        if (stage == 0) { u.A = XB + (size_t)u.pm * 256 * 2048; u.B = Wq + (size_t)head * 256 * 2048; u.nt = 16; }
        else if (stage == 1) { u.A = XQ + (size_t)u.pm * 256 * 2048 + head * 512; u.B = Kx + (size_t)(b * 256) * 2048 + head * 512; u.nt = 4; }
        else { u.A = XP + (size_t)u.pm * 256 * 2048 + head * 512; u.B = VTb + (size_t)b * ((size_t)D * D * 2) + (size_t)(head * 256) * 2048; u.nt = 4; }
        return true;
    }
};
struct CrossSched {
    const char* A; const char* B; int mode, G, c;
    __device__ __forceinline__ bool next(int i, Unit& u) const {
        const long L0 = (long)i * G + c; if (L0 >= 512) return false;
        int L = (int)L0; { const int q = 512 / 8, xcd = L % 8, off = L / 8; L = xcd * q + off; }
        const int rt = L & 15, head = (L >> 4) & 3, b = L >> 6;
        u.pm = b * 16 + rt; u.pn = head; u.kind = i; u.nt = 4;
        u.A = A + (size_t)u.pm * 256 * 2048 + head * 512;
        u.B = (mode == 0) ? B + (size_t)(b * 256) * 2048 + head * 512 : B + (size_t)(head * 256) * 4096 + b * 512;
        return true;
    }
};
struct MoeSched {
    const char* A; const char* B; unsigned lda; size_t wstride; unsigned ldb; int t0, nT, nN, nt, G, c; const int* gt;
    __device__ __forceinline__ bool next(int i, Unit& u) const {
        const long L = (long)i * G + c; if (L >= (long)nT * nN) return false;
        int pm, pn; pg8::tile_of((int)L, nT, nN, pm, pn); pm += t0;
        int g = 0;
#pragma unroll
        for (int k = 1; k < 16; ++k) g += (pm >= gt[k]) ? 1 : 0;
        g = __builtin_amdgcn_readfirstlane(g);
        u.pm = pm; u.pn = pn; u.kind = 0; u.nt = nt;
        u.A = A + (size_t)pm * 256 * lda; u.B = B + (size_t)(g & 7) * wstride + (size_t)pn * 256 * ldb; return true;
    }
};

#define XB_TMO      128
#define XB_XCNT(j)  (256  + 64 * (j))
#define XB_XSUB(j)  (1280 + 64 * (j))
#define XB_XGEN(j)  (2304 + 64 * (j))
#define XB_TOP      3328
#define XB_TOPGEN   3392
#define XCD_BAR_WORDS 3456
#define XB_SPIN_CAP (1u << 22)
__device__ __forceinline__ unsigned xb_ld(unsigned* p)              { return __hip_atomic_load(p, __ATOMIC_RELAXED, __HIP_MEMORY_SCOPE_AGENT); }
__device__ __forceinline__ unsigned xb_add(unsigned* p, unsigned v) { return __hip_atomic_fetch_add(p, v, __ATOMIC_RELAXED, __HIP_MEMORY_SCOPE_AGENT); }
__device__ __forceinline__ unsigned xb_xcc_id() { return (unsigned)__builtin_amdgcn_s_getreg((3 << 11) | 20) & 0xFu; }
#define XB_SPIN(cond, bar) do { unsigned _sp = 0; while (cond) { __builtin_amdgcn_s_sleep(1); \
    if ((++_sp & 255u) == 0u) { if (xb_ld(&(bar)[XB_TMO])) break; if (_sp > XB_SPIN_CAP) { atomicAdd(&(bar)[XB_TMO], 1u); break; } } } } while (0)
struct XcdBarrier { unsigned* bar; unsigned x; volatile LAS unsigned* st; };
__device__ __forceinline__ XcdBarrier xcd_barrier_post(unsigned* bar, volatile LAS unsigned* st) {
    XcdBarrier b; b.bar = bar; b.x = xb_xcc_id(); b.st = st;
    if (threadIdx.x == 0) (void)xb_add(&bar[XB_XCNT(b.x)], 1u);
    return b;
}
__device__ __forceinline__ void xcd_barrier_complete(unsigned* bar, unsigned x, unsigned& nloc, unsigned& nx) {
    const unsigned G = gridDim.x * gridDim.y * gridDim.z;
    unsigned sum, cnt, mine, sp = 0u;
    for (;;) {
        sum = 0u; cnt = 0u; mine = 0u;
#pragma unroll
        for (unsigned j = 0; j < 16; ++j) { const unsigned c = xb_ld(&bar[XB_XCNT(j)]); sum += c; cnt += (c > 0u) ? 1u : 0u; mine = (j == x) ? c : mine; }
        if (sum == G) break;
        __builtin_amdgcn_s_sleep(1);
        if ((++sp & 255u) == 0u) { if (xb_ld(&bar[XB_TMO])) break; if (sp > XB_SPIN_CAP) { atomicAdd(&bar[XB_TMO], 1u); break; } }
    }
    nloc = mine > 0u ? mine : 1u; nx = cnt > 0u ? cnt : 1u;
}
__device__ __noinline__ void xcd_barrier_impl(unsigned* bar_, unsigned x_, volatile LAS unsigned* st_) {
    XcdBarrier b; b.bar = bar_; b.x = x_; b.st = st_;
    asm volatile("s_waitcnt vmcnt(0)" ::: "memory");
    __syncthreads();
    if (threadIdx.x == 0) {
        unsigned* bar = b.bar;
        __builtin_amdgcn_s_waitcnt(0);
        unsigned nloc = b.st[0], nx = b.st[1];
        if (nloc == 0u) { xcd_barrier_complete(bar, b.x, nloc, nx); b.st[0] = nloc; b.st[1] = nx; }
        const unsigned old = xb_add(&bar[XB_XSUB(b.x)], 1u);
        const unsigned gen = old / nloc;
        if (old + 1u == (gen + 1u) * nloc) {
            __builtin_amdgcn_fence(__ATOMIC_RELEASE, "agent");
            asm volatile("s_waitcnt vmcnt(0)" ::: "memory");
            const unsigned og = xb_add(&bar[XB_TOP], 1u);
            const unsigned tg = og / nx;
            if (og + 1u == (tg + 1u) * nx) xb_add(&bar[XB_TOPGEN], 1u);
            else XB_SPIN(xb_ld(&bar[XB_TOPGEN]) == tg, bar);
            __builtin_amdgcn_fence(__ATOMIC_ACQUIRE, "agent");
            xb_add(&bar[XB_XGEN(b.x)], 1u);
            asm volatile("s_waitcnt vmcnt(0)" ::: "memory");
        } else {
            XB_SPIN(xb_ld(&bar[XB_XGEN(b.x)]) == gen, bar);
            __builtin_amdgcn_fence(__ATOMIC_ACQUIRE, "agent");
            asm volatile("s_waitcnt vmcnt(0)" ::: "memory");
        }
    }
    __syncthreads();
}
__device__ __forceinline__ void xcd_barrier(const XcdBarrier& b) { xcd_barrier_impl(b.bar, b.x, b.st); }

struct Args {
    const float* x; const float* mem; const int* positions; const float* norm_mix; const float* w_in; const float* attn_sink; const float* w_branch; const float* w_out;
    const float* pool_w; const float* pool_scale; const float* norm_cross; const float* norm_mem; const float* w_xq; const float* w_xkv; const float* w_xo; const float* norm_ffn;
    const float* dense_w_gu; const float* dense_w_down; const float* router_w; const float* moe_w_gu; const float* moe_w_down; const float* norm_final;
    float* out; unsigned char* ws; int ph_lo, ph_hi;
};

template <int F8 = 0>
__device__ __forceinline__ void transpose_item(const float* W, int ldw, int k0, int src, int nv, bf16* WT, size_t dst_pitch, int dst_row0, int dst_k0, LAS float* scr, int lane, const float* gain) {
    f32x4 tv[8];
    const int n4 = (lane & 7) * 4, kr = lane >> 3;
#pragma unroll
    for (int i = 0; i < 8; ++i) tv[i] = (n4 < nv) ? *(const f32x4*)(W + (size_t)(k0 + 8 * i + kr) * ldw + src + n4) : (f32x4){0.f, 0.f, 0.f, 0.f};
    if (gain) {
#pragma unroll
        for (int i = 0; i < 8; ++i) tv[i] = tv[i] * gain[k0 + 8 * i + kr]; }
#pragma unroll
    for (int i = 0; i < 8; ++i) { LAS float* d = scr + (8 * i + kr) * 33 + n4; d[0] = tv[i].x; d[1] = tv[i].y; d[2] = tv[i].z; d[3] = tv[i].w; }
    LDS_WAIT(); asm volatile("" ::: "memory");
    const int c = lane & 7;
#pragma unroll
    for (int j = 0; j < 4; ++j) { const int n = (lane >> 3) + 8 * j; const LAS float* s = scr + (8 * c) * 33 + n;
        if constexpr (F8) {
            u32x2 o; o.x = pk4_f8(s[0 * 33] * F8_WSCALE, s[1 * 33] * F8_WSCALE, s[2 * 33] * F8_WSCALE, s[3 * 33] * F8_WSCALE); o.y = pk4_f8(s[4 * 33] * F8_WSCALE, s[5 * 33] * F8_WSCALE, s[6 * 33] * F8_WSCALE, s[7 * 33] * F8_WSCALE);
            *(u32x2*)((unsigned char*)WT + (size_t)(dst_row0 + n) * dst_pitch + dst_k0 + k0 + 8 * c) = o;
        } else {
        u32x4 o; o.x = pk2(s[0 * 33], s[1 * 33]); o.y = pk2(s[2 * 33], s[3 * 33]); o.z = pk2(s[4 * 33], s[5 * 33]); o.w = pk2(s[6 * 33], s[7 * 33]);
        *(u32x4*)(WT + (size_t)(dst_row0 + n) * dst_pitch + dst_k0 + k0 + 8 * c) = o; } }
    LDS_WAIT(); asm volatile("" ::: "memory");
}
template <int MAP, int F8 = 0>
__device__ __forceinline__ void conv_seg(const float* W, int K, int ldw, int src0, bf16* WT, size_t dst_pitch, int dst_k0, int nb, int item, LAS float* scr, int lane, const float* gain = nullptr) {
    const int kb = item / nb, vb = item % nb;
    int src, nv = 32;
    if (MAP == 0) src = src0 + 32 * vb;
    else if (MAP == 1) { const int pn = vb >> 3, bj = (vb >> 2) & 1, wc = vb & 3, g = 4 * pn + wc;
        if (g < 29) src = 64 * g + 32 * bj; else if (g < 61) src = 64 * g + 4 + 32 * bj; else if (g == 61) { src = 1856; nv = bj == 0 ? 4 : 0; } else { src = 0; nv = 0; } }
    else { const int pn = vb >> 3, bj = (vb >> 2) & 1, pb = vb & 3; src = src0 + bj * DFF + 128 * pn + 32 * pb; }
    transpose_item<F8>(W, ldw, 64 * kb, src, nv, WT, dst_pitch, 32 * vb, dst_k0, scr, lane, gain);
}
struct ConvItem { const float* W; int ldw, k0, src; const float* gain; unsigned char* WT; int dpitch, drow0; };
__device__ __forceinline__ void conv_load(const ConvItem& c, f32x4 (&tv)[8], float (&gv)[8], int lane) {
    const int n4 = (lane & 7) * 4, kr = lane >> 3;
#pragma unroll
    for (int i = 0; i < 8; ++i) tv[i] = *(const f32x4*)(c.W + (size_t)(c.k0 + 8 * i + kr) * c.ldw + c.src + n4);
#pragma unroll
    for (int i = 0; i < 8; ++i) gv[i] = c.gain ? c.gain[c.k0 + 8 * i + kr] : 1.f;
}
__device__ __forceinline__ void conv_finish8(const ConvItem& c, const f32x4 (&tv)[8], const float (&gv)[8], LAS float* scr, int lane) {
    const int n4 = (lane & 7) * 4, kr = lane >> 3;
#pragma unroll
    for (int i = 0; i < 8; ++i) { const float g = gv[i] * F8_WSCALE; LAS float* d = scr + (8 * i + kr) * 33 + n4; d[0] = tv[i].x * g; d[1] = tv[i].y * g; d[2] = tv[i].z * g; d[3] = tv[i].w * g; }
    LDS_WAIT(); asm volatile("" ::: "memory");
    const int cc = lane & 7;
#pragma unroll
    for (int j = 0; j < 4; ++j) { const int n = (lane >> 3) + 8 * j; const LAS float* sp = scr + (8 * cc) * 33 + n;
        u32x2 o; o.x = pk4_f8(sp[0 * 33], sp[1 * 33], sp[2 * 33], sp[3 * 33]); o.y = pk4_f8(sp[4 * 33], sp[5 * 33], sp[6 * 33], sp[7 * 33]);
        *(u32x2*)(c.WT + (size_t)(c.drow0 + n) * c.dpitch + c.k0 + 8 * cc) = o; }
    LDS_WAIT(); asm volatile("" ::: "memory");
}
__device__ __forceinline__ void norm_row_bf16(const float* xrow, const float* g, bf16* orow, int lane) {
    const f32x4* xr = (const f32x4*)xrow + lane; const f32x4* gr = (const f32x4*)g + lane;
    f32x4 v[4]; float s = 0.f;
#pragma unroll
    for (int j = 0; j < 4; ++j) { v[j] = xr[64 * j]; s += (v[j].x * v[j].x + v[j].y * v[j].y) + (v[j].z * v[j].z + v[j].w * v[j].w); }
    const float rstd = 1.f / sqrtf(wave_sum(s) * (1.f / D) + EPS);
    unsigned long long* o8 = (unsigned long long*)orow + lane;
#pragma unroll
    for (int j = 0; j < 4; ++j) { const f32x4 gg = gr[64 * j];
        o8[64 * j] = (unsigned long long)pk2(v[j].x * rstd * gg.x, v[j].y * rstd * gg.y) | ((unsigned long long)pk2(v[j].z * rstd * gg.z, v[j].w * rstd * gg.w) << 32); }
}

constexpr int RT_P = 136;
typedef float f32x4v __attribute__((ext_vector_type(4)));
__device__ __forceinline__ void pool_phase(const bf16* proj, const bf16* wpt, const float* pscale, bf16* br23, char* lds, int G) {
    int tid = threadIdx.x; asm volatile("" : "+v"(tid)); const int lane = tid & 63, wave = tid >> 6, fr = lane & 15, fq = lane >> 4;
    bf16* Dl = (bf16*)lds;
    for (int un = blockIdx.x; un < 2048; un += G) {
        const int g = un & 3, tb = (un >> 2) & 63, b = un >> 8;
        const int win = 2 << g;
#pragma unroll
        for (int i = 0; i < 2; ++i) { const int idx = tid + 512 * i, tt = idx >> 4, pc = idx & 15, t = tb * 64 + tt;
            const bf16* up = proj + ((size_t)(b * T + t)) * NPROJ + C_PU + g * 128 + 8 * pc;
            const int cnt = (t + 1 < win) ? t + 1 : win;
            float sm[8];
#pragma unroll
            for (int q = 0; q < 8; ++q) sm[q] = 0.f;
            u32x4 wv[16];
#pragma unroll
            for (int j = 0; j < 16; ++j) wv[j] = (j < cnt) ? *(const u32x4*)(up - (size_t)j * NPROJ) : (u32x4){0u, 0u, 0u, 0u};
            const u32x4 u0 = wv[0];
#pragma unroll
            for (int j = 0; j < 16; ++j) { const u32x4 v = wv[j];
                sm[0] += __uint_as_float(v.x << 16); sm[1] += __uint_as_float(v.x & 0xffff0000u); sm[2] += __uint_as_float(v.y << 16); sm[3] += __uint_as_float(v.y & 0xffff0000u);
                sm[4] += __uint_as_float(v.z << 16); sm[5] += __uint_as_float(v.z & 0xffff0000u); sm[6] += __uint_as_float(v.w << 16); sm[7] += __uint_as_float(v.w & 0xffff0000u); }
            const float ic = 1.f / (float)cnt;
            u32x4 o;
            o.x = pk2(sm[0] * ic - __uint_as_float(u0.x << 16), sm[1] * ic - __uint_as_float(u0.x & 0xffff0000u)); o.y = pk2(sm[2] * ic - __uint_as_float(u0.y << 16), sm[3] * ic - __uint_as_float(u0.y & 0xffff0000u));
            o.z = pk2(sm[4] * ic - __uint_as_float(u0.z << 16), sm[5] * ic - __uint_as_float(u0.z & 0xffff0000u)); o.w = pk2(sm[6] * ic - __uint_as_float(u0.w << 16), sm[7] * ic - __uint_as_float(u0.w & 0xffff0000u));
            *(u32x4*)(Dl + tt * RT_P + 8 * pc) = o; }
        __syncthreads();
        const bf16* wp = wpt + (size_t)g * 16384 + (16 * wave + fr) * 128 + 8 * fq;
        bf16x8 bw[4];
#pragma unroll
        for (int ks = 0; ks < 4; ++ks) bw[ks] = *(const bf16x8*)(wp + 32 * ks);
        const float sc = pscale[g * 128 + 16 * wave + fr];
#pragma unroll
        for (int tt = 0; tt < 4; ++tt) { f32x4v d = (f32x4v){0.f, 0.f, 0.f, 0.f};
#pragma unroll
            for (int ks = 0; ks < 4; ++ks) d = __builtin_amdgcn_mfma_f32_16x16x32_bf16(*(const bf16x8*)(Dl + (16 * tt + fr) * RT_P + 32 * ks + 8 * fq), bw[ks], d, 0, 0, 0);
#pragma unroll
            for (int r = 0; r < 4; ++r) br23[((size_t)(b * T + tb * 64 + 16 * tt + 4 * fq + r)) * D + 512 + g * 128 + 16 * wave + fr] = (bf16)f2bf1(d[r] * sc); }
        __syncthreads();
    }
}
__device__ __forceinline__ float row16_max(float v) {
    v = fmaxf(v, __builtin_bit_cast(float, __builtin_amdgcn_mov_dpp(__builtin_bit_cast(int, v), 0xB1, 0xf, 0xf, true)));
    v = fmaxf(v, __builtin_bit_cast(float, __builtin_amdgcn_mov_dpp(__builtin_bit_cast(int, v), 0x4E, 0xf, 0xf, true)));
    v = fmaxf(v, __builtin_bit_cast(float, __builtin_amdgcn_mov_dpp(__builtin_bit_cast(int, v), 0x141, 0xf, 0xf, true)));
    v = fmaxf(v, __builtin_bit_cast(float, __builtin_amdgcn_mov_dpp(__builtin_bit_cast(int, v), 0x140, 0xf, 0xf, true)));
    return v;
}
__device__ __forceinline__ float row16_sum(float v) {
    v += __builtin_bit_cast(float, __builtin_amdgcn_mov_dpp(__builtin_bit_cast(int, v), 0xB1, 0xf, 0xf, true));
    v += __builtin_bit_cast(float, __builtin_amdgcn_mov_dpp(__builtin_bit_cast(int, v), 0x4E, 0xf, 0xf, true));
    v += __builtin_bit_cast(float, __builtin_amdgcn_mov_dpp(__builtin_bit_cast(int, v), 0x141, 0xf, 0xf, true));
    v += __builtin_bit_cast(float, __builtin_amdgcn_mov_dpp(__builtin_bit_cast(int, v), 0x140, 0xf, 0xf, true));
    return v;
}
constexpr int SWA_KP = 72, SWA_VP = 264, SWA_PP = 168;
__device__ __forceinline__ void swa_phase(const bf16* proj, const bf16* akv, const float* sink, bf16* br01, char* lds, int G) {
    int tid = threadIdx.x; asm volatile("" : "+v"(tid)); const int lane = tid & 63, wave = tid >> 6;
    bf16* Kl = (bf16*)lds; bf16* Vt = (bf16*)(lds + 36864); bf16* Pw = (bf16*)(lds + 36864 + 33792) + wave * 16 * SWA_PP;
    for (int un = blockIdx.x; un < 512; un += G) {
        const int nb = un & 31, kvh = (un >> 5) & 1, b = un >> 6;
        const size_t m0 = (size_t)b * T + nb * 128;
#pragma unroll
        for (int i = 0; i < 4; ++i) { const int idx = tid + 512 * i, key = idx >> 3, pc = idx & 7;
            u32x4 kv = (u32x4){0u, 0u, 0u, 0u}, vv = kv;
            if (nb > 0 || key >= 128) { const bf16* src = akv + (m0 - 128 + key) * 256 + kvh * 64 + pc * 8; kv = *(const u32x4*)src; vv = *(const u32x4*)(src + 128); }
            *(u32x4*)(Kl + key * SWA_KP + pc * 8) = kv;
            bf16* vd = Vt + (pc * 8) * SWA_VP + key;
            vd[0] = (bf16)(vv.x & 0xffffu); vd[SWA_VP] = (bf16)(vv.x >> 16); vd[2 * SWA_VP] = (bf16)(vv.y & 0xffffu); vd[3 * SWA_VP] = (bf16)(vv.y >> 16);
            vd[4 * SWA_VP] = (bf16)(vv.z & 0xffffu); vd[5 * SWA_VP] = (bf16)(vv.z >> 16); vd[6 * SWA_VP] = (bf16)(vv.w & 0xffffu); vd[7 * SWA_VP] = (bf16)(vv.w >> 16); }
        __syncthreads();
        const int g = wave >> 1, head = kvh * 4 + g, fr = lane & 15, fq = lane >> 4;
        const float sk = sink[head];
        bf16x8 qf[4][2];
#pragma unroll
        for (int j = 0; j < 4; ++j) { const bf16* qp = proj + (m0 + 16 * ((wave & 1) * 4 + j) + fr) * NPROJ + C_AQ + head * 64 + 8 * fq; qf[j][0] = *(const bf16x8*)qp; qf[j][1] = *(const bf16x8*)(qp + 32); }
#pragma unroll
        for (int j = 0; j < 4; ++j) {
            const int a = (wave & 1) * 4 + j, i0 = 16 * a, ap = a & ~1;
            const bf16x8 q0 = qf[j][0], q1 = qf[j][1];
            f32x4v sv[10];
#pragma unroll
            for (int kt = 0; kt < 10; ++kt) {
                const bf16* kp = Kl + (16 * (ap + kt) + fr) * SWA_KP + 8 * fq;
                f32x4v d = (f32x4v){0.f, 0.f, 0.f, 0.f};
                d = __builtin_amdgcn_mfma_f32_16x16x32_bf16(q0, *(const bf16x8*)kp, d, 0, 0, 0);
                d = __builtin_amdgcn_mfma_f32_16x16x32_bf16(q1, *(const bf16x8*)(kp + 32), d, 0, 0, 0);
                sv[kt] = d;
            }
            float mx[4] = {-INFINITY, -INFINITY, -INFINITY, -INFINITY};
#pragma unroll
            for (int kt = 0; kt < 10; ++kt) { const int kabs = 16 * (ap + kt) + fr;
#pragma unroll
                for (int r = 0; r < 4; ++r) { const int i = i0 + 4 * fq + r; const bool ok = (kabs >= i + 1) && (kabs <= i + 128) && (nb > 0 || kabs >= 128);
                    const float x = ok ? sv[kt][r] * 0.125f : -INFINITY; sv[kt][r] = x; mx[r] = fmaxf(mx[r], x); } }
            float den[4];
#pragma unroll
            for (int r = 0; r < 4; ++r) { mx[r] = fmaxf(row16_max(mx[r]), sk); den[r] = 0.f; }
#pragma unroll
            for (int kt = 0; kt < 10; ++kt)
#pragma unroll
                for (int r = 0; r < 4; ++r) { const float pv = __expf(sv[kt][r] - mx[r]); den[r] += pv; Pw[(4 * fq + r) * SWA_PP + 16 * kt + fr] = (bf16)f2bf1(pv); }
#pragma unroll
            for (int r = 0; r < 4; ++r) den[r] = 1.f / (row16_sum(den[r]) + __expf(sk - mx[r]));
            LDS_WAIT();
            f32x4v o[4];
#pragma unroll
            for (int dt = 0; dt < 4; ++dt) o[dt] = (f32x4v){0.f, 0.f, 0.f, 0.f};
#pragma unroll
            for (int ks = 0; ks < 5; ++ks) { const bf16x8 pa = *(const bf16x8*)(Pw + fr * SWA_PP + 32 * ks + 8 * fq);
#pragma unroll
                for (int dt = 0; dt < 4; ++dt) o[dt] = __builtin_amdgcn_mfma_f32_16x16x32_bf16(pa, *(const bf16x8*)(Vt + (16 * dt + fr) * SWA_VP + 16 * ap + 32 * ks + 8 * fq), o[dt], 0, 0, 0); }
#pragma unroll
            for (int r = 0; r < 4; ++r) { bf16* op = br01 + (m0 + i0 + 4 * fq + r) * D + head * 64 + fr;
#pragma unroll
                for (int dt = 0; dt < 4; ++dt) op[16 * dt] = (bf16)f2bf1(o[dt][r] * den[r]); }
            LDS_WAIT();
        }
        __syncthreads();
    }
}
typedef float f32x16 __attribute__((ext_vector_type(16)));
constexpr int DSA_S = 4100;
constexpr int DSA_WOFF = 8 * DSA_S * 4;
__device__ __forceinline__ float dpp_x1(float x) { return __builtin_bit_cast(float, __builtin_amdgcn_mov_dpp(__builtin_bit_cast(int, x), 0xB1, 0xf, 0xf, true)); }
__device__ __forceinline__ float dpp_x2(float x) { return __builtin_bit_cast(float, __builtin_amdgcn_mov_dpp(__builtin_bit_cast(int, x), 0x4E, 0xf, 0xf, true)); }
__device__ __forceinline__ int wave_sum_i(int v) {
    v += __builtin_amdgcn_mov_dpp(v, 0xB1, 0xf, 0xf, true);
    v += __builtin_amdgcn_mov_dpp(v, 0x4E, 0xf, 0xf, true);
    v += __builtin_amdgcn_mov_dpp(v, 0x141, 0xf, 0xf, true);
    v += __builtin_amdgcn_mov_dpp(v, 0x140, 0xf, 0xf, true);
    v += __builtin_amdgcn_update_dpp(0, v, 0x142, 0xa, 0xf, false);
    v += __builtin_amdgcn_update_dpp(0, v, 0x143, 0xc, 0xf, false);
    return __builtin_amdgcn_readlane(v, 63);
}
__device__ __forceinline__ unsigned sortable(float f) { const unsigned u = __float_as_uint(f); return (u >> 31) ? ~u : (u | 0x80000000u); }
__device__ __forceinline__ void dsa_scores(const bf16* pb, const bf16* ikb, int t0, float* scl, int wave, int lane) {
    const int n = lane & 31, kh = lane >> 5, q = n >> 2, h = n & 3;
    const bf16* qrow = pb + (size_t)(t0 + q) * NPROJ;
    bf16x8 Bq[4];
#pragma unroll
    for (int ks = 0; ks < 4; ++ks) Bq[ks] = *(const bf16x8*)(qrow + C_IQ + h * 64 + 16 * ks + 8 * kh);
    const float wq = bf2f(qrow[C_IW + h]) * 0.0625f;
    const int ntile = (t0 + 8 + 31) >> 5;
    float* dst = scl + q * DSA_S + h + 4 * kh;
#pragma unroll 1
    for (int tile0 = wave; tile0 < ntile; tile0 += 32) {
        bf16x8 a[4][4];
#pragma unroll
        for (int u = 0; u < 4; ++u) { const int tile = tile0 + 8 * u; const int tc = (tile < ntile) ? tile : 0;
            const bf16* kf = ikb + ((size_t)tc * 256 + lane) * 8;
#pragma unroll
            for (int ks = 0; ks < 4; ++ks) a[u][ks] = *(const bf16x8*)(kf + ks * 512); }
#pragma unroll
        for (int u = 0; u < 4; ++u) { const int tile = tile0 + 8 * u;
            if (tile < ntile) {
                f32x16 d;
#pragma unroll
                for (int r = 0; r < 16; ++r) d[r] = 0.f;
#pragma unroll
                for (int ks = 0; ks < 4; ++ks) d = __builtin_amdgcn_mfma_f32_32x32x16_bf16(a[u][ks], Bq[ks], d, 0, 0, 0);
                float v[16];
#pragma unroll
                for (int r = 0; r < 16; ++r) { float x = fmaxf(d[r], 0.f) * wq; x += dpp_x1(x); x += dpp_x2(x); v[r] = x; }
#pragma unroll
                for (int k = 0; k < 4; ++k) { const float val = (h == 0) ? v[4 * k] : (h == 1) ? v[4 * k + 1] : (h == 2) ? v[4 * k + 2] : v[4 * k + 3]; dst[tile * 32 + 8 * k] = val + 0.f; }
            } }
    }
}
__device__ __forceinline__ int wave_scan_incl(int v) {
    v += __builtin_amdgcn_update_dpp(0, v, 0x111, 0xf, 0xf, false);
    v += __builtin_amdgcn_update_dpp(0, v, 0x112, 0xf, 0xf, false);
    v += __builtin_amdgcn_update_dpp(0, v, 0x114, 0xf, 0xf, false);
    v += __builtin_amdgcn_update_dpp(0, v, 0x118, 0xf, 0xf, false);
    v += __builtin_amdgcn_update_dpp(0, v, 0x142, 0xa, 0xf, false);
    v += __builtin_amdgcn_update_dpp(0, v, 0x143, 0xc, 0xf, false);
    return v;
}
template <int SMODE> __device__ __forceinline__ void dsa_select(int t, float* sc, char* wl, int lane) {
    unsigned short* sel = (unsigned short*)(wl + 512);
    const int nk = t + 1;
    const int K = nk < 256 ? nk : 256;
    const int nj = (nk + 63) >> 6;
    unsigned key[64];
#pragma unroll
    for (int j = 0; j < 64; ++j) { const int s = 64 * j + lane; const unsigned kq = sortable(sc[s]); key[j] = (s < nk) ? kq : 0u; }
    if (SMODE == 1) { unsigned x = 0u;
#pragma unroll
        for (int j = 0; j < 64; ++j) x ^= key[j];
        sel[255] = (unsigned short)x; return; }
    unsigned Tk = 1u; int cT = K;
    if (nk > 256) {
        unsigned* hist = (unsigned*)sc;
        auto find_bin = [&](int Kq, int& ge, int& in) -> unsigned {
            int sl = 0;
#pragma unroll
            for (int i = 0; i < 64; ++i) sl += (int)hist[64 * lane + ((i + lane) & 63)];
            const int pre = wave_scan_incl(sl);
            const int tot = __builtin_amdgcn_readlane(pre, 63);
            const int suf = tot - pre + sl;
            const unsigned long long m1 = __ballot(suf >= Kq);
            const int Ls = 63 - __builtin_clzll(m1);
            const int above = __builtin_amdgcn_readlane(suf - sl, Ls);
            const int hi = (int)hist[64 * Ls + lane];
            const int pre2 = wave_scan_incl(hi);
            const int tot2 = __builtin_amdgcn_readlane(pre2, 63);
            const int suf2 = above + tot2 - pre2 + hi;
            const unsigned long long m2 = __ballot(suf2 >= Kq);
            const int is = 63 - __builtin_clzll(m2);
            ge = __builtin_amdgcn_readlane(suf2, is); in = __builtin_amdgcn_readlane(hi, is);
            return (unsigned)(64 * Ls + is); };
        LDS_WAIT();
#pragma unroll
        for (int i = 0; i < 16; ++i) ((u32x4*)hist)[lane + 64 * i] = (u32x4){0u, 0u, 0u, 0u};
        LDS_WAIT();
#pragma unroll
        for (int jg = 0; jg < 4; ++jg) if (16 * jg < nj) {
#pragma unroll
            for (int j = 16 * jg; j < 16 * jg + 16; ++j) if (j < nj) atomicAdd(&hist[key[j] >> 20], key[j] != 0u ? 1u : 0u); }
        LDS_WAIT();
        int ge1, in1;
        const unsigned B = find_bin(K, ge1, in1);
        Tk = B << 20; cT = ge1;
        if (cT != K) {
            const int aboveB = ge1 - in1, K2 = K - aboveB;
            LDS_WAIT();
#pragma unroll
            for (int i = 0; i < 16; ++i) ((u32x4*)hist)[lane + 64 * i] = (u32x4){0u, 0u, 0u, 0u};
            LDS_WAIT();
#pragma unroll
            for (int jg = 0; jg < 4; ++jg) if (16 * jg < nj) {
#pragma unroll
                for (int j = 16 * jg; j < 16 * jg + 16; ++j) { if ((key[j] >> 20) == B) atomicAdd(&hist[(key[j] >> 8) & 0xfffu], key[j] != 0u ? 1u : 0u);
                    if ((j & 3) == 3) __builtin_amdgcn_sched_barrier(0); } }
            LDS_WAIT();
            int ge2, in2;
            const unsigned B2 = find_bin(K2, ge2, in2);
            Tk |= B2 << 8; cT = aboveB + ge2;
            for (int bit = 7; bit >= 0 && cT != K; --bit) {
                const unsigned cand = Tk | (1u << bit); int c = 0;
#pragma unroll
                for (int jg = 0; jg < 4; ++jg) if (16 * jg < nj) {
#pragma unroll
                    for (int j = 16 * jg; j < 16 * jg + 16; ++j) c += (key[j] >= cand) ? 1 : 0; }
                const int totc = wave_sum_i(c);
                if (totc >= K) { Tk = cand; cT = totc; }
            }
        }
    }
    if (SMODE == 2) { sel[255] = (unsigned short)Tk; return; }
    LDS_WAIT();
    if (cT == K) {
        int base = 0;
#pragma unroll
        for (int jg = 0; jg < 4; ++jg) if (16 * jg < nj) {
#pragma unroll
            for (int j = 16 * jg; j < 16 * jg + 16; ++j) {
                const bool tk = key[j] >= Tk;
                const unsigned long long mk = __ballot(tk);
                const int pos = base + (int)__builtin_amdgcn_mbcnt_hi((unsigned)(mk >> 32), __builtin_amdgcn_mbcnt_lo((unsigned)mk, 0u));
                if (tk) sel[pos] = (unsigned short)(64 * j + lane);
                base += __popcll(mk);
                if ((j & 3) == 3) __builtin_amdgcn_sched_barrier(0);
            } }
    } else {
        int cg = 0;
#pragma unroll
        for (int j = 0; j < 64; ++j) cg += (key[j] > Tk) ? 1 : 0;
        const int pg = wave_scan_incl(cg);
        const int totg = __builtin_amdgcn_readlane(pg, 63);
        const int need = K - totg;
        int pos = pg - cg;
#pragma unroll
        for (int jg = 0; jg < 4; ++jg) if (16 * jg < nj) {
#pragma unroll
            for (int j = 16 * jg; j < 16 * jg + 16; ++j) if (key[j] > Tk) { sel[pos] = (unsigned short)(64 * j + lane); ++pos; } }
        const unsigned long long lt = (1ull << lane) - 1ull;
        int ties = 0;
#pragma unroll
        for (int jg = 0; jg < 4; ++jg) if (16 * jg < nj) {
#pragma unroll
            for (int j = 16 * jg; j < 16 * jg + 16; ++j) {
                const unsigned long long meq = __ballot(key[j] == Tk);
                const int rk = ties + __popcll(meq & lt);
                if (key[j] == Tk && rk < need) sel[totg + rk] = (unsigned short)(64 * j + lane);
                ties += __popcll(meq);
            } }
    }
    LDS_WAIT();
}
typedef short v4i16_t __attribute__((ext_vector_type(4)));
constexpr int DSA_VP = 72, DSA_PP = 264;
template <int MODE> __device__ __forceinline__ void dsa_attend(const bf16x8 (&qa)[2][2], const bf16* kvb, bf16* br01, int b, int t, float* sc, char* wl, int lane) {
    const unsigned short* sel = (const unsigned short*)(wl + 512);
    const size_t m = (size_t)b * T + t;
    const int K = (t + 1) < 256 ? (t + 1) : 256;
    const int fr = lane & 15, fq = lane >> 4;
    bf16* Vst = (bf16*)sc; bf16* Pl = (bf16*)sc + 64 * DSA_VP;
    LAS const char* vst3 = (LAS const char*)Vst;
    const int nch = (MODE & 1) ? 0 : ((K + 63) >> 6);
#pragma unroll
    for (int kvh = 0; kvh < 2; ++kvh) {
        f32x4v lg[16];
        {
            u32x4 k0[8], k1[8];
#pragma unroll
            for (int i = 0; i < 8; ++i) k0[i] = *(const u32x4*)(kvb + (size_t)sel[8 * i + (lane >> 3)] * 256 + kvh * 64 + 8 * (lane & 7));
#pragma unroll
            for (int i = 0; i < 8; ++i) k1[i] = *(const u32x4*)(kvb + (size_t)sel[64 + 8 * i + (lane >> 3)] * 256 + kvh * 64 + 8 * (lane & 7));
#define DSA_QK_CHUNK(c, buf, nextc) do { \
            LDS_WAIT(); \
            _Pragma("unroll") for (int i = 0; i < 8; ++i) *(u32x4*)(Vst + (8 * i + (lane >> 3)) * DSA_VP + 8 * (lane & 7)) = buf[i]; \
            if ((nextc) < 4) { \
                _Pragma("unroll") for (int i = 0; i < 8; ++i) buf[i] = *(const u32x4*)(kvb + (size_t)sel[64 * ((nextc) & 3) + 8 * i + (lane >> 3)] * 256 + kvh * 64 + 8 * (lane & 7)); } \
            LDS_WAIT(); \
            _Pragma("unroll") for (int e4 = 0; e4 < 4; ++e4) { const int et = 4 * (c) + e4; \
                const bf16* kp = Vst + (16 * e4 + fr) * DSA_VP + 8 * fq; \
                f32x4v d = (f32x4v){0.f, 0.f, 0.f, 0.f}; \
                d = __builtin_amdgcn_mfma_f32_16x16x32_bf16(qa[kvh][0], *(const bf16x8*)kp, d, 0, 0, 0); \
                d = __builtin_amdgcn_mfma_f32_16x16x32_bf16(qa[kvh][1], *(const bf16x8*)(kp + 32), d, 0, 0, 0); \
                if (16 * et + fr >= K) d = (f32x4v){-INFINITY, -INFINITY, -INFINITY, -INFINITY}; \
                lg[et] = d; } } while (0)
            DSA_QK_CHUNK(0, k0, 2);
            DSA_QK_CHUNK(1, k1, 3);
            DSA_QK_CHUNK(2, k0, 4);
            DSA_QK_CHUNK(3, k1, 5);
#undef DSA_QK_CHUNK
        }
        if (MODE & 2) { float x = 0.f;
#pragma unroll
            for (int et = 0; et < 16; ++et) x += lg[et][0] + lg[et][1] + lg[et][2] + lg[et][3];
            Pl[lane] = (bf16)f2bf1(x); continue; }
        u32x4 va[8], vb[8];
#pragma unroll
        for (int i = 0; i < 8; ++i) va[i] = *(const u32x4*)(kvb + (size_t)sel[8 * i + (lane >> 3)] * 256 + 128 + kvh * 64 + 8 * (lane & 7));
#pragma unroll
        for (int i = 0; i < 8; ++i) vb[i] = *(const u32x4*)(kvb + (size_t)sel[64 + 8 * i + (lane >> 3)] * 256 + 128 + kvh * 64 + 8 * (lane & 7));
        {
            float x[16];
#pragma unroll
            for (int et = 0; et < 16; ++et) x[et] = (fq == 0) ? lg[et][0] : (fq == 1) ? lg[et][1] : (fq == 2) ? lg[et][2] : lg[et][3];
            float mx = x[0];
#pragma unroll
            for (int et = 1; et < 16; ++et) mx = fmaxf(mx, x[et]);
            mx = row16_max(mx);
            float sm = 0.f;
#pragma unroll
            for (int et = 0; et < 16; ++et) { x[et] = __builtin_amdgcn_exp2f((x[et] - mx) * (0.125f * 1.44269504f)); sm += x[et]; }
            const float inv = 1.f / row16_sum(sm);
#pragma unroll
            for (int et = 0; et < 16; ++et) Pl[fq * DSA_PP + 16 * et + fr] = (bf16)f2bf1(x[et] * inv);
        }
        f32x4v o[4];
#pragma unroll
        for (int dt = 0; dt < 4; ++dt) o[dt] = (f32x4v){0.f, 0.f, 0.f, 0.f};
#define DSA_PV_CHUNK(c, buf, nextc) do { \
            LDS_WAIT(); \
            _Pragma("unroll") for (int i = 0; i < 8; ++i) *(u32x4*)(Vst + (8 * i + (lane >> 3)) * DSA_VP + 8 * (lane & 7)) = buf[i]; \
            if ((nextc) < nch) { \
                _Pragma("unroll") for (int i = 0; i < 8; ++i) buf[i] = *(const u32x4*)(kvb + (size_t)sel[64 * (nextc) + 8 * i + (lane >> 3)] * 256 + 128 + kvh * 64 + 8 * (lane & 7)); } \
            LDS_WAIT(); \
            _Pragma("unroll") for (int ks = 0; ks < 2; ++ks) { \
                const bf16x8 pa = *(const bf16x8*)(Pl + (fr & 3) * DSA_PP + 64 * (c) + 32 * ks + 8 * fq); \
                _Pragma("unroll") for (int dt = 0; dt < 4; ++dt) { \
                    LAS const char* a0 = vst3 + ((32 * ks + 8 * fq + (fr >> 2)) * DSA_VP + 16 * dt + 4 * (fr & 3)) * 2; \
                    const v4i16_t lo = __builtin_amdgcn_ds_read_tr16_b64_v4i16((LAS v4i16_t*)a0); \
                    const v4i16_t hi = __builtin_amdgcn_ds_read_tr16_b64_v4i16((LAS v4i16_t*)(a0 + 4 * DSA_VP * 2)); \
                    bf16x8 bv; bv[0] = lo[0]; bv[1] = lo[1]; bv[2] = lo[2]; bv[3] = lo[3]; bv[4] = hi[0]; bv[5] = hi[1]; bv[6] = hi[2]; bv[7] = hi[3]; \
                    o[dt] = __builtin_amdgcn_mfma_f32_16x16x32_bf16(pa, bv, o[dt], 0, 0, 0); } } } while (0)
        if (nch > 0) DSA_PV_CHUNK(0, va, 2);
        if (nch > 1) DSA_PV_CHUNK(1, vb, 3);
        if (nch > 2) DSA_PV_CHUNK(2, va, 4);
        if (nch > 3) DSA_PV_CHUNK(3, vb, 5);
#undef DSA_PV_CHUNK
        const f32x4v ov = (fq == 0) ? o[0] : (fq == 1) ? o[1] : (fq == 2) ? o[2] : o[3];
        bf16* op = br01 + m * D + 512 + kvh * 256 + 16 * fq + fr;
#pragma unroll
        for (int r = 0; r < 4; ++r) op[r * 64] = (bf16)f2bf1(ov[r]);
        LDS_WAIT();
    }
}
__device__ __forceinline__ void dsa_phase(const bf16* proj, const bf16* bkv, const bf16* ik, bf16* br01, char* lds, int G) {
    int tid = threadIdx.x; asm volatile("" : "+v"(tid)); const int lane = tid & 63, wave = __builtin_amdgcn_readfirstlane(tid >> 6);
    float* scl = (float*)lds;
    char* wl = lds + DSA_WOFF + wave * 1024;
    const int c = blockIdx.x, b = c & 7, j = c >> 3, R = G >> 3;
    const bf16* pb = proj + (size_t)b * T * NPROJ; const bf16* kvb = bkv + (size_t)b * T * 256; const bf16* ikb = ik + (size_t)b * T * 64;
    ((unsigned*)(wl + 512))[lane] = 0u; ((unsigned*)(wl + 512))[lane + 64] = 0u;
    for (int k = 0; ; ++k) {
        const int u = (k & 1) ? (R - 1 - j) + R * k : j + R * k;
        if (u >= T / 8) break;
        const int t0 = 8 * u;
        int l1 = lane; asm volatile("" : "+v"(l1));
        for (int r_ = 0; r_ < REP(4); ++r_) dsa_scores(pb, ikb, t0, scl, wave, l1);
        __syncthreads();
        int l2 = lane; asm volatile("" : "+v"(l2));
        bf16x8 qa[2][2];
#pragma unroll
        for (int kvh = 0; kvh < 2; ++kvh) { const bf16* qp = pb + (size_t)(t0 + wave) * NPROJ + C_BQ + (kvh * 4 + (l2 & 3)) * 64 + 8 * (l2 >> 4); qa[kvh][0] = *(const bf16x8*)qp; qa[kvh][1] = *(const bf16x8*)(qp + 32); }
        dsa_select<0>(t0 + wave, scl + wave * DSA_S, wl, l2);
        int l3 = lane; asm volatile("" : "+v"(l3));
        dsa_attend<0>(qa, kvb, br01, b, t0 + wave, scl + wave * DSA_S, wl, l3);
        __syncthreads();
    }
}
__device__ __forceinline__ void ret_u_phase(const bf16* proj, float* U, char* lds, int G) {
    int tid = threadIdx.x; asm volatile("" : "+v"(tid)); const int lane = tid & 63, wave = tid >> 6, fr = lane & 15, fq = lane >> 4;
    bf16* KdT = (bf16*)lds; bf16* VT = (bf16*)(lds + 17408);
    for (int un = blockIdx.x; un < 1024; un += G) {
        const int c = un & 31, bh = un >> 5, h = bh & 3, b = bh >> 2;
        const float lg2 = log2f(1.f - exp2f(-5.f - (float)h));
        const size_t m0 = (size_t)b * T + c * 128;
#pragma unroll
        for (int i = 0; i < 2; ++i) { const int idx = tid + 512 * i, mm = idx >> 3, pc = idx & 7;
            const u32x4 kv = *(const u32x4*)(proj + (m0 + mm) * NPROJ + C_RK + 64 * h + 8 * pc);
            const float dc = 0.125f * exp2f(lg2 * (float)(127 - mm));
            bf16* kd = KdT + (8 * pc) * RT_P + mm;
            kd[0] = (bf16)f2bf1(__uint_as_float(kv.x << 16) * dc); kd[RT_P] = (bf16)f2bf1(__uint_as_float(kv.x & 0xffff0000u) * dc);
            kd[2 * RT_P] = (bf16)f2bf1(__uint_as_float(kv.y << 16) * dc); kd[3 * RT_P] = (bf16)f2bf1(__uint_as_float(kv.y & 0xffff0000u) * dc);
            kd[4 * RT_P] = (bf16)f2bf1(__uint_as_float(kv.z << 16) * dc); kd[5 * RT_P] = (bf16)f2bf1(__uint_as_float(kv.z & 0xffff0000u) * dc);
            kd[6 * RT_P] = (bf16)f2bf1(__uint_as_float(kv.w << 16) * dc); kd[7 * RT_P] = (bf16)f2bf1(__uint_as_float(kv.w & 0xffff0000u) * dc); }
#pragma unroll
        for (int i = 0; i < 4; ++i) { const int idx = tid + 512 * i, mm = idx >> 4, pc = idx & 15;
            const u32x4 vv = *(const u32x4*)(proj + (m0 + mm) * NPROJ + C_RV + 128 * h + 8 * pc);
            bf16* vd = VT + (8 * pc) * RT_P + mm;
            vd[0] = (bf16)(vv.x & 0xffffu); vd[RT_P] = (bf16)(vv.x >> 16); vd[2 * RT_P] = (bf16)(vv.y & 0xffffu); vd[3 * RT_P] = (bf16)(vv.y >> 16);
            vd[4 * RT_P] = (bf16)(vv.z & 0xffffu); vd[5 * RT_P] = (bf16)(vv.z >> 16); vd[6 * RT_P] = (bf16)(vv.w & 0xffffu); vd[7 * RT_P] = (bf16)(vv.w >> 16); }
        __syncthreads();
        f32x4v acc[4];
#pragma unroll
        for (int dt = 0; dt < 4; ++dt) acc[dt] = (f32x4v){0.f, 0.f, 0.f, 0.f};
#pragma unroll
        for (int ks = 0; ks < 4; ++ks) { const bf16x8 bv = *(const bf16x8*)(VT + (16 * wave + fr) * RT_P + 32 * ks + 8 * fq);
#pragma unroll
            for (int dt = 0; dt < 4; ++dt) acc[dt] = __builtin_amdgcn_mfma_f32_16x16x32_bf16(*(const bf16x8*)(KdT + (16 * dt + fr) * RT_P + 32 * ks + 8 * fq), bv, acc[dt], 0, 0, 0); }
        float* up = U + (size_t)un * 8192;
#pragma unroll
        for (int dt = 0; dt < 4; ++dt)
#pragma unroll
            for (int r = 0; r < 4; ++r) up[(16 * dt + 4 * fq + r) * 128 + 16 * wave + fr] = acc[dt][r];
        __syncthreads();
    }
}
__device__ __forceinline__ void ret_scan_phase(const float* U, bf16* ST, int G) {
    int tid = threadIdx.x; asm volatile("" : "+v"(tid));
    for (int w = blockIdx.x; w < 256; w += G) {
        const int bh = w >> 3, part = w & 7, h = bh & 3;
        const float cd = exp2f(128.f * log2f(1.f - exp2f(-5.f - (float)h)));
        const int e2 = part * 512 + tid, dv = e2 & 127, dp = e2 >> 7;
        const float* up = U + (size_t)bh * 32 * 8192 + (2 * dp) * 128 + dv;
        unsigned* sp = (unsigned*)(ST + (size_t)bh * 32 * 8192 + dv * 64 + 2 * dp);
        float u0[32], u1[32];
#pragma unroll
        for (int j = 0; j < 31; ++j) { u0[j] = up[(size_t)j * 8192]; u1[j] = up[(size_t)j * 8192 + 128]; }
        float s0 = 0.f, s1 = 0.f;
        sp[0] = 0u;
#pragma unroll
        for (int c = 1; c < 32; ++c) { s0 = s0 * cd + u0[c - 1]; s1 = s1 * cd + u1[c - 1]; sp[(size_t)c * 4096] = pk2(s0, s1); }
    }
}
__device__ __forceinline__ void ret_out_phase(const bf16* proj, const bf16* ST, bf16* br23, char* lds, int G) {
    int tid = threadIdx.x; asm volatile("" : "+v"(tid)); const int lane = tid & 63, wave = tid >> 6, fr = lane & 15, fq = lane >> 4;
    bf16* Kl = (bf16*)lds; bf16* VT = (bf16*)(lds + 18432); bf16* Pw = (bf16*)(lds + 18432 + 34816) + wave * 16 * RT_P;
    for (int un = blockIdx.x; un < 1024; un += G) {
        const int c = un & 31, bh = un >> 5, h = bh & 3, b = bh >> 2;
        const float lg2 = log2f(1.f - exp2f(-5.f - (float)h));
        const size_t m0 = (size_t)b * T + c * 128;
#pragma unroll
        for (int i = 0; i < 2; ++i) { const int idx = tid + 512 * i, mm = idx >> 3, pc = idx & 7;
            *(u32x4*)(Kl + mm * 72 + 8 * pc) = *(const u32x4*)(proj + (m0 + mm) * NPROJ + C_RK + 64 * h + 8 * pc); }
#pragma unroll
        for (int i = 0; i < 4; ++i) { const int idx = tid + 512 * i, mm = idx >> 4, pc = idx & 15;
            const u32x4 vv = *(const u32x4*)(proj + (m0 + mm) * NPROJ + C_RV + 128 * h + 8 * pc);
            bf16* vd = VT + (8 * pc) * RT_P + mm;
            vd[0] = (bf16)(vv.x & 0xffffu); vd[RT_P] = (bf16)(vv.x >> 16); vd[2 * RT_P] = (bf16)(vv.y & 0xffffu); vd[3 * RT_P] = (bf16)(vv.y >> 16);
            vd[4 * RT_P] = (bf16)(vv.z & 0xffffu); vd[5 * RT_P] = (bf16)(vv.z >> 16); vd[6 * RT_P] = (bf16)(vv.w & 0xffffu); vd[7 * RT_P] = (bf16)(vv.w >> 16); }
        __syncthreads();
        const bf16* qp = proj + (m0 + 16 * wave + fr) * NPROJ + C_RQ + 64 * h + 8 * fq;
        const bf16x8 q0 = *(const bf16x8*)qp, q1 = *(const bf16x8*)(qp + 32);
        const bf16* stp = ST + (size_t)un * 8192;
        f32x4v acc[8];
#pragma unroll
        for (int dt = 0; dt < 8; ++dt) { f32x4v d = (f32x4v){0.f, 0.f, 0.f, 0.f};
            const bf16* sp = stp + (16 * dt + fr) * 64 + 8 * fq;
            d = __builtin_amdgcn_mfma_f32_16x16x32_bf16(q0, *(const bf16x8*)sp, d, 0, 0, 0);
            d = __builtin_amdgcn_mfma_f32_16x16x32_bf16(q1, *(const bf16x8*)(sp + 32), d, 0, 0, 0);
            acc[dt] = d; }
#pragma unroll
        for (int r = 0; r < 4; ++r) { const float qd = exp2f(lg2 * (float)(16 * wave + 4 * fq + r + 1));
#pragma unroll
            for (int dt = 0; dt < 8; ++dt) acc[dt][r] *= qd; }
#pragma unroll
        for (int mt = 0; mt < 8; ++mt) {
            f32x4v d = (f32x4v){0.f, 0.f, 0.f, 0.f};
            if (mt <= wave) { const bf16* kp = Kl + (16 * mt + fr) * 72 + 8 * fq;
                d = __builtin_amdgcn_mfma_f32_16x16x32_bf16(q0, *(const bf16x8*)kp, d, 0, 0, 0);
                d = __builtin_amdgcn_mfma_f32_16x16x32_bf16(q1, *(const bf16x8*)(kp + 32), d, 0, 0, 0); }
            const int mm = 16 * mt + fr;
#pragma unroll
            for (int r = 0; r < 4; ++r) { const int n = 16 * wave + 4 * fq + r;
                const float pv = (mm <= n) ? d[r] * 0.125f * exp2f(lg2 * (float)(n - mm)) : 0.f;
                Pw[(4 * fq + r) * RT_P + mm] = (bf16)f2bf1(pv); }
        }
        LDS_WAIT();
#pragma unroll
        for (int ks = 0; ks < 4; ++ks) { const bf16x8 pa = *(const bf16x8*)(Pw + fr * RT_P + 32 * ks + 8 * fq);
#pragma unroll
            for (int dt = 0; dt < 8; ++dt) acc[dt] = __builtin_amdgcn_mfma_f32_16x16x32_bf16(pa, *(const bf16x8*)(VT + (16 * dt + fr) * RT_P + 32 * ks + 8 * fq), acc[dt], 0, 0, 0); }
#pragma unroll
        for (int r = 0; r < 4; ++r) { float q = 0.f;
#pragma unroll
            for (int dt = 0; dt < 8; ++dt) q += acc[dt][r] * acc[dt][r];
            const float rs = 1.f / sqrtf(row16_sum(q) * (1.f / 128.f) + EPS);
            const size_t row = m0 + 16 * wave + 4 * fq + r;
            const bf16* gp = proj + row * NPROJ + C_RG + 128 * h + fr; bf16* op = br23 + row * D + h * 128 + fr;
#pragma unroll
            for (int dt = 0; dt < 8; ++dt) { const float gv = bf2f(gp[16 * dt]); op[16 * dt] = (bf16)f2bf1(gv / (1.f + __expf(-gv)) * acc[dt][r] * rs); } }
        __syncthreads();
    }
}

typedef const __attribute__((address_space(4))) Args* KArgs;
__device__ __forceinline__ KArgs kargs() { KArgs p = (KArgs)__builtin_amdgcn_kernarg_segment_ptr(); asm volatile("" : "+s"(p)); return p; }

__device__ __forceinline__ void ph0(LAS unsigned char* L, int layer, int slot) {
    int tid = threadIdx.x; asm volatile("" : "+v"(tid)); const int lane = tid & 63, wave = __builtin_amdgcn_readfirstlane(tid >> 6);
    int G = gridDim.x, bx = blockIdx.x; asm volatile("" : "+s"(G), "+s"(bx)); const int gw = bx * 8 + wave, NGW = G * 8;
    unsigned char* lds = (unsigned char*)L; LAS int* lcnt = (LAS int*)(L + 0); LAS int* gt = (LAS int*)(L + LDS_MISC + 512);
    (void)lane; (void)gw; (void)NGW; (void)lds; (void)lcnt; (void)gt; (void)layer; (void)slot; (void)tid; (void)bx; (void)G;
    {
        KArgs A = kargs(); unsigned char* ws = A->ws;
        LAS float* scr = (LAS float*)(L + wave * 16384);
        constexpr int I_IN = 16 * 128, I_G = 16 * 128, I_B = 8 * 32, I_SQ = 16 * 32, I_L = I_IN + I_G + 4 * I_B + 5 * I_SQ;
        constexpr int I_GU = 16 * 224, I_DN = 56 * 32, NITEMS = 2 * I_L + I_GU + I_DN;
        for (int it = gw; it < NITEMS; it += NGW) {
            int r = it;
            if (r < 2 * I_L) {
                const int l = r / I_L; r -= l * I_L;
                unsigned char* wb = ws + WS_W + (size_t)l * W_LAYER;
                const float* win = A->w_in + (size_t)l * D * D_IN;
                if (r < I_IN) { conv_seg<1>(win, D, D_IN, 0, (bf16*)(wb + W_IN), D, 0, 128, r, scr, lane, A->norm_mix + (size_t)l * D); continue; } r -= I_IN;
                if (r < I_G) { conv_seg<0, 1>(win, D, D_IN, 3908, (bf16*)(wb + W_G), D, 0, 128, r, scr, lane, A->norm_mix + (size_t)l * D); continue; } r -= I_G;
                if (r < 4 * I_B) { const int i = r / I_B; r -= i * I_B;
                    conv_seg<0>(A->w_branch + ((size_t)l * 4 + i) * 512 * D, 512, D, 0, (bf16*)(wb + W_B) + (size_t)(i >> 1) * D * D, D, (i & 1) * 512, 32, r, scr, lane); continue; } r -= 4 * I_B;
                if (r < I_SQ) { conv_seg<0>(A->w_out + (size_t)l * D * D, D, D, 0, (bf16*)(wb + W_OUT), D, 0, 32, r, scr, lane); continue; } r -= I_SQ;
                if (r < I_SQ) { conv_seg<0>(A->w_xq + (size_t)l * D * D, D, D, 0, (bf16*)(wb + W_XQ), D, 0, 32, r, scr, lane, A->norm_cross + (size_t)l * D); continue; } r -= I_SQ;
                if (r < I_SQ) { conv_seg<0>(A->w_xkv + (size_t)l * D * 2 * D, D, 2 * D, 0, (bf16*)(wb + W_XK), D, 0, 32, r, scr, lane); continue; } r -= I_SQ;
                if (r < I_SQ) { conv_seg<0>(A->w_xkv + (size_t)l * D * 2 * D, D, 2 * D, D, (bf16*)(wb + W_XV), D, 0, 32, r, scr, lane); continue; } r -= I_SQ;
                conv_seg<0, 1>(A->w_xo + (size_t)l * D * D, D, D, 0, (bf16*)(wb + W_XO), D, 0, 32, r, scr, lane); continue;
            }
            r -= 2 * I_L;
            if (r < I_GU) { conv_seg<2, 1>(A->dense_w_gu, D, 2 * DFF, 0, (bf16*)(ws + WS_WGU), D, 0, 224, r, scr, lane, A->norm_ffn); continue; } r -= I_GU;
            conv_seg<0, 1>(A->dense_w_down, DFF, D, 0, (bf16*)(ws + WS_WDN), DFF, 0, 32, r, scr, lane);
        }
        for (int it = gw; it < 64; it += NGW) { const int lg = it >> 3;
            conv_seg<0>(A->pool_w + (size_t)lg * 16384, 128, 128, 0, (bf16*)(ws + WS_WPOOL) + (size_t)lg * 16384, 128, 0, 4, it & 7, scr, lane); }
        {
            _Float16* cosT = (_Float16*)(ws + WS_ROPE); _Float16* sinT = cosT + (size_t)M * 32; const int* pos = A->positions;
            for (int i = bx * 512 + tid; i < M * 32; i += G * 512) { const int m = i >> 5, j = i & 31;
                const float ang = (float)pos[m] * INV_FREQ[j];
                const double rev = (double)ang * 0.15915494309189533577; const float fr_ = (float)(rev - rint(rev));
                const size_t to = ((size_t)((m >> 4) * 4 + (j >> 3)) * 16 + (m & 15)) * 8 + (j & 7);
                cosT[to] = (_Float16)__builtin_amdgcn_cosf(fr_); sinT[to] = (_Float16)__builtin_amdgcn_sinf(fr_); }
        }
        {
            const float* mem = A->mem; const float* nm = A->norm_mem; bf16* MN = (bf16*)(ws + WS_MN);
            for (int r = gw; r < 2 * MROWS; r += NGW) { const int l = r / MROWS, mr = r % MROWS; norm_row_bf16(mem + (size_t)mr * D, nm + (size_t)l * D, MN + (size_t)r * D, lane); }
            const float* x = A->x; bf16* XB = (bf16*)(ws + WS_HB); u64* ss0 = (u64*)(ws + WS_SS);
            for (int m = gw; m < M; m += NGW) {
                const f32x4* xr = (const f32x4*)(x + (size_t)m * D) + lane; unsigned long long* o8 = (unsigned long long*)(XB + (size_t)m * D) + lane; float q = 0.f;
#pragma unroll
                for (int j = 0; j < 4; ++j) { const f32x4 v = xr[64 * j]; q += (v.x * v.x + v.y * v.y) + (v.z * v.z + v.w * v.w);
                    o8[64 * j] = (unsigned long long)pk2(v.x, v.y) | ((unsigned long long)pk2(v.z, v.w) << 32);
                    ((unsigned*)(ws + WS_XF8 + (size_t)m * D))[lane + 64 * j] = pk4_f8(v.x, v.y, v.z, v.w); }
                q = wave_sum(q); if (lane == 0) ss0[m] = ss_fix(q); }
        }
    }
}
__device__ __forceinline__ void ph1(LAS unsigned char* L, int layer, int slot) {
    int tid = threadIdx.x; asm volatile("" : "+v"(tid)); const int lane = tid & 63, wave = __builtin_amdgcn_readfirstlane(tid >> 6);
    int G = gridDim.x, bx = blockIdx.x; asm volatile("" : "+s"(G), "+s"(bx)); const int gw = bx * 8 + wave, NGW = G * 8;
    unsigned char* lds = (unsigned char*)L; LAS int* lcnt = (LAS int*)(L + 0); LAS int* gt = (LAS int*)(L + LDS_MISC + 512);
    (void)lane; (void)gw; (void)NGW; (void)lds; (void)lcnt; (void)gt; (void)layer; (void)slot; (void)tid; (void)bx; (void)G;
    {
            unsigned char* ws = kargs()->ws; unsigned char* wb = ws + WS_W + (size_t)layer * W_LAYER;
            { pg8::GridSched S{(const char*)(ws + WS_HB), (const char*)(wb + W_IN), 2048u, 2048u, 128, 16, 16, G, bx};
              EpiProj E{(bf16*)(ws + WS_PROJ), (const _Float16*)(ws + WS_ROPE), (const _Float16*)(ws + WS_ROPE) + (size_t)M * 32, (bf16*)(ws + WS_AKV), (bf16*)(ws + WS_BKV), (bf16*)(ws + WS_IK), (const u64*)(ws + WS_SS) + (size_t)(3 * layer) * M};
              pg8::gemm_stream(L, S, E, 2048u, 2048u); }
            if (layer == 0) {
                for (int l = 0; l < 2; ++l) {
                    unsigned char* wl = ws + WS_W + (size_t)l * W_LAYER;
                    { pg8::GridSched S{(const char*)(ws + WS_MN) + (size_t)l * MROWS * D * 2, (const char*)(wl + W_XK), 2048u, 2048u, 8, 4, 16, G, bx};
                      EpiPlain E{(bf16*)(ws + WS_KX) + (size_t)l * MROWS * D, D, 1.f, nullptr};
                      pg8::gemm_stream(L, S, E, 2048u, 2048u); }
                    { pg8::GridSched S{(const char*)(wl + W_XV), (const char*)(ws + WS_MN) + (size_t)l * MROWS * D * 2, 2048u, 2048u, 4, 8, 16, G, bx};
                      EpiPlain E{(bf16*)(ws + WS_VTB) + (size_t)l * 8 * D * D, D, 1.f, nullptr, (size_t)D * D};
                      pg8::gemm_stream(L, S, E, 2048u, 2048u); }
                }
            }
        }
}
__device__ __forceinline__ void ph2(LAS unsigned char* L, int layer, int slot) {
    int tid = threadIdx.x; asm volatile("" : "+v"(tid)); const int lane = tid & 63, wave = __builtin_amdgcn_readfirstlane(tid >> 6);
    int G = gridDim.x, bx = blockIdx.x; asm volatile("" : "+s"(G), "+s"(bx)); const int gw = bx * 8 + wave, NGW = G * 8;
    unsigned char* lds = (unsigned char*)L; LAS int* lcnt = (LAS int*)(L + 0); LAS int* gt = (LAS int*)(L + LDS_MISC + 512);
    (void)lane; (void)gw; (void)NGW; (void)lds; (void)lcnt; (void)gt; (void)layer; (void)slot; (void)tid; (void)bx; (void)G;
    {
            KArgs A = kargs(); unsigned char* ws = A->ws;
            const bf16* PROJ = (const bf16*)(ws + WS_PROJ);
            for (int r_ = 0; r_ < REP(0); ++r_) ret_u_phase(PROJ, (float*)(ws + WS_U), (char*)lds, G);
            for (int r_ = 0; r_ < REP(1); ++r_) pool_phase(PROJ, (const bf16*)(ws + WS_WPOOL) + (size_t)layer * 4 * 16384, A->pool_scale + (size_t)layer * 512, (bf16*)(ws + WS_BR23), (char*)lds, G);
            for (int r_ = 0; r_ < REP(2); ++r_) swa_phase(PROJ, (const bf16*)(ws + WS_AKV), A->attn_sink + layer * 8, (bf16*)(ws + WS_BR01), (char*)lds, G);
            for (int r_ = 0; r_ < REP(3); ++r_) dsa_phase(PROJ, (const bf16*)(ws + WS_BKV), (const bf16*)(ws + WS_IK), (bf16*)(ws + WS_BR01), (char*)lds, G);
        }
}
__device__ __forceinline__ void ph3(LAS unsigned char* L, int layer, int slot) {
    int tid = threadIdx.x; asm volatile("" : "+v"(tid)); const int lane = tid & 63, wave = __builtin_amdgcn_readfirstlane(tid >> 6);
    int G = gridDim.x, bx = blockIdx.x; asm volatile("" : "+s"(G), "+s"(bx)); const int gw = bx * 8 + wave, NGW = G * 8;
    unsigned char* lds = (unsigned char*)L; LAS int* lcnt = (LAS int*)(L + 0); LAS int* gt = (LAS int*)(L + LDS_MISC + 512);
    (void)lane; (void)gw; (void)NGW; (void)lds; (void)lcnt; (void)gt; (void)layer; (void)slot; (void)tid; (void)bx; (void)G;
    { unsigned char* ws = kargs()->ws; ret_out_phase((const bf16*)(ws + WS_PROJ), (const bf16*)(ws + WS_ST), (bf16*)(ws + WS_BR23), (char*)lds, G); }
}
__device__ __forceinline__ void ph20(LAS unsigned char* L, int layer, int slot) {
    int tid = threadIdx.x; asm volatile("" : "+v"(tid)); const int lane = tid & 63, wave = __builtin_amdgcn_readfirstlane(tid >> 6);
    int G = gridDim.x, bx = blockIdx.x; asm volatile("" : "+s"(G), "+s"(bx)); const int gw = bx * 8 + wave, NGW = G * 8;
    unsigned char* lds = (unsigned char*)L; LAS int* lcnt = (LAS int*)(L + 0); LAS int* gt = (LAS int*)(L + LDS_MISC + 512);
    (void)lane; (void)gw; (void)NGW; (void)lds; (void)lcnt; (void)gt; (void)layer; (void)slot; (void)tid; (void)bx; (void)G;
    { unsigned char* ws = kargs()->ws; ret_scan_phase((const float*)(ws + WS_U), (bf16*)(ws + WS_ST), G); }
}
__device__ __forceinline__ void ph4(LAS unsigned char* L, int layer, int slot) {
    int tid = threadIdx.x; asm volatile("" : "+v"(tid)); const int lane = tid & 63, wave = __builtin_amdgcn_readfirstlane(tid >> 6);
    int G = gridDim.x, bx = blockIdx.x; asm volatile("" : "+s"(G), "+s"(bx)); const int gw = bx * 8 + wave, NGW = G * 8;
    unsigned char* lds = (unsigned char*)L; LAS int* lcnt = (LAS int*)(L + 0); LAS int* gt = (LAS int*)(L + LDS_MISC + 512);
    (void)lane; (void)gw; (void)NGW; (void)lds; (void)lcnt; (void)gt; (void)layer; (void)slot; (void)tid; (void)bx; (void)G;
    {
            unsigned char* ws = kargs()->ws; unsigned char* wb = ws + WS_W + (size_t)layer * W_LAYER;
            unsigned* scr = (unsigned*)(ws + WS_MSCR + (size_t)bx * 786432);
            for (int ti = 0; ti * G + bx < 512; ++ti) {
                int pm, pn; pg8::tile_of(ti * G + bx, 128, 4, pm, pn);
                { MergeSched<0> S{(const char*)(ws + WS_XF8), nullptr, (const char*)(wb + W_G), pm, pn};
                  EpiGate E{scr, (const u64*)(ws + WS_SS) + (size_t)(3 * layer) * M, 1.f / F8_WSCALE};
                  pg8::gemm_stream<EpiGate, MergeSched<0>, 1>(L, S, E, 1024u, 1024u); }
                { MergeSched<1> S{(const char*)(ws + WS_BR01), (const char*)(ws + WS_BR23), (const char*)(wb + W_B), pm, pn};
                  EpiUp E{scr, (bf16*)(ws + WS_MERGED)};
                  pg8::gemm_stream(L, S, E, 2048u, 2048u); }
            }
        }
}
__device__ __forceinline__ void ph5(LAS unsigned char* L, int layer, int slot) {
    int tid = threadIdx.x; asm volatile("" : "+v"(tid)); const int lane = tid & 63, wave = __builtin_amdgcn_readfirstlane(tid >> 6);
    int G = gridDim.x, bx = blockIdx.x; asm volatile("" : "+s"(G), "+s"(bx)); const int gw = bx * 8 + wave, NGW = G * 8;
    unsigned char* lds = (unsigned char*)L; LAS int* lcnt = (LAS int*)(L + 0); LAS int* gt = (LAS int*)(L + LDS_MISC + 512);
    (void)lane; (void)gw; (void)NGW; (void)lds; (void)lcnt; (void)gt; (void)layer; (void)slot; (void)tid; (void)bx; (void)G;
    {
            KArgs A = kargs(); unsigned char* ws = A->ws; unsigned char* wb = ws + WS_W + (size_t)layer * W_LAYER;
            pg8::GridSched S{(const char*)(ws + WS_MERGED), (const char*)(wb + W_OUT), 2048u, 2048u, 128, 4, 16, G, bx};
            EpiRes E{(bf16*)(ws + WS_HB), (u64*)(ws + WS_SS) + (size_t)(3 * layer + 1) * M};
            pg8::gemm_stream(L, S, E, 2048u, 2048u);
        }
}
__device__ __forceinline__ void ph6(LAS unsigned char* L, int layer, int slot) {
    int tid = threadIdx.x; asm volatile("" : "+v"(tid)); const int lane = tid & 63, wave = __builtin_amdgcn_readfirstlane(tid >> 6);
    int G = gridDim.x, bx = blockIdx.x; asm volatile("" : "+s"(G), "+s"(bx)); const int gw = bx * 8 + wave, NGW = G * 8;
    unsigned char* lds = (unsigned char*)L; LAS int* lcnt = (LAS int*)(L + 0); LAS int* gt = (LAS int*)(L + LDS_MISC + 512);
    (void)lane; (void)gw; (void)NGW; (void)lds; (void)lcnt; (void)gt; (void)layer; (void)slot; (void)tid; (void)bx; (void)G;
    { KArgs A = kargs(); const float* x = A->out; const float* g = A->norm_cross + (size_t)layer * D; bf16* HB = (bf16*)(A->ws + WS_HB);
            for (int m = gw; m < M; m += NGW) norm_row_bf16(x + (size_t)m * D, g, HB + (size_t)m * D, lane); }
}
template <int COPY> __device__ __forceinline__ void ph7(LAS unsigned char* L, int layer, int slot) {
    if (COPY) asm volatile("s_nop 0" ::: "memory");
    int tid = threadIdx.x; asm volatile("" : "+v"(tid)); const int lane = tid & 63, wave = __builtin_amdgcn_readfirstlane(tid >> 6);
    int G = gridDim.x, bx = blockIdx.x; asm volatile("" : "+s"(G), "+s"(bx)); const int gw = bx * 8 + wave, NGW = G * 8;
    unsigned char* lds = (unsigned char*)L; LAS int* lcnt = (LAS int*)(L + 0); LAS int* gt = (LAS int*)(L + LDS_MISC + 512);
    (void)lane; (void)gw; (void)NGW; (void)lds; (void)lcnt; (void)gt; (void)layer; (void)slot; (void)tid; (void)bx; (void)G;
    {
            unsigned char* ws = kargs()->ws; unsigned char* wb = ws + WS_W + (size_t)layer * W_LAYER;
            pg8::GridSched S{(const char*)(ws + WS_HB), (const char*)(wb + W_XQ), 2048u, 2048u, 128, 4, 16, G, bx};
            EpiPlain E{(bf16*)(ws + WS_XQ), D, 1.f, (const u64*)(ws + WS_SS) + (size_t)(3 * layer + 1) * M};
            pg8::gemm_stream(L, S, E, 2048u, 2048u);
        }
}
__device__ __forceinline__ void ph8(LAS unsigned char* L, int layer, int slot) {
    int tid = threadIdx.x; asm volatile("" : "+v"(tid)); const int lane = tid & 63, wave = __builtin_amdgcn_readfirstlane(tid >> 6);
    int G = gridDim.x, bx = blockIdx.x; asm volatile("" : "+s"(G), "+s"(bx)); const int gw = bx * 8 + wave, NGW = G * 8;
    unsigned char* lds = (unsigned char*)L; LAS int* lcnt = (LAS int*)(L + 0); LAS int* gt = (LAS int*)(L + LDS_MISC + 512);
    (void)lane; (void)gw; (void)NGW; (void)lds; (void)lcnt; (void)gt; (void)layer; (void)slot; (void)tid; (void)bx; (void)G;
    {
            unsigned char* ws = kargs()->ws;
            unsigned char* wb = ws + WS_W + (size_t)layer * W_LAYER;
            CrossFusedSched S{(const char*)(ws + WS_HB), (const char*)(wb + W_XQ), (const char*)(ws + WS_XQ), (const char*)(ws + WS_KX) + (size_t)layer * MROWS * D * 2,
                              (const char*)(ws + WS_XP), (const char*)(ws + WS_VTB) + (size_t)layer * 8 * D * D * 2, G, bx};
            EpiCross E{EpiPlain{(bf16*)(ws + WS_XQ), D, 1.f, (const u64*)(ws + WS_SS) + (size_t)(3 * layer + 1) * M},
                       EpiSoftmax{(bf16*)(ws + WS_XP), (LAS f32x2*)(L + LDS_XCH), 0.0625f * 1.44269504f},
                       EpiPlainT<true>{(bf16*)(ws + WS_XO), D, F8_OSCALE, nullptr}};
            pg8::gemm_stream(L, S, E, 2048u, 2048u);
        }
}
__device__ __forceinline__ void ph9(LAS unsigned char* L, int layer, int slot) {
    int tid = threadIdx.x; asm volatile("" : "+v"(tid)); const int lane = tid & 63, wave = __builtin_amdgcn_readfirstlane(tid >> 6);
    int G = gridDim.x, bx = blockIdx.x; asm volatile("" : "+s"(G), "+s"(bx)); const int gw = bx * 8 + wave, NGW = G * 8;
    unsigned char* lds = (unsigned char*)L; LAS int* lcnt = (LAS int*)(L + 0); LAS int* gt = (LAS int*)(L + LDS_MISC + 512);
    (void)lane; (void)gw; (void)NGW; (void)lds; (void)lcnt; (void)gt; (void)layer; (void)slot; (void)tid; (void)bx; (void)G;
    {
            unsigned char* ws = kargs()->ws;
            CrossSched S{(const char*)(ws + WS_XP), (const char*)(ws + WS_VT) + (size_t)layer * D * MROWS * 2, 1, G, bx};
            EpiPlain E{(bf16*)(ws + WS_XO), D, 1.f, nullptr};
            pg8::gemm_stream(L, S, E, 2048u, 4096u);
        }
}
__device__ __forceinline__ void ph10(LAS unsigned char* L, int layer, int slot) {
    int tid = threadIdx.x; asm volatile("" : "+v"(tid)); const int lane = tid & 63, wave = __builtin_amdgcn_readfirstlane(tid >> 6);
    int G = gridDim.x, bx = blockIdx.x; asm volatile("" : "+s"(G), "+s"(bx)); const int gw = bx * 8 + wave, NGW = G * 8;
    unsigned char* lds = (unsigned char*)L; LAS int* lcnt = (LAS int*)(L + 0); LAS int* gt = (LAS int*)(L + LDS_MISC + 512);
    (void)lane; (void)gw; (void)NGW; (void)lds; (void)lcnt; (void)gt; (void)layer; (void)slot; (void)tid; (void)bx; (void)G;
    {
            KArgs A = kargs(); unsigned char* ws = A->ws; unsigned char* wb = ws + WS_W + (size_t)layer * W_LAYER;
            pg8::GridSched S{(const char*)(ws + WS_XO), (const char*)(wb + W_XO), 1024u, 1024u, 128, 4, 8, G, bx};
            EpiResT<true> E{(bf16*)(ws + WS_HB), (u64*)(ws + WS_SS) + (size_t)(3 * layer + 2) * M, ws + WS_XF8, 1.f / (F8_OSCALE * F8_WSCALE)};
            pg8::gemm_stream<EpiResT<true>, pg8::GridSched, 1>(L, S, E, 1024u, 1024u);
        }
}
__device__ __forceinline__ void ph11(LAS unsigned char* L, int layer, int slot) {
    int tid = threadIdx.x; asm volatile("" : "+v"(tid)); const int lane = tid & 63, wave = __builtin_amdgcn_readfirstlane(tid >> 6);
    int G = gridDim.x, bx = blockIdx.x; asm volatile("" : "+s"(G), "+s"(bx)); const int gw = bx * 8 + wave, NGW = G * 8;
    unsigned char* lds = (unsigned char*)L; LAS int* lcnt = (LAS int*)(L + 0); LAS int* gt = (LAS int*)(L + LDS_MISC + 512);
    (void)lane; (void)gw; (void)NGW; (void)lds; (void)lcnt; (void)gt; (void)layer; (void)slot; (void)tid; (void)bx; (void)G;
    { KArgs A = kargs(); const float* x = A->out; const float* g = A->norm_ffn; bf16* HB = (bf16*)(A->ws + WS_HB);
                for (int m = gw; m < M; m += NGW) norm_row_bf16(x + (size_t)m * D, g, HB + (size_t)m * D, lane); }
}
__device__ __forceinline__ void ph12(LAS unsigned char* L, int layer, int slot) {
    int tid = threadIdx.x; asm volatile("" : "+v"(tid)); const int lane = tid & 63, wave = __builtin_amdgcn_readfirstlane(tid >> 6);
    int G = gridDim.x, bx = blockIdx.x; asm volatile("" : "+s"(G), "+s"(bx)); const int gw = bx * 8 + wave, NGW = G * 8;
    unsigned char* lds = (unsigned char*)L; LAS int* lcnt = (LAS int*)(L + 0); LAS int* gt = (LAS int*)(L + LDS_MISC + 512);
    (void)lane; (void)gw; (void)NGW; (void)lds; (void)lcnt; (void)gt; (void)layer; (void)slot; (void)tid; (void)bx; (void)G;
    {
                unsigned char* ws = kargs()->ws;
                pg8::GridSched S{(const char*)(ws + WS_XF8), (const char*)(ws + WS_WGU), 1024u, 1024u, 128, 28, 8, G, bx};
                EpiGU E{(bf16*)(ws + WS_HID), (const u64*)(ws + WS_SS) + (size_t)2 * M, 1.f / F8_WSCALE};
                pg8::gemm_stream<EpiGU, pg8::GridSched, 1>(L, S, E, 1024u, 1024u);
            }
}
__device__ __forceinline__ void ph13(LAS unsigned char* L, int layer, int slot) {
    int tid = threadIdx.x; asm volatile("" : "+v"(tid)); const int lane = tid & 63, wave = __builtin_amdgcn_readfirstlane(tid >> 6);
    int G = gridDim.x, bx = blockIdx.x; asm volatile("" : "+s"(G), "+s"(bx)); const int gw = bx * 8 + wave, NGW = G * 8;
    unsigned char* lds = (unsigned char*)L; LAS int* lcnt = (LAS int*)(L + 0); LAS int* gt = (LAS int*)(L + LDS_MISC + 512);
    (void)lane; (void)gw; (void)NGW; (void)lds; (void)lcnt; (void)gt; (void)layer; (void)slot; (void)tid; (void)bx; (void)G;
    {
                KArgs A = kargs(); unsigned char* ws = A->ws;
                pg8::GridSched S{(const char*)(ws + WS_HID), (const char*)(ws + WS_WDN), 3584u, 3584u, 128, 4, 28, G, bx};
                EpiResT<true> E{(bf16*)(ws + WS_HB), (u64*)(ws + WS_SS) + (size_t)(3) * M, ws + WS_XF8, 1.f / (F8_HSCALE * F8_WSCALE)};
                pg8::gemm_stream<EpiResT<true>, pg8::GridSched, 1>(L, S, E, 3584u, 3584u);
            }
}
__device__ __forceinline__ void ph14(LAS unsigned char* L, int layer, int slot) {
    int tid = threadIdx.x; asm volatile("" : "+v"(tid)); const int lane = tid & 63, wave = __builtin_amdgcn_readfirstlane(tid >> 6);
    int G = gridDim.x, bx = blockIdx.x; asm volatile("" : "+s"(G), "+s"(bx)); const int gw = bx * 8 + wave, NGW = G * 8;
    unsigned char* lds = (unsigned char*)L; LAS int* lcnt = (LAS int*)(L + 0); LAS int* gt = (LAS int*)(L + LDS_MISC + 512);
    (void)lane; (void)gw; (void)NGW; (void)lds; (void)lcnt; (void)gt; (void)layer; (void)slot; (void)tid; (void)bx; (void)G;
    { KArgs A = kargs(); const float* x = A->out; const float* g = A->norm_mix + D; bf16* HB = (bf16*)(A->ws + WS_HB);
                for (int m = gw; m < M; m += NGW) norm_row_bf16(x + (size_t)m * D, g, HB + (size_t)m * D, lane); }
}
__device__ __forceinline__ void ph15(LAS unsigned char* L, int layer, int slot) {
    int tid = threadIdx.x; asm volatile("" : "+v"(tid)); const int lane = tid & 63, wave = __builtin_amdgcn_readfirstlane(tid >> 6);
    int G = gridDim.x, bx = blockIdx.x; asm volatile("" : "+s"(G), "+s"(bx)); const int gw = bx * 8 + wave, NGW = G * 8;
    unsigned char* lds = (unsigned char*)L; LAS int* lcnt = (LAS int*)(L + 0); LAS int* gt = (LAS int*)(L + LDS_MISC + 512);
    (void)lane; (void)gw; (void)NGW; (void)lds; (void)lcnt; (void)gt; (void)layer; (void)slot; (void)tid; (void)bx; (void)G;
    {
                KArgs A = kargs(); unsigned char* ws = A->ws; unsigned* ctl = (unsigned*)(ws + WS_CTL);
                int* route = (int*)(ws + WS_ROUTE); bf16* HB = (bf16*)(ws + WS_HB);
                if (tid < 16) lcnt[tid] = 0;
                __syncthreads();
                const float* gn = A->norm_ffn + D; const float* rwt = A->router_w; const u64* ss5 = (const u64*)(ws + WS_SS) + (size_t)5 * M;
                f32x4 rwr[4][4][2];
#pragma unroll
                for (int j = 0; j < 4; ++j) { const f32x4 gg = ((const f32x4*)gn + lane)[64 * j]; const float* rw = rwt + (size_t)(256 * j + 4 * lane) * 8;
#pragma unroll
                    for (int q = 0; q < 4; ++q) { rwr[j][q][0] = *(const f32x4*)(rw + 8 * q) * gg[q]; rwr[j][q][1] = *(const f32x4*)(rw + 8 * q + 4) * gg[q]; } }
                for (int m = gw; m < M; m += NGW) {
                    const u32x2* xr = (const u32x2*)(HB + (size_t)m * D) + lane;
                    const float rstd = rstd_of(ss5[m]);
                    float lg[8];
#pragma unroll
                    for (int e = 0; e < 8; ++e) lg[e] = 0.f;
#pragma unroll
                    for (int j = 0; j < 4; ++j) { const u32x2 xv = xr[64 * j];
                        const f32x4 hv = (f32x4){__uint_as_float(xv.x << 16), __uint_as_float(xv.x & 0xffff0000u), __uint_as_float(xv.y << 16), __uint_as_float(xv.y & 0xffff0000u)} * rstd;
#pragma unroll
                        for (int q = 0; q < 4; ++q) { const f32x4 r0 = rwr[j][q][0], r1 = rwr[j][q][1]; const float hq = hv[q];
                            lg[0] += hq * r0.x; lg[1] += hq * r0.y; lg[2] += hq * r0.z; lg[3] += hq * r0.w; lg[4] += hq * r1.x; lg[5] += hq * r1.y; lg[6] += hq * r1.z; lg[7] += hq * r1.w; } }
#pragma unroll
                    for (int e = 0; e < 8; ++e) lg[e] = wave_sum(lg[e]);
                    int e0 = 0; float v0 = lg[0];
#pragma unroll
                    for (int e = 1; e < 8; ++e) if (lg[e] > v0) { v0 = lg[e]; e0 = e; }
                    int e1 = -1; float v1 = -INFINITY;
#pragma unroll
                    for (int e = 0; e < 8; ++e) if (e != e0 && lg[e] > v1) { v1 = lg[e]; e1 = e; }
                    const float ww1 = 1.f / (1.f + __expf(v0 - v1)), ww0 = 1.f - ww1;
                    if (lane == 0) { route[4 * m] = e0; route[4 * m + 1] = e1; ((float*)route)[4 * m + 2] = ww0; ((float*)route)[4 * m + 3] = ww1; atomicAdd((int*)&lcnt[e0], 1); atomicAdd((int*)&lcnt[8 + e1], 1); }
                }
                __syncthreads();
                if (tid < 16) atomicAdd(ctl + CW_CNT + tid, (unsigned)lcnt[tid]);
                __syncthreads();
                LAS float* scr = (LAS float*)(L + wave * 16384);
                constexpr int I_GU = 16 * 224, I_DN = 56 * 32;
                const float* mgu = A->moe_w_gu; const float* mdn = A->moe_w_down;
                for (int r_ = 0; r_ < REP(7); ++r_) {
                    auto decode = [&](int it, ConvItem& c) {
                        const int e = it / (I_GU + I_DN); int r = it % (I_GU + I_DN);
                        if (r < I_GU) { const int kb = r / 224, vb = r % 224, pn = vb >> 3, bj = (vb >> 2) & 1, pb = vb & 3;
                            c.W = mgu + (size_t)e * D * 2 * DFF; c.ldw = 2 * DFF; c.k0 = 64 * kb; c.src = bj * DFF + 128 * pn + 32 * pb; c.gain = gn; c.WT = ws + WS_MWGU + (size_t)e * 2 * DFF * D; c.dpitch = D; c.drow0 = 32 * vb; }
                        else { r -= I_GU; const int kb = r / 32, vb = r % 32;
                            c.W = mdn + (size_t)e * DFF * D; c.ldw = D; c.k0 = 64 * kb; c.src = 32 * vb; c.gain = nullptr; c.WT = ws + WS_MWDN + (size_t)e * D * DFF; c.dpitch = DFF; c.drow0 = 32 * vb; } };
                    const int NIT = 8 * (I_GU + I_DN);
                    int it = gw; ConvItem cur, nxt; f32x4 tvA[8], tvB[8]; float gA[8], gB[8];
                    if (it < NIT) { decode(it, cur); conv_load(cur, tvA, gA, lane); }
                    while (it < NIT) {
                        const int itn = it + NGW;
                        if (itn < NIT) { decode(itn, nxt); conv_load(nxt, tvB, gB, lane); }
                        conv_finish8(cur, tvA, gA, scr, lane);
                        cur = nxt; it = itn;
#pragma unroll
                        for (int i = 0; i < 8; ++i) { tvA[i] = tvB[i]; gA[i] = gB[i]; }
                    }
                }
            }
}
__device__ __forceinline__ void ph16(LAS unsigned char* L, int layer, int slot) {
    int tid = threadIdx.x; asm volatile("" : "+v"(tid)); const int lane = tid & 63, wave = __builtin_amdgcn_readfirstlane(tid >> 6);
    int G = gridDim.x, bx = blockIdx.x; asm volatile("" : "+s"(G), "+s"(bx)); const int gw = bx * 8 + wave, NGW = G * 8;
    unsigned char* lds = (unsigned char*)L; LAS int* lcnt = (LAS int*)(L + 0); LAS int* gt = (LAS int*)(L + LDS_MISC + 512);
    (void)lane; (void)gw; (void)NGW; (void)lds; (void)lcnt; (void)gt; (void)layer; (void)slot; (void)tid; (void)bx; (void)G;
    {
                unsigned char* ws = kargs()->ws; unsigned* ctl = (unsigned*)(ws + WS_CTL);
                int* route = (int*)(ws + WS_ROUTE); int* tokmap = (int*)(ws + WS_TOKMAP); float* roww = (float*)(ws + WS_ROWW); bf16* HB = (bf16*)(ws + WS_HB);
                LAS int* lbase = (LAS int*)(L + 64); LAS int* lc2 = (LAS int*)(L + 128);
                for (int chunk = bx; chunk < M / 128; chunk += G) {
                    if (tid < 16) { lcnt[tid] = 0; lc2[tid] = 0; }
                    __syncthreads();
                    const int m = chunk * 128 + (tid >> 2);
                    const int e0 = route[4 * m], e1 = route[4 * m + 1];
                    if ((tid & 3) == 0) { atomicAdd((int*)&lcnt[e0], 1); atomicAdd((int*)&lcnt[8 + e1], 1); }
                    __syncthreads();
                    if (tid < 16) lbase[tid] = (int)atomicAdd(ctl + CW_CUR + tid, (unsigned)lcnt[tid]) + gt[tid] * 256;
                    __syncthreads();
                    int p0 = 0, p1 = 0;
                    if ((tid & 3) == 0) { p0 = lbase[e0] + atomicAdd((int*)&lc2[e0], 1); p1 = lbase[8 + e1] + atomicAdd((int*)&lc2[8 + e1], 1);
                        tokmap[p0] = m; tokmap[p1] = m; roww[p0] = ((const float*)route)[4 * m + 2]; roww[p1] = ((const float*)route)[4 * m + 3];
                        const u64 sq = ((const u64*)(ws + WS_SS))[(size_t)5 * M + m]; ((u64*)(ws + WS_ROWSS))[p0] = sq; ((u64*)(ws + WS_ROWSS))[p1] = sq; }
                    p0 = __shfl(p0, lane & ~3); p1 = __shfl(p1, lane & ~3);
                    const u32x4* src = (const u32x4*)(ws + WS_XF8 + (size_t)m * D) + (tid & 3) * 16;
                    u32x4* d0 = (u32x4*)(ws + WS_XS + (size_t)p0 * D) + (tid & 3) * 16; u32x4* d1 = (u32x4*)(ws + WS_XS + (size_t)p1 * D) + (tid & 3) * 16;
#pragma unroll 8
                    for (int q = 0; q < 16; ++q) { const u32x4 v = src[q]; d0[q] = v; d1[q] = v; }
                    __syncthreads();
                }
                if (bx < 16) { const int g = bx; const int cntg = (int)__hip_atomic_load(ctl + CW_CNT + g, __ATOMIC_RELAXED, __HIP_MEMORY_SCOPE_AGENT);
                    for (int r = gt[g] * 256 + cntg + tid; r < gt[g + 1] * 256; r += 512) { tokmap[r] = -1; roww[r] = 0.f; ((u64*)(ws + WS_ROWSS))[r] = (u64)1 << 34; } }
            }
}
__device__ __forceinline__ void ph17(LAS unsigned char* L, int layer, int slot) {
    int tid = threadIdx.x; asm volatile("" : "+v"(tid)); const int lane = tid & 63, wave = __builtin_amdgcn_readfirstlane(tid >> 6);
    int G = gridDim.x, bx = blockIdx.x; asm volatile("" : "+s"(G), "+s"(bx)); const int gw = bx * 8 + wave, NGW = G * 8;
    unsigned char* lds = (unsigned char*)L; LAS int* lcnt = (LAS int*)(L + 0); LAS int* gt = (LAS int*)(L + LDS_MISC + 512);
    (void)lane; (void)gw; (void)NGW; (void)lds; (void)lcnt; (void)gt; (void)layer; (void)slot; (void)tid; (void)bx; (void)G;
    {
                unsigned char* ws = kargs()->ws;
                MoeSched S{(const char*)(ws + WS_XS), (const char*)(ws + WS_MWGU), 1024u, (size_t)2 * DFF * D, 1024u, 0, gt[16], 28, 8, G, bx, (const int*)gt};
                EpiGU E{(bf16*)(ws + WS_MHID), (const u64*)(ws + WS_ROWSS), 1.f / F8_WSCALE};
                pg8::gemm_stream<EpiGU, MoeSched, 1>(L, S, E, 1024u, 1024u);
            }
}
__device__ __forceinline__ void ph18(LAS unsigned char* L, int layer, int slot) {
    int tid = threadIdx.x; asm volatile("" : "+v"(tid)); const int lane = tid & 63, wave = __builtin_amdgcn_readfirstlane(tid >> 6);
    int G = gridDim.x, bx = blockIdx.x; asm volatile("" : "+s"(G), "+s"(bx)); const int gw = bx * 8 + wave, NGW = G * 8;
    unsigned char* lds = (unsigned char*)L; LAS int* lcnt = (LAS int*)(L + 0); LAS int* gt = (LAS int*)(L + LDS_MISC + 512);
    (void)lane; (void)gw; (void)NGW; (void)lds; (void)lcnt; (void)gt; (void)layer; (void)slot; (void)tid; (void)bx; (void)G;
    {
                    KArgs A = kargs(); unsigned char* ws = A->ws;
                    MoeSched S{(const char*)(ws + WS_MHID), (const char*)(ws + WS_MWDN), 3584u, (size_t)D * DFF, 3584u, 0, gt[16], 4, 28, G, bx, (const int*)gt};
                    EpiDownMoe E{(const int*)(ws + WS_TOKMAP), (const float*)(ws + WS_ROWW), (bf16*)(ws + WS_XS), gt[8]};
                    pg8::gemm_stream<EpiDownMoe, MoeSched, 1>(L, S, E, 3584u, 3584u);
                }
}
__device__ __forceinline__ void ph19(LAS unsigned char* L, int layer, int slot) {
    int tid = threadIdx.x; asm volatile("" : "+v"(tid)); const int lane = tid & 63, wave = __builtin_amdgcn_readfirstlane(tid >> 6);
    int G = gridDim.x, bx = blockIdx.x; asm volatile("" : "+s"(G), "+s"(bx)); const int gw = bx * 8 + wave, NGW = G * 8;
    unsigned char* lds = (unsigned char*)L; LAS int* lcnt = (LAS int*)(L + 0); LAS int* gt = (LAS int*)(L + LDS_MISC + 512);
    (void)lane; (void)gw; (void)NGW; (void)lds; (void)lcnt; (void)gt; (void)layer; (void)slot; (void)tid; (void)bx; (void)G;
    { KArgs A = kargs(); float* xo = A->out; const float* gf = A->norm_final; const bf16* XB = (const bf16*)(A->ws + WS_HB); const bf16* Y0 = (const bf16*)(A->ws + WS_XS); const bf16* Y1 = Y0 + (size_t)M * D;
                for (int m = gw; m < M; m += NGW) {
                    const u32x2* xr = (const u32x2*)(XB + (size_t)m * D) + lane; const u32x2* y0 = (const u32x2*)(Y0 + (size_t)m * D) + lane; const u32x2* y1 = (const u32x2*)(Y1 + (size_t)m * D) + lane;
                    f32x4* orow = (f32x4*)(xo + (size_t)m * D) + lane; const f32x4* gr = (const f32x4*)gf + lane;
                    u32x2 a[4], b[4], c[4];
#pragma unroll
                    for (int j = 0; j < 4; ++j) { a[j] = xr[64 * j]; b[j] = y0[64 * j]; c[j] = y1[64 * j]; }
                    f32x4 v[4]; float q = 0.f;
#pragma unroll
                    for (int j = 0; j < 4; ++j) {
                        v[j] = (f32x4){__uint_as_float(a[j].x << 16), __uint_as_float(a[j].x & 0xffff0000u), __uint_as_float(a[j].y << 16), __uint_as_float(a[j].y & 0xffff0000u)}
                             + (f32x4){__uint_as_float(b[j].x << 16), __uint_as_float(b[j].x & 0xffff0000u), __uint_as_float(b[j].y << 16), __uint_as_float(b[j].y & 0xffff0000u)}
                             + (f32x4){__uint_as_float(c[j].x << 16), __uint_as_float(c[j].x & 0xffff0000u), __uint_as_float(c[j].y << 16), __uint_as_float(c[j].y & 0xffff0000u)};
                        q += (v[j].x * v[j].x + v[j].y * v[j].y) + (v[j].z * v[j].z + v[j].w * v[j].w); }
                    const float rstd = 1.f / sqrtf(wave_sum(q) * (1.f / D) + EPS);
#pragma unroll
                    for (int j = 0; j < 4; ++j) orow[64 * j] = v[j] * rstd * gr[64 * j];
                } }
}
__global__ void __launch_bounds__(512, 2) fwd_kernel(Args a_unused) {
    extern __shared__ __attribute__((aligned(16))) unsigned char lds[];
    LAS unsigned char* L = (LAS unsigned char*)lds;
    volatile LAS unsigned* MISC = (volatile LAS unsigned*)(L + LDS_MISC);
    const int tid = threadIdx.x, lane = tid & 63, wave = __builtin_amdgcn_readfirstlane(tid >> 6);
    const int G = gridDim.x, bx = blockIdx.x;
    for (int u = tid; u < 64; u += 512) MISC[u] = 0u;
    __syncthreads();
    XcdBarrier bar; bar.bar = (unsigned*)(kargs()->ws + WS_CTL) + CW_BAR; bar.x = 0; bar.st = nullptr;
    if (!MK_PER_PHASE) bar = xcd_barrier_post(bar.bar, MISC + 8);
    int pid = 0;
    const int lo = kargs()->ph_lo, hi = kargs()->ph_hi;
#define RUN() (pid >= lo && pid < hi)
#define SEAM() do { if (!MK_PER_PHASE) { xcd_barrier(bar); if (REP(30) > 1) xcd_barrier(bar); } ++pid; } while (0)
    int slotv = 0; (void)lane;

    if (PON(0) && RUN()) for (int r_ = 0; r_ < REP(8); ++r_) ph0(L, 0, 0);
    SEAM();

    for (int layer = 0; layer < DEPTH; ++layer) {
        if (PON(1) && RUN()) for (int r_ = 0; r_ < REP(9); ++r_) ph1(L, layer, slotv);
        SEAM();
        if (PON(2) && RUN()) for (int r_ = 0; r_ < REP(10); ++r_) ph2(L, layer, slotv);
        SEAM();
        if (PON(20) && RUN()) for (int r_ = 0; r_ < REP(28); ++r_) ph20(L, layer, slotv);
        SEAM();
        if (PON(3) && RUN()) for (int r_ = 0; r_ < REP(11); ++r_) ph3(L, layer, slotv);
        SEAM();
        if (PON(4) && RUN()) for (int r_ = 0; r_ < REP(12); ++r_) ph4(L, layer, slotv);
        SEAM();
        if (PON(5) && RUN()) for (int r_ = 0; r_ < REP(13); ++r_) ph5(L, layer, slotv);
        SEAM();
        if (PON(8) && RUN()) for (int r_ = 0; r_ < REP(16); ++r_) ph8(L, layer, slotv);
        SEAM();
        if (PON(10) && RUN()) for (int r_ = 0; r_ < REP(18); ++r_) ph10(L, layer, slotv);
        SEAM();
        if (layer == 0) {
            if (PON(12) && RUN()) for (int r_ = 0; r_ < REP(20); ++r_) ph12(L, layer, slotv);
            SEAM();
            if (PON(13) && RUN()) for (int r_ = 0; r_ < REP(21); ++r_) ph13(L, layer, slotv);
            SEAM();
        } else {
            if (PON(15) && RUN()) for (int r_ = 0; r_ < REP(23); ++r_) ph15(L, layer, slotv);
            SEAM();
            LAS int* gt = (LAS int*)(L + LDS_MISC + 512);
            if (tid == 0) { unsigned* ctl = (unsigned*)(kargs()->ws + WS_CTL); int acc = 0; for (int g = 0; g < 16; ++g) { gt[g] = acc; acc += ((int)__hip_atomic_load(ctl + CW_CNT + g, __ATOMIC_RELAXED, __HIP_MEMORY_SCOPE_AGENT) + 255) >> 8; } gt[16] = acc; }
            __syncthreads();
            if (PON(16) && RUN()) for (int r_ = 0; r_ < REP(24); ++r_) ph16(L, layer, slotv);
            SEAM();
            if (PON(17) && RUN()) for (int r_ = 0; r_ < REP(25); ++r_) ph17(L, layer, slotv);
            SEAM();
            if (PON(18) && RUN()) ph18(L, layer, 0);
            SEAM();
            if (PON(19) && RUN()) for (int r_ = 0; r_ < REP(27); ++r_) ph19(L, layer, slotv);
            ++pid;
        }
    }
#undef RUN
#undef SEAM
}


constexpr int NPHASE = 1 + 10 + 13;
extern "C" void kernel_launch(void* const* d_in, const int* in_sizes, int n_in, void* d_out, int out_size, void* d_ws, size_t ws_size, hipStream_t stream) {
    static int grid = 0;
    if (grid == 0) {
        if (n_in != 22 || out_size != M * D || ws_size < WS_END) { fprintf(stderr, "kernel_launch: unexpected problem (n_in %d out %d ws %zu)\n", n_in, out_size, ws_size); grid = -1; return; }
        int dev = 0, cus = 0;
        if (hipGetDevice(&dev) != hipSuccess || hipDeviceGetAttribute(&cus, hipDeviceAttributeMultiprocessorCount, dev) != hipSuccess) { grid = -1; return; }
        if (hipFuncSetAttribute((const void*)fwd_kernel, hipFuncAttributeMaxDynamicSharedMemorySize, LDS_BYTES) != hipSuccess) { fprintf(stderr, "kernel_launch: hipFuncSetAttribute failed\n"); grid = -1; return; }
        int per_cu = 0;
        (void)hipOccupancyMaxActiveBlocksPerMultiprocessor(&per_cu, (const void*)fwd_kernel, 512, LDS_BYTES);
        (void)hipGetLastError();
        if (per_cu < 1) fprintf(stderr, "kernel_launch: occupancy query says %d\n", per_cu);
        grid = cus;
    }
    if (grid < 0) return;
    (void)hipMemsetAsync((char*)d_ws + WS_CTL, 0, CTL_ZERO_BYTES, stream);
    Args a{};
    a.x = (const float*)d_in[0]; a.mem = (const float*)d_in[1]; a.positions = (const int*)d_in[2]; a.norm_mix = (const float*)d_in[3]; a.w_in = (const float*)d_in[4];
    a.attn_sink = (const float*)d_in[5]; a.w_branch = (const float*)d_in[6]; a.w_out = (const float*)d_in[7]; a.pool_w = (const float*)d_in[8]; a.pool_scale = (const float*)d_in[9];
    a.norm_cross = (const float*)d_in[10]; a.norm_mem = (const float*)d_in[11]; a.w_xq = (const float*)d_in[12]; a.w_xkv = (const float*)d_in[13]; a.w_xo = (const float*)d_in[14];
    a.norm_ffn = (const float*)d_in[15]; a.dense_w_gu = (const float*)d_in[16]; a.dense_w_down = (const float*)d_in[17]; a.router_w = (const float*)d_in[18];
    a.moe_w_gu = (const float*)d_in[19]; a.moe_w_down = (const float*)d_in[20]; a.norm_final = (const float*)d_in[21];
    a.out = (float*)d_out; a.ws = (unsigned char*)d_ws;
#if MK_PER_PHASE
    for (int p = 0; p < NPHASE; ++p) { a.ph_lo = p; a.ph_hi = p + 1; hipLaunchKernelGGL(fwd_kernel, dim3(grid), dim3(512), LDS_BYTES, stream, a); }
#else
    a.ph_lo = 0; a.ph_hi = NPHASE;
    hipLaunchKernelGGL(fwd_kernel, dim3(grid), dim3(512), LDS_BYTES, stream, a);
#endif
}
```

```cpp
#include <hip/hip_runtime.h>
#include <cstdio>
#include <cstdint>

#ifndef MK_PER_PHASE
#define MK_PER_PHASE 0
#endif

#ifndef PHASE_MASK
#define PHASE_MASK 0xFFFFFFFFu
#endif
#define PON(k) ((PHASE_MASK >> (k)) & 1u)
#ifndef REP_MASK
#define REP_MASK 0u
#endif
#define REP(k) (1 + (int)((REP_MASK >> (k)) & 1u))
#define LAS __attribute__((address_space(3)))
#define GAS __attribute__((address_space(1)))
typedef unsigned short bf16;
typedef short bf16x8 __attribute__((ext_vector_type(8)));
typedef float f32x4 __attribute__((ext_vector_type(4)));
typedef float f32x2 __attribute__((ext_vector_type(2)));
typedef unsigned u32x4 __attribute__((ext_vector_type(4)));
typedef int i32x4 __attribute__((ext_vector_type(4)));
typedef unsigned u32x2 __attribute__((ext_vector_type(2)));
typedef __bf16 bf16x2_t __attribute__((ext_vector_type(2)));
typedef _Float16 h16x8 __attribute__((ext_vector_type(8)));

constexpr int BATCH = 8, T = 4096, D = 1024, M = BATCH * T, DEPTH = 2;
constexpr int D_IN = 8004, NPROJ = 4096, DFF = 3584, NEXP = 8, MEMLEN = 256, MROWS = BATCH * MEMLEN;
constexpr float EPS = 1e-6f;
constexpr int C_AQ = 0, C_AK = 512, C_AV = 640, C_BQ = 768, C_BK = 1280, C_BV = 1408, C_IQ = 1536, C_IK = 1792, C_RQ = 1856, C_RK = 2112, C_RV = 2368, C_RG = 2880, C_PU = 3392, C_IW = 3904;
constexpr unsigned long long ROPE_MASK = 0x3FFull | (0x3FFull << 12) | (0x1FFFull << 24);

constexpr size_t MiB = 1u << 20;
constexpr size_t WS_CTL = 0, CTL_ZERO_BYTES = 2 * MiB;
constexpr size_t WS_SS = 128 * 1024;
constexpr size_t WS_ROUTE = 2 * MiB;
constexpr size_t WS_TOKMAP = 2 * MiB + 512 * 1024;
constexpr size_t WS_ROWW = 3 * MiB;
constexpr size_t WS_ROWSS = 3 * MiB + 384 * 1024;
constexpr size_t WS_HB = 4 * MiB;
constexpr size_t WS_ROPE = 68 * MiB;
constexpr size_t WS_MN = 76 * MiB;
constexpr size_t WS_KX = 84 * MiB;
constexpr size_t WS_VT = 92 * MiB;
constexpr size_t WS_W = 100 * MiB;
constexpr size_t W_IN = 0, W_G = 8 * MiB, W_B = 16 * MiB, W_OUT = 20 * MiB, W_XQ = 22 * MiB, W_XK = 24 * MiB, W_XV = 26 * MiB, W_XO = 28 * MiB, W_LAYER = 30 * MiB;
constexpr size_t WS_WGU = WS_W + 2 * W_LAYER;
constexpr size_t WS_WDN = WS_WGU + 14 * MiB;
constexpr size_t WS_R = 181 * MiB;
constexpr size_t WS_PROJ = WS_R;
constexpr size_t WS_BR01 = WS_R + 256 * MiB;
constexpr size_t WS_BR23 = WS_R + 320 * MiB;
constexpr size_t WS_U = WS_R + 384 * MiB;
constexpr size_t WS_R_END = WS_R + 416 * MiB;
constexpr size_t WS_AKV = 600 * MiB;
constexpr size_t WS_BKV = 616 * MiB;
constexpr size_t WS_IK = 632 * MiB;
constexpr size_t WS_VTB = 656 * MiB;
constexpr size_t WS_WPOOL = 652 * MiB;
constexpr size_t WS_ST = 636 * MiB;
constexpr size_t WS_MSCR = WS_PROJ;
constexpr size_t WS_MERGED = WS_PROJ + 192 * MiB;
constexpr size_t WS_XQ = WS_PROJ;
constexpr size_t WS_XP = WS_PROJ + 64 * MiB;
constexpr size_t WS_XO = WS_PROJ + 128 * MiB;
constexpr size_t WS_HID = WS_PROJ;
constexpr int MOE_ROWS = 2 * M + 16 * 256;
constexpr size_t WS_MWGU = 100 * MiB;
constexpr size_t WS_MWDN = 212 * MiB;
constexpr size_t WS_MHID = 268 * MiB;
constexpr size_t WS_XS = 744 * MiB;
constexpr size_t WS_XF8 = 812 * MiB;
constexpr size_t WS_END = 880 * MiB;
static_assert(WS_MHID + (size_t)MOE_ROWS * DFF * 2 <= WS_XS && WS_XS + (size_t)MOE_ROWS * D * 2 <= WS_END, "moe map");
static_assert(WS_WDN + 7 * MiB <= WS_R, "weights map");
constexpr int CW_BAR = 4096;
constexpr int CW_CNT = 16384;
constexpr int CW_CUR = 16384 + 64;

constexpr int LDS_STAGE = 131072;
constexpr int LDS_XCH = 131072;
constexpr int LDS_MISC = 131072 + 16384;
constexpr int LDS_BYTES = 131072 + 16384 + 8192;
constexpr int WAVE_LDS = 17408;

__device__ const float INV_FREQ[32] = {1.000000000e+00f, 7.498942018e-01f, 5.623413324e-01f, 4.216965139e-01f, 3.162277639e-01f, 2.371373922e-01f, 1.778279394e-01f, 1.333521456e-01f, 1.000000015e-01f, 7.498941571e-02f, 5.623412877e-02f, 4.216964915e-02f, 3.162277862e-02f, 2.371373586e-02f, 1.778279431e-02f, 1.333521493e-02f, 9.999999776e-03f, 7.498942316e-03f, 5.623413250e-03f, 4.216964822e-03f, 3.162277862e-03f, 2.371373819e-03f, 1.778279431e-03f, 1.333521446e-03f, 1.000000047e-03f, 7.498941850e-04f, 5.623413017e-04f, 4.216965463e-04f, 3.162277862e-04f, 2.371373848e-04f, 1.778279402e-04f, 1.333521504e-04f};
__device__ __forceinline__ float bf2f(unsigned short v) { return __uint_as_float(((unsigned)v) << 16); }
__device__ __forceinline__ unsigned f2bf(float f) { unsigned u = __float_as_uint(f); return (u + 0x7fffu + ((u >> 16) & 1u)) >> 16; }
__device__ __forceinline__ unsigned pk2(float lo, float hi) { return f2bf(lo) | (f2bf(hi) << 16); }
__device__ __forceinline__ unsigned f2bf1(float f) { return (unsigned)__builtin_bit_cast(unsigned short, (__bf16)f); }
__device__ __forceinline__ unsigned cvt_pk_bf16(float lo, float hi) { unsigned r; asm volatile("v_cvt_pk_bf16_f32 %0, %1, %2" : "=v"(r) : "v"(lo), "v"(hi)); return r; }
__device__ __forceinline__ float dot2(unsigned a, unsigned b, float acc) { return __builtin_amdgcn_fdot2_f32_bf16(__builtin_bit_cast(bf16x2_t, a), __builtin_bit_cast(bf16x2_t, b), acc, false); }
__device__ __forceinline__ float wave_sum(float v) {
#pragma unroll
    for (int o = 1; o < 64; o <<= 1) v += __shfl_xor(v, o);
    return v;
}
__device__ __forceinline__ float wave_max(float v) {
#pragma unroll
    for (int o = 1; o < 64; o <<= 1) v = fmaxf(v, __shfl_xor(v, o));
    return v;
}
#define LDS_WAIT() asm volatile("s_waitcnt lgkmcnt(0)" ::: "memory")
typedef unsigned long long u64;
__device__ __forceinline__ float rstd_of(u64 ssfix) { return 1.f / sqrtf((float)ssfix * (5.9604645e-8f / 1024.f) + 1e-6f); }
__device__ __forceinline__ u64 ss_fix(float q) { return (u64)(q * 16777216.f); }
__device__ __forceinline__ unsigned pk4_f8(float a, float b, float c, float d) {
    int w = 0;
    w = __builtin_amdgcn_cvt_pk_fp8_f32(__builtin_amdgcn_fmed3f(a, -448.f, 448.f), __builtin_amdgcn_fmed3f(b, -448.f, 448.f), w, false);
    w = __builtin_amdgcn_cvt_pk_fp8_f32(__builtin_amdgcn_fmed3f(c, -448.f, 448.f), __builtin_amdgcn_fmed3f(d, -448.f, 448.f), w, true);
    return (unsigned)w; }
constexpr float F8_MSCALE = 8.f, F8_OSCALE = 16.f;
constexpr float F8_HSCALE = 4.f;
constexpr float F8_WSCALE = 64.f;

namespace pg8 {
constexpr int BM = 256, BK = 64, HALF = 128, HTB = HALF * BK * 2, STAGE_BYTES = 8 * HTB, NXCD = 8, WGM = 8;
__host__ __device__ __forceinline__ int lds_byte(int r, int c) { const int st = (r >> 4) * 2 + (c >> 5), rr = r & 15, cc = c & 31, ob = rr * 64 + cc * 2; return st * 1024 + (ob ^ (((ob >> 9) & 1) << 5)); }
__host__ __device__ __forceinline__ void stage_rc(int b, int& R, int& C) { const int st = b / 1024, sb = b % 1024, swz = sb ^ (((sb >> 9) & 1) << 5); R = (st >> 1) * 16 + swz / 64; C = (st & 1) * 32 + (swz % 64) / 2; }
__host__ __device__ __forceinline__ int perm32(int rho) { const int n = rho >> 4, i = rho & 15; return 8 * (i >> 2) + 4 * n + (i & 3); }

struct Unit { const char* A; const char* B; int nt; int pm, pn, kind; };

__device__ __forceinline__ void tile_of(int wgid, int nM, int nN, int& pm, int& pn) {
    const int nwg = nM * nN;
    { const int q = nwg / NXCD, r = nwg % NXCD, xcd = wgid % NXCD, off = wgid / NXCD; wgid = (xcd < r ? xcd * (q + 1) : r * (q + 1) + (xcd - r) * q) + off; }
    const int nig = WGM * nN, gid = wgid / nig, fm = gid * WGM, gsz = (nM - fm) < WGM ? (nM - fm) : WGM;
    pm = fm + ((wgid % nig) % gsz); pn = (wgid % nig) / gsz;
}
struct GridSched {
    const char* A; const char* B; unsigned lda, ldb; int nM, nN, nt, G, c;
    __device__ __forceinline__ bool next(int i, Unit& u) const {
        const long L = (long)i * G + c; if (L >= (long)nM * nN) return false;
        tile_of((int)L, nM, nN, u.pm, u.pn);
        u.A = A + (size_t)u.pm * 256 * lda; u.B = B + (size_t)u.pn * 256 * ldb; u.nt = nt; u.kind = 0; return true;
    }
};

template <class Epi, class Sched, int F8 = 0>
__device__ __forceinline__ void gemm_stream(LAS unsigned char* lds, const Sched& S, const Epi& E, const unsigned lda, const unsigned ldb) {
    int tid = threadIdx.x; asm volatile("" : "+v"(tid));
    const int wid = __builtin_amdgcn_readfirstlane(tid >> 6), lane = tid & 63, wr = wid >> 2, wc = wid & 3, fr = lane & 15, fq = lane >> 4;
    unsigned voffA, voffB;
    { int R, C; stage_rc(tid * 16, R, C); const int Rb = (R & ~31) + perm32(R & 31); voffA = (unsigned)R * lda + (unsigned)C * 2u; voffB = (unsigned)Rb * ldb + (unsigned)C * 2u; }
    const size_t kstep = (size_t)(BK * 2);
    const size_t hA = (size_t)HALF * lda, hB = (size_t)HALF * ldb, qA = (size_t)64 * lda, qB = (size_t)64 * ldb;
    const unsigned ldsw = (unsigned)wid * 1024u;
    const int aoff = lds_byte(wr * 64 + fr, fq * 8), boff = lds_byte(wc * 32 + fr, fq * 8);
#define PG8_SA(b, h) (((b) * 2 + (h)) * HTB)
#define PG8_SB(b, h) ((4 + (b) * 2 + (h)) * HTB)
#define PG8_STAGE(bufoff, gbase, voff) do { \
        __builtin_amdgcn_global_load_lds((const unsigned*)((const char*)(gbase) + (voff)), (LAS unsigned*)(lds + (bufoff) + ldsw), 16, 0, 0); \
        __builtin_amdgcn_global_load_lds((const unsigned*)((const char*)(gbase) + ((&(voff) == &voffA) ? qA : qB) + (voff)), (LAS unsigned*)(lds + (bufoff) + ldsw + 8192), 16, 0, 0); } while (0)
#define PG8_LDA(dst, b, h) do { _Pragma("unroll") for (int m = 0; m < 4; ++m) _Pragma("unroll") for (int k = 0; k < 2; ++k) dst[m][k] = *(const LAS bf16x8*)(lds + PG8_SA(b, h) + aoff + m * 2048 + k * 1024); } while (0)
#define PG8_LDB(dst, b, h) do { _Pragma("unroll") for (int n = 0; n < 2; ++n) _Pragma("unroll") for (int k = 0; k < 2; ++k) dst[n][k] = *(const LAS bf16x8*)(lds + PG8_SB(b, h) + boff + n * 2048 + k * 1024); } while (0)
#define PG8_MMA(ai, bj, At, Bt) do { __builtin_amdgcn_s_setprio(1); _Pragma("unroll") for (int m = 0; m < 4; ++m) _Pragma("unroll") for (int n = 0; n < 2; ++n) _Pragma("unroll") for (int k = 0; k < 2; ++k) \
        acc[ai][bj][m][n] = __builtin_amdgcn_mfma_f32_16x16x32_bf16(Bt[n][k], At[m][k], acc[ai][bj][m][n], 0, 0, 0); __builtin_amdgcn_s_setprio(0); } while (0)
#define PG8_CAT(x) __builtin_shufflevector(__builtin_bit_cast(i32x4, x[0]), __builtin_bit_cast(i32x4, x[1]), 0, 1, 2, 3, 4, 5, 6, 7)
#define PG8_MMA8(ai, bj, At, Bt) do { __builtin_amdgcn_s_setprio(1); _Pragma("unroll") for (int m = 0; m < 4; ++m) _Pragma("unroll") for (int n = 0; n < 2; ++n) \
        asm volatile("v_mfma_f32_16x16x128_f8f6f4 %0, %1, %2, %0" : "+v"(acc[ai][bj][m][n]) : "v"(PG8_CAT(Bt[n])), "v"(PG8_CAT(At[m]))); __builtin_amdgcn_s_setprio(0); } while (0)
#define PG8_MM(ai, bj, At, Bt) do { if constexpr (F8) PG8_MMA8(ai, bj, At, Bt); else PG8_MMA(ai, bj, At, Bt); } while (0)
#define PG8_WAIT_V(n) asm volatile("s_waitcnt vmcnt(" #n ")" ::: "memory")
#define PG8_WAIT_L(n) asm volatile("s_waitcnt lgkmcnt(" #n ")" ::: "memory")
#define PG8_BAR __builtin_amdgcn_s_barrier()
#define PG8_SCHED __builtin_amdgcn_sched_barrier(0)
    Unit cur, nxt; int ui = 0;
    if (!S.next(0, cur)) return;
    f32x4 acc[2][2][4][2];
#pragma unroll
    for (int a = 0; a < 2; ++a)
#pragma unroll
        for (int b = 0; b < 2; ++b)
#pragma unroll
            for (int m = 0; m < 4; ++m)
#pragma unroll
                for (int n = 0; n < 2; ++n) acc[a][b][m][n] = (f32x4){0.f, 0.f, 0.f, 0.f};
    bf16x8 At[4][2], B0[2][2], B1[2][2];
    const char* cA = cur.A; const char* cB = cur.B;
    PG8_STAGE(PG8_SB(0, 0), cB, voffB); PG8_STAGE(PG8_SB(0, 1), cB + hB, voffB); PG8_STAGE(PG8_SA(0, 0), cA, voffA); PG8_STAGE(PG8_SA(0, 1), cA + hA, voffA);
    if (wr == 1) PG8_BAR;
    PG8_WAIT_V(2); PG8_BAR;
    PG8_STAGE(PG8_SB(1, 0), cB + kstep, voffB); PG8_STAGE(PG8_SA(1, 0), cA + kstep, voffA); PG8_STAGE(PG8_SB(1, 1), cB + hB + kstep, voffB);
    PG8_WAIT_V(6); PG8_BAR;
    for (;;) {
        const bool has_next = S.next(ui + 1, nxt);
        const char* nA = has_next ? nxt.A : cA; const char* nB = has_next ? nxt.B : cB;
        int nt = cur.nt; asm volatile("" : "+s"(nt));
        asm volatile(".p2align 8" ::: "memory");
#pragma unroll 1
        for (int t = 0; t < nt; t += 2) {
            const bool last = (t == nt - 2);
            const char* a1 = cA + (size_t)(t + 1) * kstep;
            const char* a2 = last ? nA : cA + (size_t)(t + 2) * kstep; const char* b2 = last ? nB : cB + (size_t)(t + 2) * kstep;
            const char* a3 = a2 + kstep; const char* b3 = b2 + kstep;
            if constexpr (Epi::HOOK) {
                if (last && has_next && nxt.kind >= 2) { asm volatile("s_waitcnt vmcnt(0)" ::: "memory"); PG8_BAR; PG8_BAR; asm volatile("" ::: "memory"); } }
            PG8_LDB(B0, 0, 0); PG8_LDB(B1, 0, 1); PG8_SCHED; PG8_LDA(At, 0, 0); PG8_STAGE(PG8_SA(1, 1), a1 + hA, voffA);
            PG8_WAIT_V(8); PG8_WAIT_L(0); PG8_BAR; PG8_MM(0, 0, At, B0); PG8_MM(0, 1, At, B1); PG8_BAR; PG8_SCHED;
            PG8_LDA(At, 0, 1); PG8_STAGE(PG8_SB(0, 0), b2, voffB); PG8_STAGE(PG8_SB(0, 1), b2 + hB, voffB); PG8_STAGE(PG8_SA(0, 0), a2, voffA);
            PG8_WAIT_V(8); PG8_WAIT_L(0); PG8_BAR; PG8_MM(1, 0, At, B0); PG8_MM(1, 1, At, B1); PG8_BAR; PG8_SCHED;
            PG8_LDB(B0, 1, 0); PG8_LDB(B1, 1, 1); PG8_SCHED; PG8_LDA(At, 1, 0); PG8_STAGE(PG8_SA(0, 1), a2 + hA, voffA);
            PG8_WAIT_V(8); PG8_WAIT_L(0); PG8_BAR; PG8_MM(0, 0, At, B0); PG8_MM(0, 1, At, B1); PG8_BAR; PG8_SCHED;
            PG8_LDA(At, 1, 1); PG8_STAGE(PG8_SB(1, 0), b3, voffB); PG8_STAGE(PG8_SB(1, 1), b3 + hB, voffB); PG8_STAGE(PG8_SA(1, 0), a3, voffA);
            PG8_WAIT_V(8); PG8_WAIT_L(0); PG8_BAR; PG8_MM(1, 0, At, B0); PG8_MM(1, 1, At, B1); PG8_BAR; PG8_SCHED;
        }
        if constexpr (F8) asm volatile("s_nop 7\n\ts_nop 7\n\ts_nop 7" ::: "memory");
        if constexpr (Epi::ALIGN) { if (wr == 0) PG8_BAR; }
        if constexpr (Epi::TWICE) { if (REP(26) > 1) (void)E(acc, cur, wr, wc, fr, fq); }
        const bool keep = E(acc, cur, wr, wc, fr, fq);
        if (!has_next) break;
        if constexpr (Epi::CHAIN) {
            const float kf = keep ? 1.f : 0.f;
#pragma unroll
            for (int a = 0; a < 2; ++a)
#pragma unroll
                for (int b = 0; b < 2; ++b)
#pragma unroll
                    for (int m = 0; m < 4; ++m)
#pragma unroll
                        for (int n = 0; n < 2; ++n) acc[a][b][m][n] = acc[a][b][m][n] * kf;
        } else {
#pragma unroll
            for (int a = 0; a < 2; ++a)
#pragma unroll
                for (int b = 0; b < 2; ++b)
#pragma unroll
                    for (int m = 0; m < 4; ++m)
#pragma unroll
                        for (int n = 0; n < 2; ++n) acc[a][b][m][n] = (f32x4){0.f, 0.f, 0.f, 0.f};
        }
        cur = nxt; cA = nA; cB = nB; ++ui;
        if constexpr (Epi::ALIGN) { if (wr == 1) PG8_BAR; }
    }
    PG8_WAIT_V(0);
    if constexpr (!Epi::ALIGN) { if (wr == 0) PG8_BAR; }
    PG8_BAR;
#undef PG8_SA
#undef PG8_SB
#undef PG8_STAGE
#undef PG8_LDA
#undef PG8_LDB
#undef PG8_MMA
#undef PG8_MMA8
#undef PG8_MM
#undef PG8_CAT
#undef PG8_WAIT_V
#undef PG8_WAIT_L
#undef PG8_BAR
#undef PG8_SCHED
}
}
using pg8::Unit;

#define EPI_ARGS f32x4 (&acc)[2][2][4][2], const Unit& u, int wr, int wc, int fr_in, int fq_in
#define EPI_LANE int lane_l = threadIdx.x & 63; asm volatile("" : "+v"(lane_l)); const int fr = lane_l & 15, fq = lane_l >> 4; (void)fr_in; (void)fq_in;
#ifndef EPI_ALIGN
#define EPI_ALIGN true
#endif
struct EpiProj {
    static constexpr bool CHAIN = false, TWICE = true;
    static constexpr bool HOOK = false;
    static constexpr bool ALIGN = true;
    bf16* O; const _Float16* cosT; const _Float16* sinT; bf16* AKV; bf16* BKV; bf16* IK; const u64* ss;
    __device__ __forceinline__ bool operator()(EPI_ARGS) const {
        EPI_LANE
        const int g = 4 * u.pn + wc; const bool rope = (ROPE_MASK >> g) & 1ull;
        const int row0 = u.pm * 256 + wr * 64 + fr;
        u64 sq[8];
#pragma unroll
        for (int k = 0; k < 8; ++k) sq[k] = ss[row0 + (k >> 2) * 128 + (k & 3) * 16];
#pragma unroll
        for (int ai = 0; ai < 2; ++ai) {
            h16x8 ct[4], st[4];
            if (rope) {
#pragma unroll
                for (int k = 0; k < 4; ++k) { const int rr = row0 + ai * 128 + k * 16; const size_t ro = ((size_t)((rr >> 4) * 4 + fq) * 16 + (rr & 15)) * 8;
                    ct[k] = *(const h16x8*)(cosT + ro); st[k] = *(const h16x8*)(sinT + ro); }
            }
#pragma unroll
            for (int m = 0; m < 4; ++m) {
                const int r = row0 + ai * 128 + m * 16;
                const float rs = rstd_of(sq[ai * 4 + m]);
                f32x4 x1a = acc[ai][0][m][0] * rs, x1b = acc[ai][0][m][1] * rs, x2a = acc[ai][1][m][0] * rs, x2b = acc[ai][1][m][1] * rs;
                if (rope) {
                    const h16x8 c8 = ct[m], s8 = st[m];
                    const f32x4 ca = (f32x4){(float)c8[0], (float)c8[1], (float)c8[2], (float)c8[3]}, cb = (f32x4){(float)c8[4], (float)c8[5], (float)c8[6], (float)c8[7]};
                    const f32x4 sa = (f32x4){(float)s8[0], (float)s8[1], (float)s8[2], (float)s8[3]}, sb = (f32x4){(float)s8[4], (float)s8[5], (float)s8[6], (float)s8[7]};
                    const f32x4 o1a = x1a * ca - x2a * sa, o1b = x1b * cb - x2b * sb, o2a = x2a * ca + x1a * sa, o2b = x2b * cb + x1b * sb;
                    x1a = o1a; x1b = o1b; x2a = o2a; x2b = o2b;
                }
                bf16* rowp = (g >= 8 && g < 12) ? AKV + (size_t)r * 256 + 64 * (g - 8) + 8 * fq : (g >= 20 && g < 24) ? BKV + (size_t)r * 256 + 64 * (g - 20) + 8 * fq
                           : (g == 28) ? IK + ((size_t)((r >> 5) * 4 + (fq >> 1)) * 64 + (fq & 1) * 32 + (r & 31)) * 8 : O + (size_t)r * NPROJ + 64 * g + 8 * fq;
                u32x4 w1, w2;
                w1.x = cvt_pk_bf16(x1a[0], x1a[1]); w1.y = cvt_pk_bf16(x1a[2], x1a[3]); w1.z = cvt_pk_bf16(x1b[0], x1b[1]); w1.w = cvt_pk_bf16(x1b[2], x1b[3]);
                w2.x = cvt_pk_bf16(x2a[0], x2a[1]); w2.y = cvt_pk_bf16(x2a[2], x2a[3]); w2.z = cvt_pk_bf16(x2b[0], x2b[1]); w2.w = cvt_pk_bf16(x2b[2], x2b[3]);
                *(u32x4*)(rowp) = w1; *(u32x4*)(rowp + ((g == 28) ? 1024 : 32)) = w2;
            }
        }
        return false;
    }
};
template <bool F8O> struct EpiPlainT {
    static constexpr bool CHAIN = false, TWICE = true;
    static constexpr bool HOOK = false;
#ifndef EPI_ALIGN
#define EPI_ALIGN true
#endif
    static constexpr bool ALIGN = EPI_ALIGN;
    bf16* O; int ldc; float scale; const u64* ss; size_t pn_stride = 0;
    __device__ __forceinline__ bool operator()(EPI_ARGS) const {
        EPI_LANE
        const int row0 = u.pm * 256 + wr * 64 + fr, col0 = (pn_stride ? 0 : u.pn * 256) + wc * 32 + 8 * fq;
        bf16* Ob = O + (size_t)u.pn * pn_stride;
        u64 sq[8];
#pragma unroll
        for (int k = 0; k < 8; ++k) sq[k] = ss ? ss[row0 + (k >> 2) * 128 + (k & 3) * 16] : 0ull;
#pragma unroll
        for (int ai = 0; ai < 2; ++ai)
#pragma unroll
            for (int m = 0; m < 4; ++m) { bf16* rowp = Ob + (size_t)(row0 + ai * 128 + m * 16) * ldc + col0;
                const float sc_ = ss ? rstd_of(sq[ai * 4 + m]) : scale;
#pragma unroll
                for (int bj = 0; bj < 2; ++bj) { const f32x4 v0 = acc[ai][bj][m][0] * sc_, v1 = acc[ai][bj][m][1] * sc_;
                    if constexpr (F8O) {
                        u32x2 w8; w8.x = pk4_f8(v0[0], v0[1], v0[2], v0[3]); w8.y = pk4_f8(v1[0], v1[1], v1[2], v1[3]);
                        *(u32x2*)((unsigned char*)Ob + (size_t)(row0 + ai * 128 + m * 16) * ldc + col0 + bj * 128) = w8;
                    } else {
                    u32x4 w; w.x = cvt_pk_bf16(v0[0], v0[1]); w.y = cvt_pk_bf16(v0[2], v0[3]); w.z = cvt_pk_bf16(v1[0], v1[1]); w.w = cvt_pk_bf16(v1[2], v1[3]);
                    *(u32x4*)(rowp + bj * 128) = w; } } }
        return false;
    }
};
typedef EpiPlainT<false> EpiPlain;
template <bool F8OUT> struct EpiResT {
    static constexpr bool CHAIN = false, TWICE = false;
    static constexpr bool HOOK = false;
#ifndef EPI_ALIGN
#define EPI_ALIGN true
#endif
    static constexpr bool ALIGN = EPI_ALIGN;
    bf16* X; u64* ssn; unsigned char* X8 = nullptr; float sc = 1.f;
    __device__ __forceinline__ bool operator()(EPI_ARGS) const {
        EPI_LANE
        const int row0 = u.pm * 256 + wr * 64 + fr, col0 = u.pn * 256 + wc * 32 + 8 * fq;
#pragma unroll
        for (int ai = 0; ai < 2; ++ai) {
            u32x4 xv[4][2];
#pragma unroll
            for (int m = 0; m < 4; ++m)
#pragma unroll
                for (int bj = 0; bj < 2; ++bj) xv[m][bj] = *(const u32x4*)(X + (size_t)(row0 + ai * 128 + m * 16) * D + col0 + bj * 128);
#pragma unroll
            for (int m = 0; m < 4; ++m) { const int r = row0 + ai * 128 + m * 16; bf16* rowp = X + (size_t)r * D + col0; float q = 0.f;
#pragma unroll
                for (int bj = 0; bj < 2; ++bj) {
                    const u32x4 xq = xv[m][bj];
                    f32x4 v0 = acc[ai][bj][m][0] * sc, v1 = acc[ai][bj][m][1] * sc;
                    v0[0] += __uint_as_float(xq.x << 16); v0[1] += __uint_as_float(xq.x & 0xffff0000u); v0[2] += __uint_as_float(xq.y << 16); v0[3] += __uint_as_float(xq.y & 0xffff0000u);
                    v1[0] += __uint_as_float(xq.z << 16); v1[1] += __uint_as_float(xq.z & 0xffff0000u); v1[2] += __uint_as_float(xq.w << 16); v1[3] += __uint_as_float(xq.w & 0xffff0000u);
                    q += (v0[0] * v0[0] + v0[1] * v0[1]) + (v0[2] * v0[2] + v0[3] * v0[3]) + (v1[0] * v1[0] + v1[1] * v1[1]) + (v1[2] * v1[2] + v1[3] * v1[3]);
                    u32x4 w; w.x = cvt_pk_bf16(v0[0], v0[1]); w.y = cvt_pk_bf16(v0[2], v0[3]); w.z = cvt_pk_bf16(v1[0], v1[1]); w.w = cvt_pk_bf16(v1[2], v1[3]);
                    *(u32x4*)(rowp + bj * 128) = w;
                    if constexpr (F8OUT) { u32x2 w8; w8.x = pk4_f8(v0[0], v0[1], v0[2], v0[3]); w8.y = pk4_f8(v1[0], v1[1], v1[2], v1[3]); *(u32x2*)(X8 + (size_t)r * D + col0 + bj * 128) = w8; } }
                q += __shfl_xor(q, 16); q += __shfl_xor(q, 32);
                if (fq == 0) atomicAdd(ssn + r, ss_fix(q)); }
            asm volatile("" ::: "memory"); }
        return false;
    }
};
typedef EpiResT<false> EpiRes;
struct EpiGate {
    static constexpr bool CHAIN = false, TWICE = true;
    static constexpr bool HOOK = false;
#ifndef EPI_ALIGN
#define EPI_ALIGN true
#endif
    static constexpr bool ALIGN = EPI_ALIGN;
    unsigned* scr; const u64* ss; float wsc;
    __device__ __forceinline__ bool operator()(EPI_ARGS) const {
        EPI_LANE
        const unsigned voff = (unsigned)(((unsigned)__builtin_amdgcn_readfirstlane(threadIdx.x >> 6) * 64u + (unsigned)lane_l) * 16u);
        char* sb = (char*)scr + (size_t)u.kind * 131072;
        u64 sq[8];
#pragma unroll
        for (int k = 0; k < 8; ++k) sq[k] = ss[u.pm * 256 + (k >> 2) * 128 + wr * 64 + (k & 3) * 16 + fr];
#pragma unroll
        for (int ai = 0; ai < 2; ++ai)
#pragma unroll
            for (int m = 0; m < 4; ++m)
#pragma unroll
                for (int bj = 0; bj < 2; ++bj) {
                    const float ns = -1.44269504f * wsc * rstd_of(sq[ai * 4 + m]);
                    f32x4 v0 = acc[ai][bj][m][0], v1 = acc[ai][bj][m][1]; u32x4 w;
#pragma unroll
                    for (int j = 0; j < 4; ++j) { v0[j] = fmaxf(__builtin_amdgcn_rcpf(1.f + __builtin_amdgcn_exp2f(ns * v0[j])), 1e-6f); v1[j] = fmaxf(__builtin_amdgcn_rcpf(1.f + __builtin_amdgcn_exp2f(ns * v1[j])), 1e-6f); }
                    w.x = cvt_pk_bf16(v0[0], v0[1]); w.y = cvt_pk_bf16(v0[2], v0[3]); w.z = cvt_pk_bf16(v1[0], v1[1]); w.w = cvt_pk_bf16(v1[2], v1[3]);
                    *(u32x4*)(sb + (size_t)((ai * 4 + m) * 2 + bj) * 8192 + voff) = w; asm volatile("" ::: "memory"); }
        return false;
    }
};
struct EpiUp {
    static constexpr bool CHAIN = false, TWICE = false;
    static constexpr bool HOOK = false;
#ifndef EPI_ALIGN
#define EPI_ALIGN true
#endif
    static constexpr bool ALIGN = EPI_ALIGN;
    unsigned* scr; bf16* O;
    __device__ __forceinline__ bool operator()(EPI_ARGS) const {
        EPI_LANE
        const unsigned tl = (unsigned)__builtin_amdgcn_readfirstlane(threadIdx.x >> 6) * 64u + (unsigned)lane_l;
        const char* s0 = (const char*)scr + (size_t)u.kind * 131072;
        char* pb = (char*)scr + 4 * 131072;
        const int row0 = u.pm * 256 + wr * 64 + fr, col0 = u.pn * 256 + wc * 32 + 8 * fq;
#pragma unroll
        for (int ai = 0; ai < 2; ++ai) {
            u32x4 av[8], pv[8];
#pragma unroll
            for (int k = 0; k < 8; ++k) { const int slot = ai * 8 + k; av[k] = *(const u32x4*)(s0 + (size_t)slot * 8192 + tl * 16u);
                pv[k] = (u.kind > 0) ? *(const u32x4*)(pb + (size_t)slot * 8192 + tl * 16u) : (u32x4){0u, 0u, 0u, 0u}; }
#pragma unroll
            for (int m = 0; m < 4; ++m)
#pragma unroll
                for (int bj = 0; bj < 2; ++bj) {
                    const int k = m * 2 + bj, slot = ai * 8 + k; const u32x4 a = av[k], q = pv[k];
                    f32x4 p0 = (f32x4){__uint_as_float(q.x << 16), __uint_as_float(q.x & 0xffff0000u), __uint_as_float(q.y << 16), __uint_as_float(q.y & 0xffff0000u)};
                    f32x4 p1 = (f32x4){__uint_as_float(q.z << 16), __uint_as_float(q.z & 0xffff0000u), __uint_as_float(q.w << 16), __uint_as_float(q.w & 0xffff0000u)};
                    const f32x4 f0 = (f32x4){__uint_as_float(a.x << 16), __uint_as_float(a.x & 0xffff0000u), __uint_as_float(a.y << 16), __uint_as_float(a.y & 0xffff0000u)};
                    const f32x4 f1 = (f32x4){__uint_as_float(a.z << 16), __uint_as_float(a.z & 0xffff0000u), __uint_as_float(a.w << 16), __uint_as_float(a.w & 0xffff0000u)};
                    p0 = p0 + acc[ai][bj][m][0] * f0; p1 = p1 + acc[ai][bj][m][1] * f1;
                    u32x4 w; w.x = cvt_pk_bf16(p0[0], p0[1]); w.y = cvt_pk_bf16(p0[2], p0[3]); w.z = cvt_pk_bf16(p1[0], p1[1]); w.w = cvt_pk_bf16(p1[2], p1[3]);
                    if (u.kind < 3) *(u32x4*)(pb + (size_t)slot * 8192 + tl * 16u) = w;
                    else *(u32x4*)(O + (size_t)(row0 + ai * 128 + m * 16) * D + col0 + bj * 128) = w;
                }
            asm volatile("" ::: "memory"); }
        return false;
    }
};
struct EpiSoftmax {
    static constexpr bool CHAIN = false, TWICE = false;
    static constexpr bool HOOK = false;
#ifndef EPI_ALIGN
#define EPI_ALIGN true
#endif
    static constexpr bool ALIGN = true;
    bf16* P; LAS f32x2* xch; float scale_log2;
    __device__ __forceinline__ bool operator()(EPI_ARGS) const {
        EPI_LANE
        LAS f32x2* X = xch + (size_t)(u.kind & 1) * 1024;
#pragma unroll
        for (int ai = 0; ai < 2; ++ai)
#pragma unroll
            for (int m = 0; m < 4; ++m) {
                float v = -3.0e38f;
#pragma unroll
                for (int bj = 0; bj < 2; ++bj)
#pragma unroll
                    for (int n = 0; n < 2; ++n) { const f32x4 x = acc[ai][bj][m][n]; v = fmaxf(v, fmaxf(fmaxf(x[0], x[1]), fmaxf(x[2], x[3]))); }
                v *= scale_log2;
                v = fmaxf(v, __shfl_xor(v, 16)); v = fmaxf(v, __shfl_xor(v, 32));
                float s = 0.f;
#pragma unroll
                for (int bj = 0; bj < 2; ++bj)
#pragma unroll
                    for (int n = 0; n < 2; ++n) { const f32x4 x = acc[ai][bj][m][n];
#pragma unroll
                        for (int j = 0; j < 4; ++j) s += __builtin_amdgcn_exp2f(x[j] * scale_log2 - v); }
                s += __shfl_xor(s, 16); s += __shfl_xor(s, 32);
                if (fq == 0) X[(ai * 128 + wr * 64 + m * 16 + fr) * 4 + wc] = (f32x2){v, s};
            }
        asm volatile("s_waitcnt lgkmcnt(0)" ::: "memory"); __builtin_amdgcn_s_barrier(); asm volatile("" ::: "memory");
        const int row0 = u.pm * 256 + wr * 64 + fr, col0 = u.pn * 256 + wc * 32 + 8 * fq;
#pragma unroll
        for (int ai = 0; ai < 2; ++ai)
#pragma unroll
            for (int m = 0; m < 4; ++m) {
                const int rl = ai * 128 + wr * 64 + m * 16 + fr;
                const f32x2 p0 = X[rl * 4 + 0], p1 = X[rl * 4 + 1], p2 = X[rl * 4 + 2], p3 = X[rl * 4 + 3];
                const float gm = fmaxf(fmaxf(p0.x, p1.x), fmaxf(p2.x, p3.x));
                const float tot = p0.y * __builtin_amdgcn_exp2f(p0.x - gm) + p1.y * __builtin_amdgcn_exp2f(p1.x - gm) + p2.y * __builtin_amdgcn_exp2f(p2.x - gm) + p3.y * __builtin_amdgcn_exp2f(p3.x - gm);
                const float inv = 1.f / tot;
                bf16* rowp = P + (size_t)(row0 + ai * 128 + m * 16) * D + col0;
#pragma unroll
                for (int bj = 0; bj < 2; ++bj) { f32x4 v0 = acc[ai][bj][m][0], v1 = acc[ai][bj][m][1];
#pragma unroll
                    for (int j = 0; j < 4; ++j) { v0[j] = __builtin_amdgcn_exp2f(v0[j] * scale_log2 - gm) * inv; v1[j] = __builtin_amdgcn_exp2f(v1[j] * scale_log2 - gm) * inv; }
                    u32x4 w; w.x = cvt_pk_bf16(v0[0], v0[1]); w.y = cvt_pk_bf16(v0[2], v0[3]); w.z = cvt_pk_bf16(v1[0], v1[1]); w.w = cvt_pk_bf16(v1[2], v1[3]);
                    *(u32x4*)(rowp + bj * 128) = w; }
                asm volatile("" ::: "memory");
            }
        return false;
    }
};
struct EpiCross {
    static constexpr bool CHAIN = false, TWICE = false;
    static constexpr bool ALIGN = true, HOOK = true;
    EpiPlain q; EpiSoftmax sm; EpiPlainT<true> o;
    __device__ __forceinline__ bool operator()(EPI_ARGS) const {
        if (u.kind < 2) return q(acc, u, wr, wc, fr_in, fq_in);
        if (u.kind < 4) return sm(acc, u, wr, wc, fr_in, fq_in);
        return o(acc, u, wr, wc, fr_in, fq_in);
    }
};
struct EpiGU {
    static constexpr bool CHAIN = false, TWICE = true;
    static constexpr bool HOOK = false;
#ifndef EPI_ALIGN
#define EPI_ALIGN true
#endif
    static constexpr bool ALIGN = EPI_ALIGN;
    bf16* H; const u64* ss; float wsc;
    __device__ __forceinline__ bool operator()(EPI_ARGS) const {
        EPI_LANE
        const int row0 = u.pm * 256 + wr * 64 + fr, col0 = u.pn * 128 + wc * 32 + 8 * fq;
        u64 sq[8];
#pragma unroll
        for (int k = 0; k < 8; ++k) sq[k] = ss[row0 + (k >> 2) * 128 + (k & 3) * 16];
#pragma unroll
        for (int ai = 0; ai < 2; ++ai)
#pragma unroll
            for (int m = 0; m < 4; ++m) {
                const float rs = rstd_of(sq[ai * 4 + m]) * wsc, ns = -1.44269504f * rs;
                f32x4 v[2];
#pragma unroll
                for (int n = 0; n < 2; ++n) { const f32x4 g = acc[ai][0][m][n], uu = acc[ai][1][m][n];
#pragma unroll
                    for (int j = 0; j < 4; ++j) v[n][j] = (g[j] * rs) * __builtin_amdgcn_rcpf(1.f + __builtin_amdgcn_exp2f(ns * g[j])) * (uu[j] * (rs * F8_HSCALE)); }
                u32x2 w; w.x = pk4_f8(v[0][0], v[0][1], v[0][2], v[0][3]); w.y = pk4_f8(v[1][0], v[1][1], v[1][2], v[1][3]);
                *(u32x2*)((unsigned char*)H + (size_t)(row0 + ai * 128 + m * 16) * DFF + col0) = w; asm volatile("" ::: "memory");
            }
        return false;
    }
};
struct EpiDownMoe {
    static constexpr bool CHAIN = false, TWICE = false;
    static constexpr bool HOOK = false;
    static constexpr bool ALIGN = true;
    const int* tokmap; const float* roww; bf16* Y; int t_slot1;
    __device__ __forceinline__ bool operator()(EPI_ARGS) const {
        EPI_LANE
        const int row0 = u.pm * 256 + wr * 64 + fr, col0 = u.pn * 256 + wc * 32 + 8 * fq;
        bf16* Ys = Y + ((u.pm >= t_slot1) ? (size_t)M * D : (size_t)0);
        int tk[8]; float wg[8];
#pragma unroll
        for (int k = 0; k < 8; ++k) { const int r = row0 + (k >> 2) * 128 + (k & 3) * 16; tk[k] = tokmap[r]; wg[k] = roww[r] * (1.f / (F8_HSCALE * F8_WSCALE)); }
#pragma unroll
        for (int ai = 0; ai < 2; ++ai)
#pragma unroll
            for (int m = 0; m < 4; ++m) { const int t_ = tk[ai * 4 + m];
                if (t_ >= 0) { const float wgt = wg[ai * 4 + m]; bf16* rowp = Ys + (size_t)t_ * D + col0;
#pragma unroll
                    for (int bj = 0; bj < 2; ++bj) { const f32x4 v0 = acc[ai][bj][m][0] * wgt, v1 = acc[ai][bj][m][1] * wgt;
                        u32x4 w; w.x = cvt_pk_bf16(v0[0], v0[1]); w.y = cvt_pk_bf16(v0[2], v0[3]); w.z = cvt_pk_bf16(v1[0], v1[1]); w.w = cvt_pk_bf16(v1[2], v1[3]);
                        *(u32x4*)(rowp + bj * 128) = w; } } }
        return false;
    }
};

template <int MODE> struct MergeSched {
    const char* A0; const char* A1; const char* W; int pm, pn;
    __device__ __forceinline__ bool next(int i, Unit& u) const {
        if (i >= 4) return false;
        u.pm = pm; u.pn = pn; u.kind = i;
        if (MODE == 0) { u.A = A0 + (size_t)pm * 256 * 1024; u.B = W + (size_t)(i * 1024 + pn * 256) * 1024; u.nt = 8; }
        else { u.A = ((i < 2) ? A0 : A1) + (size_t)pm * 256 * 2048 + (i & 1) * 1024; u.B = W + (size_t)(i >> 1) * (2 * MiB) + (size_t)pn * 256 * 2048 + (i & 1) * 1024; u.nt = 8; }
        return true;
    }
};
struct CrossFusedSched {
    const char* XB; const char* Wq; const char* XQ; const char* Kx; const char* XP; const char* VTb; int G, c;
    __device__ __forceinline__ bool next(int i, Unit& u) const {
        if (i >= 6) return false;
        const int ti = i & 1, stage = i >> 1;
        int L = ti * G + c; if (L >= 512) return false;
        { const int q = 512 / 8, xcd = L % 8, off = L / 8; L = xcd * q + off; }
        const int rt = L & 15, head = (L >> 4) & 3, b = L >> 6;
        u.pm = b * 16 + rt; u.pn = head; u.kind = 2 * stage + ti;
        if (stage == 0) { u.A = XB + (size_t)u.pm * 256 * 2048; u.B = Wq + (size_t)head * 256 * 2048; u.nt = 16; }
        else if (stage == 1) { u.A = XQ + (size_t)u.pm * 256 * 2048 + head * 512; u.B = Kx + (size_t)(b * 256) * 2048 + head * 512; u.nt = 4; }
        else { u.A = XP + (size_t)u.pm * 256 * 2048 + head * 512; u.B = VTb + (size_t)b * ((size_t)D * D * 2) + (size_t)(head * 256) * 2048; u.nt = 4; }
        return true;
    }
};
struct CrossSched {
    const char* A; const char* B; int mode, G, c;
    __device__ __forceinline__ bool next(int i, Unit& u) const {
        const long L0 = (long)i * G + c; if (L0 >= 512) return false;
        int L = (int)L0; { const int q = 512 / 8, xcd = L % 8, off = L / 8; L = xcd * q + off; }
        const int rt = L & 15, head = (L >> 4) & 3, b = L >> 6;
        u.pm = b * 16 + rt; u.pn = head; u.kind = i; u.nt = 4;
        u.A = A + (size_t)u.pm * 256 * 2048 + head * 512;
        u.B = (mode == 0) ? B + (size_t)(b * 256) * 2048 + head * 512 : B + (size_t)(head * 256) * 4096 + b * 512;
        return true;
    }
};
struct MoeSched {
    const char* A; const char* B; unsigned lda; size_t wstride; unsigned ldb; int t0, nT, nN, nt, G, c; const int* gt;
    __device__ __forceinline__ bool next(int i, Unit& u) const {
        const long L = (long)i * G + c; if (L >= (long)nT * nN) return false;
        int pm, pn; pg8::tile_of((int)L, nT, nN, pm, pn); pm += t0;
        int g = 0;
#pragma unroll
        for (int k = 1; k < 16; ++k) g += (pm >= gt[k]) ? 1 : 0;
        g = __builtin_amdgcn_readfirstlane(g);
        u.pm = pm; u.pn = pn; u.kind = 0; u.nt = nt;
        u.A = A + (size_t)pm * 256 * lda; u.B = B + (size_t)(g & 7) * wstride + (size_t)pn * 256 * ldb; return true;
    }
};

#define XB_TMO      128
#define XB_XCNT(j)  (256  + 64 * (j))
#define XB_XSUB(j)  (1280 + 64 * (j))
#define XB_XGEN(j)  (2304 + 64 * (j))
#define XB_TOP      3328
#define XB_TOPGEN   3392
#define XCD_BAR_WORDS 3456
#define XB_SPIN_CAP (1u << 22)
__device__ __forceinline__ unsigned xb_ld(unsigned* p)              { return __hip_atomic_load(p, __ATOMIC_RELAXED, __HIP_MEMORY_SCOPE_AGENT); }
__device__ __forceinline__ unsigned xb_add(unsigned* p, unsigned v) { return __hip_atomic_fetch_add(p, v, __ATOMIC_RELAXED, __HIP_MEMORY_SCOPE_AGENT); }
__device__ __forceinline__ unsigned xb_xcc_id() { return (unsigned)__builtin_amdgcn_s_getreg((3 << 11) | 20) & 0xFu; }
#define XB_SPIN(cond, bar) do { unsigned _sp = 0; while (cond) { __builtin_amdgcn_s_sleep(1); \
    if ((++_sp & 255u) == 0u) { if (xb_ld(&(bar)[XB_TMO])) break; if (_sp > XB_SPIN_CAP) { atomicAdd(&(bar)[XB_TMO], 1u); break; } } } } while (0)
struct XcdBarrier { unsigned* bar; unsigned x; volatile LAS unsigned* st; };
__device__ __forceinline__ XcdBarrier xcd_barrier_post(unsigned* bar, volatile LAS unsigned* st) {
    XcdBarrier b; b.bar = bar; b.x = xb_xcc_id(); b.st = st;
    if (threadIdx.x == 0) (void)xb_add(&bar[XB_XCNT(b.x)], 1u);
    return b;
}
__device__ __forceinline__ void xcd_barrier_complete(unsigned* bar, unsigned x, unsigned& nloc, unsigned& nx) {
    const unsigned G = gridDim.x * gridDim.y * gridDim.z;
    unsigned sum, cnt, mine, sp = 0u;
    for (;;) {
        sum = 0u; cnt = 0u; mine = 0u;
#pragma unroll
        for (unsigned j = 0; j < 16; ++j) { const unsigned c = xb_ld(&bar[XB_XCNT(j)]); sum += c; cnt += (c > 0u) ? 1u : 0u; mine = (j == x) ? c : mine; }
        if (sum == G) break;
        __builtin_amdgcn_s_sleep(1);
        if ((++sp & 255u) == 0u) { if (xb_ld(&bar[XB_TMO])) break; if (sp > XB_SPIN_CAP) { atomicAdd(&bar[XB_TMO], 1u); break; } }
    }
    nloc = mine > 0u ? mine : 1u; nx = cnt > 0u ? cnt : 1u;
}
__device__ __noinline__ void xcd_barrier_impl(unsigned* bar_, unsigned x_, volatile LAS unsigned* st_) {
    XcdBarrier b; b.bar = bar_; b.x = x_; b.st = st_;
    asm volatile("s_waitcnt vmcnt(0)" ::: "memory");
    __syncthreads();
    if (threadIdx.x == 0) {
        unsigned* bar = b.bar;
        __builtin_amdgcn_s_waitcnt(0);
        unsigned nloc = b.st[0], nx = b.st[1];
        if (nloc == 0u) { xcd_barrier_complete(bar, b.x, nloc, nx); b.st[0] = nloc; b.st[1] = nx; }
        const unsigned old = xb_add(&bar[XB_XSUB(b.x)], 1u);
        const unsigned gen = old / nloc;
        if (old + 1u == (gen + 1u) * nloc) {
            __builtin_amdgcn_fence(__ATOMIC_RELEASE, "agent");
            asm volatile("s_waitcnt vmcnt(0)" ::: "memory");
            const unsigned og = xb_add(&bar[XB_TOP], 1u);
            const unsigned tg = og / nx;
            if (og + 1u == (tg + 1u) * nx) xb_add(&bar[XB_TOPGEN], 1u);
            else XB_SPIN(xb_ld(&bar[XB_TOPGEN]) == tg, bar);
            __builtin_amdgcn_fence(__ATOMIC_ACQUIRE, "agent");
            xb_add(&bar[XB_XGEN(b.x)], 1u);
            asm volatile("s_waitcnt vmcnt(0)" ::: "memory");
        } else {
            XB_SPIN(xb_ld(&bar[XB_XGEN(b.x)]) == gen, bar);
            __builtin_amdgcn_fence(__ATOMIC_ACQUIRE, "agent");
            asm volatile("s_waitcnt vmcnt(0)" ::: "memory");
        }
    }
    __syncthreads();
}
__device__ __forceinline__ void xcd_barrier(const XcdBarrier& b) { xcd_barrier_impl(b.bar, b.x, b.st); }

struct Args {
    const float* x; const float* mem; const int* positions; const float* norm_mix; const float* w_in; const float* attn_sink; const float* w_branch; const float* w_out;
    const float* pool_w; const float* pool_scale; const float* norm_cross; const float* norm_mem; const float* w_xq; const float* w_xkv; const float* w_xo; const float* norm_ffn;
    const float* dense_w_gu; const float* dense_w_down; const float* router_w; const float* moe_w_gu; const float* moe_w_down; const float* norm_final;
    float* out; unsigned char* ws; int ph_lo, ph_hi;
};

template <int F8 = 0>
__device__ __forceinline__ void transpose_item(const float* W, int ldw, int k0, int src, int nv, bf16* WT, size_t dst_pitch, int dst_row0, int dst_k0, LAS float* scr, int lane, const float* gain) {
    f32x4 tv[8];
    const int n4 = (lane & 7) * 4, kr = lane >> 3;
#pragma unroll
    for (int i = 0; i < 8; ++i) tv[i] = (n4 < nv) ? *(const f32x4*)(W + (size_t)(k0 + 8 * i + kr) * ldw + src + n4) : (f32x4){0.f, 0.f, 0.f, 0.f};
    if (gain) {
#pragma unroll
        for (int i = 0; i < 8; ++i) tv[i] = tv[i] * gain[k0 + 8 * i + kr]; }
#pragma unroll
    for (int i = 0; i < 8; ++i) { LAS float* d = scr + (8 * i + kr) * 33 + n4; d[0] = tv[i].x; d[1] = tv[i].y; d[2] = tv[i].z; d[3] = tv[i].w; }
    LDS_WAIT(); asm volatile("" ::: "memory");
    const int c = lane & 7;
#pragma unroll
    for (int j = 0; j < 4; ++j) { const int n = (lane >> 3) + 8 * j; const LAS float* s = scr + (8 * c) * 33 + n;
        if constexpr (F8) {
            u32x2 o; o.x = pk4_f8(s[0 * 33] * F8_WSCALE, s[1 * 33] * F8_WSCALE, s[2 * 33] * F8_WSCALE, s[3 * 33] * F8_WSCALE); o.y = pk4_f8(s[4 * 33] * F8_WSCALE, s[5 * 33] * F8_WSCALE, s[6 * 33] * F8_WSCALE, s[7 * 33] * F8_WSCALE);
            *(u32x2*)((unsigned char*)WT + (size_t)(dst_row0 + n) * dst_pitch + dst_k0 + k0 + 8 * c) = o;
        } else {
        u32x4 o; o.x = pk2(s[0 * 33], s[1 * 33]); o.y = pk2(s[2 * 33], s[3 * 33]); o.z = pk2(s[4 * 33], s[5 * 33]); o.w = pk2(s[6 * 33], s[7 * 33]);
        *(u32x4*)(WT + (size_t)(dst_row0 + n) * dst_pitch + dst_k0 + k0 + 8 * c) = o; } }
    LDS_WAIT(); asm volatile("" ::: "memory");
}
template <int MAP, int F8 = 0>
__device__ __forceinline__ void conv_seg(const float* W, int K, int ldw, int src0, bf16* WT, size_t dst_pitch, int dst_k0, int nb, int item, LAS float* scr, int lane, const float* gain = nullptr) {
    const int kb = item / nb, vb = item % nb;
    int src, nv = 32;
    if (MAP == 0) src = src0 + 32 * vb;
    else if (MAP == 1) { const int pn = vb >> 3, bj = (vb >> 2) & 1, wc = vb & 3, g = 4 * pn + wc;
        if (g < 29) src = 64 * g + 32 * bj; else if (g < 61) src = 64 * g + 4 + 32 * bj; else if (g == 61) { src = 1856; nv = bj == 0 ? 4 : 0; } else { src = 0; nv = 0; } }
    else { const int pn = vb >> 3, bj = (vb >> 2) & 1, pb = vb & 3; src = src0 + bj * DFF + 128 * pn + 32 * pb; }
    transpose_item<F8>(W, ldw, 64 * kb, src, nv, WT, dst_pitch, 32 * vb, dst_k0, scr, lane, gain);
}
struct ConvItem { const float* W; int ldw, k0, src; const float* gain; unsigned char* WT; int dpitch, drow0; };
__device__ __forceinline__ void conv_load(const ConvItem& c, f32x4 (&tv)[8], float (&gv)[8], int lane) {
    const int n4 = (lane & 7) * 4, kr = lane >> 3;
#pragma unroll
    for (int i = 0; i < 8; ++i) tv[i] = *(const f32x4*)(c.W + (size_t)(c.k0 + 8 * i + kr) * c.ldw + c.src + n4);
#pragma unroll
    for (int i = 0; i < 8; ++i) gv[i] = c.gain ? c.gain[c.k0 + 8 * i + kr] : 1.f;
}
__device__ __forceinline__ void conv_finish8(const ConvItem& c, const f32x4 (&tv)[8], const float (&gv)[8], LAS float* scr, int lane) {
    const int n4 = (lane & 7) * 4, kr = lane >> 3;
#pragma unroll
    for (int i = 0; i < 8; ++i) { const float g = gv[i] * F8_WSCALE; LAS float* d = scr + (8 * i + kr) * 33 + n4; d[0] = tv[i].x * g; d[1] = tv[i].y * g; d[2] = tv[i].z * g; d[3] = tv[i].w * g; }
    LDS_WAIT(); asm volatile("" ::: "memory");
    const int cc = lane & 7;
#pragma unroll
    for (int j = 0; j < 4; ++j) { const int n = (lane >> 3) + 8 * j; const LAS float* sp = scr + (8 * cc) * 33 + n;
        u32x2 o; o.x = pk4_f8(sp[0 * 33], sp[1 * 33], sp[2 * 33], sp[3 * 33]); o.y = pk4_f8(sp[4 * 33], sp[5 * 33], sp[6 * 33], sp[7 * 33]);
        *(u32x2*)(c.WT + (size_t)(c.drow0 + n) * c.dpitch + c.k0 + 8 * cc) = o; }
    LDS_WAIT(); asm volatile("" ::: "memory");
}
__device__ __forceinline__ void norm_row_bf16(const float* xrow, const float* g, bf16* orow, int lane) {
    const f32x4* xr = (const f32x4*)xrow + lane; const f32x4* gr = (const f32x4*)g + lane;
    f32x4 v[4]; float s = 0.f;
#pragma unroll
    for (int j = 0; j < 4; ++j) { v[j] = xr[64 * j]; s += (v[j].x * v[j].x + v[j].y * v[j].y) + (v[j].z * v[j].z + v[j].w * v[j].w); }
    const float rstd = 1.f / sqrtf(wave_sum(s) * (1.f / D) + EPS);
    unsigned long long* o8 = (unsigned long long*)orow + lane;
#pragma unroll
    for (int j = 0; j < 4; ++j) { const f32x4 gg = gr[64 * j];
        o8[64 * j] = (unsigned long long)pk2(v[j].x * rstd * gg.x, v[j].y * rstd * gg.y) | ((unsigned long long)pk2(v[j].z * rstd * gg.z, v[j].w * rstd * gg.w) << 32); }
}

constexpr int RT_P = 136;
typedef float f32x4v __attribute__((ext_vector_type(4)));
__device__ __forceinline__ void pool_phase(const bf16* proj, const bf16* wpt, const float* pscale, bf16* br23, char* lds, int G) {
    int tid = threadIdx.x; asm volatile("" : "+v"(tid)); const int lane = tid & 63, wave = tid >> 6, fr = lane & 15, fq = lane >> 4;
    bf16* Dl = (bf16*)lds;
    for (int un = blockIdx.x; un < 2048; un += G) {
        const int g = un & 3, tb = (un >> 2) & 63, b = un >> 8;
        const int win = 2 << g;
        const bf16* wp = wpt + (size_t)g * 16384 + (16 * wave + fr) * 128 + 8 * fq;
        bf16x8 bw[4];
#pragma unroll
        for (int ks = 0; ks < 4; ++ks) bw[ks] = *(const bf16x8*)(wp + 32 * ks);
        const float sc = pscale[g * 128 + 16 * wave + fr];
#pragma unroll
        for (int i = 0; i < 2; ++i) { const int idx = tid + 512 * i, tt = idx >> 4, pc = idx & 15, t = tb * 64 + tt;
            const bf16* up = proj + ((size_t)(b * T + t)) * NPROJ + C_PU + g * 128 + 8 * pc;
            const int cnt = (t + 1 < win) ? t + 1 : win;
            float sm[8];
#pragma unroll
            for (int q = 0; q < 8; ++q) sm[q] = 0.f;
            u32x4 wv[16];
#pragma unroll
            for (int j = 0; j < 16; ++j) wv[j] = (j < cnt) ? *(const u32x4*)(up - (size_t)j * NPROJ) : (u32x4){0u, 0u, 0u, 0u};
            const u32x4 u0 = wv[0];
#pragma unroll
            for (int j = 0; j < 16; ++j) { const u32x4 v = wv[j];
                sm[0] += __uint_as_float(v.x << 16); sm[1] += __uint_as_float(v.x & 0xffff0000u); sm[2] += __uint_as_float(v.y << 16); sm[3] += __uint_as_float(v.y & 0xffff0000u);
                sm[4] += __uint_as_float(v.z << 16); sm[5] += __uint_as_float(v.z & 0xffff0000u); sm[6] += __uint_as_float(v.w << 16); sm[7] += __uint_as_float(v.w & 0xffff0000u); }
            const float ic = 1.f / (float)cnt;
            u32x4 o;
            o.x = pk2(sm[0] * ic - __uint_as_float(u0.x << 16), sm[1] * ic - __uint_as_float(u0.x & 0xffff0000u)); o.y = pk2(sm[2] * ic - __uint_as_float(u0.y << 16), sm[3] * ic - __uint_as_float(u0.y & 0xffff0000u));
            o.z = pk2(sm[4] * ic - __uint_as_float(u0.z << 16), sm[5] * ic - __uint_as_float(u0.z & 0xffff0000u)); o.w = pk2(sm[6] * ic - __uint_as_float(u0.w << 16), sm[7] * ic - __uint_as_float(u0.w & 0xffff0000u));
            *(u32x4*)(Dl + tt * RT_P + 8 * pc) = o; }
        __syncthreads();
#pragma unroll
        for (int tt = 0; tt < 4; ++tt) { f32x4v d = (f32x4v){0.f, 0.f, 0.f, 0.f};
#pragma unroll
            for (int ks = 0; ks < 4; ++ks) d = __builtin_amdgcn_mfma_f32_16x16x32_bf16(*(const bf16x8*)(Dl + (16 * tt + fr) * RT_P + 32 * ks + 8 * fq), bw[ks], d, 0, 0, 0);
#pragma unroll
            for (int r = 0; r < 4; ++r) br23[((size_t)(b * T + tb * 64 + 16 * tt + 4 * fq + r)) * D + 512 + g * 128 + 16 * wave + fr] = (bf16)f2bf1(d[r] * sc); }
        __syncthreads();
    }
}
__device__ __forceinline__ float row16_max(float v) {
    v = fmaxf(v, __builtin_bit_cast(float, __builtin_amdgcn_mov_dpp(__builtin_bit_cast(int, v), 0xB1, 0xf, 0xf, true)));
    v = fmaxf(v, __builtin_bit_cast(float, __builtin_amdgcn_mov_dpp(__builtin_bit_cast(int, v), 0x4E, 0xf, 0xf, true)));
    v = fmaxf(v, __builtin_bit_cast(float, __builtin_amdgcn_mov_dpp(__builtin_bit_cast(int, v), 0x141, 0xf, 0xf, true)));
    v = fmaxf(v, __builtin_bit_cast(float, __builtin_amdgcn_mov_dpp(__builtin_bit_cast(int, v), 0x140, 0xf, 0xf, true)));
    return v;
}
__device__ __forceinline__ float row16_sum(float v) {
    v += __builtin_bit_cast(float, __builtin_amdgcn_mov_dpp(__builtin_bit_cast(int, v), 0xB1, 0xf, 0xf, true));
    v += __builtin_bit_cast(float, __builtin_amdgcn_mov_dpp(__builtin_bit_cast(int, v), 0x4E, 0xf, 0xf, true));
    v += __builtin_bit_cast(float, __builtin_amdgcn_mov_dpp(__builtin_bit_cast(int, v), 0x141, 0xf, 0xf, true));
    v += __builtin_bit_cast(float, __builtin_amdgcn_mov_dpp(__builtin_bit_cast(int, v), 0x140, 0xf, 0xf, true));
    return v;
}
constexpr int SWA_KP = 72, SWA_VP = 264, SWA_PP = 168;
__device__ __forceinline__ void swa_phase(const bf16* proj, const bf16* akv, const float* sink, bf16* br01, char* lds, int G) {
    int tid = threadIdx.x; asm volatile("" : "+v"(tid)); const int lane = tid & 63, wave = tid >> 6;
    bf16* Kl = (bf16*)lds; bf16* Vt = (bf16*)(lds + 36864); bf16* Pw = (bf16*)(lds + 36864 + 33792) + wave * 16 * SWA_PP;
    for (int un = blockIdx.x; un < 512; un += G) {
        const int nb = un & 31, kvh = (un >> 5) & 1, b = un >> 6;
        const size_t m0 = (size_t)b * T + nb * 128;
        const int g = wave >> 1, head = kvh * 4 + g, fr = lane & 15, fq = lane >> 4;
        const float sk = sink[head];
        bf16x8 qf[4][2];
#pragma unroll
        for (int j = 0; j < 4; ++j) { const bf16* qp = proj + (m0 + 16 * ((wave & 1) * 4 + j) + fr) * NPROJ + C_AQ + head * 64 + 8 * fq; qf[j][0] = *(const bf16x8*)qp; qf[j][1] = *(const bf16x8*)(qp + 32); }
#pragma unroll
        for (int i = 0; i < 4; ++i) { const int idx = tid + 512 * i, key = idx >> 3, pc = idx & 7;
            u32x4 kv = (u32x4){0u, 0u, 0u, 0u}, vv = kv;
            if (nb > 0 || key >= 128) { const bf16* src = akv + (m0 - 128 + key) * 256 + kvh * 64 + pc * 8; kv = *(const u32x4*)src; vv = *(const u32x4*)(src + 128); }
            *(u32x4*)(Kl + key * SWA_KP + pc * 8) = kv;
            bf16* vd = Vt + (pc * 8) * SWA_VP + key;
            vd[0] = (bf16)(vv.x & 0xffffu); vd[SWA_VP] = (bf16)(vv.x >> 16); vd[2 * SWA_VP] = (bf16)(vv.y & 0xffffu); vd[3 * SWA_VP] = (bf16)(vv.y >> 16);
            vd[4 * SWA_VP] = (bf16)(vv.z & 0xffffu); vd[5 * SWA_VP] = (bf16)(vv.z >> 16); vd[6 * SWA_VP] = (bf16)(vv.w & 0xffffu); vd[7 * SWA_VP] = (bf16)(vv.w >> 16); }
        __syncthreads();
#pragma unroll
        for (int j = 0; j < 4; ++j) {
            const int a = (wave & 1) * 4 + j, i0 = 16 * a, ap = a & ~1;
            const bf16x8 q0 = qf[j][0], q1 = qf[j][1];
            f32x4v sv[10];
#pragma unroll
            for (int kt = 0; kt < 10; ++kt) {
                const bf16* kp = Kl + (16 * (ap + kt) + fr) * SWA_KP + 8 * fq;
                f32x4v d = (f32x4v){0.f, 0.f, 0.f, 0.f};
                d = __builtin_amdgcn_mfma_f32_16x16x32_bf16(q0, *(const bf16x8*)kp, d, 0, 0, 0);
                d = __builtin_amdgcn_mfma_f32_16x16x32_bf16(q1, *(const bf16x8*)(kp + 32), d, 0, 0, 0);
                sv[kt] = d;
            }
            float mx[4] = {-INFINITY, -INFINITY, -INFINITY, -INFINITY};
#pragma unroll
            for (int kt = 0; kt < 10; ++kt) { const int kabs = 16 * (ap + kt) + fr;
#pragma unroll
                for (int r = 0; r < 4; ++r) { const int i = i0 + 4 * fq + r; const bool ok = (kabs >= i + 1) && (kabs <= i + 128) && (nb > 0 || kabs >= 128);
                    const float x = ok ? sv[kt][r] * 0.125f : -INFINITY; sv[kt][r] = x; mx[r] = fmaxf(mx[r], x); } }
            float den[4];
#pragma unroll
            for (int r = 0; r < 4; ++r) { mx[r] = fmaxf(row16_max(mx[r]), sk); den[r] = 0.f; }
#pragma unroll
            for (int kt = 0; kt < 10; ++kt)
#pragma unroll
                for (int r = 0; r < 4; ++r) { const float pv = __expf(sv[kt][r] - mx[r]); den[r] += pv; Pw[(4 * fq + r) * SWA_PP + 16 * kt + fr] = (bf16)f2bf1(pv); }
#pragma unroll
            for (int r = 0; r < 4; ++r) den[r] = 1.f / (row16_sum(den[r]) + __expf(sk - mx[r]));
            LDS_WAIT();
            f32x4v o[4];
#pragma unroll
            for (int dt = 0; dt < 4; ++dt) o[dt] = (f32x4v){0.f, 0.f, 0.f, 0.f};
#pragma unroll
            for (int ks = 0; ks < 5; ++ks) { const bf16x8 pa = *(const bf16x8*)(Pw + fr * SWA_PP + 32 * ks + 8 * fq);
#pragma unroll
                for (int dt = 0; dt < 4; ++dt) o[dt] = __builtin_amdgcn_mfma_f32_16x16x32_bf16(pa, *(const bf16x8*)(Vt + (16 * dt + fr) * SWA_VP + 16 * ap + 32 * ks + 8 * fq), o[dt], 0, 0, 0); }
#pragma unroll
            for (int r = 0; r < 4; ++r) { bf16* op = br01 + (m0 + i0 + 4 * fq + r) * D + head * 64 + fr;
#pragma unroll
                for (int dt = 0; dt < 4; ++dt) op[16 * dt] = (bf16)f2bf1(o[dt][r] * den[r]); }
            LDS_WAIT();
        }
        __syncthreads();
    }
}
typedef float f32x16 __attribute__((ext_vector_type(16)));
constexpr int DSA_S = 4100;
constexpr int DSA_WOFF = 8 * DSA_S * 4;
__device__ __forceinline__ float dpp_x1(float x) { return __builtin_bit_cast(float, __builtin_amdgcn_mov_dpp(__builtin_bit_cast(int, x), 0xB1, 0xf, 0xf, true)); }
__device__ __forceinline__ float dpp_x2(float x) { return __builtin_bit_cast(float, __builtin_amdgcn_mov_dpp(__builtin_bit_cast(int, x), 0x4E, 0xf, 0xf, true)); }
__device__ __forceinline__ int wave_sum_i(int v) {
    v += __builtin_amdgcn_mov_dpp(v, 0xB1, 0xf, 0xf, true);
    v += __builtin_amdgcn_mov_dpp(v, 0x4E, 0xf, 0xf, true);
    v += __builtin_amdgcn_mov_dpp(v, 0x141, 0xf, 0xf, true);
    v += __builtin_amdgcn_mov_dpp(v, 0x140, 0xf, 0xf, true);
    v += __builtin_amdgcn_update_dpp(0, v, 0x142, 0xa, 0xf, false);
    v += __builtin_amdgcn_update_dpp(0, v, 0x143, 0xc, 0xf, false);
    return __builtin_amdgcn_readlane(v, 63);
}
__device__ __forceinline__ unsigned sortable(float f) { const unsigned u = __float_as_uint(f); return (u >> 31) ? ~u : (u | 0x80000000u); }
__device__ __forceinline__ void dsa_scores(const bf16* pb, const bf16* ikb, int t0, float* scl, int wave, int lane) {
    const int n = lane & 31, kh = lane >> 5, q = n >> 2, h = n & 3;
    const bf16* qrow = pb + (size_t)(t0 + q) * NPROJ;
    bf16x8 Bq[4];
#pragma unroll
    for (int ks = 0; ks < 4; ++ks) Bq[ks] = *(const bf16x8*)(qrow + C_IQ + h * 64 + 16 * ks + 8 * kh);
    const float wq = bf2f(qrow[C_IW + h]) * 0.0625f;
    const int ntile = (t0 + 8 + 31) >> 5;
    float* dst = scl + q * DSA_S + h + 4 * kh;
#pragma unroll 1
    for (int tile0 = wave; tile0 < ntile; tile0 += 32) {
        bf16x8 a[4][4];
#pragma unroll
        for (int u = 0; u < 4; ++u) { const int tile = tile0 + 8 * u; const int tc = (tile < ntile) ? tile : 0;
            const bf16* kf = ikb + ((size_t)tc * 256 + lane) * 8;
#pragma unroll
            for (int ks = 0; ks < 4; ++ks) a[u][ks] = *(const bf16x8*)(kf + ks * 512); }
#pragma unroll
        for (int u = 0; u < 4; ++u) { const int tile = tile0 + 8 * u;
            if (tile < ntile) {
                f32x16 d;
#pragma unroll
                for (int r = 0; r < 16; ++r) d[r] = 0.f;
#pragma unroll
                for (int ks = 0; ks < 4; ++ks) d = __builtin_amdgcn_mfma_f32_32x32x16_bf16(a[u][ks], Bq[ks], d, 0, 0, 0);
                float v[16];
#pragma unroll
                for (int r = 0; r < 16; ++r) { float x = fmaxf(d[r], 0.f) * wq; x += dpp_x1(x); x += dpp_x2(x); v[r] = x; }
#pragma unroll
                for (int k = 0; k < 4; ++k) { const float val = (h == 0) ? v[4 * k] : (h == 1) ? v[4 * k + 1] : (h == 2) ? v[4 * k + 2] : v[4 * k + 3]; dst[tile * 32 + 8 * k] = val + 0.f; }
            } }
    }
}
__device__ __forceinline__ int wave_scan_incl(int v) {
    v += __builtin_amdgcn_update_dpp(0, v, 0x111, 0xf, 0xf, false);
    v += __builtin_amdgcn_update_dpp(0, v, 0x112, 0xf, 0xf, false);
    v += __builtin_amdgcn_update_dpp(0, v, 0x114, 0xf, 0xf, false);
    v += __builtin_amdgcn_update_dpp(0, v, 0x118, 0xf, 0xf, false);
    v += __builtin_amdgcn_update_dpp(0, v, 0x142, 0xa, 0xf, false);
    v += __builtin_amdgcn_update_dpp(0, v, 0x143, 0xc, 0xf, false);
    return v;
}
template <int SMODE> __device__ __forceinline__ void dsa_select(int t, float* sc, char* wl, int lane) {
    unsigned short* sel = (unsigned short*)(wl + 512);
    const int nk = t + 1;
    const int K = nk < 256 ? nk : 256;
    const int nj = (nk + 63) >> 6;
    unsigned key[64];
#pragma unroll
    for (int j = 0; j < 64; ++j) { const int s = 64 * j + lane; const unsigned kq = sortable(sc[s]); key[j] = (s < nk) ? kq : 0u; }
    if (SMODE == 1) { unsigned x = 0u;
#pragma unroll
        for (int j = 0; j < 64; ++j) x ^= key[j];
        sel[255] = (unsigned short)x; return; }
    unsigned Tk = 1u; int cT = K;
    if (nk > 256) {
        unsigned* hist = (unsigned*)sc;
        auto find_bin = [&](int Kq, int& ge, int& in) -> unsigned {
            int sl = 0;
#pragma unroll
            for (int i = 0; i < 64; ++i) sl += (int)hist[64 * lane + ((i + lane) & 63)];
            const int pre = wave_scan_incl(sl);
            const int tot = __builtin_amdgcn_readlane(pre, 63);
            const int suf = tot - pre + sl;
            const unsigned long long m1 = __ballot(suf >= Kq);
            const int Ls = 63 - __builtin_clzll(m1);
            const int above = __builtin_amdgcn_readlane(suf - sl, Ls);
            const int hi = (int)hist[64 * Ls + lane];
            const int pre2 = wave_scan_incl(hi);
            const int tot2 = __builtin_amdgcn_readlane(pre2, 63);
            const int suf2 = above + tot2 - pre2 + hi;
            const unsigned long long m2 = __ballot(suf2 >= Kq);
            const int is = 63 - __builtin_clzll(m2);
            ge = __builtin_amdgcn_readlane(suf2, is); in = __builtin_amdgcn_readlane(hi, is);
            return (unsigned)(64 * Ls + is); };
        LDS_WAIT();
#pragma unroll
        for (int i = 0; i < 16; ++i) ((u32x4*)hist)[lane + 64 * i] = (u32x4){0u, 0u, 0u, 0u};
        LDS_WAIT();
#pragma unroll
        for (int jg = 0; jg < 4; ++jg) if (16 * jg < nj) {
#pragma unroll
            for (int j = 16 * jg; j < 16 * jg + 16; ++j) if (j < nj) atomicAdd(&hist[key[j] >> 20], key[j] != 0u ? 1u : 0u); }
        LDS_WAIT();
        int ge1, in1;
        const unsigned B = find_bin(K, ge1, in1);
        Tk = B << 20; cT = ge1;
        if (cT != K) {
            const int aboveB = ge1 - in1, K2 = K - aboveB;
            LDS_WAIT();
#pragma unroll
            for (int i = 0; i < 16; ++i) ((u32x4*)hist)[lane + 64 * i] = (u32x4){0u, 0u, 0u, 0u};
            LDS_WAIT();
#pragma unroll
            for (int jg = 0; jg < 4; ++jg) if (16 * jg < nj) {
#pragma unroll
                for (int j = 16 * jg; j < 16 * jg + 16; ++j) { if ((key[j] >> 20) == B) atomicAdd(&hist[(key[j] >> 8) & 0xfffu], key[j] != 0u ? 1u : 0u);
                    if ((j & 3) == 3) __builtin_amdgcn_sched_barrier(0); } }
            LDS_WAIT();
            int ge2, in2;
            const unsigned B2 = find_bin(K2, ge2, in2);
            Tk |= B2 << 8; cT = aboveB + ge2;
            for (int bit = 7; bit >= 0 && cT != K; --bit) {
                const unsigned cand = Tk | (1u << bit); int c = 0;
#pragma unroll
                for (int jg = 0; jg < 4; ++jg) if (16 * jg < nj) {
#pragma unroll
                    for (int j = 16 * jg; j < 16 * jg + 16; ++j) c += (key[j] >= cand) ? 1 : 0; }
                const int totc = wave_sum_i(c);
                if (totc >= K) { Tk = cand; cT = totc; }
            }
        }
    }
    if (SMODE == 2) { sel[255] = (unsigned short)Tk; return; }
    LDS_WAIT();
    if (cT == K) {
        int base = 0;
#pragma unroll
        for (int jg = 0; jg < 4; ++jg) if (16 * jg < nj) {
#pragma unroll
            for (int j = 16 * jg; j < 16 * jg + 16; ++j) {
                const bool tk = key[j] >= Tk;
                const unsigned long long mk = __ballot(tk);
                const int pos = base + (int)__builtin_amdgcn_mbcnt_hi((unsigned)(mk >> 32), __builtin_amdgcn_mbcnt_lo((unsigned)mk, 0u));
                if (tk) sel[pos] = (unsigned short)(64 * j + lane);
                base += __popcll(mk);
                if ((j & 3) == 3) __builtin_amdgcn_sched_barrier(0);
            } }
    } else {
        int cg = 0;
#pragma unroll
        for (int j = 0; j < 64; ++j) cg += (key[j] > Tk) ? 1 : 0;
        const int pg = wave_scan_incl(cg);
        const int totg = __builtin_amdgcn_readlane(pg, 63);
        const int need = K - totg;
        int pos = pg - cg;
#pragma unroll
        for (int jg = 0; jg < 4; ++jg) if (16 * jg < nj) {
#pragma unroll
            for (int j = 16 * jg; j < 16 * jg + 16; ++j) if (key[j] > Tk) { sel[pos] = (unsigned short)(64 * j + lane); ++pos; } }
        const unsigned long long lt = (1ull << lane) - 1ull;
        int ties = 0;
#pragma unroll
        for (int jg = 0; jg < 4; ++jg) if (16 * jg < nj) {
#pragma unroll
            for (int j = 16 * jg; j < 16 * jg + 16; ++j) {
                const unsigned long long meq = __ballot(key[j] == Tk);
                const int rk = ties + __popcll(meq & lt);
                if (key[j] == Tk && rk < need) sel[totg + rk] = (unsigned short)(64 * j + lane);
                ties += __popcll(meq);
            } }
    }
    LDS_WAIT();
}
typedef short v4i16_t __attribute__((ext_vector_type(4)));
constexpr int DSA_VP = 72, DSA_PP = 264;
template <int MODE> __device__ __forceinline__ void dsa_attend(const bf16x8 (&qa)[2][2], const bf16* kvb, bf16* br01, int b, int t, float* sc, char* wl, int lane) {
    const unsigned short* sel = (const unsigned short*)(wl + 512);
    const size_t m = (size_t)b * T + t;
    const int K = (t + 1) < 256 ? (t + 1) : 256;
    const int fr = lane & 15, fq = lane >> 4;
    bf16* Vst = (bf16*)sc; bf16* Pl = (bf16*)sc + 64 * DSA_VP;
    LAS const char* vst3 = (LAS const char*)Vst;
    const int nch = (MODE & 1) ? 0 : ((K + 63) >> 6);
#pragma unroll
    for (int kvh = 0; kvh < 2; ++kvh) {
        f32x4v lg[16];
        {
            u32x4 k0[8], k1[8];
#pragma unroll
            for (int i = 0; i < 8; ++i) k0[i] = *(const u32x4*)(kvb + (size_t)sel[8 * i + (lane >> 3)] * 256 + kvh * 64 + 8 * (lane & 7));
#pragma unroll
            for (int i = 0; i < 8; ++i) k1[i] = *(const u32x4*)(kvb + (size_t)sel[64 + 8 * i + (lane >> 3)] * 256 + kvh * 64 + 8 * (lane & 7));
#define DSA_QK_CHUNK(c, buf, nextc) do { \
            LDS_WAIT(); \
            _Pragma("unroll") for (int i = 0; i < 8; ++i) *(u32x4*)(Vst + (8 * i + (lane >> 3)) * DSA_VP + 8 * (lane & 7)) = buf[i]; \
            if ((nextc) < 4) { \
                _Pragma("unroll") for (int i = 0; i < 8; ++i) buf[i] = *(const u32x4*)(kvb + (size_t)sel[64 * ((nextc) & 3) + 8 * i + (lane >> 3)] * 256 + kvh * 64 + 8 * (lane & 7)); } \
            LDS_WAIT(); \
            _Pragma("unroll") for (int e4 = 0; e4 < 4; ++e4) { const int et = 4 * (c) + e4; \
                const bf16* kp = Vst + (16 * e4 + fr) * DSA_VP + 8 * fq; \
                f32x4v d = (f32x4v){0.f, 0.f, 0.f, 0.f}; \
                d = __builtin_amdgcn_mfma_f32_16x16x32_bf16(qa[kvh][0], *(const bf16x8*)kp, d, 0, 0, 0); \
                d = __builtin_amdgcn_mfma_f32_16x16x32_bf16(qa[kvh][1], *(const bf16x8*)(kp + 32), d, 0, 0, 0); \
                if (16 * et + fr >= K) d = (f32x4v){-INFINITY, -INFINITY, -INFINITY, -INFINITY}; \
                lg[et] = d; } } while (0)
            DSA_QK_CHUNK(0, k0, 2);
            DSA_QK_CHUNK(1, k1, 3);
            DSA_QK_CHUNK(2, k0, 4);
            DSA_QK_CHUNK(3, k1, 5);
#undef DSA_QK_CHUNK
        }
        if (MODE & 2) { float x = 0.f;
#pragma unroll
            for (int et = 0; et < 16; ++et) x += lg[et][0] + lg[et][1] + lg[et][2] + lg[et][3];
            Pl[lane] = (bf16)f2bf1(x); continue; }
        u32x4 va[8], vb[8];
#pragma unroll
        for (int i = 0; i < 8; ++i) va[i] = *(const u32x4*)(kvb + (size_t)sel[8 * i + (lane >> 3)] * 256 + 128 + kvh * 64 + 8 * (lane & 7));
#pragma unroll
        for (int i = 0; i < 8; ++i) vb[i] = *(const u32x4*)(kvb + (size_t)sel[64 + 8 * i + (lane >> 3)] * 256 + 128 + kvh * 64 + 8 * (lane & 7));
        {
            float x[16];
#pragma unroll
            for (int et = 0; et < 16; ++et) x[et] = (fq == 0) ? lg[et][0] : (fq == 1) ? lg[et][1] : (fq == 2) ? lg[et][2] : lg[et][3];
            float mx = x[0];
#pragma unroll
            for (int et = 1; et < 16; ++et) mx = fmaxf(mx, x[et]);
            mx = row16_max(mx);
            float sm = 0.f;
#pragma unroll
            for (int et = 0; et < 16; ++et) { x[et] = __builtin_amdgcn_exp2f((x[et] - mx) * (0.125f * 1.44269504f)); sm += x[et]; }
            const float inv = 1.f / row16_sum(sm);
#pragma unroll
            for (int et = 0; et < 16; ++et) Pl[fq * DSA_PP + 16 * et + fr] = (bf16)f2bf1(x[et] * inv);
        }
        f32x4v o[4];
#pragma unroll
        for (int dt = 0; dt < 4; ++dt) o[dt] = (f32x4v){0.f, 0.f, 0.f, 0.f};
#define DSA_PV_CHUNK(c, buf, nextc) do { \
            LDS_WAIT(); \
            _Pragma("unroll") for (int i = 0; i < 8; ++i) *(u32x4*)(Vst + (8 * i + (lane >> 3)) * DSA_VP + 8 * (lane & 7)) = buf[i]; \
            if ((nextc) < nch) { \
                _Pragma("unroll") for (int i = 0; i < 8; ++i) buf[i] = *(const u32x4*)(kvb + (size_t)sel[64 * (nextc) + 8 * i + (lane >> 3)] * 256 + 128 + kvh * 64 + 8 * (lane & 7)); } \
            LDS_WAIT(); \
            _Pragma("unroll") for (int ks = 0; ks < 2; ++ks) { \
                const bf16x8 pa = *(const bf16x8*)(Pl + (fr & 3) * DSA_PP + 64 * (c) + 32 * ks + 8 * fq); \
                _Pragma("unroll") for (int dt = 0; dt < 4; ++dt) { \
                    LAS const char* a0 = vst3 + ((32 * ks + 8 * fq + (fr >> 2)) * DSA_VP + 16 * dt + 4 * (fr & 3)) * 2; \
                    const v4i16_t lo = __builtin_amdgcn_ds_read_tr16_b64_v4i16((LAS v4i16_t*)a0); \
                    const v4i16_t hi = __builtin_amdgcn_ds_read_tr16_b64_v4i16((LAS v4i16_t*)(a0 + 4 * DSA_VP * 2)); \
                    bf16x8 bv; bv[0] = lo[0]; bv[1] = lo[1]; bv[2] = lo[2]; bv[3] = lo[3]; bv[4] = hi[0]; bv[5] = hi[1]; bv[6] = hi[2]; bv[7] = hi[3]; \
                    o[dt] = __builtin_amdgcn_mfma_f32_16x16x32_bf16(pa, bv, o[dt], 0, 0, 0); } } } while (0)
        if (nch > 0) DSA_PV_CHUNK(0, va, 2);
        if (nch > 1) DSA_PV_CHUNK(1, vb, 3);
        if (nch > 2) DSA_PV_CHUNK(2, va, 4);
        if (nch > 3) DSA_PV_CHUNK(3, vb, 5);
#undef DSA_PV_CHUNK
        const f32x4v ov = (fq == 0) ? o[0] : (fq == 1) ? o[1] : (fq == 2) ? o[2] : o[3];
        bf16* op = br01 + m * D + 512 + kvh * 256 + 16 * fq + fr;
#pragma unroll
        for (int r = 0; r < 4; ++r) op[r * 64] = (bf16)f2bf1(ov[r]);
        LDS_WAIT();
    }
}
__device__ __forceinline__ void dsa_phase(const bf16* proj, const bf16* bkv, const bf16* ik, bf16* br01, char* lds, int G) {
    int tid = threadIdx.x; asm volatile("" : "+v"(tid)); const int lane = tid & 63, wave = __builtin_amdgcn_readfirstlane(tid >> 6);
    float* scl = (float*)lds;
    char* wl = lds + DSA_WOFF + wave * 1024;
    const int c = blockIdx.x, b = c & 7, j = c >> 3, R = G >> 3;
    const bf16* pb = proj + (size_t)b * T * NPROJ; const bf16* kvb = bkv + (size_t)b * T * 256; const bf16* ikb = ik + (size_t)b * T * 64;
    ((unsigned*)(wl + 512))[lane] = 0u; ((unsigned*)(wl + 512))[lane + 64] = 0u;
    for (int k = 0; ; ++k) {
        const int u = (k & 1) ? (R - 1 - j) + R * k : j + R * k;
        if (u >= T / 8) break;
        const int t0 = 8 * u;
        int l1 = lane; asm volatile("" : "+v"(l1));
        for (int r_ = 0; r_ < REP(4); ++r_) dsa_scores(pb, ikb, t0, scl, wave, l1);
        __syncthreads();
        int l2 = lane; asm volatile("" : "+v"(l2));
        bf16x8 qa[2][2];
#pragma unroll
        for (int kvh = 0; kvh < 2; ++kvh) { const bf16* qp = pb + (size_t)(t0 + wave) * NPROJ + C_BQ + (kvh * 4 + (l2 & 3)) * 64 + 8 * (l2 >> 4); qa[kvh][0] = *(const bf16x8*)qp; qa[kvh][1] = *(const bf16x8*)(qp + 32); }
        dsa_select<0>(t0 + wave, scl + wave * DSA_S, wl, l2);
        int l3 = lane; asm volatile("" : "+v"(l3));
        dsa_attend<0>(qa, kvb, br01, b, t0 + wave, scl + wave * DSA_S, wl, l3);
        __syncthreads();
    }
}
__device__ __forceinline__ void ret_u_phase(const bf16* proj, float* U, char* lds, int G) {
    int tid = threadIdx.x; asm volatile("" : "+v"(tid)); const int lane = tid & 63, wave = tid >> 6, fr = lane & 15, fq = lane >> 4;
    bf16* KdT = (bf16*)lds; bf16* VT = (bf16*)(lds + 17408);
    for (int un = blockIdx.x; un < 1024; un += G) {
        const int c = un & 31, bh = un >> 5, h = bh & 3, b = bh >> 2;
        const float lg2 = log2f(1.f - exp2f(-5.f - (float)h));
        const size_t m0 = (size_t)b * T + c * 128;
#pragma unroll
        for (int i = 0; i < 2; ++i) { const int idx = tid + 512 * i, mm = idx >> 3, pc = idx & 7;
            const u32x4 kv = *(const u32x4*)(proj + (m0 + mm) * NPROJ + C_RK + 64 * h + 8 * pc);
            const float dc = 0.125f * exp2f(lg2 * (float)(127 - mm));
            bf16* kd = KdT + (8 * pc) * RT_P + mm;
            kd[0] = (bf16)f2bf1(__uint_as_float(kv.x << 16) * dc); kd[RT_P] = (bf16)f2bf1(__uint_as_float(kv.x & 0xffff0000u) * dc);
            kd[2 * RT_P] = (bf16)f2bf1(__uint_as_float(kv.y << 16) * dc); kd[3 * RT_P] = (bf16)f2bf1(__uint_as_float(kv.y & 0xffff0000u) * dc);
            kd[4 * RT_P] = (bf16)f2bf1(__uint_as_float(kv.z << 16) * dc); kd[5 * RT_P] = (bf16)f2bf1(__uint_as_float(kv.z & 0xffff0000u) * dc);
            kd[6 * RT_P] = (bf16)f2bf1(__uint_as_float(kv.w << 16) * dc); kd[7 * RT_P] = (bf16)f2bf1(__uint_as_float(kv.w & 0xffff0000u) * dc); }
#pragma unroll
        for (int i = 0; i < 4; ++i) { const int idx = tid + 512 * i, mm = idx >> 4, pc = idx & 15;
            const u32x4 vv = *(const u32x4*)(proj + (m0 + mm) * NPROJ + C_RV + 128 * h + 8 * pc);
            bf16* vd = VT + (8 * pc) * RT_P + mm;
            vd[0] = (bf16)(vv.x & 0xffffu); vd[RT_P] = (bf16)(vv.x >> 16); vd[2 * RT_P] = (bf16)(vv.y & 0xffffu); vd[3 * RT_P] = (bf16)(vv.y >> 16);
            vd[4 * RT_P] = (bf16)(vv.z & 0xffffu); vd[5 * RT_P] = (bf16)(vv.z >> 16); vd[6 * RT_P] = (bf16)(vv.w & 0xffffu); vd[7 * RT_P] = (bf16)(vv.w >> 16); }
        __syncthreads();
        f32x4v acc[4];
#pragma unroll
        for (int dt = 0; dt < 4; ++dt) acc[dt] = (f32x4v){0.f, 0.f, 0.f, 0.f};
#pragma unroll
        for (int ks = 0; ks < 4; ++ks) { const bf16x8 bv = *(const bf16x8*)(VT + (16 * wave + fr) * RT_P + 32 * ks + 8 * fq);
#pragma unroll
            for (int dt = 0; dt < 4; ++dt) acc[dt] = __builtin_amdgcn_mfma_f32_16x16x32_bf16(*(const bf16x8*)(KdT + (16 * dt + fr) * RT_P + 32 * ks + 8 * fq), bv, acc[dt], 0, 0, 0); }
        float* up = U + (size_t)un * 8192;
#pragma unroll
        for (int dt = 0; dt < 4; ++dt)
#pragma unroll
            for (int r = 0; r < 4; ++r) up[(16 * dt + 4 * fq + r) * 128 + 16 * wave + fr] = acc[dt][r];
        __syncthreads();
    }
}
__device__ __forceinline__ void ret_scan_phase(const float* U, bf16* ST, int G) {
    int tid = threadIdx.x; asm volatile("" : "+v"(tid));
    for (int w = blockIdx.x; w < 256; w += G) {
        const int bh = w >> 3, part = w & 7, h = bh & 3;
        const float cd = exp2f(128.f * log2f(1.f - exp2f(-5.f - (float)h)));
        const int e2 = part * 512 + tid, dv = e2 & 127, dp = e2 >> 7;
        const float* up = U + (size_t)bh * 32 * 8192 + (2 * dp) * 128 + dv;
        unsigned* sp = (unsigned*)(ST + (size_t)bh * 32 * 8192 + dv * 64 + 2 * dp);
        float u0[32], u1[32];
#pragma unroll
        for (int j = 0; j < 31; ++j) { u0[j] = up[(size_t)j * 8192]; u1[j] = up[(size_t)j * 8192 + 128]; }
        float s0 = 0.f, s1 = 0.f;
        sp[0] = 0u;
#pragma unroll
        for (int c = 1; c < 32; ++c) { s0 = s0 * cd + u0[c - 1]; s1 = s1 * cd + u1[c - 1]; sp[(size_t)c * 4096] = pk2(s0, s1); }
    }
}
__device__ __forceinline__ void ret_out_phase(const bf16* proj, const bf16* ST, bf16* br23, char* lds, int G) {
    int tid = threadIdx.x; asm volatile("" : "+v"(tid)); const int lane = tid & 63, wave = tid >> 6, fr = lane & 15, fq = lane >> 4;
    bf16* Kl = (bf16*)lds; bf16* VT = (bf16*)(lds + 18432); bf16* Pw = (bf16*)(lds + 18432 + 34816) + wave * 16 * RT_P;
    for (int un = blockIdx.x; un < 1024; un += G) {
        const int c = un & 31, bh = un >> 5, h = bh & 3, b = bh >> 2;
        const float lg2 = log2f(1.f - exp2f(-5.f - (float)h));
        const size_t m0 = (size_t)b * T + c * 128;
        const bf16* qp = proj + (m0 + 16 * wave + fr) * NPROJ + C_RQ + 64 * h + 8 * fq;
        const bf16x8 q0 = *(const bf16x8*)qp, q1 = *(const bf16x8*)(qp + 32);
        const bf16* stp = ST + (size_t)un * 8192;
        bf16x8 stf[8][2];
#pragma unroll
        for (int dt = 0; dt < 8; ++dt) { const bf16* sp = stp + (16 * dt + fr) * 64 + 8 * fq; stf[dt][0] = *(const bf16x8*)sp; stf[dt][1] = *(const bf16x8*)(sp + 32); }
#pragma unroll
        for (int i = 0; i < 2; ++i) { const int idx = tid + 512 * i, mm = idx >> 3, pc = idx & 7;
            *(u32x4*)(Kl + mm * 72 + 8 * pc) = *(const u32x4*)(proj + (m0 + mm) * NPROJ + C_RK + 64 * h + 8 * pc); }
#pragma unroll
        for (int i = 0; i < 4; ++i) { const int idx = tid + 512 * i, mm = idx >> 4, pc = idx & 15;
            const u32x4 vv = *(const u32x4*)(proj + (m0 + mm) * NPROJ + C_RV + 128 * h + 8 * pc);
            bf16* vd = VT + (8 * pc) * RT_P + mm;
            vd[0] = (bf16)(vv.x & 0xffffu); vd[RT_P] = (bf16)(vv.x >> 16); vd[2 * RT_P] = (bf16)(vv.y & 0xffffu); vd[3 * RT_P] = (bf16)(vv.y >> 16);
            vd[4 * RT_P] = (bf16)(vv.z & 0xffffu); vd[5 * RT_P] = (bf16)(vv.z >> 16); vd[6 * RT_P] = (bf16)(vv.w & 0xffffu); vd[7 * RT_P] = (bf16)(vv.w >> 16); }
        __syncthreads();
        f32x4v acc[8];
#pragma unroll
        for (int dt = 0; dt < 8; ++dt) { f32x4v d = (f32x4v){0.f, 0.f, 0.f, 0.f};
            d = __builtin_amdgcn_mfma_f32_16x16x32_bf16(q0, stf[dt][0], d, 0, 0, 0);
            d = __builtin_amdgcn_mfma_f32_16x16x32_bf16(q1, stf[dt][1], d, 0, 0, 0);
            acc[dt] = d; }
#pragma unroll
        for (int r = 0; r < 4; ++r) { const float qd = exp2f(lg2 * (float)(16 * wave + 4 * fq + r + 1));
#pragma unroll
            for (int dt = 0; dt < 8; ++dt) acc[dt][r] *= qd; }
#pragma unroll
        for (int mt = 0; mt < 8; ++mt) {
            f32x4v d = (f32x4v){0.f, 0.f, 0.f, 0.f};
            if (mt <= wave) { const bf16* kp = Kl + (16 * mt + fr) * 72 + 8 * fq;
                d = __builtin_amdgcn_mfma_f32_16x16x32_bf16(q0, *(const bf16x8*)kp, d, 0, 0, 0);
                d = __builtin_amdgcn_mfma_f32_16x16x32_bf16(q1, *(const bf16x8*)(kp + 32), d, 0, 0, 0); }
            const int mm = 16 * mt + fr;
#pragma unroll
            for (int r = 0; r < 4; ++r) { const int n = 16 * wave + 4 * fq + r;
                const float pv = (mm <= n) ? d[r] * 0.125f * exp2f(lg2 * (float)(n - mm)) : 0.f;
                Pw[(4 * fq + r) * RT_P + mm] = (bf16)f2bf1(pv); }
        }
        bf16 gh[4][8];
#pragma unroll
        for (int r = 0; r < 4; ++r) { const bf16* gp = proj + (m0 + 16 * wave + 4 * fq + r) * NPROJ + C_RG + 128 * h + fr;
#pragma unroll
            for (int dt = 0; dt < 8; ++dt) gh[r][dt] = gp[16 * dt]; }
        LDS_WAIT();
#pragma unroll
        for (int ks = 0; ks < 4; ++ks) { const bf16x8 pa = *(const bf16x8*)(Pw + fr * RT_P + 32 * ks + 8 * fq);
#pragma unroll
            for (int dt = 0; dt < 8; ++dt) acc[dt] = __builtin_amdgcn_mfma_f32_16x16x32_bf16(pa, *(const bf16x8*)(VT + (16 * dt + fr) * RT_P + 32 * ks + 8 * fq), acc[dt], 0, 0, 0); }
#pragma unroll
        for (int r = 0; r < 4; ++r) { float q = 0.f;
#pragma unroll
            for (int dt = 0; dt < 8; ++dt) q += acc[dt][r] * acc[dt][r];
            const float rs = 1.f / sqrtf(row16_sum(q) * (1.f / 128.f) + EPS);
            const size_t row = m0 + 16 * wave + 4 * fq + r;
            bf16* op = br23 + row * D + h * 128 + fr;
#pragma unroll
            for (int dt = 0; dt < 8; ++dt) { const float gv = bf2f(gh[r][dt]); op[16 * dt] = (bf16)f2bf1(gv / (1.f + __expf(-gv)) * acc[dt][r] * rs); } }
        __syncthreads();
    }
}

typedef const __attribute__((address_space(4))) Args* KArgs;
__device__ __forceinline__ KArgs kargs() { KArgs p = (KArgs)__builtin_amdgcn_kernarg_segment_ptr(); asm volatile("" : "+s"(p)); return p; }

__device__ __forceinline__ void ph0(LAS unsigned char* L, int layer, int slot) {
    int tid = threadIdx.x; asm volatile("" : "+v"(tid)); const int lane = tid & 63, wave = __builtin_amdgcn_readfirstlane(tid >> 6);
    int G = gridDim.x, bx = blockIdx.x; asm volatile("" : "+s"(G), "+s"(bx)); const int gw = bx * 8 + wave, NGW = G * 8;
    unsigned char* lds = (unsigned char*)L; LAS int* lcnt = (LAS int*)(L + 0); LAS int* gt = (LAS int*)(L + LDS_MISC + 512);
    (void)lane; (void)gw; (void)NGW; (void)lds; (void)lcnt; (void)gt; (void)layer; (void)slot; (void)tid; (void)bx; (void)G;
    {
        KArgs A = kargs(); unsigned char* ws = A->ws;
        LAS float* scr = (LAS float*)(L + wave * 16384);
        constexpr int I_IN = 16 * 128, I_G = 16 * 128, I_B = 8 * 32, I_SQ = 16 * 32, I_L = I_IN + I_G + 4 * I_B + 5 * I_SQ;
        constexpr int I_GU = 16 * 224, I_DN = 56 * 32, NITEMS = 2 * I_L + I_GU + I_DN;
        for (int it = gw; it < NITEMS; it += NGW) {
            int r = it;
            if (r < 2 * I_L) {
                const int l = r / I_L; r -= l * I_L;
                unsigned char* wb = ws + WS_W + (size_t)l * W_LAYER;
                const float* win = A->w_in + (size_t)l * D * D_IN;
                if (r < I_IN) { conv_seg<1>(win, D, D_IN, 0, (bf16*)(wb + W_IN), D, 0, 128, r, scr, lane, A->norm_mix + (size_t)l * D); continue; } r -= I_IN;
                if (r < I_G) { conv_seg<0, 1>(win, D, D_IN, 3908, (bf16*)(wb + W_G), D, 0, 128, r, scr, lane, A->norm_mix + (size_t)l * D); continue; } r -= I_G;
                if (r < 4 * I_B) { const int i = r / I_B; r -= i * I_B;
                    conv_seg<0>(A->w_branch + ((size_t)l * 4 + i) * 512 * D, 512, D, 0, (bf16*)(wb + W_B) + (size_t)(i >> 1) * D * D, D, (i & 1) * 512, 32, r, scr, lane); continue; } r -= 4 * I_B;
                if (r < I_SQ) { conv_seg<0>(A->w_out + (size_t)l * D * D, D, D, 0, (bf16*)(wb + W_OUT), D, 0, 32, r, scr, lane); continue; } r -= I_SQ;
                if (r < I_SQ) { conv_seg<0>(A->w_xq + (size_t)l * D * D, D, D, 0, (bf16*)(wb + W_XQ), D, 0, 32, r, scr, lane, A->norm_cross + (size_t)l * D); continue; } r -= I_SQ;
                if (r < I_SQ) { conv_seg<0>(A->w_xkv + (size_t)l * D * 2 * D, D, 2 * D, 0, (bf16*)(wb + W_XK), D, 0, 32, r, scr, lane); continue; } r -= I_SQ;
                if (r < I_SQ) { conv_seg<0>(A->w_xkv + (size_t)l * D * 2 * D, D, 2 * D, D, (bf16*)(wb + W_XV), D, 0, 32, r, scr, lane); continue; } r -= I_SQ;
                conv_seg<0, 1>(A->w_xo + (size_t)l * D * D, D, D, 0, (bf16*)(wb + W_XO), D, 0, 32, r, scr, lane); continue;
            }
            r -= 2 * I_L;
            if (r < I_GU) { conv_seg<2, 1>(A->dense_w_gu, D, 2 * DFF, 0, (bf16*)(ws + WS_WGU), D, 0, 224, r, scr, lane, A->norm_ffn); continue; } r -= I_GU;
            conv_seg<0, 1>(A->dense_w_down, DFF, D, 0, (bf16*)(ws + WS_WDN), DFF, 0, 32, r, scr, lane);
        }
        for (int it = gw; it < 64; it += NGW) { const int lg = it >> 3;
            conv_seg<0>(A->pool_w + (size_t)lg * 16384, 128, 128, 0, (bf16*)(ws + WS_WPOOL) + (size_t)lg * 16384, 128, 0, 4, it & 7, scr, lane); }
        {
            _Float16* cosT = (_Float16*)(ws + WS_ROPE); _Float16* sinT = cosT + (size_t)M * 32; const int* pos = A->positions;
            for (int i = bx * 512 + tid; i < M * 32; i += G * 512) { const int m = i >> 5, j = i & 31;
                const float ang = (float)pos[m] * INV_FREQ[j];
                const double rev = (double)ang * 0.15915494309189533577; const float fr_ = (float)(rev - rint(rev));
                const size_t to = ((size_t)((m >> 4) * 4 + (j >> 3)) * 16 + (m & 15)) * 8 + (j & 7);
                cosT[to] = (_Float16)__builtin_amdgcn_cosf(fr_); sinT[to] = (_Float16)__builtin_amdgcn_sinf(fr_); }
        }
        {
            const float* mem = A->mem; const float* nm = A->norm_mem; bf16* MN = (bf16*)(ws + WS_MN);
            for (int r = gw; r < 2 * MROWS; r += NGW) { const int l = r / MROWS, mr = r % MROWS; norm_row_bf16(mem + (size_t)mr * D, nm + (size_t)l * D, MN + (size_t)r * D, lane); }
            const float* x = A->x; bf16* XB = (bf16*)(ws + WS_HB); u64* ss0 = (u64*)(ws + WS_SS);
            for (int m = gw; m < M; m += NGW) {
                const f32x4* xr = (const f32x4*)(x + (size_t)m * D) + lane; unsigned long long* o8 = (unsigned long long*)(XB + (size_t)m * D) + lane; float q = 0.f;
#pragma unroll
                for (int j = 0; j < 4; ++j) { const f32x4 v = xr[64 * j]; q += (v.x * v.x + v.y * v.y) + (v.z * v.z + v.w * v.w);
                    o8[64 * j] = (unsigned long long)pk2(v.x, v.y) | ((unsigned long long)pk2(v.z, v.w) << 32);
                    ((unsigned*)(ws + WS_XF8 + (size_t)m * D))[lane + 64 * j] = pk4_f8(v.x, v.y, v.z, v.w); }
                q = wave_sum(q); if (lane == 0) ss0[m] = ss_fix(q); }
        }
    }
}
__device__ __forceinline__ void ph1(LAS unsigned char* L, int layer, int slot) {
    int tid = threadIdx.x; asm volatile("" : "+v"(tid)); const int lane = tid & 63, wave = __builtin_amdgcn_readfirstlane(tid >> 6);
    int G = gridDim.x, bx = blockIdx.x; asm volatile("" : "+s"(G), "+s"(bx)); const int gw = bx * 8 + wave, NGW = G * 8;
    unsigned char* lds = (unsigned char*)L; LAS int* lcnt = (LAS int*)(L + 0); LAS int* gt = (LAS int*)(L + LDS_MISC + 512);
    (void)lane; (void)gw; (void)NGW; (void)lds; (void)lcnt; (void)gt; (void)layer; (void)slot; (void)tid; (void)bx; (void)G;
    {
            unsigned char* ws = kargs()->ws; unsigned char* wb = ws + WS_W + (size_t)layer * W_LAYER;
            { pg8::GridSched S{(const char*)(ws + WS_HB), (const char*)(wb + W_IN), 2048u, 2048u, 128, 16, 16, G, bx};
              EpiProj E{(bf16*)(ws + WS_PROJ), (const _Float16*)(ws + WS_ROPE), (const _Float16*)(ws + WS_ROPE) + (size_t)M * 32, (bf16*)(ws + WS_AKV), (bf16*)(ws + WS_BKV), (bf16*)(ws + WS_IK), (const u64*)(ws + WS_SS) + (size_t)(3 * layer) * M};
              pg8::gemm_stream(L, S, E, 2048u, 2048u); }
            if (layer == 0) {
                for (int l = 0; l < 2; ++l) {
                    unsigned char* wl = ws + WS_W + (size_t)l * W_LAYER;
                    { pg8::GridSched S{(const char*)(ws + WS_MN) + (size_t)l * MROWS * D * 2, (const char*)(wl + W_XK), 2048u, 2048u, 8, 4, 16, G, bx};
                      EpiPlain E{(bf16*)(ws + WS_KX) + (size_t)l * MROWS * D, D, 1.f, nullptr};
                      pg8::gemm_stream(L, S, E, 2048u, 2048u); }
                    { pg8::GridSched S{(const char*)(wl + W_XV), (const char*)(ws + WS_MN) + (size_t)l * MROWS * D * 2, 2048u, 2048u, 4, 8, 16, G, bx};
                      EpiPlain E{(bf16*)(ws + WS_VTB) + (size_t)l * 8 * D * D, D, 1.f, nullptr, (size_t)D * D};
                      pg8::gemm_stream(L, S, E, 2048u, 2048u); }
                }
            }
        }
}
__device__ __forceinline__ void ph2(LAS unsigned char* L, int layer, int slot) {
    int tid = threadIdx.x; asm volatile("" : "+v"(tid)); const int lane = tid & 63, wave = __builtin_amdgcn_readfirstlane(tid >> 6);
    int G = gridDim.x, bx = blockIdx.x; asm volatile("" : "+s"(G), "+s"(bx)); const int gw = bx * 8 + wave, NGW = G * 8;
    unsigned char* lds = (unsigned char*)L; LAS int* lcnt = (LAS int*)(L + 0); LAS int* gt = (LAS int*)(L + LDS_MISC + 512);
    (void)lane; (void)gw; (void)NGW; (void)lds; (void)lcnt; (void)gt; (void)layer; (void)slot; (void)tid; (void)bx; (void)G;
    {
            KArgs A = kargs(); unsigned char* ws = A->ws;
            const bf16* PROJ = (const bf16*)(ws + WS_PROJ);
            for (int r_ = 0; r_ < REP(0); ++r_) ret_u_phase(PROJ, (float*)(ws + WS_U), (char*)lds, G);
            for (int r_ = 0; r_ < REP(1); ++r_) pool_phase(PROJ, (const bf16*)(ws + WS_WPOOL) + (size_t)layer * 4 * 16384, A->pool_scale + (size_t)layer * 512, (bf16*)(ws + WS_BR23), (char*)lds, G);
            for (int r_ = 0; r_ < REP(2); ++r_) swa_phase(PROJ, (const bf16*)(ws + WS_AKV), A->attn_sink + layer * 8, (bf16*)(ws + WS_BR01), (char*)lds, G);
            for (int r_ = 0; r_ < REP(3); ++r_) dsa_phase(PROJ, (const bf16*)(ws + WS_BKV), (const bf16*)(ws + WS_IK), (bf16*)(ws + WS_BR01), (char*)lds, G);
        }
}
__device__ __forceinline__ void ph3(LAS unsigned char* L, int layer, int slot) {
    int tid = threadIdx.x; asm volatile("" : "+v"(tid)); const int lane = tid & 63, wave = __builtin_amdgcn_readfirstlane(tid >> 6);
    int G = gridDim.x, bx = blockIdx.x; asm volatile("" : "+s"(G), "+s"(bx)); const int gw = bx * 8 + wave, NGW = G * 8;
    unsigned char* lds = (unsigned char*)L; LAS int* lcnt = (LAS int*)(L + 0); LAS int* gt = (LAS int*)(L + LDS_MISC + 512);
    (void)lane; (void)gw; (void)NGW; (void)lds; (void)lcnt; (void)gt; (void)layer; (void)slot; (void)tid; (void)bx; (void)G;
    { unsigned char* ws = kargs()->ws; ret_out_phase((const bf16*)(ws + WS_PROJ), (const bf16*)(ws + WS_ST), (bf16*)(ws + WS_BR23), (char*)lds, G); }
}
__device__ __forceinline__ void ph20(LAS unsigned char* L, int layer, int slot) {
    int tid = threadIdx.x; asm volatile("" : "+v"(tid)); const int lane = tid & 63, wave = __builtin_amdgcn_readfirstlane(tid >> 6);
    int G = gridDim.x, bx = blockIdx.x; asm volatile("" : "+s"(G), "+s"(bx)); const int gw = bx * 8 + wave, NGW = G * 8;
    unsigned char* lds = (unsigned char*)L; LAS int* lcnt = (LAS int*)(L + 0); LAS int* gt = (LAS int*)(L + LDS_MISC + 512);
    (void)lane; (void)gw; (void)NGW; (void)lds; (void)lcnt; (void)gt; (void)layer; (void)slot; (void)tid; (void)bx; (void)G;
    { unsigned char* ws = kargs()->ws; ret_scan_phase((const float*)(ws + WS_U), (bf16*)(ws + WS_ST), G); }
}
__device__ __forceinline__ void ph4(LAS unsigned char* L, int layer, int slot) {
    int tid = threadIdx.x; asm volatile("" : "+v"(tid)); const int lane = tid & 63, wave = __builtin_amdgcn_readfirstlane(tid >> 6);
    int G = gridDim.x, bx = blockIdx.x; asm volatile("" : "+s"(G), "+s"(bx)); const int gw = bx * 8 + wave, NGW = G * 8;
    unsigned char* lds = (unsigned char*)L; LAS int* lcnt = (LAS int*)(L + 0); LAS int* gt = (LAS int*)(L + LDS_MISC + 512);
    (void)lane; (void)gw; (void)NGW; (void)lds; (void)lcnt; (void)gt; (void)layer; (void)slot; (void)tid; (void)bx; (void)G;
    {
            unsigned char* ws = kargs()->ws; unsigned char* wb = ws + WS_W + (size_t)layer * W_LAYER;
            unsigned* scr = (unsigned*)(ws + WS_MSCR + (size_t)bx * 786432);
            for (int ti = 0; ti * G + bx < 512; ++ti) {
                int pm, pn; pg8::tile_of(ti * G + bx, 128, 4, pm, pn);
                { MergeSched<0> S{(const char*)(ws + WS_XF8), nullptr, (const char*)(wb + W_G), pm, pn};
                  EpiGate E{scr, (const u64*)(ws + WS_SS) + (size_t)(3 * layer) * M, 1.f / F8_WSCALE};
                  pg8::gemm_stream<EpiGate, MergeSched<0>, 1>(L, S, E, 1024u, 1024u); }
                { MergeSched<1> S{(const char*)(ws + WS_BR01), (const char*)(ws + WS_BR23), (const char*)(wb + W_B), pm, pn};
                  EpiUp E{scr, (bf16*)(ws + WS_MERGED)};
                  pg8::gemm_stream(L, S, E, 2048u, 2048u); }
            }
        }
}
__device__ __forceinline__ void ph5(LAS unsigned char* L, int layer, int slot) {
    int tid = threadIdx.x; asm volatile("" : "+v"(tid)); const int lane = tid & 63, wave = __builtin_amdgcn_readfirstlane(tid >> 6);
    int G = gridDim.x, bx = blockIdx.x; asm volatile("" : "+s"(G), "+s"(bx)); const int gw = bx * 8 + wave, NGW = G * 8;
    unsigned char* lds = (unsigned char*)L; LAS int* lcnt = (LAS int*)(L + 0); LAS int* gt = (LAS int*)(L + LDS_MISC + 512);
    (void)lane; (void)gw; (void)NGW; (void)lds; (void)lcnt; (void)gt; (void)layer; (void)slot; (void)tid; (void)bx; (void)G;
    {
            KArgs A = kargs(); unsigned char* ws = A->ws; unsigned char* wb = ws + WS_W + (size_t)layer * W_LAYER;
            pg8::GridSched S{(const char*)(ws + WS_MERGED), (const char*)(wb + W_OUT), 2048u, 2048u, 128, 4, 16, G, bx};
            EpiRes E{(bf16*)(ws + WS_HB), (u64*)(ws + WS_SS) + (size_t)(3 * layer + 1) * M};
            pg8::gemm_stream(L, S, E, 2048u, 2048u);
        }
}
__device__ __forceinline__ void ph6(LAS unsigned char* L, int layer, int slot) {
    int tid = threadIdx.x; asm volatile("" : "+v"(tid)); const int lane = tid & 63, wave = __builtin_amdgcn_readfirstlane(tid >> 6);
    int G = gridDim.x, bx = blockIdx.x; asm volatile("" : "+s"(G), "+s"(bx)); const int gw = bx * 8 + wave, NGW = G * 8;
    unsigned char* lds = (unsigned char*)L; LAS int* lcnt = (LAS int*)(L + 0); LAS int* gt = (LAS int*)(L + LDS_MISC + 512);
    (void)lane; (void)gw; (void)NGW; (void)lds; (void)lcnt; (void)gt; (void)layer; (void)slot; (void)tid; (void)bx; (void)G;
    { KArgs A = kargs(); const float* x = A->out; const float* g = A->norm_cross + (size_t)layer * D; bf16* HB = (bf16*)(A->ws + WS_HB);
            for (int m = gw; m < M; m += NGW) norm_row_bf16(x + (size_t)m * D, g, HB + (size_t)m * D, lane); }
}
template <int COPY> __device__ __forceinline__ void ph7(LAS unsigned char* L, int layer, int slot) {
    if (COPY) asm volatile("s_nop 0" ::: "memory");
    int tid = threadIdx.x; asm volatile("" : "+v"(tid)); const int lane = tid & 63, wave = __builtin_amdgcn_readfirstlane(tid >> 6);
    int G = gridDim.x, bx = blockIdx.x; asm volatile("" : "+s"(G), "+s"(bx)); const int gw = bx * 8 + wave, NGW = G * 8;
    unsigned char* lds = (unsigned char*)L; LAS int* lcnt = (LAS int*)(L + 0); LAS int* gt = (LAS int*)(L + LDS_MISC + 512);
    (void)lane; (void)gw; (void)NGW; (void)lds; (void)lcnt; (void)gt; (void)layer; (void)slot; (void)tid; (void)bx; (void)G;
    {
            unsigned char* ws = kargs()->ws; unsigned char* wb = ws + WS_W + (size_t)layer * W_LAYER;
            pg8::GridSched S{(const char*)(ws + WS_HB), (const char*)(wb + W_XQ), 2048u, 2048u, 128, 4, 16, G, bx};
            EpiPlain E{(bf16*)(ws + WS_XQ), D, 1.f, (const u64*)(ws + WS_SS) + (size_t)(3 * layer + 1) * M};
            pg8::gemm_stream(L, S, E, 2048u, 2048u);
        }
}
__device__ __forceinline__ void ph8(LAS unsigned char* L, int layer, int slot) {
    int tid = threadIdx.x; asm volatile("" : "+v"(tid)); const int lane = tid & 63, wave = __builtin_amdgcn_readfirstlane(tid >> 6);
    int G = gridDim.x, bx = blockIdx.x; asm volatile("" : "+s"(G), "+s"(bx)); const int gw = bx * 8 + wave, NGW = G * 8;
    unsigned char* lds = (unsigned char*)L; LAS int* lcnt = (LAS int*)(L + 0); LAS int* gt = (LAS int*)(L + LDS_MISC + 512);
    (void)lane; (void)gw; (void)NGW; (void)lds; (void)lcnt; (void)gt; (void)layer; (void)slot; (void)tid; (void)bx; (void)G;
    {
            unsigned char* ws = kargs()->ws;
            unsigned char* wb = ws + WS_W + (size_t)layer * W_LAYER;
            CrossFusedSched S{(const char*)(ws + WS_HB), (const char*)(wb + W_XQ), (const char*)(ws + WS_XQ), (const char*)(ws + WS_KX) + (size_t)layer * MROWS * D * 2,
                              (const char*)(ws + WS_XP), (const char*)(ws + WS_VTB) + (size_t)layer * 8 * D * D * 2, G, bx};
            EpiCross E{EpiPlain{(bf16*)(ws + WS_XQ), D, 1.f, (const u64*)(ws + WS_SS) + (size_t)(3 * layer + 1) * M},
                       EpiSoftmax{(bf16*)(ws + WS_XP), (LAS f32x2*)(L + LDS_XCH), 0.0625f * 1.44269504f},
                       EpiPlainT<true>{(bf16*)(ws + WS_XO), D, F8_OSCALE, nullptr}};
            pg8::gemm_stream(L, S, E, 2048u, 2048u);
        }
}
__device__ __forceinline__ void ph9(LAS unsigned char* L, int layer, int slot) {
    int tid = threadIdx.x; asm volatile("" : "+v"(tid)); const int lane = tid & 63, wave = __builtin_amdgcn_readfirstlane(tid >> 6);
    int G = gridDim.x, bx = blockIdx.x; asm volatile("" : "+s"(G), "+s"(bx)); const int gw = bx * 8 + wave, NGW = G * 8;
    unsigned char* lds = (unsigned char*)L; LAS int* lcnt = (LAS int*)(L + 0); LAS int* gt = (LAS int*)(L + LDS_MISC + 512);
    (void)lane; (void)gw; (void)NGW; (void)lds; (void)lcnt; (void)gt; (void)layer; (void)slot; (void)tid; (void)bx; (void)G;
    {
            unsigned char* ws = kargs()->ws;
            CrossSched S{(const char*)(ws + WS_XP), (const char*)(ws + WS_VT) + (size_t)layer * D * MROWS * 2, 1, G, bx};
            EpiPlain E{(bf16*)(ws + WS_XO), D, 1.f, nullptr};
            pg8::gemm_stream(L, S, E, 2048u, 4096u);
        }
}
__device__ __forceinline__ void ph10(LAS unsigned char* L, int layer, int slot) {
    int tid = threadIdx.x; asm volatile("" : "+v"(tid)); const int lane = tid & 63, wave = __builtin_amdgcn_readfirstlane(tid >> 6);
    int G = gridDim.x, bx = blockIdx.x; asm volatile("" : "+s"(G), "+s"(bx)); const int gw = bx * 8 + wave, NGW = G * 8;
    unsigned char* lds = (unsigned char*)L; LAS int* lcnt = (LAS int*)(L + 0); LAS int* gt = (LAS int*)(L + LDS_MISC + 512);
    (void)lane; (void)gw; (void)NGW; (void)lds; (void)lcnt; (void)gt; (void)layer; (void)slot; (void)tid; (void)bx; (void)G;
    {
            KArgs A = kargs(); unsigned char* ws = A->ws; unsigned char* wb = ws + WS_W + (size_t)layer * W_LAYER;
            pg8::GridSched S{(const char*)(ws + WS_XO), (const char*)(wb + W_XO), 1024u, 1024u, 128, 4, 8, G, bx};
            EpiResT<true> E{(bf16*)(ws + WS_HB), (u64*)(ws + WS_SS) + (size_t)(3 * layer + 2) * M, ws + WS_XF8, 1.f / (F8_OSCALE * F8_WSCALE)};
            pg8::gemm_stream<EpiResT<true>, pg8::GridSched, 1>(L, S, E, 1024u, 1024u);
        }
}
__device__ __forceinline__ void ph11(LAS unsigned char* L, int layer, int slot) {
    int tid = threadIdx.x; asm volatile("" : "+v"(tid)); const int lane = tid & 63, wave = __builtin_amdgcn_readfirstlane(tid >> 6);
    int G = gridDim.x, bx = blockIdx.x; asm volatile("" : "+s"(G), "+s"(bx)); const int gw = bx * 8 + wave, NGW = G * 8;
    unsigned char* lds = (unsigned char*)L; LAS int* lcnt = (LAS int*)(L + 0); LAS int* gt = (LAS int*)(L + LDS_MISC + 512);
    (void)lane; (void)gw; (void)NGW; (void)lds; (void)lcnt; (void)gt; (void)layer; (void)slot; (void)tid; (void)bx; (void)G;
    { KArgs A = kargs(); const float* x = A->out; const float* g = A->norm_ffn; bf16* HB = (bf16*)(A->ws + WS_HB);
                for (int m = gw; m < M; m += NGW) norm_row_bf16(x + (size_t)m * D, g, HB + (size_t)m * D, lane); }
}
__device__ __forceinline__ void ph12(LAS unsigned char* L, int layer, int slot) {
    int tid = threadIdx.x; asm volatile("" : "+v"(tid)); const int lane = tid & 63, wave = __builtin_amdgcn_readfirstlane(tid >> 6);
    int G = gridDim.x, bx = blockIdx.x; asm volatile("" : "+s"(G), "+s"(bx)); const int gw = bx * 8 + wave, NGW = G * 8;
    unsigned char* lds = (unsigned char*)L; LAS int* lcnt = (LAS int*)(L + 0); LAS int* gt = (LAS int*)(L + LDS_MISC + 512);
    (void)lane; (void)gw; (void)NGW; (void)lds; (void)lcnt; (void)gt; (void)layer; (void)slot; (void)tid; (void)bx; (void)G;
    {
                unsigned char* ws = kargs()->ws;
                pg8::GridSched S{(const char*)(ws + WS_XF8), (const char*)(ws + WS_WGU), 1024u, 1024u, 128, 28, 8, G, bx};
                EpiGU E{(bf16*)(ws + WS_HID), (const u64*)(ws + WS_SS) + (size_t)2 * M, 1.f / F8_WSCALE};
                pg8::gemm_stream<EpiGU, pg8::GridSched, 1>(L, S, E, 1024u, 1024u);
            }
}
__device__ __forceinline__ void ph13(LAS unsigned char* L, int layer, int slot) {
    int tid = threadIdx.x; asm volatile("" : "+v"(tid)); const int lane = tid & 63, wave = __builtin_amdgcn_readfirstlane(tid >> 6);
    int G = gridDim.x, bx = blockIdx.x; asm volatile("" : "+s"(G), "+s"(bx)); const int gw = bx * 8 + wave, NGW = G * 8;
    unsigned char* lds = (unsigned char*)L; LAS int* lcnt = (LAS int*)(L + 0); LAS int* gt = (LAS int*)(L + LDS_MISC + 512);
    (void)lane; (void)gw; (void)NGW; (void)lds; (void)lcnt; (void)gt; (void)layer; (void)slot; (void)tid; (void)bx; (void)G;
    {
                KArgs A = kargs(); unsigned char* ws = A->ws;
                pg8::GridSched S{(const char*)(ws + WS_HID), (const char*)(ws + WS_WDN), 3584u, 3584u, 128, 4, 28, G, bx};
                EpiResT<true> E{(bf16*)(ws + WS_HB), (u64*)(ws + WS_SS) + (size_t)(3) * M, ws + WS_XF8, 1.f / (F8_HSCALE * F8_WSCALE)};
                pg8::gemm_stream<EpiResT<true>, pg8::GridSched, 1>(L, S, E, 3584u, 3584u);
            }
}
__device__ __forceinline__ void ph14(LAS unsigned char* L, int layer, int slot) {
    int tid = threadIdx.x; asm volatile("" : "+v"(tid)); const int lane = tid & 63, wave = __builtin_amdgcn_readfirstlane(tid >> 6);
    int G = gridDim.x, bx = blockIdx.x; asm volatile("" : "+s"(G), "+s"(bx)); const int gw = bx * 8 + wave, NGW = G * 8;
    unsigned char* lds = (unsigned char*)L; LAS int* lcnt = (LAS int*)(L + 0); LAS int* gt = (LAS int*)(L + LDS_MISC + 512);
    (void)lane; (void)gw; (void)NGW; (void)lds; (void)lcnt; (void)gt; (void)layer; (void)slot; (void)tid; (void)bx; (void)G;
    { KArgs A = kargs(); const float* x = A->out; const float* g = A->norm_mix + D; bf16* HB = (bf16*)(A->ws + WS_HB);
                for (int m = gw; m < M; m += NGW) norm_row_bf16(x + (size_t)m * D, g, HB + (size_t)m * D, lane); }
}
__device__ __forceinline__ void ph15(LAS unsigned char* L, int layer, int slot) {
    int tid = threadIdx.x; asm volatile("" : "+v"(tid)); const int lane = tid & 63, wave = __builtin_amdgcn_readfirstlane(tid >> 6);
    int G = gridDim.x, bx = blockIdx.x; asm volatile("" : "+s"(G), "+s"(bx)); const int gw = bx * 8 + wave, NGW = G * 8;
    unsigned char* lds = (unsigned char*)L; LAS int* lcnt = (LAS int*)(L + 0); LAS int* gt = (LAS int*)(L + LDS_MISC + 512);
    (void)lane; (void)gw; (void)NGW; (void)lds; (void)lcnt; (void)gt; (void)layer; (void)slot; (void)tid; (void)bx; (void)G;
    {
                KArgs A = kargs(); unsigned char* ws = A->ws; unsigned* ctl = (unsigned*)(ws + WS_CTL);
                int* route = (int*)(ws + WS_ROUTE); bf16* HB = (bf16*)(ws + WS_HB);
                if (tid < 16) lcnt[tid] = 0;
                __syncthreads();
                const float* gn = A->norm_ffn + D; const float* rwt = A->router_w; const u64* ss5 = (const u64*)(ws + WS_SS) + (size_t)5 * M;
                f32x4 rwr[4][4][2];
#pragma unroll
                for (int j = 0; j < 4; ++j) { const f32x4 gg = ((const f32x4*)gn + lane)[64 * j]; const float* rw = rwt + (size_t)(256 * j + 4 * lane) * 8;
#pragma unroll
                    for (int q = 0; q < 4; ++q) { rwr[j][q][0] = *(const f32x4*)(rw + 8 * q) * gg[q]; rwr[j][q][1] = *(const f32x4*)(rw + 8 * q + 4) * gg[q]; } }
                for (int m = gw; m < M; m += NGW) {
                    const u32x2* xr = (const u32x2*)(HB + (size_t)m * D) + lane;
                    const float rstd = rstd_of(ss5[m]);
                    float lg[8];
#pragma unroll
                    for (int e = 0; e < 8; ++e) lg[e] = 0.f;
#pragma unroll
                    for (int j = 0; j < 4; ++j) { const u32x2 xv = xr[64 * j];
                        const f32x4 hv = (f32x4){__uint_as_float(xv.x << 16), __uint_as_float(xv.x & 0xffff0000u), __uint_as_float(xv.y << 16), __uint_as_float(xv.y & 0xffff0000u)} * rstd;
#pragma unroll
                        for (int q = 0; q < 4; ++q) { const f32x4 r0 = rwr[j][q][0], r1 = rwr[j][q][1]; const float hq = hv[q];
                            lg[0] += hq * r0.x; lg[1] += hq * r0.y; lg[2] += hq * r0.z; lg[3] += hq * r0.w; lg[4] += hq * r1.x; lg[5] += hq * r1.y; lg[6] += hq * r1.z; lg[7] += hq * r1.w; } }
#pragma unroll
                    for (int e = 0; e < 8; ++e) lg[e] = wave_sum(lg[e]);
                    int e0 = 0; float v0 = lg[0];
#pragma unroll
                    for (int e = 1; e < 8; ++e) if (lg[e] > v0) { v0 = lg[e]; e0 = e; }
                    int e1 = -1; float v1 = -INFINITY;
#pragma unroll
                    for (int e = 0; e < 8; ++e) if (e != e0 && lg[e] > v1) { v1 = lg[e]; e1 = e; }
                    const float ww1 = 1.f / (1.f + __expf(v0 - v1)), ww0 = 1.f - ww1;
                    if (lane == 0) { route[4 * m] = e0; route[4 * m + 1] = e1; ((float*)route)[4 * m + 2] = ww0; ((float*)route)[4 * m + 3] = ww1; atomicAdd((int*)&lcnt[e0], 1); atomicAdd((int*)&lcnt[8 + e1], 1); }
                }
                __syncthreads();
                if (tid < 16) atomicAdd(ctl + CW_CNT + tid, (unsigned)lcnt[tid]);
                __syncthreads();
                LAS float* scr = (LAS float*)(L + wave * 16384);
                constexpr int I_GU = 16 * 224, I_DN = 56 * 32;
                const float* mgu = A->moe_w_gu; const float* mdn = A->moe_w_down;
                for (int r_ = 0; r_ < REP(7); ++r_) {
                    auto decode = [&](int it, ConvItem& c) {
                        const int e = it / (I_GU + I_DN); int r = it % (I_GU + I_DN);
                        if (r < I_GU) { const int kb = r / 224, vb = r % 224, pn = vb >> 3, bj = (vb >> 2) & 1, pb = vb & 3;
                            c.W = mgu + (size_t)e * D * 2 * DFF; c.ldw = 2 * DFF; c.k0 = 64 * kb; c.src = bj * DFF + 128 * pn + 32 * pb; c.gain = gn; c.WT = ws + WS_MWGU + (size_t)e * 2 * DFF * D; c.dpitch = D; c.drow0 = 32 * vb; }
                        else { r -= I_GU; const int kb = r / 32, vb = r % 32;
                            c.W = mdn + (size_t)e * DFF * D; c.ldw = D; c.k0 = 64 * kb; c.src = 32 * vb; c.gain = nullptr; c.WT = ws + WS_MWDN + (size_t)e * D * DFF; c.dpitch = DFF; c.drow0 = 32 * vb; } };
                    const int NIT = 8 * (I_GU + I_DN);
                    int it = gw; ConvItem cur, nxt; f32x4 tvA[8], tvB[8]; float gA[8], gB[8];
                    if (it < NIT) { decode(it, cur); conv_load(cur, tvA, gA, lane); }
                    while (it < NIT) {
                        const int itn = it + NGW;
                        if (itn < NIT) { decode(itn, nxt); conv_load(nxt, tvB, gB, lane); }
                        conv_finish8(cur, tvA, gA, scr, lane);
                        cur = nxt; it = itn;
#pragma unroll
                        for (int i = 0; i < 8; ++i) { tvA[i] = tvB[i]; gA[i] = gB[i]; }
                    }
                }
            }
}
__device__ __forceinline__ void ph16(LAS unsigned char* L, int layer, int slot) {
    int tid = threadIdx.x; asm volatile("" : "+v"(tid)); const int lane = tid & 63, wave = __builtin_amdgcn_readfirstlane(tid >> 6);
    int G = gridDim.x, bx = blockIdx.x; asm volatile("" : "+s"(G), "+s"(bx)); const int gw = bx * 8 + wave, NGW = G * 8;
    unsigned char* lds = (unsigned char*)L; LAS int* lcnt = (LAS int*)(L + 0); LAS int* gt = (LAS int*)(L + LDS_MISC + 512);
    (void)lane; (void)gw; (void)NGW; (void)lds; (void)lcnt; (void)gt; (void)layer; (void)slot; (void)tid; (void)bx; (void)G;
    {
                unsigned char* ws = kargs()->ws; unsigned* ctl = (unsigned*)(ws + WS_CTL);
                int* route = (int*)(ws + WS_ROUTE); int* tokmap = (int*)(ws + WS_TOKMAP); float* roww = (float*)(ws + WS_ROWW); bf16* HB = (bf16*)(ws + WS_HB);
                LAS int* lbase = (LAS int*)(L + 64); LAS int* lc2 = (LAS int*)(L + 128);
                for (int chunk = bx; chunk < M / 128; chunk += G) {
                    if (tid < 16) { lcnt[tid] = 0; lc2[tid] = 0; }
                    __syncthreads();
                    const int m = chunk * 128 + (tid >> 2);
                    const int e0 = route[4 * m], e1 = route[4 * m + 1];
                    if ((tid & 3) == 0) { atomicAdd((int*)&lcnt[e0], 1); atomicAdd((int*)&lcnt[8 + e1], 1); }
                    __syncthreads();
                    if (tid < 16) lbase[tid] = (int)atomicAdd(ctl + CW_CUR + tid, (unsigned)lcnt[tid]) + gt[tid] * 256;
                    __syncthreads();
                    int p0 = 0, p1 = 0;
                    if ((tid & 3) == 0) { p0 = lbase[e0] + atomicAdd((int*)&lc2[e0], 1); p1 = lbase[8 + e1] + atomicAdd((int*)&lc2[8 + e1], 1);
                        tokmap[p0] = m; tokmap[p1] = m; roww[p0] = ((const float*)route)[4 * m + 2]; roww[p1] = ((const float*)route)[4 * m + 3];
                        const u64 sq = ((const u64*)(ws + WS_SS))[(size_t)5 * M + m]; ((u64*)(ws + WS_ROWSS))[p0] = sq; ((u64*)(ws + WS_ROWSS))[p1] = sq; }
                    p0 = __shfl(p0, lane & ~3); p1 = __shfl(p1, lane & ~3);
                    const u32x4* src = (const u32x4*)(ws + WS_XF8 + (size_t)m * D) + (tid & 3) * 16;
                    u32x4* d0 = (u32x4*)(ws + WS_XS + (size_t)p0 * D) + (tid & 3) * 16; u32x4* d1 = (u32x4*)(ws + WS_XS + (size_t)p1 * D) + (tid & 3) * 16;
#pragma unroll 8
                    for (int q = 0; q < 16; ++q) { const u32x4 v = src[q]; d0[q] = v; d1[q] = v; }
                    __syncthreads();
                }
                if (bx < 16) { const int g = bx; const int cntg = (int)__hip_atomic_load(ctl + CW_CNT + g, __ATOMIC_RELAXED, __HIP_MEMORY_SCOPE_AGENT);
                    for (int r = gt[g] * 256 + cntg + tid; r < gt[g + 1] * 256; r += 512) { tokmap[r] = -1; roww[r] = 0.f; ((u64*)(ws + WS_ROWSS))[r] = (u64)1 << 34; } }
            }
}
__device__ __forceinline__ void ph17(LAS unsigned char* L, int layer, int slot) {
    int tid = threadIdx.x; asm volatile("" : "+v"(tid)); const int lane = tid & 63, wave = __builtin_amdgcn_readfirstlane(tid >> 6);
    int G = gridDim.x, bx = blockIdx.x; asm volatile("" : "+s"(G), "+s"(bx)); const int gw = bx * 8 + wave, NGW = G * 8;
    unsigned char* lds = (unsigned char*)L; LAS int* lcnt = (LAS int*)(L + 0); LAS int* gt = (LAS int*)(L + LDS_MISC + 512);
    (void)lane; (void)gw; (void)NGW; (void)lds; (void)lcnt; (void)gt; (void)layer; (void)slot; (void)tid; (void)bx; (void)G;
    {
                unsigned char* ws = kargs()->ws;
                MoeSched S{(const char*)(ws + WS_XS), (const char*)(ws + WS_MWGU), 1024u, (size_t)2 * DFF * D, 1024u, 0, gt[16], 28, 8, G, bx, (const int*)gt};
                EpiGU E{(bf16*)(ws + WS_MHID), (const u64*)(ws + WS_ROWSS), 1.f / F8_WSCALE};
                pg8::gemm_stream<EpiGU, MoeSched, 1>(L, S, E, 1024u, 1024u);
            }
}
__device__ __forceinline__ void ph18(LAS unsigned char* L, int layer, int slot) {
    int tid = threadIdx.x; asm volatile("" : "+v"(tid)); const int lane = tid & 63, wave = __builtin_amdgcn_readfirstlane(tid >> 6);
    int G = gridDim.x, bx = blockIdx.x; asm volatile("" : "+s"(G), "+s"(bx)); const int gw = bx * 8 + wave, NGW = G * 8;
    unsigned char* lds = (unsigned char*)L; LAS int* lcnt = (LAS int*)(L + 0); LAS int* gt = (LAS int*)(L + LDS_MISC + 512);
    (void)lane; (void)gw; (void)NGW; (void)lds; (void)lcnt; (void)gt; (void)layer; (void)slot; (void)tid; (void)bx; (void)G;
    {
                    KArgs A = kargs(); unsigned char* ws = A->ws;
                    MoeSched S{(const char*)(ws + WS_MHID), (const char*)(ws + WS_MWDN), 3584u, (size_t)D * DFF, 3584u, 0, gt[16], 4, 28, G, bx, (const int*)gt};
                    EpiDownMoe E{(const int*)(ws + WS_TOKMAP), (const float*)(ws + WS_ROWW), (bf16*)(ws + WS_XS), gt[8]};
                    pg8::gemm_stream<EpiDownMoe, MoeSched, 1>(L, S, E, 3584u, 3584u);
                }
}
__device__ __forceinline__ void ph19(LAS unsigned char* L, int layer, int slot) {
    int tid = threadIdx.x; asm volatile("" : "+v"(tid)); const int lane = tid & 63, wave = __builtin_amdgcn_readfirstlane(tid >> 6);
    int G = gridDim.x, bx = blockIdx.x; asm volatile("" : "+s"(G), "+s"(bx)); const int gw = bx * 8 + wave, NGW = G * 8;
    unsigned char* lds = (unsigned char*)L; LAS int* lcnt = (LAS int*)(L + 0); LAS int* gt = (LAS int*)(L + LDS_MISC + 512);
    (void)lane; (void)gw; (void)NGW; (void)lds; (void)lcnt; (void)gt; (void)layer; (void)slot; (void)tid; (void)bx; (void)G;
    { KArgs A = kargs(); float* xo = A->out; const float* gf = A->norm_final; const bf16* XB = (const bf16*)(A->ws + WS_HB); const bf16* Y0 = (const bf16*)(A->ws + WS_XS); const bf16* Y1 = Y0 + (size_t)M * D;
                for (int m = gw; m < M; m += NGW) {
                    const u32x2* xr = (const u32x2*)(XB + (size_t)m * D) + lane; const u32x2* y0 = (const u32x2*)(Y0 + (size_t)m * D) + lane; const u32x2* y1 = (const u32x2*)(Y1 + (size_t)m * D) + lane;
                    f32x4* orow = (f32x4*)(xo + (size_t)m * D) + lane; const f32x4* gr = (const f32x4*)gf + lane;
                    u32x2 a[4], b[4], c[4];
#pragma unroll
                    for (int j = 0; j < 4; ++j) { a[j] = xr[64 * j]; b[j] = y0[64 * j]; c[j] = y1[64 * j]; }
                    f32x4 v[4]; float q = 0.f;
#pragma unroll
                    for (int j = 0; j < 4; ++j) {
                        v[j] = (f32x4){__uint_as_float(a[j].x << 16), __uint_as_float(a[j].x & 0xffff0000u), __uint_as_float(a[j].y << 16), __uint_as_float(a[j].y & 0xffff0000u)}
                             + (f32x4){__uint_as_float(b[j].x << 16), __uint_as_float(b[j].x & 0xffff0000u), __uint_as_float(b[j].y << 16), __uint_as_float(b[j].y & 0xffff0000u)}
                             + (f32x4){__uint_as_float(c[j].x << 16), __uint_as_float(c[j].x & 0xffff0000u), __uint_as_float(c[j].y << 16), __uint_as_float(c[j].y & 0xffff0000u)};
                        q += (v[j].x * v[j].x + v[j].y * v[j].y) + (v[j].z * v[j].z + v[j].w * v[j].w); }
                    const float rstd = 1.f / sqrtf(wave_sum(q) * (1.f / D) + EPS);
#pragma unroll
                    for (int j = 0; j < 4; ++j) orow[64 * j] = v[j] * rstd * gr[64 * j];
                } }
}
__global__ void __launch_bounds__(512, 2) fwd_kernel(Args a_unused) {
    extern __shared__ __attribute__((aligned(16))) unsigned char lds[];
    LAS unsigned char* L = (LAS unsigned char*)lds;
    volatile LAS unsigned* MISC = (volatile LAS unsigned*)(L + LDS_MISC);
    const int tid = threadIdx.x, lane = tid & 63, wave = __builtin_amdgcn_readfirstlane(tid >> 6);
    const int G = gridDim.x, bx = blockIdx.x;
    for (int u = tid; u < 64; u += 512) MISC[u] = 0u;
    __syncthreads();
    XcdBarrier bar; bar.bar = (unsigned*)(kargs()->ws + WS_CTL) + CW_BAR; bar.x = 0; bar.st = nullptr;
    if (!MK_PER_PHASE) bar = xcd_barrier_post(bar.bar, MISC + 8);
    int pid = 0;
    const int lo = kargs()->ph_lo, hi = kargs()->ph_hi;
#define RUN() (pid >= lo && pid < hi)
#define SEAM() do { if (!MK_PER_PHASE) { xcd_barrier(bar); if (REP(30) > 1) xcd_barrier(bar); } ++pid; } while (0)
    int slotv = 0; (void)lane;

    if (PON(0) && RUN()) for (int r_ = 0; r_ < REP(8); ++r_) ph0(L, 0, 0);
    SEAM();

    for (int layer = 0; layer < DEPTH; ++layer) {
        if (PON(1) && RUN()) for (int r_ = 0; r_ < REP(9); ++r_) ph1(L, layer, slotv);
        SEAM();
        if (PON(2) && RUN()) for (int r_ = 0; r_ < REP(10); ++r_) ph2(L, layer, slotv);
        SEAM();
        if (PON(20) && RUN()) for (int r_ = 0; r_ < REP(28); ++r_) ph20(L, layer, slotv);
        SEAM();
        if (PON(3) && RUN()) for (int r_ = 0; r_ < REP(11); ++r_) ph3(L, layer, slotv);
        SEAM();
        if (PON(4) && RUN()) for (int r_ = 0; r_ < REP(12); ++r_) ph4(L, layer, slotv);
        SEAM();
        if (PON(5) && RUN()) for (int r_ = 0; r_ < REP(13); ++r_) ph5(L, layer, slotv);
        SEAM();
        if (PON(8) && RUN()) for (int r_ = 0; r_ < REP(16); ++r_) ph8(L, layer, slotv);
        SEAM();
        if (PON(10) && RUN()) for (int r_ = 0; r_ < REP(18); ++r_) ph10(L, layer, slotv);
        SEAM();
        if (layer == 0) {
            if (PON(12) && RUN()) for (int r_ = 0; r_ < REP(20); ++r_) ph12(L, layer, slotv);
            SEAM();
            if (PON(13) && RUN()) for (int r_ = 0; r_ < REP(21); ++r_) ph13(L, layer, slotv);
            SEAM();
        } else {
            if (PON(15) && RUN()) for (int r_ = 0; r_ < REP(23); ++r_) ph15(L, layer, slotv);
            SEAM();
            LAS int* gt = (LAS int*)(L + LDS_MISC + 512);
            if (tid == 0) { unsigned* ctl = (unsigned*)(kargs()->ws + WS_CTL); int acc = 0; for (int g = 0; g < 16; ++g) { gt[g] = acc; acc += ((int)__hip_atomic_load(ctl + CW_CNT + g, __ATOMIC_RELAXED, __HIP_MEMORY_SCOPE_AGENT) + 255) >> 8; } gt[16] = acc; }
            __syncthreads();
            if (PON(16) && RUN()) for (int r_ = 0; r_ < REP(24); ++r_) ph16(L, layer, slotv);
            SEAM();
            if (PON(17) && RUN()) for (int r_ = 0; r_ < REP(25); ++r_) ph17(L, layer, slotv);
            SEAM();
            if (PON(18) && RUN()) ph18(L, layer, 0);
            SEAM();
            if (PON(19) && RUN()) for (int r_ = 0; r_ < REP(27); ++r_) ph19(L, layer, slotv);
            ++pid;
        }
    }
#undef RUN
#undef SEAM
}


constexpr int NPHASE = 1 + 10 + 13;
extern "C" void kernel_launch(void* const* d_in, const int* in_sizes, int n_in, void* d_out, int out_size, void* d_ws, size_t ws_size, hipStream_t stream) {
    static int grid = 0;
    if (grid == 0) {
        if (n_in != 22 || out_size != M * D || ws_size < WS_END) { fprintf(stderr, "kernel_launch: unexpected problem (n_in %d out %d ws %zu)\n", n_in, out_size, ws_size); grid = -1; return; }
        int dev = 0, cus = 0;
        if (hipGetDevice(&dev) != hipSuccess || hipDeviceGetAttribute(&cus, hipDeviceAttributeMultiprocessorCount, dev) != hipSuccess) { grid = -1; return; }
        if (hipFuncSetAttribute((const void*)fwd_kernel, hipFuncAttributeMaxDynamicSharedMemorySize, LDS_BYTES) != hipSuccess) { fprintf(stderr, "kernel_launch: hipFuncSetAttribute failed\n"); grid = -1; return; }
        int per_cu = 0;
        (void)hipOccupancyMaxActiveBlocksPerMultiprocessor(&per_cu, (const void*)fwd_kernel, 512, LDS_BYTES);
        (void)hipGetLastError();
        if (per_cu < 1) fprintf(stderr, "kernel_launch: occupancy query says %d\n", per_cu);
        grid = cus;
    }
    if (grid < 0) return;
    (void)hipMemsetAsync((char*)d_ws + WS_CTL, 0, CTL_ZERO_BYTES, stream);
    Args a{};
    a.x = (const float*)d_in[0]; a.mem = (const float*)d_in[1]; a.positions = (const int*)d_in[2]; a.norm_mix = (const float*)d_in[3]; a.w_in = (const float*)d_in[4];
    a.attn_sink = (const float*)d_in[5]; a.w_branch = (const float*)d_in[6]; a.w_out = (const float*)d_in[7]; a.pool_w = (const float*)d_in[8]; a.pool_scale = (const float*)d_in[9];
    a.norm_cross = (const float*)d_in[10]; a.norm_mem = (const float*)d_in[11]; a.w_xq = (const float*)d_in[12]; a.w_xkv = (const float*)d_in[13]; a.w_xo = (const float*)d_in[14];
    a.norm_ffn = (const float*)d_in[15]; a.dense_w_gu = (const float*)d_in[16]; a.dense_w_down = (const float*)d_in[17]; a.router_w = (const float*)d_in[18];
    a.moe_w_gu = (const float*)d_in[19]; a.moe_w_down = (const float*)d_in[20]; a.norm_final = (const float*)d_in[21];
    a.out = (float*)d_out; a.ws = (unsigned char*)d_ws;
#if MK_PER_PHASE
    for (int p = 0; p < NPHASE; ++p) { a.ph_lo = p; a.ph_hi = p + 1; hipLaunchKernelGGL(fwd_kernel, dim3(grid), dim3(512), LDS_BYTES, stream, a); }
#else
    a.ph_lo = 0; a.ph_hi = NPHASE;
    hipLaunchKernelGGL(fwd_kernel, dim3(grid), dim3(512), LDS_BYTES, stream, a);
#endif
}
```

```cpp
#include <hip/hip_runtime.h>
#include <cstdio>
#include <cstdint>

#ifndef MK_PER_PHASE
#define MK_PER_PHASE 0
#endif

#ifndef PHASE_MASK
#define PHASE_MASK 0xFFFFFFFFu
#endif
#define PON(k) ((PHASE_MASK >> (k)) & 1u)
#ifndef REP_MASK
#define REP_MASK 0u
#endif
#define REP(k) (1 + (int)((REP_MASK >> (k)) & 1u))
#define LAS __attribute__((address_space(3)))
#define GAS __attribute__((address_space(1)))
typedef unsigned short bf16;
typedef short bf16x8 __attribute__((ext_vector_type(8)));
typedef float f32x4 __attribute__((ext_vector_type(4)));
typedef float f32x2 __attribute__((ext_vector_type(2)));
typedef unsigned u32x4 __attribute__((ext_vector_type(4)));
typedef int i32x4 __attribute__((ext_vector_type(4)));
typedef unsigned u32x2 __attribute__((ext_vector_type(2)));
typedef __bf16 bf16x2_t __attribute__((ext_vector_type(2)));
typedef _Float16 h16x8 __attribute__((ext_vector_type(8)));

constexpr int BATCH = 8, T = 4096, D = 1024, M = BATCH * T, DEPTH = 2;
constexpr int D_IN = 8004, NPROJ = 4096, DFF = 3584, NEXP = 8, MEMLEN = 256, MROWS = BATCH * MEMLEN;
constexpr float EPS = 1e-6f;
constexpr int C_AQ = 0, C_AK = 512, C_AV = 640, C_BQ = 768, C_BK = 1280, C_BV = 1408, C_IQ = 1536, C_IK = 1792, C_RQ = 1856, C_RK = 2112, C_RV = 2368, C_RG = 2880, C_PU = 3392, C_IW = 3904;
constexpr unsigned long long ROPE_MASK = 0x3FFull | (0x3FFull << 12) | (0x1FFFull << 24);

constexpr size_t MiB = 1u << 20;
constexpr size_t WS_CTL = 0, CTL_ZERO_BYTES = 2 * MiB;
constexpr size_t WS_SS = 128 * 1024;
constexpr size_t WS_ROUTE = 2 * MiB;
constexpr size_t WS_TOKMAP = 2 * MiB + 512 * 1024;
constexpr size_t WS_ROWW = 3 * MiB;
constexpr size_t WS_ROWSS = 3 * MiB + 384 * 1024;
constexpr size_t WS_HB = 4 * MiB;
constexpr size_t WS_ROPE = 68 * MiB;
constexpr size_t WS_MN = 76 * MiB;
constexpr size_t WS_KX = 84 * MiB;
constexpr size_t WS_VT = 92 * MiB;
constexpr size_t WS_W = 100 * MiB;
constexpr size_t W_IN = 0, W_G = 8 * MiB, W_B = 16 * MiB, W_OUT = 20 * MiB, W_XQ = 22 * MiB, W_XK = 24 * MiB, W_XV = 26 * MiB, W_XO = 28 * MiB, W_LAYER = 30 * MiB;
constexpr size_t WS_WGU = WS_W + 2 * W_LAYER;
constexpr size_t WS_WDN = WS_WGU + 14 * MiB;
constexpr size_t WS_R = 181 * MiB;
constexpr size_t WS_PROJ = WS_R;
constexpr size_t WS_BR01 = WS_R + 256 * MiB;
constexpr size_t WS_BR23 = WS_R + 320 * MiB;
constexpr size_t WS_U = WS_R + 384 * MiB;
constexpr size_t WS_R_END = WS_R + 416 * MiB;
constexpr size_t WS_AKV = 600 * MiB;
constexpr size_t WS_BKV = 616 * MiB;
constexpr size_t WS_IK = 632 * MiB;
constexpr size_t WS_VTB = 656 * MiB;
constexpr size_t WS_WPOOL = 652 * MiB;
constexpr size_t WS_ST = 636 * MiB;
constexpr size_t WS_MSCR = WS_PROJ;
constexpr size_t WS_MERGED = WS_PROJ + 192 * MiB;
constexpr size_t WS_XQ = WS_PROJ;
constexpr size_t WS_XP = WS_PROJ + 64 * MiB;
constexpr size_t WS_XO = WS_PROJ + 128 * MiB;
constexpr size_t WS_HID = WS_PROJ;
constexpr int MOE_ROWS = 2 * M + 16 * 256;
constexpr size_t WS_MWGU = 100 * MiB;
constexpr size_t WS_MWDN = 212 * MiB;
constexpr size_t WS_MHID = 268 * MiB;
constexpr size_t WS_XS = 744 * MiB;
constexpr size_t WS_XF8 = 812 * MiB;
constexpr size_t WS_END = 880 * MiB;
static_assert(WS_MHID + (size_t)MOE_ROWS * DFF * 2 <= WS_XS && WS_XS + (size_t)MOE_ROWS * D * 2 <= WS_END, "moe map");
static_assert(WS_WDN + 7 * MiB <= WS_R, "weights map");
constexpr int CW_BAR = 4096;
constexpr int CW_CNT = 16384;
constexpr int CW_CUR = 16384 + 64;

constexpr int LDS_STAGE = 131072;
constexpr int LDS_XCH = 131072;
constexpr int LDS_MISC = 131072 + 16384;
constexpr int LDS_BYTES = 131072 + 16384 + 8192;
constexpr int WAVE_LDS = 17408;

__device__ const float INV_FREQ[32] = {1.000000000e+00f, 7.498942018e-01f, 5.623413324e-01f, 4.216965139e-01f, 3.162277639e-01f, 2.371373922e-01f, 1.778279394e-01f, 1.333521456e-01f, 1.000000015e-01f, 7.498941571e-02f, 5.623412877e-02f, 4.216964915e-02f, 3.162277862e-02f, 2.371373586e-02f, 1.778279431e-02f, 1.333521493e-02f, 9.999999776e-03f, 7.498942316e-03f, 5.623413250e-03f, 4.216964822e-03f, 3.162277862e-03f, 2.371373819e-03f, 1.778279431e-03f, 1.333521446e-03f, 1.000000047e-03f, 7.498941850e-04f, 5.623413017e-04f, 4.216965463e-04f, 3.162277862e-04f, 2.371373848e-04f, 1.778279402e-04f, 1.333521504e-04f};
__device__ __forceinline__ float bf2f(unsigned short v) { return __uint_as_float(((unsigned)v) << 16); }
__device__ __forceinline__ unsigned f2bf(float f) { unsigned u = __float_as_uint(f); return (u + 0x7fffu + ((u >> 16) & 1u)) >> 16; }
__device__ __forceinline__ unsigned pk2(float lo, float hi) { return f2bf(lo) | (f2bf(hi) << 16); }
__device__ __forceinline__ unsigned f2bf1(float f) { return (unsigned)__builtin_bit_cast(unsigned short, (__bf16)f); }
__device__ __forceinline__ unsigned cvt_pk_bf16(float lo, float hi) { unsigned r; asm volatile("v_cvt_pk_bf16_f32 %0, %1, %2" : "=v"(r) : "v"(lo), "v"(hi)); return r; }
__device__ __forceinline__ float dot2(unsigned a, unsigned b, float acc) { return __builtin_amdgcn_fdot2_f32_bf16(__builtin_bit_cast(bf16x2_t, a), __builtin_bit_cast(bf16x2_t, b), acc, false); }
__device__ __forceinline__ float wave_sum(float v) {
#pragma unroll
    for (int o = 1; o < 64; o <<= 1) v += __shfl_xor(v, o);
    return v;
}
__device__ __forceinline__ float wave_max(float v) {
#pragma unroll
    for (int o = 1; o < 64; o <<= 1) v = fmaxf(v, __shfl_xor(v, o));
    return v;
}
#define LDS_WAIT() asm volatile("s_waitcnt lgkmcnt(0)" ::: "memory")
typedef unsigned long long u64;
__device__ __forceinline__ float rstd_of(u64 ssfix) { return 1.f / sqrtf((float)ssfix * (5.9604645e-8f / 1024.f) + 1e-6f); }
__device__ __forceinline__ u64 ss_fix(float q) { return (u64)(q * 16777216.f); }
__device__ __forceinline__ unsigned pk4_f8(float a, float b, float c, float d) {
    int w = 0;
    w = __builtin_amdgcn_cvt_pk_fp8_f32(__builtin_amdgcn_fmed3f(a, -448.f, 448.f), __builtin_amdgcn_fmed3f(b, -448.f, 448.f), w, false);
    w = __builtin_amdgcn_cvt_pk_fp8_f32(__builtin_amdgcn_fmed3f(c, -448.f, 448.f), __builtin_amdgcn_fmed3f(d, -448.f, 448.f), w, true);
    return (unsigned)w; }
constexpr float F8_MSCALE = 8.f, F8_OSCALE = 16.f;
constexpr float F8_HSCALE = 4.f;
constexpr float F8_WSCALE = 64.f;

namespace pg8 {
constexpr int BM = 256, BK = 64, HALF = 128, HTB = HALF * BK * 2, STAGE_BYTES = 8 * HTB, NXCD = 8, WGM = 8;
__host__ __device__ __forceinline__ int lds_byte(int r, int c) { const int st = (r >> 4) * 2 + (c >> 5), rr = r & 15, cc = c & 31, ob = rr * 64 + cc * 2; return st * 1024 + (ob ^ (((ob >> 9) & 1) << 5)); }
__host__ __device__ __forceinline__ void stage_rc(int b, int& R, int& C) { const int st = b / 1024, sb = b % 1024, swz = sb ^ (((sb >> 9) & 1) << 5); R = (st >> 1) * 16 + swz / 64; C = (st & 1) * 32 + (swz % 64) / 2; }
__host__ __device__ __forceinline__ int perm32(int rho) { const int n = rho >> 4, i = rho & 15; return 8 * (i >> 2) + 4 * n + (i & 3); }

struct Unit { const char* A; const char* B; int nt; int pm, pn, kind; };

__device__ __forceinline__ void tile_of(int wgid, int nM, int nN, int& pm, int& pn) {
    const int nwg = nM * nN;
    { const int q = nwg / NXCD, r = nwg % NXCD, xcd = wgid % NXCD, off = wgid / NXCD; wgid = (xcd < r ? xcd * (q + 1) : r * (q + 1) + (xcd - r) * q) + off; }
    const int nig = WGM * nN, gid = wgid / nig, fm = gid * WGM, gsz = (nM - fm) < WGM ? (nM - fm) : WGM;
    pm = fm + ((wgid % nig) % gsz); pn = (wgid % nig) / gsz;
}
struct GridSched {
    const char* A; const char* B; unsigned lda, ldb; int nM, nN, nt, G, c;
    __device__ __forceinline__ bool next(int i, Unit& u) const {
        const long L = (long)i * G + c; if (L >= (long)nM * nN) return false;
        tile_of((int)L, nM, nN, u.pm, u.pn);
        u.A = A + (size_t)u.pm * 256 * lda; u.B = B + (size_t)u.pn * 256 * ldb; u.nt = nt; u.kind = 0; return true;
    }
};

template <class Epi, class Sched, int F8 = 0>
__device__ __forceinline__ void gemm_stream(LAS unsigned char* lds, const Sched& S, const Epi& E, const unsigned lda, const unsigned ldb) {
    int tid = threadIdx.x; asm volatile("" : "+v"(tid));
    const int wid = __builtin_amdgcn_readfirstlane(tid >> 6), lane = tid & 63, wr = wid >> 2, wc = wid & 3, fr = lane & 15, fq = lane >> 4;
    unsigned voffA, voffB;
    { int R, C; stage_rc(tid * 16, R, C); const int Rb = (R & ~31) + perm32(R & 31); voffA = (unsigned)R * lda + (unsigned)C * 2u; voffB = (unsigned)Rb * ldb + (unsigned)C * 2u; }
    const size_t kstep = (size_t)(BK * 2);
    const size_t hA = (size_t)HALF * lda, hB = (size_t)HALF * ldb, qA = (size_t)64 * lda, qB = (size_t)64 * ldb;
    const unsigned ldsw = (unsigned)wid * 1024u;
    const int aoff = lds_byte(wr * 64 + fr, fq * 8), boff = lds_byte(wc * 32 + fr, fq * 8);
#define PG8_SA(b, h) (((b) * 2 + (h)) * HTB)
#define PG8_SB(b, h) ((4 + (b) * 2 + (h)) * HTB)
#define PG8_STAGE(bufoff, gbase, voff) do { \
        __builtin_amdgcn_global_load_lds((const unsigned*)((const char*)(gbase) + (voff)), (LAS unsigned*)(lds + (bufoff) + ldsw), 16, 0, 0); \
        __builtin_amdgcn_global_load_lds((const unsigned*)((const char*)(gbase) + ((&(voff) == &voffA) ? qA : qB) + (voff)), (LAS unsigned*)(lds + (bufoff) + ldsw + 8192), 16, 0, 0); } while (0)
#define PG8_LDA(dst, b, h) do { _Pragma("unroll") for (int m = 0; m < 4; ++m) _Pragma("unroll") for (int k = 0; k < 2; ++k) dst[m][k] = *(const LAS bf16x8*)(lds + PG8_SA(b, h) + aoff + m * 2048 + k * 1024); } while (0)
#define PG8_LDB(dst, b, h) do { _Pragma("unroll") for (int n = 0; n < 2; ++n) _Pragma("unroll") for (int k = 0; k < 2; ++k) dst[n][k] = *(const LAS bf16x8*)(lds + PG8_SB(b, h) + boff + n * 2048 + k * 1024); } while (0)
#define PG8_MMA(ai, bj, At, Bt) do { __builtin_amdgcn_s_setprio(1); _Pragma("unroll") for (int m = 0; m < 4; ++m) _Pragma("unroll") for (int n = 0; n < 2; ++n) _Pragma("unroll") for (int k = 0; k < 2; ++k) \
        acc[ai][bj][m][n] = __builtin_amdgcn_mfma_f32_16x16x32_bf16(Bt[n][k], At[m][k], acc[ai][bj][m][n], 0, 0, 0); __builtin_amdgcn_s_setprio(0); } while (0)
#define PG8_CAT(x) __builtin_shufflevector(__builtin_bit_cast(i32x4, x[0]), __builtin_bit_cast(i32x4, x[1]), 0, 1, 2, 3, 4, 5, 6, 7)
#define PG8_MMA8(ai, bj, At, Bt) do { __builtin_amdgcn_s_setprio(1); _Pragma("unroll") for (int m = 0; m < 4; ++m) _Pragma("unroll") for (int n = 0; n < 2; ++n) \
        asm volatile("v_mfma_f32_16x16x128_f8f6f4 %0, %1, %2, %0" : "+v"(acc[ai][bj][m][n]) : "v"(PG8_CAT(Bt[n])), "v"(PG8_CAT(At[m]))); __builtin_amdgcn_s_setprio(0); } while (0)
#define PG8_MM(ai, bj, At, Bt) do { if constexpr (F8) PG8_MMA8(ai, bj, At, Bt); else PG8_MMA(ai, bj, At, Bt); } while (0)
#define PG8_WAIT_V(n) asm volatile("s_waitcnt vmcnt(" #n ")" ::: "memory")
#define PG8_WAIT_L(n) asm volatile("s_waitcnt lgkmcnt(" #n ")" ::: "memory")
#define PG8_BAR __builtin_amdgcn_s_barrier()
#define PG8_SCHED __builtin_amdgcn_sched_barrier(0)
    Unit cur, nxt; int ui = 0;
    if (!S.next(0, cur)) return;
    f32x4 acc[2][2][4][2];
#pragma unroll
    for (int a = 0; a < 2; ++a)
#pragma unroll
        for (int b = 0; b < 2; ++b)
#pragma unroll
            for (int m = 0; m < 4; ++m)
#pragma unroll
                for (int n = 0; n < 2; ++n) acc[a][b][m][n] = (f32x4){0.f, 0.f, 0.f, 0.f};
    bf16x8 At[4][2], B0[2][2], B1[2][2];
    const char* cA = cur.A; const char* cB = cur.B;
    PG8_STAGE(PG8_SB(0, 0), cB, voffB); PG8_STAGE(PG8_SB(0, 1), cB + hB, voffB); PG8_STAGE(PG8_SA(0, 0), cA, voffA); PG8_STAGE(PG8_SA(0, 1), cA + hA, voffA);
    if (wr == 1) PG8_BAR;
    PG8_WAIT_V(2); PG8_BAR;
    PG8_STAGE(PG8_SB(1, 0), cB + kstep, voffB); PG8_STAGE(PG8_SA(1, 0), cA + kstep, voffA); PG8_STAGE(PG8_SB(1, 1), cB + hB + kstep, voffB);
    PG8_WAIT_V(6); PG8_BAR;
    for (;;) {
        const bool has_next = S.next(ui + 1, nxt);
        const char* nA = has_next ? nxt.A : cA; const char* nB = has_next ? nxt.B : cB;
        int nt = cur.nt; asm volatile("" : "+s"(nt));
        asm volatile(".p2align 8" ::: "memory");
#pragma unroll 1
        for (int t = 0; t < nt; t += 2) {
            const bool last = (t == nt - 2);
            const char* a1 = cA + (size_t)(t + 1) * kstep;
            const char* a2 = last ? nA : cA + (size_t)(t + 2) * kstep; const char* b2 = last ? nB : cB + (size_t)(t + 2) * kstep;
            const char* a3 = a2 + kstep; const char* b3 = b2 + kstep;
            if constexpr (Epi::HOOK) {
                if (last && has_next && nxt.kind >= 2) { asm volatile("s_waitcnt vmcnt(0)" ::: "memory"); PG8_BAR; PG8_BAR; asm volatile("" ::: "memory"); } }
            PG8_LDB(B0, 0, 0); PG8_LDB(B1, 0, 1); PG8_SCHED; PG8_LDA(At, 0, 0); PG8_STAGE(PG8_SA(1, 1), a1 + hA, voffA);
            PG8_WAIT_V(8); PG8_WAIT_L(0); PG8_BAR; PG8_MM(0, 0, At, B0); PG8_MM(0, 1, At, B1); PG8_BAR; PG8_SCHED;
            PG8_LDA(At, 0, 1); PG8_STAGE(PG8_SB(0, 0), b2, voffB); PG8_STAGE(PG8_SB(0, 1), b2 + hB, voffB); PG8_STAGE(PG8_SA(0, 0), a2, voffA);
            PG8_WAIT_V(8); PG8_WAIT_L(0); PG8_BAR; PG8_MM(1, 0, At, B0); PG8_MM(1, 1, At, B1); PG8_BAR; PG8_SCHED;
            PG8_LDB(B0, 1, 0); PG8_LDB(B1, 1, 1); PG8_SCHED; PG8_LDA(At, 1, 0); PG8_STAGE(PG8_SA(0, 1), a2 + hA, voffA);
            PG8_WAIT_V(8); PG8_WAIT_L(0); PG8_BAR; PG8_MM(0, 0, At, B0); PG8_MM(0, 1, At, B1); PG8_BAR; PG8_SCHED;
            PG8_LDA(At, 1, 1); PG8_STAGE(PG8_SB(1, 0), b3, voffB); PG8_STAGE(PG8_SB(1, 1), b3 + hB, voffB); PG8_STAGE(PG8_SA(1, 0), a3, voffA);
            PG8_WAIT_V(8); PG8_WAIT_L(0); PG8_BAR; PG8_MM(1, 0, At, B0); PG8_MM(1, 1, At, B1); PG8_BAR; PG8_SCHED;
        }
        if constexpr (F8) asm volatile("s_nop 7\n\ts_nop 7\n\ts_nop 7" ::: "memory");
        if constexpr (Epi::ALIGN) { if (wr == 0) PG8_BAR; }
        if constexpr (Epi::TWICE) { if (REP(26) > 1) (void)E(acc, cur, wr, wc, fr, fq); }
        const bool keep = E(acc, cur, wr, wc, fr, fq);
        if (!has_next) break;
        if constexpr (Epi::CHAIN) {
            const float kf = keep ? 1.f : 0.f;
#pragma unroll
            for (int a = 0; a < 2; ++a)
#pragma unroll
                for (int b = 0; b < 2; ++b)
#pragma unroll
                    for (int m = 0; m < 4; ++m)
#pragma unroll
                        for (int n = 0; n < 2; ++n) acc[a][b][m][n] = acc[a][b][m][n] * kf;
        } else {
#pragma unroll
            for (int a = 0; a < 2; ++a)
#pragma unroll
                for (int b = 0; b < 2; ++b)
#pragma unroll
                    for (int m = 0; m < 4; ++m)
#pragma unroll
                        for (int n = 0; n < 2; ++n) acc[a][b][m][n] = (f32x4){0.f, 0.f, 0.f, 0.f};
        }
        cur = nxt; cA = nA; cB = nB; ++ui;
        if constexpr (Epi::ALIGN) { if (wr == 1) PG8_BAR; }
    }
    PG8_WAIT_V(0);
    if constexpr (!Epi::ALIGN) { if (wr == 0) PG8_BAR; }
    PG8_BAR;
#undef PG8_SA
#undef PG8_SB
#undef PG8_STAGE
#undef PG8_LDA
#undef PG8_LDB
#undef PG8_MMA
#undef PG8_MMA8
#undef PG8_MM
#undef PG8_CAT
#undef PG8_WAIT_V
#undef PG8_WAIT_L
#undef PG8_BAR
#undef PG8_SCHED
}
}
using pg8::Unit;

#define EPI_ARGS f32x4 (&acc)[2][2][4][2], const Unit& u, int wr, int wc, int fr_in, int fq_in
#define EPI_LANE int lane_l = threadIdx.x & 63; asm volatile("" : "+v"(lane_l)); const int fr = lane_l & 15, fq = lane_l >> 4; (void)fr_in; (void)fq_in;
#ifndef EPI_ALIGN
#define EPI_ALIGN true
#endif
struct EpiProj {
    static constexpr bool CHAIN = false, TWICE = true;
    static constexpr bool HOOK = false;
    static constexpr bool ALIGN = true;
    bf16* O; const _Float16* cosT; const _Float16* sinT; bf16* AKV; bf16* BKV; bf16* IK; const u64* ss;
    __device__ __forceinline__ bool operator()(EPI_ARGS) const {
        EPI_LANE
        const int g = 4 * u.pn + wc; const bool rope = (ROPE_MASK >> g) & 1ull;
        const int row0 = u.pm * 256 + wr * 64 + fr;
        u64 sq[8];
#pragma unroll
        for (int k = 0; k < 8; ++k) sq[k] = ss[row0 + (k >> 2) * 128 + (k & 3) * 16];
#pragma unroll
        for (int ai = 0; ai < 2; ++ai) {
            h16x8 ct[4], st[4];
            if (rope) {
#pragma unroll
                for (int k = 0; k < 4; ++k) { const int rr = row0 + ai * 128 + k * 16; const size_t ro = ((size_t)((rr >> 4) * 4 + fq) * 16 + (rr & 15)) * 8;
                    ct[k] = *(const h16x8*)(cosT + ro); st[k] = *(const h16x8*)(sinT + ro); }
            }
#pragma unroll
            for (int m = 0; m < 4; ++m) {
                const int r = row0 + ai * 128 + m * 16;
                const float rs = rstd_of(sq[ai * 4 + m]);
                f32x4 x1a = acc[ai][0][m][0] * rs, x1b = acc[ai][0][m][1] * rs, x2a = acc[ai][1][m][0] * rs, x2b = acc[ai][1][m][1] * rs;
                if (rope) {
                    const h16x8 c8 = ct[m], s8 = st[m];
                    const f32x4 ca = (f32x4){(float)c8[0], (float)c8[1], (float)c8[2], (float)c8[3]}, cb = (f32x4){(float)c8[4], (float)c8[5], (float)c8[6], (float)c8[7]};
                    const f32x4 sa = (f32x4){(float)s8[0], (float)s8[1], (float)s8[2], (float)s8[3]}, sb = (f32x4){(float)s8[4], (float)s8[5], (float)s8[6], (float)s8[7]};
                    const f32x4 o1a = x1a * ca - x2a * sa, o1b = x1b * cb - x2b * sb, o2a = x2a * ca + x1a * sa, o2b = x2b * cb + x1b * sb;
                    x1a = o1a; x1b = o1b; x2a = o2a; x2b = o2b;
                }
                bf16* rowp = (g >= 8 && g < 12) ? AKV + (size_t)r * 256 + 64 * (g - 8) + 8 * fq : (g >= 20 && g < 24) ? BKV + (size_t)r * 256 + 64 * (g - 20) + 8 * fq
                           : (g == 28) ? IK + ((size_t)((r >> 5) * 4 + (fq >> 1)) * 64 + (fq & 1) * 32 + (r & 31)) * 8 : O + (size_t)r * NPROJ + 64 * g + 8 * fq;
                u32x4 w1, w2;
                w1.x = cvt_pk_bf16(x1a[0], x1a[1]); w1.y = cvt_pk_bf16(x1a[2], x1a[3]); w1.z = cvt_pk_bf16(x1b[0], x1b[1]); w1.w = cvt_pk_bf16(x1b[2], x1b[3]);
                w2.x = cvt_pk_bf16(x2a[0], x2a[1]); w2.y = cvt_pk_bf16(x2a[2], x2a[3]); w2.z = cvt_pk_bf16(x2b[0], x2b[1]); w2.w = cvt_pk_bf16(x2b[2], x2b[3]);
                *(u32x4*)(rowp) = w1; *(u32x4*)(rowp + ((g == 28) ? 1024 : 32)) = w2;
            }
        }
        return false;
    }
};
template <bool F8O> struct EpiPlainT {
    static constexpr bool CHAIN = false, TWICE = true;
    static constexpr bool HOOK = false;
#ifndef EPI_ALIGN
#define EPI_ALIGN true
#endif
    static constexpr bool ALIGN = EPI_ALIGN;
    bf16* O; int ldc; float scale; const u64* ss; size_t pn_stride = 0;
    __device__ __forceinline__ bool operator()(EPI_ARGS) const {
        EPI_LANE
        const int row0 = u.pm * 256 + wr * 64 + fr, col0 = (pn_stride ? 0 : u.pn * 256) + wc * 32 + 8 * fq;
        bf16* Ob = O + (size_t)u.pn * pn_stride;
        u64 sq[8];
#pragma unroll
        for (int k = 0; k < 8; ++k) sq[k] = ss ? ss[row0 + (k >> 2) * 128 + (k & 3) * 16] : 0ull;
#pragma unroll
        for (int ai = 0; ai < 2; ++ai)
#pragma unroll
            for (int m = 0; m < 4; ++m) { bf16* rowp = Ob + (size_t)(row0 + ai * 128 + m * 16) * ldc + col0;
                const float sc_ = ss ? rstd_of(sq[ai * 4 + m]) : scale;
#pragma unroll
                for (int bj = 0; bj < 2; ++bj) { const f32x4 v0 = acc[ai][bj][m][0] * sc_, v1 = acc[ai][bj][m][1] * sc_;
                    if constexpr (F8O) {
                        u32x2 w8; w8.x = pk4_f8(v0[0], v0[1], v0[2], v0[3]); w8.y = pk4_f8(v1[0], v1[1], v1[2], v1[3]);
                        *(u32x2*)((unsigned char*)Ob + (size_t)(row0 + ai * 128 + m * 16) * ldc + col0 + bj * 128) = w8;
                    } else {
                    u32x4 w; w.x = cvt_pk_bf16(v0[0], v0[1]); w.y = cvt_pk_bf16(v0[2], v0[3]); w.z = cvt_pk_bf16(v1[0], v1[1]); w.w = cvt_pk_bf16(v1[2], v1[3]);
                    *(u32x4*)(rowp + bj * 128) = w; } } }
        return false;
    }
};
typedef EpiPlainT<false> EpiPlain;
template <bool F8OUT> struct EpiResT {
    static constexpr bool CHAIN = false, TWICE = false;
    static constexpr bool HOOK = false;
#ifndef EPI_ALIGN
#define EPI_ALIGN true
#endif
    static constexpr bool ALIGN = EPI_ALIGN;
    bf16* X; u64* ssn; unsigned char* X8 = nullptr; float sc = 1.f;
    __device__ __forceinline__ bool operator()(EPI_ARGS) const {
        EPI_LANE
        const int row0 = u.pm * 256 + wr * 64 + fr, col0 = u.pn * 256 + wc * 32 + 8 * fq;
#pragma unroll
        for (int ai = 0; ai < 2; ++ai) {
            u32x4 xv[4][2];
#pragma unroll
            for (int m = 0; m < 4; ++m)
#pragma unroll
                for (int bj = 0; bj < 2; ++bj) xv[m][bj] = *(const u32x4*)(X + (size_t)(row0 + ai * 128 + m * 16) * D + col0 + bj * 128);
#pragma unroll
            for (int m = 0; m < 4; ++m) { const int r = row0 + ai * 128 + m * 16; bf16* rowp = X + (size_t)r * D + col0; float q = 0.f;
#pragma unroll
                for (int bj = 0; bj < 2; ++bj) {
                    const u32x4 xq = xv[m][bj];
                    f32x4 v0 = acc[ai][bj][m][0] * sc, v1 = acc[ai][bj][m][1] * sc;
                    v0[0] += __uint_as_float(xq.x << 16); v0[1] += __uint_as_float(xq.x & 0xffff0000u); v0[2] += __uint_as_float(xq.y << 16); v0[3] += __uint_as_float(xq.y & 0xffff0000u);
                    v1[0] += __uint_as_float(xq.z << 16); v1[1] += __uint_as_float(xq.z & 0xffff0000u); v1[2] += __uint_as_float(xq.w << 16); v1[3] += __uint_as_float(xq.w & 0xffff0000u);
                    q += (v0[0] * v0[0] + v0[1] * v0[1]) + (v0[2] * v0[2] + v0[3] * v0[3]) + (v1[0] * v1[0] + v1[1] * v1[1]) + (v1[2] * v1[2] + v1[3] * v1[3]);
                    u32x4 w; w.x = cvt_pk_bf16(v0[0], v0[1]); w.y = cvt_pk_bf16(v0[2], v0[3]); w.z = cvt_pk_bf16(v1[0], v1[1]); w.w = cvt_pk_bf16(v1[2], v1[3]);
                    *(u32x4*)(rowp + bj * 128) = w;
                    if constexpr (F8OUT) { u32x2 w8; w8.x = pk4_f8(v0[0], v0[1], v0[2], v0[3]); w8.y = pk4_f8(v1[0], v1[1], v1[2], v1[3]); *(u32x2*)(X8 + (size_t)r * D + col0 + bj * 128) = w8; } }
                q += __shfl_xor(q, 16); q += __shfl_xor(q, 32);
                if (fq == 0) atomicAdd(ssn + r, ss_fix(q)); }
            asm volatile("" ::: "memory"); }
        return false;
    }
};
typedef EpiResT<false> EpiRes;
struct EpiGate {
    static constexpr bool CHAIN = false, TWICE = true;
    static constexpr bool HOOK = false;
#ifndef EPI_ALIGN
#define EPI_ALIGN true
#endif
    static constexpr bool ALIGN = EPI_ALIGN;
    unsigned* scr; const u64* ss; float wsc;
    __device__ __forceinline__ bool operator()(EPI_ARGS) const {
        EPI_LANE
        const unsigned voff = (unsigned)(((unsigned)__builtin_amdgcn_readfirstlane(threadIdx.x >> 6) * 64u + (unsigned)lane_l) * 16u);
        char* sb = (char*)scr + (size_t)u.kind * 131072;
        u64 sq[8];
#pragma unroll
        for (int k = 0; k < 8; ++k) sq[k] = ss[u.pm * 256 + (k >> 2) * 128 + wr * 64 + (k & 3) * 16 + fr];
#pragma unroll
        for (int ai = 0; ai < 2; ++ai)
#pragma unroll
            for (int m = 0; m < 4; ++m)
#pragma unroll
                for (int bj = 0; bj < 2; ++bj) {
                    const float ns = -1.44269504f * wsc * rstd_of(sq[ai * 4 + m]);
                    f32x4 v0 = acc[ai][bj][m][0], v1 = acc[ai][bj][m][1]; u32x4 w;
#pragma unroll
                    for (int j = 0; j < 4; ++j) { v0[j] = fmaxf(__builtin_amdgcn_rcpf(1.f + __builtin_amdgcn_exp2f(ns * v0[j])), 1e-6f); v1[j] = fmaxf(__builtin_amdgcn_rcpf(1.f + __builtin_amdgcn_exp2f(ns * v1[j])), 1e-6f); }
                    w.x = cvt_pk_bf16(v0[0], v0[1]); w.y = cvt_pk_bf16(v0[2], v0[3]); w.z = cvt_pk_bf16(v1[0], v1[1]); w.w = cvt_pk_bf16(v1[2], v1[3]);
                    *(u32x4*)(sb + (size_t)((ai * 4 + m) * 2 + bj) * 8192 + voff) = w; asm volatile("" ::: "memory"); }
        return false;
    }
};
struct EpiUp {
    static constexpr bool CHAIN = false, TWICE = false;
    static constexpr bool HOOK = false;
#ifndef EPI_ALIGN
#define EPI_ALIGN true
#endif
    static constexpr bool ALIGN = EPI_ALIGN;
    unsigned* scr; bf16* O;
    __device__ __forceinline__ bool operator()(EPI_ARGS) const {
        EPI_LANE
        const unsigned tl = (unsigned)__builtin_amdgcn_readfirstlane(threadIdx.x >> 6) * 64u + (unsigned)lane_l;
        const char* s0 = (const char*)scr + (size_t)u.kind * 131072;
        char* pb = (char*)scr + 4 * 131072;
        const int row0 = u.pm * 256 + wr * 64 + fr, col0 = u.pn * 256 + wc * 32 + 8 * fq;
#pragma unroll
        for (int ai = 0; ai < 2; ++ai) {
            u32x4 av[8], pv[8];
#pragma unroll
            for (int k = 0; k < 8; ++k) { const int slot = ai * 8 + k; av[k] = *(const u32x4*)(s0 + (size_t)slot * 8192 + tl * 16u);
                pv[k] = (u.kind > 0) ? *(const u32x4*)(pb + (size_t)slot * 8192 + tl * 16u) : (u32x4){0u, 0u, 0u, 0u}; }
#pragma unroll
            for (int m = 0; m < 4; ++m)
#pragma unroll
                for (int bj = 0; bj < 2; ++bj) {
                    const int k = m * 2 + bj, slot = ai * 8 + k; const u32x4 a = av[k], q = pv[k];
                    f32x4 p0 = (f32x4){__uint_as_float(q.x << 16), __uint_as_float(q.x & 0xffff0000u), __uint_as_float(q.y << 16), __uint_as_float(q.y & 0xffff0000u)};
                    f32x4 p1 = (f32x4){__uint_as_float(q.z << 16), __uint_as_float(q.z & 0xffff0000u), __uint_as_float(q.w << 16), __uint_as_float(q.w & 0xffff0000u)};
                    const f32x4 f0 = (f32x4){__uint_as_float(a.x << 16), __uint_as_float(a.x & 0xffff0000u), __uint_as_float(a.y << 16), __uint_as_float(a.y & 0xffff0000u)};
                    const f32x4 f1 = (f32x4){__uint_as_float(a.z << 16), __uint_as_float(a.z & 0xffff0000u), __uint_as_float(a.w << 16), __uint_as_float(a.w & 0xffff0000u)};
                    p0 = p0 + acc[ai][bj][m][0] * f0; p1 = p1 + acc[ai][bj][m][1] * f1;
                    u32x4 w; w.x = cvt_pk_bf16(p0[0], p0[1]); w.y = cvt_pk_bf16(p0[2], p0[3]); w.z = cvt_pk_bf16(p1[0], p1[1]); w.w = cvt_pk_bf16(p1[2], p1[3]);
                    if (u.kind < 3) *(u32x4*)(pb + (size_t)slot * 8192 + tl * 16u) = w;
                    else *(u32x4*)(O + (size_t)(row0 + ai * 128 + m * 16) * D + col0 + bj * 128) = w;
                }
            asm volatile("" ::: "memory"); }
        return false;
    }
};
struct EpiSoftmax {
    static constexpr bool CHAIN = false, TWICE = false;
    static constexpr bool HOOK = false;
#ifndef EPI_ALIGN
#define EPI_ALIGN true
#endif
    static constexpr bool ALIGN = true;
    bf16* P; LAS f32x2* xch; float scale_log2;
    __device__ __forceinline__ bool operator()(EPI_ARGS) const {
        EPI_LANE
        LAS f32x2* X = xch + (size_t)(u.kind & 1) * 1024;
#pragma unroll
        for (int ai = 0; ai < 2; ++ai)
#pragma unroll
            for (int m = 0; m < 4; ++m) {
                float v = -3.0e38f;
#pragma unroll
                for (int bj = 0; bj < 2; ++bj)
#pragma unroll
                    for (int n = 0; n < 2; ++n) { const f32x4 x = acc[ai][bj][m][n]; v = fmaxf(v, fmaxf(fmaxf(x[0], x[1]), fmaxf(x[2], x[3]))); }
                v *= scale_log2;
                v = fmaxf(v, __shfl_xor(v, 16)); v = fmaxf(v, __shfl_xor(v, 32));
                float s = 0.f;
#pragma unroll
                for (int bj = 0; bj < 2; ++bj)
#pragma unroll
                    for (int n = 0; n < 2; ++n) { const f32x4 x = acc[ai][bj][m][n];
#pragma unroll
                        for (int j = 0; j < 4; ++j) s += __builtin_amdgcn_exp2f(x[j] * scale_log2 - v); }
                s += __shfl_xor(s, 16); s += __shfl_xor(s, 32);
                if (fq == 0) X[(ai * 128 + wr * 64 + m * 16 + fr) * 4 + wc] = (f32x2){v, s};
            }
        asm volatile("s_waitcnt lgkmcnt(0)" ::: "memory"); __builtin_amdgcn_s_barrier(); asm volatile("" ::: "memory");
        const int row0 = u.pm * 256 + wr * 64 + fr, col0 = u.pn * 256 + wc * 32 + 8 * fq;
#pragma unroll
        for (int ai = 0; ai < 2; ++ai)
#pragma unroll
            for (int m = 0; m < 4; ++m) {
                const int rl = ai * 128 + wr * 64 + m * 16 + fr;
                const f32x2 p0 = X[rl * 4 + 0], p1 = X[rl * 4 + 1], p2 = X[rl * 4 + 2], p3 = X[rl * 4 + 3];
                const float gm = fmaxf(fmaxf(p0.x, p1.x), fmaxf(p2.x, p3.x));
                const float tot = p0.y * __builtin_amdgcn_exp2f(p0.x - gm) + p1.y * __builtin_amdgcn_exp2f(p1.x - gm) + p2.y * __builtin_amdgcn_exp2f(p2.x - gm) + p3.y * __builtin_amdgcn_exp2f(p3.x - gm);
                const float inv = 1.f / tot;
                bf16* rowp = P + (size_t)(row0 + ai * 128 + m * 16) * D + col0;
#pragma unroll
                for (int bj = 0; bj < 2; ++bj) { f32x4 v0 = acc[ai][bj][m][0], v1 = acc[ai][bj][m][1];
#pragma unroll
                    for (int j = 0; j < 4; ++j) { v0[j] = __builtin_amdgcn_exp2f(v0[j] * scale_log2 - gm) * inv; v1[j] = __builtin_amdgcn_exp2f(v1[j] * scale_log2 - gm) * inv; }
                    u32x4 w; w.x = cvt_pk_bf16(v0[0], v0[1]); w.y = cvt_pk_bf16(v0[2], v0[3]); w.z = cvt_pk_bf16(v1[0], v1[1]); w.w = cvt_pk_bf16(v1[2], v1[3]);
                    *(u32x4*)(rowp + bj * 128) = w; }
                asm volatile("" ::: "memory");
            }
        return false;
    }
};
struct EpiCross {
    static constexpr bool CHAIN = false, TWICE = false;
    static constexpr bool ALIGN = true, HOOK = true;
    EpiPlain q; EpiSoftmax sm; EpiPlainT<true> o;
    __device__ __forceinline__ bool operator()(EPI_ARGS) const {
        if (u.kind < 2) return q(acc, u, wr, wc, fr_in, fq_in);
        if (u.kind < 4) return sm(acc, u, wr, wc, fr_in, fq_in);
        return o(acc, u, wr, wc, fr_in, fq_in);
    }
};
struct EpiGU {
    static constexpr bool CHAIN = false, TWICE = true;
    static constexpr bool HOOK = false;
#ifndef EPI_ALIGN
#define EPI_ALIGN true
#endif
    static constexpr bool ALIGN = EPI_ALIGN;
    bf16* H; const u64* ss; float wsc;
    __device__ __forceinline__ bool operator()(EPI_ARGS) const {
        EPI_LANE
        const int row0 = u.pm * 256 + wr * 64 + fr, col0 = u.pn * 128 + wc * 32 + 8 * fq;
        u64 sq[8];
#pragma unroll
        for (int k = 0; k < 8; ++k) sq[k] = ss[row0 + (k >> 2) * 128 + (k & 3) * 16];
#pragma unroll
        for (int ai = 0; ai < 2; ++ai)
#pragma unroll
            for (int m = 0; m < 4; ++m) {
                const float rs = rstd_of(sq[ai * 4 + m]) * wsc, ns = -1.44269504f * rs;
                f32x4 v[2];
#pragma unroll
                for (int n = 0; n < 2; ++n) { const f32x4 g = acc[ai][0][m][n], uu = acc[ai][1][m][n];
#pragma unroll
                    for (int j = 0; j < 4; ++j) v[n][j] = (g[j] * rs) * __builtin_amdgcn_rcpf(1.f + __builtin_amdgcn_exp2f(ns * g[j])) * (uu[j] * (rs * F8_HSCALE)); }
                u32x2 w; w.x = pk4_f8(v[0][0], v[0][1], v[0][2], v[0][3]); w.y = pk4_f8(v[1][0], v[1][1], v[1][2], v[1][3]);
                *(u32x2*)((unsigned char*)H + (size_t)(row0 + ai * 128 + m * 16) * DFF + col0) = w; asm volatile("" ::: "memory");
            }
        return false;
    }
};
struct EpiDownMoe {
    static constexpr bool CHAIN = false, TWICE = false;
    static constexpr bool HOOK = false;
    static constexpr bool ALIGN = true;
    const int* tokmap; const float* roww; bf16* Y; int t_slot1;
    __device__ __forceinline__ bool operator()(EPI_ARGS) const {
        EPI_LANE
        const int row0 = u.pm * 256 + wr * 64 + fr, col0 = u.pn * 256 + wc * 32 + 8 * fq;
        bf16* Ys = Y + ((u.pm >= t_slot1) ? (size_t)M * D : (size_t)0);
        int tk[8]; float wg[8];
#pragma unroll
        for (int k = 0; k < 8; ++k) { const int r = row0 + (k >> 2) * 128 + (k & 3) * 16; tk[k] = tokmap[r]; wg[k] = roww[r] * (1.f / (F8_HSCALE * F8_WSCALE)); }
#pragma unroll
        for (int ai = 0; ai < 2; ++ai)
#pragma unroll
            for (int m = 0; m < 4; ++m) { const int t_ = tk[ai * 4 + m];
                if (t_ >= 0) { const float wgt = wg[ai * 4 + m]; bf16* rowp = Ys + (size_t)t_ * D + col0;
#pragma unroll
                    for (int bj = 0; bj < 2; ++bj) { const f32x4 v0 = acc[ai][bj][m][0] * wgt, v1 = acc[ai][bj][m][1] * wgt;
                        u32x4 w; w.x = cvt_pk_bf16(v0[0], v0[1]); w.y = cvt_pk_bf16(v0[2], v0[3]); w.z = cvt_pk_bf16(v1[0], v1[1]); w.w = cvt_pk_bf16(v1[2], v1[3]);
                        *(u32x4*)(rowp + bj * 128) = w; } } }
        return false;
    }
};

template <int MODE> struct MergeSched {
    const char* A0; const char* A1; const char* W; int pm, pn;
    __device__ __forceinline__ bool next(int i, Unit& u) const {
        if (i >= 4) return false;
        u.pm = pm; u.pn = pn; u.kind = i;
        if (MODE == 0) { u.A = A0 + (size_t)pm * 256 * 1024; u.B = W + (size_t)(i * 1024 + pn * 256) * 1024; u.nt = 8; }
        else { u.A = ((i < 2) ? A0 : A1) + (size_t)pm * 256 * 2048 + (i & 1) * 1024; u.B = W + (size_t)(i >> 1) * (2 * MiB) + (size_t)pn * 256 * 2048 + (i & 1) * 1024; u.nt = 8; }
        return true;
    }
};
struct CrossFusedSched {
    const char* XB; const char* Wq; const char* XQ; const char* Kx; const char* XP; const char* VTb; int G, c;
    __device__ __forceinline__ bool next(int i, Unit& u) const {
        if (i >= 6) return false;
        const int ti = i & 1, stage = i >> 1;
        int L = ti * G + c; if (L >= 512) return false;
        { const int q = 512 / 8, xcd = L % 8, off = L / 8; L = xcd * q + off; }
        const int rt = L & 15, head = (L >> 4) & 3, b = L >> 6;
        u.pm = b * 16 + rt; u.pn = head; u.kind = 2 * stage + ti;
        if (stage == 0) { u.A = XB + (size_t)u.pm * 256 * 2048; u.B = Wq + (size_t)head * 256 * 2048; u.nt = 16; }
        else if (stage == 1) { u.A = XQ + (size_t)u.pm * 256 * 2048 + head * 512; u.B = Kx + (size_t)(b * 256) * 2048 + head * 512; u.nt = 4; }
        else { u.A = XP + (size_t)u.pm * 256 * 2048 + head * 512; u.B = VTb + (size_t)b * ((size_t)D * D * 2) + (size_t)(head * 256) * 2048; u.nt = 4; }
        return true;
    }
};
struct CrossSched {
    const char* A; const char* B; int mode, G, c;
    __device__ __forceinline__ bool next(int i, Unit& u) const {
        const long L0 = (long)i * G + c; if (L0 >= 512) return false;
        int L = (int)L0; { const int q = 512 / 8, xcd = L % 8, off = L / 8; L = xcd * q + off; }
        const int rt = L & 15, head = (L >> 4) & 3, b = L >> 6;
        u.pm = b * 16 + rt; u.pn = head; u.kind = i; u.nt = 4;
        u.A = A + (size_t)u.pm * 256 * 2048 + head * 512;
        u.B = (mode == 0) ? B + (size_t)(b * 256) * 2048 + head * 512 : B + (size_t)(head * 256) * 4096 + b * 512;
        return true;
    }
};
struct MoeSched {
    const char* A; const char* B; unsigned lda; size_t wstride; unsigned ldb; int t0, nT, nN, nt, G, c; const int* gt;
    __device__ __forceinline__ bool next(int i, Unit& u) const {
        const long L = (long)i * G + c; if (L >= (long)nT * nN) return false;
        int pm, pn; pg8::tile_of((int)L, nT, nN, pm, pn); pm += t0;
        int g = 0;
#pragma unroll
        for (int k = 1; k < 16; ++k) g += (pm >= gt[k]) ? 1 : 0;
        g = __builtin_amdgcn_readfirstlane(g);
        u.pm = pm; u.pn = pn; u.kind = 0; u.nt = nt;
        u.A = A + (size_t)pm * 256 * lda; u.B = B + (size_t)(g & 7) * wstride + (size_t)pn * 256 * ldb; return true;
    }
};

#define XB_TMO      128
#define XB_XCNT(j)  (256  + 64 * (j))
#define XB_XSUB(j)  (1280 + 64 * (j))
#define XB_XGEN(j)  (2304 + 64 * (j))
#define XB_TOP      3328
#define XB_TOPGEN   3392
#define XCD_BAR_WORDS 3456
#define XB_SPIN_CAP (1u << 22)
__device__ __forceinline__ unsigned xb_ld(unsigned* p)              { return __hip_atomic_load(p, __ATOMIC_RELAXED, __HIP_MEMORY_SCOPE_AGENT); }
__device__ __forceinline__ unsigned xb_add(unsigned* p, unsigned v) { return __hip_atomic_fetch_add(p, v, __ATOMIC_RELAXED, __HIP_MEMORY_SCOPE_AGENT); }
__device__ __forceinline__ unsigned xb_xcc_id() { return (unsigned)__builtin_amdgcn_s_getreg((3 << 11) | 20) & 0xFu; }
#define XB_SPIN(cond, bar) do { unsigned _sp = 0; while (cond) { __builtin_amdgcn_s_sleep(1); \
    if ((++_sp & 255u) == 0u) { if (xb_ld(&(bar)[XB_TMO])) break; if (_sp > XB_SPIN_CAP) { atomicAdd(&(bar)[XB_TMO], 1u); break; } } } } while (0)
struct XcdBarrier { unsigned* bar; unsigned x; volatile LAS unsigned* st; };
__device__ __forceinline__ XcdBarrier xcd_barrier_post(unsigned* bar, volatile LAS unsigned* st) {
    XcdBarrier b; b.bar = bar; b.x = xb_xcc_id(); b.st = st;
    if (threadIdx.x == 0) (void)xb_add(&bar[XB_XCNT(b.x)], 1u);
    return b;
}
__device__ __forceinline__ void xcd_barrier_complete(unsigned* bar, unsigned x, unsigned& nloc, unsigned& nx) {
    const unsigned G = gridDim.x * gridDim.y * gridDim.z;
    unsigned sum, cnt, mine, sp = 0u;
    for (;;) {
        sum = 0u; cnt = 0u; mine = 0u;
#pragma unroll
        for (unsigned j = 0; j < 16; ++j) { const unsigned c = xb_ld(&bar[XB_XCNT(j)]); sum += c; cnt += (c > 0u) ? 1u : 0u; mine = (j == x) ? c : mine; }
        if (sum == G) break;
        __builtin_amdgcn_s_sleep(1);
        if ((++sp & 255u) == 0u) { if (xb_ld(&bar[XB_TMO])) break; if (sp > XB_SPIN_CAP) { atomicAdd(&bar[XB_TMO], 1u); break; } }
    }
    nloc = mine > 0u ? mine : 1u; nx = cnt > 0u ? cnt : 1u;
}
__device__ __noinline__ void xcd_barrier_impl(unsigned* bar_, unsigned x_, volatile LAS unsigned* st_) {
    XcdBarrier b; b.bar = bar_; b.x = x_; b.st = st_;
    asm volatile("s_waitcnt vmcnt(0)" ::: "memory");
    __syncthreads();
    if (threadIdx.x == 0) {
        unsigned* bar = b.bar;
        __builtin_amdgcn_s_waitcnt(0);
        unsigned nloc = b.st[0], nx = b.st[1];
        if (nloc == 0u) { xcd_barrier_complete(bar, b.x, nloc, nx); b.st[0] = nloc; b.st[1] = nx; }
        const unsigned old = xb_add(&bar[XB_XSUB(b.x)], 1u);
        const unsigned gen = old / nloc;
        if (old + 1u == (gen + 1u) * nloc) {
            __builtin_amdgcn_fence(__ATOMIC_RELEASE, "agent");
            asm volatile("s_waitcnt vmcnt(0)" ::: "memory");
            const unsigned og = xb_add(&bar[XB_TOP], 1u);
            const unsigned tg = og / nx;
            if (og + 1u == (tg + 1u) * nx) xb_add(&bar[XB_TOPGEN], 1u);
            else XB_SPIN(xb_ld(&bar[XB_TOPGEN]) == tg, bar);
            __builtin_amdgcn_fence(__ATOMIC_ACQUIRE, "agent");
            xb_add(&bar[XB_XGEN(b.x)], 1u);
            asm volatile("s_waitcnt vmcnt(0)" ::: "memory");
        } else {
            XB_SPIN(xb_ld(&bar[XB_XGEN(b.x)]) == gen, bar);
            __builtin_amdgcn_fence(__ATOMIC_ACQUIRE, "agent");
            asm volatile("s_waitcnt vmcnt(0)" ::: "memory");
        }
    }
    __syncthreads();
}
__device__ __forceinline__ void xcd_barrier(const XcdBarrier& b) { xcd_barrier_impl(b.bar, b.x, b.st); }

struct Args {
    const float* x; const float* mem; const int* positions; const float* norm_mix; const float* w_in; const float* attn_sink; const float* w_branch; const float* w_out;
    const float* pool_w; const float* pool_scale; const float* norm_cross; const float* norm_mem; const float* w_xq; const float* w_xkv; const float* w_xo; const float* norm_ffn;
    const float* dense_w_gu; const float* dense_w_down; const float* router_w; const float* moe_w_gu; const float* moe_w_down; const float* norm_final;
    float* out; unsigned char* ws; int ph_lo, ph_hi;
};

template <int F8 = 0>
__device__ __forceinline__ void transpose_item(const float* W, int ldw, int k0, int src, int nv, bf16* WT, size_t dst_pitch, int dst_row0, int dst_k0, LAS float* scr, int lane, const float* gain) {
    f32x4 tv[8];
    const int n4 = (lane & 7) * 4, kr = lane >> 3;
#pragma unroll
    for (int i = 0; i < 8; ++i) tv[i] = (n4 < nv) ? *(const f32x4*)(W + (size_t)(k0 + 8 * i + kr) * ldw + src + n4) : (f32x4){0.f, 0.f, 0.f, 0.f};
    if (gain) {
#pragma unroll
        for (int i = 0; i < 8; ++i) tv[i] = tv[i] * gain[k0 + 8 * i + kr]; }
#pragma unroll
    for (int i = 0; i < 8; ++i) { LAS float* d = scr + (8 * i + kr) * 33 + n4; d[0] = tv[i].x; d[1] = tv[i].y; d[2] = tv[i].z; d[3] = tv[i].w; }
    LDS_WAIT(); asm volatile("" ::: "memory");
    const int c = lane & 7;
#pragma unroll
    for (int j = 0; j < 4; ++j) { const int n = (lane >> 3) + 8 * j; const LAS float* s = scr + (8 * c) * 33 + n;
        if constexpr (F8) {
            u32x2 o; o.x = pk4_f8(s[0 * 33] * F8_WSCALE, s[1 * 33] * F8_WSCALE, s[2 * 33] * F8_WSCALE, s[3 * 33] * F8_WSCALE); o.y = pk4_f8(s[4 * 33] * F8_WSCALE, s[5 * 33] * F8_WSCALE, s[6 * 33] * F8_WSCALE, s[7 * 33] * F8_WSCALE);
            *(u32x2*)((unsigned char*)WT + (size_t)(dst_row0 + n) * dst_pitch + dst_k0 + k0 + 8 * c) = o;
        } else {
        u32x4 o; o.x = pk2(s[0 * 33], s[1 * 33]); o.y = pk2(s[2 * 33], s[3 * 33]); o.z = pk2(s[4 * 33], s[5 * 33]); o.w = pk2(s[6 * 33], s[7 * 33]);
        *(u32x4*)(WT + (size_t)(dst_row0 + n) * dst_pitch + dst_k0 + k0 + 8 * c) = o; } }
    LDS_WAIT(); asm volatile("" ::: "memory");
}
template <int MAP, int F8 = 0>
__device__ __forceinline__ void conv_seg(const float* W, int K, int ldw, int src0, bf16* WT, size_t dst_pitch, int dst_k0, int nb, int item, LAS float* scr, int lane, const float* gain = nullptr) {
    const int kb = item / nb, vb = item % nb;
    int src, nv = 32;
    if (MAP == 0) src = src0 + 32 * vb;
    else if (MAP == 1) { const int pn = vb >> 3, bj = (vb >> 2) & 1, wc = vb & 3, g = 4 * pn + wc;
        if (g < 29) src = 64 * g + 32 * bj; else if (g < 61) src = 64 * g + 4 + 32 * bj; else if (g == 61) { src = 1856; nv = bj == 0 ? 4 : 0; } else { src = 0; nv = 0; } }
    else { const int pn = vb >> 3, bj = (vb >> 2) & 1, pb = vb & 3; src = src0 + bj * DFF + 128 * pn + 32 * pb; }
    transpose_item<F8>(W, ldw, 64 * kb, src, nv, WT, dst_pitch, 32 * vb, dst_k0, scr, lane, gain);
}
struct ConvItem { const float* W; int ldw, k0, src; const float* gain; unsigned char* WT; int dpitch, drow0; };
__device__ __forceinline__ void conv_load(const ConvItem& c, f32x4 (&tv)[8], float (&gv)[8], int lane) {
    const int n4 = (lane & 7) * 4, kr = lane >> 3;
#pragma unroll
    for (int i = 0; i < 8; ++i) tv[i] = *(const f32x4*)(c.W + (size_t)(c.k0 + 8 * i + kr) * c.ldw + c.src + n4);
#pragma unroll
    for (int i = 0; i < 8; ++i) gv[i] = c.gain ? c.gain[c.k0 + 8 * i + kr] : 1.f;
}
__device__ __forceinline__ void conv_finish8(const ConvItem& c, const f32x4 (&tv)[8], const float (&gv)[8], LAS float* scr, int lane) {
    const int n4 = (lane & 7) * 4, kr = lane >> 3;
#pragma unroll
    for (int i = 0; i < 8; ++i) { const float g = gv[i] * F8_WSCALE; LAS float* d = scr + (8 * i + kr) * 33 + n4; d[0] = tv[i].x * g; d[1] = tv[i].y * g; d[2] = tv[i].z * g; d[3] = tv[i].w * g; }
    LDS_WAIT(); asm volatile("" ::: "memory");
    const int cc = lane & 7;
#pragma unroll
    for (int j = 0; j < 4; ++j) { const int n = (lane >> 3) + 8 * j; const LAS float* sp = scr + (8 * cc) * 33 + n;
        u32x2 o; o.x = pk4_f8(sp[0 * 33], sp[1 * 33], sp[2 * 33], sp[3 * 33]); o.y = pk4_f8(sp[4 * 33], sp[5 * 33], sp[6 * 33], sp[7 * 33]);
        *(u32x2*)(c.WT + (size_t)(c.drow0 + n) * c.dpitch + c.k0 + 8 * cc) = o; }
    LDS_WAIT(); asm volatile("" ::: "memory");
}
__device__ __forceinline__ void norm_row_bf16(const float* xrow, const float* g, bf16* orow, int lane) {
    const f32x4* xr = (const f32x4*)xrow + lane; const f32x4* gr = (const f32x4*)g + lane;
    f32x4 v[4]; float s = 0.f;
#pragma unroll
    for (int j = 0; j < 4; ++j) { v[j] = xr[64 * j]; s += (v[j].x * v[j].x + v[j].y * v[j].y) + (v[j].z * v[j].z + v[j].w * v[j].w); }
    const float rstd = 1.f / sqrtf(wave_sum(s) * (1.f / D) + EPS);
    unsigned long long* o8 = (unsigned long long*)orow + lane;
#pragma unroll
    for (int j = 0; j < 4; ++j) { const f32x4 gg = gr[64 * j];
        o8[64 * j] = (unsigned long long)pk2(v[j].x * rstd * gg.x, v[j].y * rstd * gg.y) | ((unsigned long long)pk2(v[j].z * rstd * gg.z, v[j].w * rstd * gg.w) << 32); }
}

constexpr int RT_P = 136;
typedef float f32x4v __attribute__((ext_vector_type(4)));
__device__ __forceinline__ void pool_phase(const bf16* proj, const bf16* wpt, const float* pscale, bf16* br23, char* lds, int G) {
    int tid = threadIdx.x; asm volatile("" : "+v"(tid)); const int lane = tid & 63, wave = tid >> 6, fr = lane & 15, fq = lane >> 4;
    bf16* Dl = (bf16*)lds;
    for (int un = blockIdx.x; un < 2048; un += G) {
        const int g = un & 3, tb = (un >> 2) & 63, b = un >> 8;
        const int win = 2 << g;
        const bf16* wp = wpt + (size_t)g * 16384 + (16 * wave + fr) * 128 + 8 * fq;
        bf16x8 bw[4];
#pragma unroll
        for (int ks = 0; ks < 4; ++ks) bw[ks] = *(const bf16x8*)(wp + 32 * ks);
        const float sc = pscale[g * 128 + 16 * wave + fr];
#pragma unroll
        for (int i = 0; i < 2; ++i) { const int idx = tid + 512 * i, tt = idx >> 4, pc = idx & 15, t = tb * 64 + tt;
            const bf16* up = proj + ((size_t)(b * T + t)) * NPROJ + C_PU + g * 128 + 8 * pc;
            const int cnt = (t + 1 < win) ? t + 1 : win;
            float sm[8];
#pragma unroll
            for (int q = 0; q < 8; ++q) sm[q] = 0.f;
            u32x4 wv[16];
#pragma unroll
            for (int j = 0; j < 16; ++j) wv[j] = (j < cnt) ? *(const u32x4*)(up - (size_t)j * NPROJ) : (u32x4){0u, 0u, 0u, 0u};
            const u32x4 u0 = wv[0];
#pragma unroll
            for (int j = 0; j < 16; ++j) { const u32x4 v = wv[j];
                sm[0] += __uint_as_float(v.x << 16); sm[1] += __uint_as_float(v.x & 0xffff0000u); sm[2] += __uint_as_float(v.y << 16); sm[3] += __uint_as_float(v.y & 0xffff0000u);
                sm[4] += __uint_as_float(v.z << 16); sm[5] += __uint_as_float(v.z & 0xffff0000u); sm[6] += __uint_as_float(v.w << 16); sm[7] += __uint_as_float(v.w & 0xffff0000u); }
            const float ic = 1.f / (float)cnt;
            u32x4 o;
            o.x = pk2(sm[0] * ic - __uint_as_float(u0.x << 16), sm[1] * ic - __uint_as_float(u0.x & 0xffff0000u)); o.y = pk2(sm[2] * ic - __uint_as_float(u0.y << 16), sm[3] * ic - __uint_as_float(u0.y & 0xffff0000u));
            o.z = pk2(sm[4] * ic - __uint_as_float(u0.z << 16), sm[5] * ic - __uint_as_float(u0.z & 0xffff0000u)); o.w = pk2(sm[6] * ic - __uint_as_float(u0.w << 16), sm[7] * ic - __uint_as_float(u0.w & 0xffff0000u));
            *(u32x4*)(Dl + tt * RT_P + 8 * pc) = o; }
        __syncthreads();
#pragma unroll
        for (int tt = 0; tt < 4; ++tt) { f32x4v d = (f32x4v){0.f, 0.f, 0.f, 0.f};
#pragma unroll
            for (int ks = 0; ks < 4; ++ks) d = __builtin_amdgcn_mfma_f32_16x16x32_bf16(*(const bf16x8*)(Dl + (16 * tt + fr) * RT_P + 32 * ks + 8 * fq), bw[ks], d, 0, 0, 0);
#pragma unroll
            for (int r = 0; r < 4; ++r) br23[((size_t)(b * T + tb * 64 + 16 * tt + 4 * fq + r)) * D + 512 + g * 128 + 16 * wave + fr] = (bf16)f2bf1(d[r] * sc); }
        __syncthreads();
    }
}
__device__ __forceinline__ float row16_max(float v) {
    v = fmaxf(v, __builtin_bit_cast(float, __builtin_amdgcn_mov_dpp(__builtin_bit_cast(int, v), 0xB1, 0xf, 0xf, true)));
    v = fmaxf(v, __builtin_bit_cast(float, __builtin_amdgcn_mov_dpp(__builtin_bit_cast(int, v), 0x4E, 0xf, 0xf, true)));
    v = fmaxf(v, __builtin_bit_cast(float, __builtin_amdgcn_mov_dpp(__builtin_bit_cast(int, v), 0x141, 0xf, 0xf, true)));
    v = fmaxf(v, __builtin_bit_cast(float, __builtin_amdgcn_mov_dpp(__builtin_bit_cast(int, v), 0x140, 0xf, 0xf, true)));
    return v;
}
__device__ __forceinline__ float row16_sum(float v) {
    v += __builtin_bit_cast(float, __builtin_amdgcn_mov_dpp(__builtin_bit_cast(int, v), 0xB1, 0xf, 0xf, true));
    v += __builtin_bit_cast(float, __builtin_amdgcn_mov_dpp(__builtin_bit_cast(int, v), 0x4E, 0xf, 0xf, true));
    v += __builtin_bit_cast(float, __builtin_amdgcn_mov_dpp(__builtin_bit_cast(int, v), 0x141, 0xf, 0xf, true));
    v += __builtin_bit_cast(float, __builtin_amdgcn_mov_dpp(__builtin_bit_cast(int, v), 0x140, 0xf, 0xf, true));
    return v;
}
constexpr int SWA_KP = 72, SWA_VP = 264, SWA_PP = 168;
__device__ __forceinline__ void swa_phase(const bf16* proj, const bf16* akv, const float* sink, bf16* br01, char* lds, int G) {
    int tid = threadIdx.x; asm volatile("" : "+v"(tid)); const int lane = tid & 63, wave = tid >> 6;
    bf16* Kl = (bf16*)lds; bf16* Vt = (bf16*)(lds + 36864); bf16* Pw = (bf16*)(lds + 36864 + 33792) + wave * 16 * SWA_PP;
    for (int un = blockIdx.x; un < 512; un += G) {
        const int nb = un & 31, kvh = (un >> 5) & 1, b = un >> 6;
        const size_t m0 = (size_t)b * T + nb * 128;
        const int g = wave >> 1, head = kvh * 4 + g, fr = lane & 15, fq = lane >> 4;
        const float sk = sink[head];
        bf16x8 qf[4][2];
#pragma unroll
        for (int j = 0; j < 4; ++j) { const bf16* qp = proj + (m0 + 16 * ((wave & 1) * 4 + j) + fr) * NPROJ + C_AQ + head * 64 + 8 * fq; qf[j][0] = *(const bf16x8*)qp; qf[j][1] = *(const bf16x8*)(qp + 32); }
#pragma unroll
        for (int i = 0; i < 4; ++i) { const int idx = tid + 512 * i, key = idx >> 3, pc = idx & 7;
            u32x4 kv = (u32x4){0u, 0u, 0u, 0u}, vv = kv;
            if (nb > 0 || key >= 128) { const bf16* src = akv + (m0 - 128 + key) * 256 + kvh * 64 + pc * 8; kv = *(const u32x4*)src; vv = *(const u32x4*)(src + 128); }
            *(u32x4*)(Kl + key * SWA_KP + pc * 8) = kv;
            bf16* vd = Vt + (pc * 8) * SWA_VP + key;
            vd[0] = (bf16)(vv.x & 0xffffu); vd[SWA_VP] = (bf16)(vv.x >> 16); vd[2 * SWA_VP] = (bf16)(vv.y & 0xffffu); vd[3 * SWA_VP] = (bf16)(vv.y >> 16);
            vd[4 * SWA_VP] = (bf16)(vv.z & 0xffffu); vd[5 * SWA_VP] = (bf16)(vv.z >> 16); vd[6 * SWA_VP] = (bf16)(vv.w & 0xffffu); vd[7 * SWA_VP] = (bf16)(vv.w >> 16); }
        __syncthreads();
#pragma unroll
        for (int j = 0; j < 4; ++j) {
            const int a = (wave & 1) * 4 + j, i0 = 16 * a, ap = a & ~1;
            const bf16x8 q0 = qf[j][0], q1 = qf[j][1];
            f32x4v sv[10];
#pragma unroll
            for (int kt = 0; kt < 10; ++kt) {
                const bf16* kp = Kl + (16 * (ap + kt) + fr) * SWA_KP + 8 * fq;
                f32x4v d = (f32x4v){0.f, 0.f, 0.f, 0.f};
                d = __builtin_amdgcn_mfma_f32_16x16x32_bf16(q0, *(const bf16x8*)kp, d, 0, 0, 0);
                d = __builtin_amdgcn_mfma_f32_16x16x32_bf16(q1, *(const bf16x8*)(kp + 32), d, 0, 0, 0);
                sv[kt] = d;
            }
            float mx[4] = {-INFINITY, -INFINITY, -INFINITY, -INFINITY};
#pragma unroll
            for (int kt = 0; kt < 10; ++kt) { const int kabs = 16 * (ap + kt) + fr;
#pragma unroll
                for (int r = 0; r < 4; ++r) { const int i = i0 + 4 * fq + r; const bool ok = (kabs >= i + 1) && (kabs <= i + 128) && (nb > 0 || kabs >= 128);
                    const float x = ok ? sv[kt][r] * 0.125f : -INFINITY; sv[kt][r] = x; mx[r] = fmaxf(mx[r], x); } }
            float den[4];
#pragma unroll
            for (int r = 0; r < 4; ++r) { mx[r] = fmaxf(row16_max(mx[r]), sk); den[r] = 0.f; }
#pragma unroll
            for (int kt = 0; kt < 10; ++kt)
#pragma unroll
                for (int r = 0; r < 4; ++r) { const float pv = __expf(sv[kt][r] - mx[r]); den[r] += pv; Pw[(4 * fq + r) * SWA_PP + 16 * kt + fr] = (bf16)f2bf1(pv); }
#pragma unroll
            for (int r = 0; r < 4; ++r) den[r] = 1.f / (row16_sum(den[r]) + __expf(sk - mx[r]));
            LDS_WAIT();
            f32x4v o[4];
#pragma unroll
            for (int dt = 0; dt < 4; ++dt) o[dt] = (f32x4v){0.f, 0.f, 0.f, 0.f};
#pragma unroll
            for (int ks = 0; ks < 5; ++ks) { const bf16x8 pa = *(const bf16x8*)(Pw + fr * SWA_PP + 32 * ks + 8 * fq);
#pragma unroll
                for (int dt = 0; dt < 4; ++dt) o[dt] = __builtin_amdgcn_mfma_f32_16x16x32_bf16(pa, *(const bf16x8*)(Vt + (16 * dt + fr) * SWA_VP + 16 * ap + 32 * ks + 8 * fq), o[dt], 0, 0, 0); }
#pragma unroll
            for (int r = 0; r < 4; ++r) { bf16* op = br01 + (m0 + i0 + 4 * fq + r) * D + head * 64 + fr;
#pragma unroll
                for (int dt = 0; dt < 4; ++dt) op[16 * dt] = (bf16)f2bf1(o[dt][r] * den[r]); }
            LDS_WAIT();
        }
        __syncthreads();
    }
}
typedef float f32x16 __attribute__((ext_vector_type(16)));
constexpr int DSA_S = 4100;
constexpr int DSA_WOFF = 8 * DSA_S * 4;
__device__ __forceinline__ float dpp_x1(float x) { return __builtin_bit_cast(float, __builtin_amdgcn_mov_dpp(__builtin_bit_cast(int, x), 0xB1, 0xf, 0xf, true)); }
__device__ __forceinline__ float dpp_x2(float x) { return __builtin_bit_cast(float, __builtin_amdgcn_mov_dpp(__builtin_bit_cast(int, x), 0x4E, 0xf, 0xf, true)); }
__device__ __forceinline__ int wave_sum_i(int v) {
    v += __builtin_amdgcn_mov_dpp(v, 0xB1, 0xf, 0xf, true);
    v += __builtin_amdgcn_mov_dpp(v, 0x4E, 0xf, 0xf, true);
    v += __builtin_amdgcn_mov_dpp(v, 0x141, 0xf, 0xf, true);
    v += __builtin_amdgcn_mov_dpp(v, 0x140, 0xf, 0xf, true);
    v += __builtin_amdgcn_update_dpp(0, v, 0x142, 0xa, 0xf, false);
    v += __builtin_amdgcn_update_dpp(0, v, 0x143, 0xc, 0xf, false);
    return __builtin_amdgcn_readlane(v, 63);
}
__device__ __forceinline__ unsigned sortable(float f) { const unsigned u = __float_as_uint(f); return (u >> 31) ? ~u : (u | 0x80000000u); }
__device__ __forceinline__ void dsa_scores(const bf16* pb, const bf16* ikb, int t0, float* scl, int wave, int lane) {
    const int n = lane & 31, kh = lane >> 5, q = n >> 2, h = n & 3;
    const bf16* qrow = pb + (size_t)(t0 + q) * NPROJ;
    bf16x8 Bq[4];
#pragma unroll
    for (int ks = 0; ks < 4; ++ks) Bq[ks] = *(const bf16x8*)(qrow + C_IQ + h * 64 + 16 * ks + 8 * kh);
    const float wq = bf2f(qrow[C_IW + h]) * 0.0625f;
    const int ntile = (t0 + 8 + 31) >> 5;
    float* dst = scl + q * DSA_S + h + 4 * kh;
#pragma unroll 1
    for (int tile0 = wave; tile0 < ntile; tile0 += 32) {
        bf16x8 a[4][4];
#pragma unroll
        for (int u = 0; u < 4; ++u) { const int tile = tile0 + 8 * u; const int tc = (tile < ntile) ? tile : 0;
            const bf16* kf = ikb + ((size_t)tc * 256 + lane) * 8;
#pragma unroll
            for (int ks = 0; ks < 4; ++ks) a[u][ks] = *(const bf16x8*)(kf + ks * 512); }
#pragma unroll
        for (int u = 0; u < 4; ++u) { const int tile = tile0 + 8 * u;
            if (tile < ntile) {
                f32x16 d;
#pragma unroll
                for (int r = 0; r < 16; ++r) d[r] = 0.f;
#pragma unroll
                for (int ks = 0; ks < 4; ++ks) d = __builtin_amdgcn_mfma_f32_32x32x16_bf16(a[u][ks], Bq[ks], d, 0, 0, 0);
                float v[16];
#pragma unroll
                for (int r = 0; r < 16; ++r) { float x = fmaxf(d[r], 0.f) * wq; x += dpp_x1(x); x += dpp_x2(x); v[r] = x; }
#pragma unroll
                for (int k = 0; k < 4; ++k) { const float val = (h == 0) ? v[4 * k] : (h == 1) ? v[4 * k + 1] : (h == 2) ? v[4 * k + 2] : v[4 * k + 3]; dst[tile * 32 + 8 * k] = val + 0.f; }
            } }
    }
}
__device__ __forceinline__ int wave_scan_incl(int v) {
    v += __builtin_amdgcn_update_dpp(0, v, 0x111, 0xf, 0xf, false);
    v += __builtin_amdgcn_update_dpp(0, v, 0x112, 0xf, 0xf, false);
    v += __builtin_amdgcn_update_dpp(0, v, 0x114, 0xf, 0xf, false);
    v += __builtin_amdgcn_update_dpp(0, v, 0x118, 0xf, 0xf, false);
    v += __builtin_amdgcn_update_dpp(0, v, 0x142, 0xa, 0xf, false);
    v += __builtin_amdgcn_update_dpp(0, v, 0x143, 0xc, 0xf, false);
    return v;
}
template <int SMODE> __device__ __forceinline__ void dsa_select(int t, float* sc, char* wl, int lane) {
    unsigned short* sel = (unsigned short*)(wl + 512);
    const int nk = t + 1;
    const int K = nk < 256 ? nk : 256;
    const int nj = (nk + 63) >> 6;
    unsigned key[64];
#pragma unroll
    for (int j = 0; j < 64; ++j) { const int s = 64 * j + lane; const unsigned kq = sortable(sc[s]); key[j] = (s < nk) ? kq : 0u; }
    if (SMODE == 1) { unsigned x = 0u;
#pragma unroll
        for (int j = 0; j < 64; ++j) x ^= key[j];
        sel[255] = (unsigned short)x; return; }
    unsigned Tk = 1u; int cT = K;
    if (nk > 256) {
        unsigned* hist = (unsigned*)sc;
        auto find_bin = [&](int Kq, int& ge, int& in) -> unsigned {
            int sl = 0;
#pragma unroll
            for (int i = 0; i < 64; ++i) sl += (int)hist[64 * lane + ((i + lane) & 63)];
            const int pre = wave_scan_incl(sl);
            const int tot = __builtin_amdgcn_readlane(pre, 63);
            const int suf = tot - pre + sl;
            const unsigned long long m1 = __ballot(suf >= Kq);
            const int Ls = 63 - __builtin_clzll(m1);
            const int above = __builtin_amdgcn_readlane(suf - sl, Ls);
            const int hi = (int)hist[64 * Ls + lane];
            const int pre2 = wave_scan_incl(hi);
            const int tot2 = __builtin_amdgcn_readlane(pre2, 63);
            const int suf2 = above + tot2 - pre2 + hi;
            const unsigned long long m2 = __ballot(suf2 >= Kq);
            const int is = 63 - __builtin_clzll(m2);
            ge = __builtin_amdgcn_readlane(suf2, is); in = __builtin_amdgcn_readlane(hi, is);
            return (unsigned)(64 * Ls + is); };
        LDS_WAIT();
#pragma unroll
        for (int i = 0; i < 16; ++i) ((u32x4*)hist)[lane + 64 * i] = (u32x4){0u, 0u, 0u, 0u};
        LDS_WAIT();
#pragma unroll
        for (int jg = 0; jg < 4; ++jg) if (16 * jg < nj) {
#pragma unroll
            for (int j = 16 * jg; j < 16 * jg + 16; ++j) if (j < nj) atomicAdd(&hist[key[j] >> 20], key[j] != 0u ? 1u : 0u); }
        LDS_WAIT();
        int ge1, in1;
        const unsigned B = find_bin(K, ge1, in1);
        Tk = B << 20; cT = ge1;
        if (cT != K) {
            const int aboveB = ge1 - in1, K2 = K - aboveB;
            LDS_WAIT();
#pragma unroll
            for (int i = 0; i < 16; ++i) ((u32x4*)hist)[lane + 64 * i] = (u32x4){0u, 0u, 0u, 0u};
            LDS_WAIT();
#pragma unroll
            for (int jg = 0; jg < 4; ++jg) if (16 * jg < nj) {
#pragma unroll
                for (int j = 16 * jg; j < 16 * jg + 16; ++j) { if ((key[j] >> 20) == B) atomicAdd(&hist[(key[j] >> 8) & 0xfffu], key[j] != 0u ? 1u : 0u);
                    if ((j & 3) == 3) __builtin_amdgcn_sched_barrier(0); } }
            LDS_WAIT();
            int ge2, in2;
            const unsigned B2 = find_bin(K2, ge2, in2);
            Tk |= B2 << 8; cT = aboveB + ge2;
            for (int bit = 7; bit >= 0 && cT != K; --bit) {
                const unsigned cand = Tk | (1u << bit); int c = 0;
#pragma unroll
                for (int jg = 0; jg < 4; ++jg) if (16 * jg < nj) {
#pragma unroll
                    for (int j = 16 * jg; j < 16 * jg + 16; ++j) c += (key[j] >= cand) ? 1 : 0; }
                const int totc = wave_sum_i(c);
                if (totc >= K) { Tk = cand; cT = totc; }
            }
        }
    }
    if (SMODE == 2) { sel[255] = (unsigned short)Tk; return; }
    LDS_WAIT();
    if (cT == K) {
        int base = 0;
#pragma unroll
        for (int jg = 0; jg < 4; ++jg) if (16 * jg < nj) {
#pragma unroll
            for (int j = 16 * jg; j < 16 * jg + 16; ++j) {
                const bool tk = key[j] >= Tk;
                const unsigned long long mk = __ballot(tk);
                const int pos = base + (int)__builtin_amdgcn_mbcnt_hi((unsigned)(mk >> 32), __builtin_amdgcn_mbcnt_lo((unsigned)mk, 0u));
                if (tk) sel[pos] = (unsigned short)(64 * j + lane);
                base += __popcll(mk);
                if ((j & 3) == 3) __builtin_amdgcn_sched_barrier(0);
            } }
    } else {
        int cg = 0;
#pragma unroll
        for (int j = 0; j < 64; ++j) cg += (key[j] > Tk) ? 1 : 0;
        const int pg = wave_scan_incl(cg);
        const int totg = __builtin_amdgcn_readlane(pg, 63);
        const int need = K - totg;
        int pos = pg - cg;
#pragma unroll
        for (int jg = 0; jg < 4; ++jg) if (16 * jg < nj) {
#pragma unroll
            for (int j = 16 * jg; j < 16 * jg + 16; ++j) if (key[j] > Tk) { sel[pos] = (unsigned short)(64 * j + lane); ++pos; } }
        const unsigned long long lt = (1ull << lane) - 1ull;
        int ties = 0;
#pragma unroll
        for (int jg = 0; jg < 4; ++jg) if (16 * jg < nj) {
#pragma unroll
            for (int j = 16 * jg; j < 16 * jg + 16; ++j) {
                const unsigned long long meq = __ballot(key[j] == Tk);
                const int rk = ties + __popcll(meq & lt);
                if (key[j] == Tk && rk < need) sel[totg + rk] = (unsigned short)(64 * j + lane);
                ties += __popcll(meq);
            } }
    }
    LDS_WAIT();
}
typedef short v4i16_t __attribute__((ext_vector_type(4)));
constexpr int DSA_VP = 72, DSA_PP = 264;
template <int MODE> __device__ __forceinline__ void dsa_attend(const bf16x8 (&qa)[2][2], const bf16* kvb, bf16* br01, int b, int t, float* sc, char* wl, int lane) {
    const unsigned short* sel = (const unsigned short*)(wl + 512);
    const size_t m = (size_t)b * T + t;
    const int K = (t + 1) < 256 ? (t + 1) : 256;
    const int fr = lane & 15, fq = lane >> 4;
    bf16* Vst = (bf16*)sc; bf16* Pl = (bf16*)sc + 64 * DSA_VP;
    LAS const char* vst3 = (LAS const char*)Vst;
    const int nch = (MODE & 1) ? 0 : ((K + 63) >> 6);
#pragma unroll
    for (int kvh = 0; kvh < 2; ++kvh) {
        f32x4v lg[16];
        {
            u32x4 k0[8], k1[8];
#pragma unroll
            for (int i = 0; i < 8; ++i) k0[i] = *(const u32x4*)(kvb + (size_t)sel[8 * i + (lane >> 3)] * 256 + kvh * 64 + 8 * (lane & 7));
#pragma unroll
            for (int i = 0; i < 8; ++i) k1[i] = *(const u32x4*)(kvb + (size_t)sel[64 + 8 * i + (lane >> 3)] * 256 + kvh * 64 + 8 * (lane & 7));
#define DSA_QK_CHUNK(c, buf, nextc) do { \
            LDS_WAIT(); \
            _Pragma("unroll") for (int i = 0; i < 8; ++i) *(u32x4*)(Vst + (8 * i + (lane >> 3)) * DSA_VP + 8 * (lane & 7)) = buf[i]; \
            if ((nextc) < 4) { \
                _Pragma("unroll") for (int i = 0; i < 8; ++i) buf[i] = *(const u32x4*)(kvb + (size_t)sel[64 * ((nextc) & 3) + 8 * i + (lane >> 3)] * 256 + kvh * 64 + 8 * (lane & 7)); } \
            LDS_WAIT(); \
            _Pragma("unroll") for (int e4 = 0; e4 < 4; ++e4) { const int et = 4 * (c) + e4; \
                const bf16* kp = Vst + (16 * e4 + fr) * DSA_VP + 8 * fq; \
                f32x4v d = (f32x4v){0.f, 0.f, 0.f, 0.f}; \
                d = __builtin_amdgcn_mfma_f32_16x16x32_bf16(qa[kvh][0], *(const bf16x8*)kp, d, 0, 0, 0); \
                d = __builtin_amdgcn_mfma_f32_16x16x32_bf16(qa[kvh][1], *(const bf16x8*)(kp + 32), d, 0, 0, 0); \
                if (16 * et + fr >= K) d = (f32x4v){-INFINITY, -INFINITY, -INFINITY, -INFINITY}; \
                lg[et] = d; } } while (0)
            DSA_QK_CHUNK(0, k0, 2);
            DSA_QK_CHUNK(1, k1, 3);
            DSA_QK_CHUNK(2, k0, 4);
            DSA_QK_CHUNK(3, k1, 5);
#undef DSA_QK_CHUNK
        }
        if (MODE & 2) { float x = 0.f;
#pragma unroll
            for (int et = 0; et < 16; ++et) x += lg[et][0] + lg[et][1] + lg[et][2] + lg[et][3];
            Pl[lane] = (bf16)f2bf1(x); continue; }
        u32x4 va[8], vb[8];
#pragma unroll
        for (int i = 0; i < 8; ++i) va[i] = *(const u32x4*)(kvb + (size_t)sel[8 * i + (lane >> 3)] * 256 + 128 + kvh * 64 + 8 * (lane & 7));
#pragma unroll
        for (int i = 0; i < 8; ++i) vb[i] = *(const u32x4*)(kvb + (size_t)sel[64 + 8 * i + (lane >> 3)] * 256 + 128 + kvh * 64 + 8 * (lane & 7));
        {
            float x[16];
#pragma unroll
            for (int et = 0; et < 16; ++et) x[et] = (fq == 0) ? lg[et][0] : (fq == 1) ? lg[et][1] : (fq == 2) ? lg[et][2] : lg[et][3];
            float mx = x[0];
#pragma unroll
            for (int et = 1; et < 16; ++et) mx = fmaxf(mx, x[et]);
            mx = row16_max(mx);
            float sm = 0.f;
#pragma unroll
            for (int et = 0; et < 16; ++et) { x[et] = __builtin_amdgcn_exp2f((x[et] - mx) * (0.125f * 1.44269504f)); sm += x[et]; }
            const float inv = 1.f / row16_sum(sm);
#pragma unroll
            for (int et = 0; et < 16; ++et) Pl[fq * DSA_PP + 16 * et + fr] = (bf16)f2bf1(x[et] * inv);
        }
        f32x4v o[4];
#pragma unroll
        for (int dt = 0; dt < 4; ++dt) o[dt] = (f32x4v){0.f, 0.f, 0.f, 0.f};
#define DSA_PV_CHUNK(c, buf, nextc) do { \
            LDS_WAIT(); \
            _Pragma("unroll") for (int i = 0; i < 8; ++i) *(u32x4*)(Vst + (8 * i + (lane >> 3)) * DSA_VP + 8 * (lane & 7)) = buf[i]; \
            if ((nextc) < nch) { \
                _Pragma("unroll") for (int i = 0; i < 8; ++i) buf[i] = *(const u32x4*)(kvb + (size_t)sel[64 * (nextc) + 8 * i + (lane >> 3)] * 256 + 128 + kvh * 64 + 8 * (lane & 7)); } \
            LDS_WAIT(); \
            _Pragma("unroll") for (int ks = 0; ks < 2; ++ks) { \
                const bf16x8 pa = *(const bf16x8*)(Pl + (fr & 3) * DSA_PP + 64 * (c) + 32 * ks + 8 * fq); \
                _Pragma("unroll") for (int dt = 0; dt < 4; ++dt) { \
                    LAS const char* a0 = vst3 + ((32 * ks + 8 * fq + (fr >> 2)) * DSA_VP + 16 * dt + 4 * (fr & 3)) * 2; \
                    const v4i16_t lo = __builtin_amdgcn_ds_read_tr16_b64_v4i16((LAS v4i16_t*)a0); \
                    const v4i16_t hi = __builtin_amdgcn_ds_read_tr16_b64_v4i16((LAS v4i16_t*)(a0 + 4 * DSA_VP * 2)); \
                    bf16x8 bv; bv[0] = lo[0]; bv[1] = lo[1]; bv[2] = lo[2]; bv[3] = lo[3]; bv[4] = hi[0]; bv[5] = hi[1]; bv[6] = hi[2]; bv[7] = hi[3]; \
                    o[dt] = __builtin_amdgcn_mfma_f32_16x16x32_bf16(pa, bv, o[dt], 0, 0, 0); } } } while (0)
        if (nch > 0) DSA_PV_CHUNK(0, va, 2);
        if (nch > 1) DSA_PV_CHUNK(1, vb, 3);
        if (nch > 2) DSA_PV_CHUNK(2, va, 4);
        if (nch > 3) DSA_PV_CHUNK(3, vb, 5);
#undef DSA_PV_CHUNK
        const f32x4v ov = (fq == 0) ? o[0] : (fq == 1) ? o[1] : (fq == 2) ? o[2] : o[3];
        bf16* op = br01 + m * D + 512 + kvh * 256 + 16 * fq + fr;
#pragma unroll
        for (int r = 0; r < 4; ++r) op[r * 64] = (bf16)f2bf1(ov[r]);
        LDS_WAIT();
    }
}
__device__ __forceinline__ void dsa_phase(const bf16* proj, const bf16* bkv, const bf16* ik, bf16* br01, char* lds, int G) {
    int tid = threadIdx.x; asm volatile("" : "+v"(tid)); const int lane = tid & 63, wave = __builtin_amdgcn_readfirstlane(tid >> 6);
    float* scl = (float*)lds;
    char* wl = lds + DSA_WOFF + wave * 1024;
    const int c = blockIdx.x, b = c & 7, j = c >> 3, R = G >> 3;
    const bf16* pb = proj + (size_t)b * T * NPROJ; const bf16* kvb = bkv + (size_t)b * T * 256; const bf16* ikb = ik + (size_t)b * T * 64;
    ((unsigned*)(wl + 512))[lane] = 0u; ((unsigned*)(wl + 512))[lane + 64] = 0u;
    for (int k = 0; ; ++k) {
        const int u = (k & 1) ? (R - 1 - j) + R * k : j + R * k;
        if (u >= T / 8) break;
        const int t0 = 8 * u;
        int l1 = lane; asm volatile("" : "+v"(l1));
        for (int r_ = 0; r_ < REP(4); ++r_) dsa_scores(pb, ikb, t0, scl, wave, l1);
        __syncthreads();
        int l2 = lane; asm volatile("" : "+v"(l2));
        bf16x8 qa[2][2];
#pragma unroll
        for (int kvh = 0; kvh < 2; ++kvh) { const bf16* qp = pb + (size_t)(t0 + wave) * NPROJ + C_BQ + (kvh * 4 + (l2 & 3)) * 64 + 8 * (l2 >> 4); qa[kvh][0] = *(const bf16x8*)qp; qa[kvh][1] = *(const bf16x8*)(qp + 32); }
        dsa_select<0>(t0 + wave, scl + wave * DSA_S, wl, l2);
        int l3 = lane; asm volatile("" : "+v"(l3));
        dsa_attend<0>(qa, kvb, br01, b, t0 + wave, scl + wave * DSA_S, wl, l3);
        __syncthreads();
    }
}
__device__ __forceinline__ void ret_u_phase(const bf16* proj, float* U, char* lds, int G) {
    int tid = threadIdx.x; asm volatile("" : "+v"(tid)); const int lane = tid & 63, wave = tid >> 6, fr = lane & 15, fq = lane >> 4;
    bf16* KdT = (bf16*)lds; bf16* VT = (bf16*)(lds + 17408);
    for (int un = blockIdx.x; un < 1024; un += G) {
        const int c = un & 31, bh = un >> 5, h = bh & 3, b = bh >> 2;
        const float lg2 = log2f(1.f - exp2f(-5.f - (float)h));
        const size_t m0 = (size_t)b * T + c * 128;
#pragma unroll
        for (int i = 0; i < 2; ++i) { const int idx = tid + 512 * i, mm = idx >> 3, pc = idx & 7;
            const u32x4 kv = *(const u32x4*)(proj + (m0 + mm) * NPROJ + C_RK + 64 * h + 8 * pc);
            const float dc = 0.125f * exp2f(lg2 * (float)(127 - mm));
            bf16* kd = KdT + (8 * pc) * RT_P + mm;
            kd[0] = (bf16)f2bf1(__uint_as_float(kv.x << 16) * dc); kd[RT_P] = (bf16)f2bf1(__uint_as_float(kv.x & 0xffff0000u) * dc);
            kd[2 * RT_P] = (bf16)f2bf1(__uint_as_float(kv.y << 16) * dc); kd[3 * RT_P] = (bf16)f2bf1(__uint_as_float(kv.y & 0xffff0000u) * dc);
            kd[4 * RT_P] = (bf16)f2bf1(__uint_as_float(kv.z << 16) * dc); kd[5 * RT_P] = (bf16)f2bf1(__uint_as_float(kv.z & 0xffff0000u) * dc);
            kd[6 * RT_P] = (bf16)f2bf1(__uint_as_float(kv.w << 16) * dc); kd[7 * RT_P] = (bf16)f2bf1(__uint_as_float(kv.w & 0xffff0000u) * dc); }
#pragma unroll
        for (int i = 0; i < 4; ++i) { const int idx = tid + 512 * i, mm = idx >> 4, pc = idx & 15;
            const u32x4 vv = *(const u32x4*)(proj + (m0 + mm) * NPROJ + C_RV + 128 * h + 8 * pc);
            bf16* vd = VT + (8 * pc) * RT_P + mm;
            vd[0] = (bf16)(vv.x & 0xffffu); vd[RT_P] = (bf16)(vv.x >> 16); vd[2 * RT_P] = (bf16)(vv.y & 0xffffu); vd[3 * RT_P] = (bf16)(vv.y >> 16);
            vd[4 * RT_P] = (bf16)(vv.z & 0xffffu); vd[5 * RT_P] = (bf16)(vv.z >> 16); vd[6 * RT_P] = (bf16)(vv.w & 0xffffu); vd[7 * RT_P] = (bf16)(vv.w >> 16); }
        __syncthreads();
        f32x4v acc[4];
#pragma unroll
        for (int dt = 0; dt < 4; ++dt) acc[dt] = (f32x4v){0.f, 0.f, 0.f, 0.f};
#pragma unroll
        for (int ks = 0; ks < 4; ++ks) { const bf16x8 bv = *(const bf16x8*)(VT + (16 * wave + fr) * RT_P + 32 * ks + 8 * fq);
#pragma unroll
            for (int dt = 0; dt < 4; ++dt) acc[dt] = __builtin_amdgcn_mfma_f32_16x16x32_bf16(*(const bf16x8*)(KdT + (16 * dt + fr) * RT_P + 32 * ks + 8 * fq), bv, acc[dt], 0, 0, 0); }
        float* up = U + (size_t)un * 8192;
#pragma unroll
        for (int dt = 0; dt < 4; ++dt)
#pragma unroll
            for (int r = 0; r < 4; ++r) up[(16 * dt + 4 * fq + r) * 128 + 16 * wave + fr] = acc[dt][r];
        __syncthreads();
    }
}
__device__ __forceinline__ void ret_scan_phase(const float* U, bf16* ST, int G) {
    int tid = threadIdx.x; asm volatile("" : "+v"(tid));
    for (int w = blockIdx.x; w < 256; w += G) {
        const int bh = w >> 3, part = w & 7, h = bh & 3;
        const float cd = exp2f(128.f * log2f(1.f - exp2f(-5.f - (float)h)));
        const int e2 = part * 512 + tid, dv = e2 & 127, dp = e2 >> 7;
        const float* up = U + (size_t)bh * 32 * 8192 + (2 * dp) * 128 + dv;
        unsigned* sp = (unsigned*)(ST + (size_t)bh * 32 * 8192 + dv * 64 + 2 * dp);
        float u0[32], u1[32];
#pragma unroll
        for (int j = 0; j < 31; ++j) { u0[j] = up[(size_t)j * 8192]; u1[j] = up[(size_t)j * 8192 + 128]; }
        float s0 = 0.f, s1 = 0.f;
        sp[0] = 0u;
#pragma unroll
        for (int c = 1; c < 32; ++c) { s0 = s0 * cd + u0[c - 1]; s1 = s1 * cd + u1[c - 1]; sp[(size_t)c * 4096] = pk2(s0, s1); }
    }
}
__device__ __forceinline__ void ret_out_phase(const bf16* proj, const bf16* ST, bf16* br23, char* lds, int G) {
    int tid = threadIdx.x; asm volatile("" : "+v"(tid)); const int lane = tid & 63, wave = tid >> 6, fr = lane & 15, fq = lane >> 4;
    bf16* Kl = (bf16*)lds; bf16* VT = (bf16*)(lds + 18432); bf16* Pw = (bf16*)(lds + 18432 + 34816) + wave * 16 * RT_P;
    for (int un = blockIdx.x; un < 1024; un += G) {
        const int c = un & 31, bh = un >> 5, h = bh & 3, b = bh >> 2;
        const float lg2 = log2f(1.f - exp2f(-5.f - (float)h));
        const size_t m0 = (size_t)b * T + c * 128;
        const bf16* qp = proj + (m0 + 16 * wave + fr) * NPROJ + C_RQ + 64 * h + 8 * fq;
        const bf16x8 q0 = *(const bf16x8*)qp, q1 = *(const bf16x8*)(qp + 32);
        const bf16* stp = ST + (size_t)un * 8192;
        bf16x8 stf[8][2];
#pragma unroll
        for (int dt = 0; dt < 8; ++dt) { const bf16* sp = stp + (16 * dt + fr) * 64 + 8 * fq; stf[dt][0] = *(const bf16x8*)sp; stf[dt][1] = *(const bf16x8*)(sp + 32); }
#pragma unroll
        for (int i = 0; i < 2; ++i) { const int idx = tid + 512 * i, mm = idx >> 3, pc = idx & 7;
            *(u32x4*)(Kl + mm * 72 + 8 * pc) = *(const u32x4*)(proj + (m0 + mm) * NPROJ + C_RK + 64 * h + 8 * pc); }
#pragma unroll
        for (int i = 0; i < 4; ++i) { const int idx = tid + 512 * i, mm = idx >> 4, pc = idx & 15;
            const u32x4 vv = *(const u32x4*)(proj + (m0 + mm) * NPROJ + C_RV + 128 * h + 8 * pc);
            bf16* vd = VT + (8 * pc) * RT_P + mm;
            vd[0] = (bf16)(vv.x & 0xffffu); vd[RT_P] = (bf16)(vv.x >> 16); vd[2 * RT_P] = (bf16)(vv.y & 0xffffu); vd[3 * RT_P] = (bf16)(vv.y >> 16);
            vd[4 * RT_P] = (bf16)(vv.z & 0xffffu); vd[5 * RT_P] = (bf16)(vv.z >> 16); vd[6 * RT_P] = (bf16)(vv.w & 0xffffu); vd[7 * RT_P] = (bf16)(vv.w >> 16); }
        __syncthreads();
        f32x4v acc[8];
#pragma unroll
        for (int dt = 0; dt < 8; ++dt) { f32x4v d = (f32x4v){0.f, 0.f, 0.f, 0.f};
            d = __builtin_amdgcn_mfma_f32_16x16x32_bf16(q0, stf[dt][0], d, 0, 0, 0);
            d = __builtin_amdgcn_mfma_f32_16x16x32_bf16(q1, stf[dt][1], d, 0, 0, 0);
            acc[dt] = d; }
#pragma unroll
        for (int r = 0; r < 4; ++r) { const float qd = exp2f(lg2 * (float)(16 * wave + 4 * fq + r + 1));
#pragma unroll
            for (int dt = 0; dt < 8; ++dt) acc[dt][r] *= qd; }
#pragma unroll
        for (int mt = 0; mt < 8; ++mt) {
            f32x4v d = (f32x4v){0.f, 0.f, 0.f, 0.f};
            if (mt <= wave) { const bf16* kp = Kl + (16 * mt + fr) * 72 + 8 * fq;
                d = __builtin_amdgcn_mfma_f32_16x16x32_bf16(q0, *(const bf16x8*)kp, d, 0, 0, 0);
                d = __builtin_amdgcn_mfma_f32_16x16x32_bf16(q1, *(const bf16x8*)(kp + 32), d, 0, 0, 0); }
            const int mm = 16 * mt + fr;
#pragma unroll
            for (int r = 0; r < 4; ++r) { const int n = 16 * wave + 4 * fq + r;
                const float pv = (mm <= n) ? d[r] * 0.125f * exp2f(lg2 * (float)(n - mm)) : 0.f;
                Pw[(4 * fq + r) * RT_P + mm] = (bf16)f2bf1(pv); }
        }
        bf16 gh[4][8];
#pragma unroll
        for (int r = 0; r < 4; ++r) { const bf16* gp = proj + (m0 + 16 * wave + 4 * fq + r) * NPROJ + C_RG + 128 * h + fr;
#pragma unroll
            for (int dt = 0; dt < 8; ++dt) gh[r][dt] = gp[16 * dt]; }
        LDS_WAIT();
#pragma unroll
        for (int ks = 0; ks < 4; ++ks) { const bf16x8 pa = *(const bf16x8*)(Pw + fr * RT_P + 32 * ks + 8 * fq);
#pragma unroll
            for (int dt = 0; dt < 8; ++dt) acc[dt] = __builtin_amdgcn_mfma_f32_16x16x32_bf16(pa, *(const bf16x8*)(VT + (16 * dt + fr) * RT_P + 32 * ks + 8 * fq), acc[dt], 0, 0, 0); }
#pragma unroll
        for (int r = 0; r < 4; ++r) { float q = 0.f;
#pragma unroll
            for (int dt = 0; dt < 8; ++dt) q += acc[dt][r] * acc[dt][r];
            const float rs = 1.f / sqrtf(row16_sum(q) * (1.f / 128.f) + EPS);
            const size_t row = m0 + 16 * wave + 4 * fq + r;
            bf16* op = br23 + row * D + h * 128 + fr;
#pragma unroll
            for (int dt = 0; dt < 8; ++dt) { const float gv = bf2f(gh[r][dt]); op[16 * dt] = (bf16)f2bf1(gv / (1.f + __expf(-gv)) * acc[dt][r] * rs); } }
        __syncthreads();
    }
}

typedef const __attribute__((address_space(4))) Args* KArgs;
__device__ __forceinline__ KArgs kargs() { KArgs p = (KArgs)__builtin_amdgcn_kernarg_segment_ptr(); asm volatile("" : "+s"(p)); return p; }

__device__ __forceinline__ void ph0(LAS unsigned char* L, int layer, int slot) {
    int tid = threadIdx.x; asm volatile("" : "+v"(tid)); const int lane = tid & 63, wave = __builtin_amdgcn_readfirstlane(tid >> 6);
    int G = gridDim.x, bx = blockIdx.x; asm volatile("" : "+s"(G), "+s"(bx)); const int gw = bx * 8 + wave, NGW = G * 8;
    unsigned char* lds = (unsigned char*)L; LAS int* lcnt = (LAS int*)(L + 0); LAS int* gt = (LAS int*)(L + LDS_MISC + 512);
    (void)lane; (void)gw; (void)NGW; (void)lds; (void)lcnt; (void)gt; (void)layer; (void)slot; (void)tid; (void)bx; (void)G;
    {
        KArgs A = kargs(); unsigned char* ws = A->ws;
        LAS float* scr = (LAS float*)(L + wave * 16384);
        constexpr int I_IN = 16 * 128, I_G = 16 * 128, I_B = 8 * 32, I_SQ = 16 * 32, I_L = I_IN + I_G + 4 * I_B + 5 * I_SQ;
        constexpr int I_GU = 16 * 224, I_DN = 56 * 32, NITEMS = 2 * I_L + I_GU + I_DN;
        for (int it = gw; it < NITEMS; it += NGW) {
            int r = it;
            if (r < 2 * I_L) {
                const int l = r / I_L; r -= l * I_L;
                unsigned char* wb = ws + WS_W + (size_t)l * W_LAYER;
                const float* win = A->w_in + (size_t)l * D * D_IN;
                if (r < I_IN) { conv_seg<1>(win, D, D_IN, 0, (bf16*)(wb + W_IN), D, 0, 128, r, scr, lane, A->norm_mix + (size_t)l * D); continue; } r -= I_IN;
                if (r < I_G) { conv_seg<0, 1>(win, D, D_IN, 3908, (bf16*)(wb + W_G), D, 0, 128, r, scr, lane, A->norm_mix + (size_t)l * D); continue; } r -= I_G;
                if (r < 4 * I_B) { const int i = r / I_B; r -= i * I_B;
                    conv_seg<0>(A->w_branch + ((size_t)l * 4 + i) * 512 * D, 512, D, 0, (bf16*)(wb + W_B) + (size_t)(i >> 1) * D * D, D, (i & 1) * 512, 32, r, scr, lane); continue; } r -= 4 * I_B;
                if (r < I_SQ) { conv_seg<0>(A->w_out + (size_t)l * D * D, D, D, 0, (bf16*)(wb + W_OUT), D, 0, 32, r, scr, lane); continue; } r -= I_SQ;
                if (r < I_SQ) { conv_seg<0>(A->w_xq + (size_t)l * D * D, D, D, 0, (bf16*)(wb + W_XQ), D, 0, 32, r, scr, lane, A->norm_cross + (size_t)l * D); continue; } r -= I_SQ;
                if (r < I_SQ) { conv_seg<0>(A->w_xkv + (size_t)l * D * 2 * D, D, 2 * D, 0, (bf16*)(wb + W_XK), D, 0, 32, r, scr, lane); continue; } r -= I_SQ;
                if (r < I_SQ) { conv_seg<0>(A->w_xkv + (size_t)l * D * 2 * D, D, 2 * D, D, (bf16*)(wb + W_XV), D, 0, 32, r, scr, lane); continue; } r -= I_SQ;
                conv_seg<0, 1>(A->w_xo + (size_t)l * D * D, D, D, 0, (bf16*)(wb + W_XO), D, 0, 32, r, scr, lane); continue;
            }
            r -= 2 * I_L;
            if (r < I_GU) { conv_seg<2, 1>(A->dense_w_gu, D, 2 * DFF, 0, (bf16*)(ws + WS_WGU), D, 0, 224, r, scr, lane, A->norm_ffn); continue; } r -= I_GU;
            conv_seg<0, 1>(A->dense_w_down, DFF, D, 0, (bf16*)(ws + WS_WDN), DFF, 0, 32, r, scr, lane);
        }
        for (int it = gw; it < 64; it += NGW) { const int lg = it >> 3;
            conv_seg<0>(A->pool_w + (size_t)lg * 16384, 128, 128, 0, (bf16*)(ws + WS_WPOOL) + (size_t)lg * 16384, 128, 0, 4, it & 7, scr, lane); }
        {
            _Float16* cosT = (_Float16*)(ws + WS_ROPE); _Float16* sinT = cosT + (size_t)M * 32; const int* pos = A->positions;
            for (int i = bx * 512 + tid; i < M * 32; i += G * 512) { const int m = i >> 5, j = i & 31;
                const float ang = (float)pos[m] * INV_FREQ[j];
                const double rev = (double)ang * 0.15915494309189533577; const float fr_ = (float)(rev - rint(rev));
                const size_t to = ((size_t)((m >> 4) * 4 + (j >> 3)) * 16 + (m & 15)) * 8 + (j & 7);
                cosT[to] = (_Float16)__builtin_amdgcn_cosf(fr_); sinT[to] = (_Float16)__builtin_amdgcn_sinf(fr_); }
        }
        {
            const float* mem = A->mem; const float* nm = A->norm_mem; bf16* MN = (bf16*)(ws + WS_MN);
            for (int r = gw; r < 2 * MROWS; r += NGW) { const int l = r / MROWS, mr = r % MROWS; norm_row_bf16(mem + (size_t)mr * D, nm + (size_t)l * D, MN + (size_t)r * D, lane); }
            const float* x = A->x; bf16* XB = (bf16*)(ws + WS_HB); u64* ss0 = (u64*)(ws + WS_SS);
            for (int m = gw; m < M; m += NGW) {
                const f32x4* xr = (const f32x4*)(x + (size_t)m * D) + lane; unsigned long long* o8 = (unsigned long long*)(XB + (size_t)m * D) + lane; float q = 0.f;
#pragma unroll
                for (int j = 0; j < 4; ++j) { const f32x4 v = xr[64 * j]; q += (v.x * v.x + v.y * v.y) + (v.z * v.z + v.w * v.w);
                    o8[64 * j] = (unsigned long long)pk2(v.x, v.y) | ((unsigned long long)pk2(v.z, v.w) << 32);
                    ((unsigned*)(ws + WS_XF8 + (size_t)m * D))[lane + 64 * j] = pk4_f8(v.x, v.y, v.z, v.w); }
                q = wave_sum(q); if (lane == 0) ss0[m] = ss_fix(q); }
        }
    }
}
__device__ __forceinline__ void ph1(LAS unsigned char* L, int layer, int slot) {
    int tid = threadIdx.x; asm volatile("" : "+v"(tid)); const int lane = tid & 63, wave = __builtin_amdgcn_readfirstlane(tid >> 6);
    int G = gridDim.x, bx = blockIdx.x; asm volatile("" : "+s"(G), "+s"(bx)); const int gw = bx * 8 + wave, NGW = G * 8;
    unsigned char* lds = (unsigned char*)L; LAS int* lcnt = (LAS int*)(L + 0); LAS int* gt = (LAS int*)(L + LDS_MISC + 512);
    (void)lane; (void)gw; (void)NGW; (void)lds; (void)lcnt; (void)gt; (void)layer; (void)slot; (void)tid; (void)bx; (void)G;
    {
            unsigned char* ws = kargs()->ws; unsigned char* wb = ws + WS_W + (size_t)layer * W_LAYER;
            { pg8::GridSched S{(const char*)(ws + WS_HB), (const char*)(wb + W_IN), 2048u, 2048u, 128, 16, 16, G, bx};
              EpiProj E{(bf16*)(ws + WS_PROJ), (const _Float16*)(ws + WS_ROPE), (const _Float16*)(ws + WS_ROPE) + (size_t)M * 32, (bf16*)(ws + WS_AKV), (bf16*)(ws + WS_BKV), (bf16*)(ws + WS_IK), (const u64*)(ws + WS_SS) + (size_t)(3 * layer) * M};
              pg8::gemm_stream(L, S, E, 2048u, 2048u); }
            if (layer == 0) {
                for (int l = 0; l < 2; ++l) {
                    unsigned char* wl = ws + WS_W + (size_t)l * W_LAYER;
                    { pg8::GridSched S{(const char*)(ws + WS_MN) + (size_t)l * MROWS * D * 2, (const char*)(wl + W_XK), 2048u, 2048u, 8, 4, 16, G, bx};
                      EpiPlain E{(bf16*)(ws + WS_KX) + (size_t)l * MROWS * D, D, 1.f, nullptr};
                      pg8::gemm_stream(L, S, E, 2048u, 2048u); }
                    { pg8::GridSched S{(const char*)(wl + W_XV), (const char*)(ws + WS_MN) + (size_t)l * MROWS * D * 2, 2048u, 2048u, 4, 8, 16, G, bx};
                      EpiPlain E{(bf16*)(ws + WS_VTB) + (size_t)l * 8 * D * D, D, 1.f, nullptr, (size_t)D * D};
                      pg8::gemm_stream(L, S, E, 2048u, 2048u); }
                }
            }
        }
}
__device__ __forceinline__ void ph2(LAS unsigned char* L, int layer, int slot) {
    int tid = threadIdx.x; asm volatile("" : "+v"(tid)); const int lane = tid & 63, wave = __builtin_amdgcn_readfirstlane(tid >> 6);
    int G = gridDim.x, bx = blockIdx.x; asm volatile("" : "+s"(G), "+s"(bx)); const int gw = bx * 8 + wave, NGW = G * 8;
    unsigned char* lds = (unsigned char*)L; LAS int* lcnt = (LAS int*)(L + 0); LAS int* gt = (LAS int*)(L + LDS_MISC + 512);
    (void)lane; (void)gw; (void)NGW; (void)lds; (void)lcnt; (void)gt; (void)layer; (void)slot; (void)tid; (void)bx; (void)G;
    {
            KArgs A = kargs(); unsigned char* ws = A->ws;
            const bf16* PROJ = (const bf16*)(ws + WS_PROJ);
            for (int r_ = 0; r_ < REP(0); ++r_) ret_u_phase(PROJ, (float*)(ws + WS_U), (char*)lds, G);
            for (int r_ = 0; r_ < REP(1); ++r_) pool_phase(PROJ, (const bf16*)(ws + WS_WPOOL) + (size_t)layer * 4 * 16384, A->pool_scale + (size_t)layer * 512, (bf16*)(ws + WS_BR23), (char*)lds, G);
            for (int r_ = 0; r_ < REP(2); ++r_) swa_phase(PROJ, (const bf16*)(ws + WS_AKV), A->attn_sink + layer * 8, (bf16*)(ws + WS_BR01), (char*)lds, G);
            for (int r_ = 0; r_ < REP(3); ++r_) dsa_phase(PROJ, (const bf16*)(ws + WS_BKV), (const bf16*)(ws + WS_IK), (bf16*)(ws + WS_BR01), (char*)lds, G);
        }
}
__device__ __forceinline__ void ph3(LAS unsigned char* L, int layer, int slot) {
    int tid = threadIdx.x; asm volatile("" : "+v"(tid)); const int lane = tid & 63, wave = __builtin_amdgcn_readfirstlane(tid >> 6);
    int G = gridDim.x, bx = blockIdx.x; asm volatile("" : "+s"(G), "+s"(bx)); const int gw = bx * 8 + wave, NGW = G * 8;
    unsigned char* lds = (unsigned char*)L; LAS int* lcnt = (LAS int*)(L + 0); LAS int* gt = (LAS int*)(L + LDS_MISC + 512);
    (void)lane; (void)gw; (void)NGW; (void)lds; (void)lcnt; (void)gt; (void)layer; (void)slot; (void)tid; (void)bx; (void)G;
    { unsigned char* ws = kargs()->ws; ret_out_phase((const bf16*)(ws + WS_PROJ), (const bf16*)(ws + WS_ST), (bf16*)(ws + WS_BR23), (char*)lds, G); }
}
__device__ __forceinline__ void ph20(LAS unsigned char* L, int layer, int slot) {
    int tid = threadIdx.x; asm volatile("" : "+v"(tid)); const int lane = tid & 63, wave = __builtin_amdgcn_readfirstlane(tid >> 6);
    int G = gridDim.x, bx = blockIdx.x; asm volatile("" : "+s"(G), "+s"(bx)); const int gw = bx * 8 + wave, NGW = G * 8;
    unsigned char* lds = (unsigned char*)L; LAS int* lcnt = (LAS int*)(L + 0); LAS int* gt = (LAS int*)(L + LDS_MISC + 512);
    (void)lane; (void)gw; (void)NGW; (void)lds; (void)lcnt; (void)gt; (void)layer; (void)slot; (void)tid; (void)bx; (void)G;
    { unsigned char* ws = kargs()->ws; ret_scan_phase((const float*)(ws + WS_U), (bf16*)(ws + WS_ST), G); }
}
__device__ __forceinline__ void ph4(LAS unsigned char* L, int layer, int slot) {
    int tid = threadIdx.x; asm volatile("" : "+v"(tid)); const int lane = tid & 63, wave = __builtin_amdgcn_readfirstlane(tid >> 6);
    int G = gridDim.x, bx = blockIdx.x; asm volatile("" : "+s"(G), "+s"(bx)); const int gw = bx * 8 + wave, NGW = G * 8;
    unsigned char* lds = (unsigned char*)L; LAS int* lcnt = (LAS int*)(L + 0); LAS int* gt = (LAS int*)(L + LDS_MISC + 512);
    (void)lane; (void)gw; (void)NGW; (void)lds; (void)lcnt; (void)gt; (void)layer; (void)slot; (void)tid; (void)bx; (void)G;
    {
            unsigned char* ws = kargs()->ws; unsigned char* wb = ws + WS_W + (size_t)layer * W_LAYER;
            unsigned* scr = (unsigned*)(ws + WS_MSCR + (size_t)bx * 786432);
            for (int ti = 0; ti * G + bx < 512; ++ti) {
                int pm, pn; pg8::tile_of(ti * G + bx, 128, 4, pm, pn);
                { MergeSched<0> S{(const char*)(ws + WS_XF8), nullptr, (const char*)(wb + W_G), pm, pn};
                  EpiGate E{scr, (const u64*)(ws + WS_SS) + (size_t)(3 * layer) * M, 1.f / F8_WSCALE};
                  pg8::gemm_stream<EpiGate, MergeSched<0>, 1>(L, S, E, 1024u, 1024u); }
                { MergeSched<1> S{(const char*)(ws + WS_BR01), (const char*)(ws + WS_BR23), (const char*)(wb + W_B), pm, pn};
                  EpiUp E{scr, (bf16*)(ws + WS_MERGED)};
                  pg8::gemm_stream(L, S, E, 2048u, 2048u); }
            }
        }
}
__device__ __forceinline__ void ph5(LAS unsigned char* L, int layer, int slot) {
    int tid = threadIdx.x; asm volatile("" : "+v"(tid)); const int lane = tid & 63, wave = __builtin_amdgcn_readfirstlane(tid >> 6);
    int G = gridDim.x, bx = blockIdx.x; asm volatile("" : "+s"(G), "+s"(bx)); const int gw = bx * 8 + wave, NGW = G * 8;
    unsigned char* lds = (unsigned char*)L; LAS int* lcnt = (LAS int*)(L + 0); LAS int* gt = (LAS int*)(L + LDS_MISC + 512);
    (void)lane; (void)gw; (void)NGW; (void)lds; (void)lcnt; (void)gt; (void)layer; (void)slot; (void)tid; (void)bx; (void)G;
    {
            KArgs A = kargs(); unsigned char* ws = A->ws; unsigned char* wb = ws + WS_W + (size_t)layer * W_LAYER;
            pg8::GridSched S{(const char*)(ws + WS_MERGED), (const char*)(wb + W_OUT), 2048u, 2048u, 128, 4, 16, G, bx};
            EpiRes E{(bf16*)(ws + WS_HB), (u64*)(ws + WS_SS) + (size_t)(3 * layer + 1) * M};
            pg8::gemm_stream(L, S, E, 2048u, 2048u);
        }
}
__device__ __forceinline__ void ph6(LAS unsigned char* L, int layer, int slot) {
    int tid = threadIdx.x; asm volatile("" : "+v"(tid)); const int lane = tid & 63, wave = __builtin_amdgcn_readfirstlane(tid >> 6);
    int G = gridDim.x, bx = blockIdx.x; asm volatile("" : "+s"(G), "+s"(bx)); const int gw = bx * 8 + wave, NGW = G * 8;
    unsigned char* lds = (unsigned char*)L; LAS int* lcnt = (LAS int*)(L + 0); LAS int* gt = (LAS int*)(L + LDS_MISC + 512);
    (void)lane; (void)gw; (void)NGW; (void)lds; (void)lcnt; (void)gt; (void)layer; (void)slot; (void)tid; (void)bx; (void)G;
    { KArgs A = kargs(); const float* x = A->out; const float* g = A->norm_cross + (size_t)layer * D; bf16* HB = (bf16*)(A->ws + WS_HB);
            for (int m = gw; m < M; m += NGW) norm_row_bf16(x + (size_t)m * D, g, HB + (size_t)m * D, lane); }
}
template <int COPY> __device__ __forceinline__ void ph7(LAS unsigned char* L, int layer, int slot) {
    if (COPY) asm volatile("s_nop 0" ::: "memory");
    int tid = threadIdx.x; asm volatile("" : "+v"(tid)); const int lane = tid & 63, wave = __builtin_amdgcn_readfirstlane(tid >> 6);
    int G = gridDim.x, bx = blockIdx.x; asm volatile("" : "+s"(G), "+s"(bx)); const int gw = bx * 8 + wave, NGW = G * 8;
    unsigned char* lds = (unsigned char*)L; LAS int* lcnt = (LAS int*)(L + 0); LAS int* gt = (LAS int*)(L + LDS_MISC + 512);
    (void)lane; (void)gw; (void)NGW; (void)lds; (void)lcnt; (void)gt; (void)layer; (void)slot; (void)tid; (void)bx; (void)G;
    {
            unsigned char* ws = kargs()->ws; unsigned char* wb = ws + WS_W + (size_t)layer * W_LAYER;
            pg8::GridSched S{(const char*)(ws + WS_HB), (const char*)(wb + W_XQ), 2048u, 2048u, 128, 4, 16, G, bx};
            EpiPlain E{(bf16*)(ws + WS_XQ), D, 1.f, (const u64*)(ws + WS_SS) + (size_t)(3 * layer + 1) * M};
            pg8::gemm_stream(L, S, E, 2048u, 2048u);
        }
}
__device__ __forceinline__ void ph8(LAS unsigned char* L, int layer, int slot) {
    int tid = threadIdx.x; asm volatile("" : "+v"(tid)); const int lane = tid & 63, wave = __builtin_amdgcn_readfirstlane(tid >> 6);
    int G = gridDim.x, bx = blockIdx.x; asm volatile("" : "+s"(G), "+s"(bx)); const int gw = bx * 8 + wave, NGW = G * 8;
    unsigned char* lds = (unsigned char*)L; LAS int* lcnt = (LAS int*)(L + 0); LAS int* gt = (LAS int*)(L + LDS_MISC + 512);
    (void)lane; (void)gw; (void)NGW; (void)lds; (void)lcnt; (void)gt; (void)layer; (void)slot; (void)tid; (void)bx; (void)G;
    {
            unsigned char* ws = kargs()->ws;
            unsigned char* wb = ws + WS_W + (size_t)layer * W_LAYER;
            CrossFusedSched S{(const char*)(ws + WS_HB), (const char*)(wb + W_XQ), (const char*)(ws + WS_XQ), (const char*)(ws + WS_KX) + (size_t)layer * MROWS * D * 2,
                              (const char*)(ws + WS_XP), (const char*)(ws + WS_VTB) + (size_t)layer * 8 * D * D * 2, G, bx};
            EpiCross E{EpiPlain{(bf16*)(ws + WS_XQ), D, 1.f, (const u64*)(ws + WS_SS) + (size_t)(3 * layer + 1) * M},
                       EpiSoftmax{(bf16*)(ws + WS_XP), (LAS f32x2*)(L + LDS_XCH), 0.0625f * 1.44269504f},
                       EpiPlainT<true>{(bf16*)(ws + WS_XO), D, F8_OSCALE, nullptr}};
            pg8::gemm_stream(L, S, E, 2048u, 2048u);
        }
}
__device__ __forceinline__ void ph9(LAS unsigned char* L, int layer, int slot) {
    int tid = threadIdx.x; asm volatile("" : "+v"(tid)); const int lane = tid & 63, wave = __builtin_amdgcn_readfirstlane(tid >> 6);
    int G = gridDim.x, bx = blockIdx.x; asm volatile("" : "+s"(G), "+s"(bx)); const int gw = bx * 8 + wave, NGW = G * 8;
    unsigned char* lds = (unsigned char*)L; LAS int* lcnt = (LAS int*)(L + 0); LAS int* gt = (LAS int*)(L + LDS_MISC + 512);
    (void)lane; (void)gw; (void)NGW; (void)lds; (void)lcnt; (void)gt; (void)layer; (void)slot; (void)tid; (void)bx; (void)G;
    {
            unsigned char* ws = kargs()->ws;
            CrossSched S{(const char*)(ws + WS_XP), (const char*)(ws + WS_VT) + (size_t)layer * D * MROWS * 2, 1, G, bx};
            EpiPlain E{(bf16*)(ws + WS_XO), D, 1.f, nullptr};
            pg8::gemm_stream(L, S, E, 2048u, 4096u);
        }
}
__device__ __forceinline__ void ph10(LAS unsigned char* L, int layer, int slot) {
    int tid = threadIdx.x; asm volatile("" : "+v"(tid)); const int lane = tid & 63, wave = __builtin_amdgcn_readfirstlane(tid >> 6);
    int G = gridDim.x, bx = blockIdx.x; asm volatile("" : "+s"(G), "+s"(bx)); const int gw = bx * 8 + wave, NGW = G * 8;
    unsigned char* lds = (unsigned char*)L; LAS int* lcnt = (LAS int*)(L + 0); LAS int* gt = (LAS int*)(L + LDS_MISC + 512);
    (void)lane; (void)gw; (void)NGW; (void)lds; (void)lcnt; (void)gt; (void)layer; (void)slot; (void)tid; (void)bx; (void)G;
    {
            KArgs A = kargs(); unsigned char* ws = A->ws; unsigned char* wb = ws + WS_W + (size_t)layer * W_LAYER;
            pg8::GridSched S{(const char*)(ws + WS_XO), (const char*)(wb + W_XO), 1024u, 1024u, 128, 4, 8, G, bx};
            EpiResT<true> E{(bf16*)(ws + WS_HB), (u64*)(ws + WS_SS) + (size_t)(3 * layer + 2) * M, ws + WS_XF8, 1.f / (F8_OSCALE * F8_WSCALE)};
            pg8::gemm_stream<EpiResT<true>, pg8::GridSched, 1>(L, S, E, 1024u, 1024u);
        }
}
__device__ __forceinline__ void ph11(LAS unsigned char* L, int layer, int slot) {
    int tid = threadIdx.x; asm volatile("" : "+v"(tid)); const int lane = tid & 63, wave = __builtin_amdgcn_readfirstlane(tid >> 6);
    int G = gridDim.x, bx = blockIdx.x; asm volatile("" : "+s"(G), "+s"(bx)); const int gw = bx * 8 + wave, NGW = G * 8;
    unsigned char* lds = (unsigned char*)L; LAS int* lcnt = (LAS int*)(L + 0); LAS int* gt = (LAS int*)(L + LDS_MISC + 512);
    (void)lane; (void)gw; (void)NGW; (void)lds; (void)lcnt; (void)gt; (void)layer; (void)slot; (void)tid; (void)bx; (void)G;
    { KArgs A = kargs(); const float* x = A->out; const float* g = A->norm_ffn; bf16* HB = (bf16*)(A->ws + WS_HB);
                for (int m = gw; m < M; m += NGW) norm_row_bf16(x + (size_t)m * D, g, HB + (size_t)m * D, lane); }
}
__device__ __forceinline__ void ph12(LAS unsigned char* L, int layer, int slot) {
    int tid = threadIdx.x; asm volatile("" : "+v"(tid)); const int lane = tid & 63, wave = __builtin_amdgcn_readfirstlane(tid >> 6);
    int G = gridDim.x, bx = blockIdx.x; asm volatile("" : "+s"(G), "+s"(bx)); const int gw = bx * 8 + wave, NGW = G * 8;
    unsigned char* lds = (unsigned char*)L; LAS int* lcnt = (LAS int*)(L + 0); LAS int* gt = (LAS int*)(L + LDS_MISC + 512);
    (void)lane; (void)gw; (void)NGW; (void)lds; (void)lcnt; (void)gt; (void)layer; (void)slot; (void)tid; (void)bx; (void)G;
    {
                unsigned char* ws = kargs()->ws;
                pg8::GridSched S{(const char*)(ws + WS_XF8), (const char*)(ws + WS_WGU), 1024u, 1024u, 128, 28, 8, G, bx};
                EpiGU E{(bf16*)(ws + WS_HID), (const u64*)(ws + WS_SS) + (size_t)2 * M, 1.f / F8_WSCALE};
                pg8::gemm_stream<EpiGU, pg8::GridSched, 1>(L, S, E, 1024u, 1024u);
            }
}
__device__ __forceinline__ void ph13(LAS unsigned char* L, int layer, int slot) {
    int tid = threadIdx.x; asm volatile("" : "+v"(tid)); const int lane = tid & 63, wave = __builtin_amdgcn_readfirstlane(tid >> 6);
    int G = gridDim.x, bx = blockIdx.x; asm volatile("" : "+s"(G), "+s"(bx)); const int gw = bx * 8 + wave, NGW = G * 8;
    unsigned char* lds = (unsigned char*)L; LAS int* lcnt = (LAS int*)(L + 0); LAS int* gt = (LAS int*)(L + LDS_MISC + 512);
    (void)lane; (void)gw; (void)NGW; (void)lds; (void)lcnt; (void)gt; (void)layer; (void)slot; (void)tid; (void)bx; (void)G;
    {
                KArgs A = kargs(); unsigned char* ws = A->ws;
                pg8::GridSched S{(const char*)(ws + WS_HID), (const char*)(ws + WS_WDN), 3584u, 3584u, 128, 4, 28, G, bx};
                EpiResT<true> E{(bf16*)(ws + WS_HB), (u64*)(ws + WS_SS) + (size_t)(3) * M, ws + WS_XF8, 1.f / (F8_HSCALE * F8_WSCALE)};
                pg8::gemm_stream<EpiResT<true>, pg8::GridSched, 1>(L, S, E, 3584u, 3584u);
            }
}
__device__ __forceinline__ void ph14(LAS unsigned char* L, int layer, int slot) {
    int tid = threadIdx.x; asm volatile("" : "+v"(tid)); const int lane = tid & 63, wave = __builtin_amdgcn_readfirstlane(tid >> 6);
    int G = gridDim.x, bx = blockIdx.x; asm volatile("" : "+s"(G), "+s"(bx)); const int gw = bx * 8 + wave, NGW = G * 8;
    unsigned char* lds = (unsigned char*)L; LAS int* lcnt = (LAS int*)(L + 0); LAS int* gt = (LAS int*)(L + LDS_MISC + 512);
    (void)lane; (void)gw; (void)NGW; (void)lds; (void)lcnt; (void)gt; (void)layer; (void)slot; (void)tid; (void)bx; (void)G;
    { KArgs A = kargs(); const float* x = A->out; const float* g = A->norm_mix + D; bf16* HB = (bf16*)(A->ws + WS_HB);
                for (int m = gw; m < M; m += NGW) norm_row_bf16(x + (size_t)m * D, g, HB + (size_t)m * D, lane); }
}
__device__ __forceinline__ void ph15(LAS unsigned char* L, int layer, int slot) {
    int tid = threadIdx.x; asm volatile("" : "+v"(tid)); const int lane = tid & 63, wave = __builtin_amdgcn_readfirstlane(tid >> 6);
    int G = gridDim.x, bx = blockIdx.x; asm volatile("" : "+s"(G), "+s"(bx)); const int gw = bx * 8 + wave, NGW = G * 8;
    unsigned char* lds = (unsigned char*)L; LAS int* lcnt = (LAS int*)(L + 0); LAS int* gt = (LAS int*)(L + LDS_MISC + 512);
    (void)lane; (void)gw; (void)NGW; (void)lds; (void)lcnt; (void)gt; (void)layer; (void)slot; (void)tid; (void)bx; (void)G;
    {
                KArgs A = kargs(); unsigned char* ws = A->ws; unsigned* ctl = (unsigned*)(ws + WS_CTL);
                int* route = (int*)(ws + WS_ROUTE); bf16* HB = (bf16*)(ws + WS_HB);
                if (tid < 16) lcnt[tid] = 0;
                __syncthreads();
                const float* gn = A->norm_ffn + D; const float* rwt = A->router_w; const u64* ss5 = (const u64*)(ws + WS_SS) + (size_t)5 * M;
                f32x4 rwr[4][4][2];
#pragma unroll
                for (int j = 0; j < 4; ++j) { const f32x4 gg = ((const f32x4*)gn + lane)[64 * j]; const float* rw = rwt + (size_t)(256 * j + 4 * lane) * 8;
#pragma unroll
                    for (int q = 0; q < 4; ++q) { rwr[j][q][0] = *(const f32x4*)(rw + 8 * q) * gg[q]; rwr[j][q][1] = *(const f32x4*)(rw + 8 * q + 4) * gg[q]; } }
                for (int m = gw; m < M; m += NGW) {
                    const u32x2* xr = (const u32x2*)(HB + (size_t)m * D) + lane;
                    const float rstd = rstd_of(ss5[m]);
                    float lg[8];
#pragma unroll
                    for (int e = 0; e < 8; ++e) lg[e] = 0.f;
#pragma unroll
                    for (int j = 0; j < 4; ++j) { const u32x2 xv = xr[64 * j];
                        const f32x4 hv = (f32x4){__uint_as_float(xv.x << 16), __uint_as_float(xv.x & 0xffff0000u), __uint_as_float(xv.y << 16), __uint_as_float(xv.y & 0xffff0000u)} * rstd;
#pragma unroll
                        for (int q = 0; q < 4; ++q) { const f32x4 r0 = rwr[j][q][0], r1 = rwr[j][q][1]; const float hq = hv[q];
                            lg[0] += hq * r0.x; lg[1] += hq * r0.y; lg[2] += hq * r0.z; lg[3] += hq * r0.w; lg[4] += hq * r1.x; lg[5] += hq * r1.y; lg[6] += hq * r1.z; lg[7] += hq * r1.w; } }
#pragma unroll
                    for (int e = 0; e < 8; ++e) lg[e] = wave_sum(lg[e]);
                    int e0 = 0; float v0 = lg[0];
#pragma unroll
                    for (int e = 1; e < 8; ++e) if (lg[e] > v0) { v0 = lg[e]; e0 = e; }
                    int e1 = -1; float v1 = -INFINITY;
#pragma unroll
                    for (int e = 0; e < 8; ++e) if (e != e0 && lg[e] > v1) { v1 = lg[e]; e1 = e; }
                    const float ww1 = 1.f / (1.f + __expf(v0 - v1)), ww0 = 1.f - ww1;
                    if (lane == 0) { route[4 * m] = e0; route[4 * m + 1] = e1; ((float*)route)[4 * m + 2] = ww0; ((float*)route)[4 * m + 3] = ww1; atomicAdd((int*)&lcnt[e0], 1); atomicAdd((int*)&lcnt[8 + e1], 1); }
                }
                __syncthreads();
                if (tid < 16) atomicAdd(ctl + CW_CNT + tid, (unsigned)lcnt[tid]);
                __syncthreads();
                LAS float* scr = (LAS float*)(L + wave * 16384);
                constexpr int I_GU = 16 * 224, I_DN = 56 * 32;
                const float* mgu = A->moe_w_gu; const float* mdn = A->moe_w_down;
                for (int r_ = 0; r_ < REP(7); ++r_) {
                    auto decode = [&](int it, ConvItem& c) {
                        const int e = it / (I_GU + I_DN); int r = it % (I_GU + I_DN);
                        if (r < I_GU) { const int kb = r / 224, vb = r % 224, pn = vb >> 3, bj = (vb >> 2) & 1, pb = vb & 3;
                            c.W = mgu + (size_t)e * D * 2 * DFF; c.ldw = 2 * DFF; c.k0 = 64 * kb; c.src = bj * DFF + 128 * pn + 32 * pb; c.gain = gn; c.WT = ws + WS_MWGU + (size_t)e * 2 * DFF * D; c.dpitch = D; c.drow0 = 32 * vb; }
                        else { r -= I_GU; const int kb = r / 32, vb = r % 32;
                            c.W = mdn + (size_t)e * DFF * D; c.ldw = D; c.k0 = 64 * kb; c.src = 32 * vb; c.gain = nullptr; c.WT = ws + WS_MWDN + (size_t)e * D * DFF; c.dpitch = DFF; c.drow0 = 32 * vb; } };
                    const int NIT = 8 * (I_GU + I_DN);
                    int it = gw; ConvItem cur, nxt; f32x4 tvA[8], tvB[8]; float gA[8], gB[8];
                    if (it < NIT) { decode(it, cur); conv_load(cur, tvA, gA, lane); }
                    while (it < NIT) {
                        const int itn = it + NGW;
                        if (itn < NIT) { decode(itn, nxt); conv_load(nxt, tvB, gB, lane); }
                        conv_finish8(cur, tvA, gA, scr, lane);
                        cur = nxt; it = itn;
#pragma unroll
                        for (int i = 0; i < 8; ++i) { tvA[i] = tvB[i]; gA[i] = gB[i]; }
                    }
                }
            }
}
__device__ __forceinline__ void ph16(LAS unsigned char* L, int layer, int slot) {
    int tid = threadIdx.x; asm volatile("" : "+v"(tid)); const int lane = tid & 63, wave = __builtin_amdgcn_readfirstlane(tid >> 6);
    int G = gridDim.x, bx = blockIdx.x; asm volatile("" : "+s"(G), "+s"(bx)); const int gw = bx * 8 + wave, NGW = G * 8;
    unsigned char* lds = (unsigned char*)L; LAS int* lcnt = (LAS int*)(L + 0); LAS int* gt = (LAS int*)(L + LDS_MISC + 512);
    (void)lane; (void)gw; (void)NGW; (void)lds; (void)lcnt; (void)gt; (void)layer; (void)slot; (void)tid; (void)bx; (void)G;
    {
                unsigned char* ws = kargs()->ws; unsigned* ctl = (unsigned*)(ws + WS_CTL);
                int* route = (int*)(ws + WS_ROUTE); int* tokmap = (int*)(ws + WS_TOKMAP); float* roww = (float*)(ws + WS_ROWW); bf16* HB = (bf16*)(ws + WS_HB);
                LAS int* lbase = (LAS int*)(L + 64); LAS int* lc2 = (LAS int*)(L + 128);
                for (int chunk = bx; chunk < M / 128; chunk += G) {
                    if (tid < 16) { lcnt[tid] = 0; lc2[tid] = 0; }
                    __syncthreads();
                    const int m = chunk * 128 + (tid >> 2);
                    const int e0 = route[4 * m], e1 = route[4 * m + 1];
                    if ((tid & 3) == 0) { atomicAdd((int*)&lcnt[e0], 1); atomicAdd((int*)&lcnt[8 + e1], 1); }
                    __syncthreads();
                    if (tid < 16) lbase[tid] = (int)atomicAdd(ctl + CW_CUR + tid, (unsigned)lcnt[tid]) + gt[tid] * 256;
                    __syncthreads();
                    int p0 = 0, p1 = 0;
                    if ((tid & 3) == 0) { p0 = lbase[e0] + atomicAdd((int*)&lc2[e0], 1); p1 = lbase[8 + e1] + atomicAdd((int*)&lc2[8 + e1], 1);
                        tokmap[p0] = m; tokmap[p1] = m; roww[p0] = ((const float*)route)[4 * m + 2]; roww[p1] = ((const float*)route)[4 * m + 3];
                        const u64 sq = ((const u64*)(ws + WS_SS))[(size_t)5 * M + m]; ((u64*)(ws + WS_ROWSS))[p0] = sq; ((u64*)(ws + WS_ROWSS))[p1] = sq; }
                    p0 = __shfl(p0, lane & ~3); p1 = __shfl(p1, lane & ~3);
                    const u32x4* src = (const u32x4*)(ws + WS_XF8 + (size_t)m * D) + (tid & 3) * 16;
                    u32x4* d0 = (u32x4*)(ws + WS_XS + (size_t)p0 * D) + (tid & 3) * 16; u32x4* d1 = (u32x4*)(ws + WS_XS + (size_t)p1 * D) + (tid & 3) * 16;
                    u32x4 gv[16];
#pragma unroll
                    for (int q = 0; q < 16; ++q) gv[q] = src[q];
#pragma unroll
                    for (int q = 0; q < 16; ++q) { d0[q] = gv[q]; d1[q] = gv[q]; }
                    __syncthreads();
                }
                if (bx < 16) { const int g = bx; const int cntg = (int)__hip_atomic_load(ctl + CW_CNT + g, __ATOMIC_RELAXED, __HIP_MEMORY_SCOPE_AGENT);
                    for (int r = gt[g] * 256 + cntg + tid; r < gt[g + 1] * 256; r += 512) { tokmap[r] = -1; roww[r] = 0.f; ((u64*)(ws + WS_ROWSS))[r] = (u64)1 << 34; } }
            }
}
__device__ __forceinline__ void ph17(LAS unsigned char* L, int layer, int slot) {
    int tid = threadIdx.x; asm volatile("" : "+v"(tid)); const int lane = tid & 63, wave = __builtin_amdgcn_readfirstlane(tid >> 6);
    int G = gridDim.x, bx = blockIdx.x; asm volatile("" : "+s"(G), "+s"(bx)); const int gw = bx * 8 + wave, NGW = G * 8;
    unsigned char* lds = (unsigned char*)L; LAS int* lcnt = (LAS int*)(L + 0); LAS int* gt = (LAS int*)(L + LDS_MISC + 512);
    (void)lane; (void)gw; (void)NGW; (void)lds; (void)lcnt; (void)gt; (void)layer; (void)slot; (void)tid; (void)bx; (void)G;
    {
                unsigned char* ws = kargs()->ws;
                MoeSched S{(const char*)(ws + WS_XS), (const char*)(ws + WS_MWGU), 1024u, (size_t)2 * DFF * D, 1024u, 0, gt[16], 28, 8, G, bx, (const int*)gt};
                EpiGU E{(bf16*)(ws + WS_MHID), (const u64*)(ws + WS_ROWSS), 1.f / F8_WSCALE};
                pg8::gemm_stream<EpiGU, MoeSched, 1>(L, S, E, 1024u, 1024u);
            }
}
__device__ __forceinline__ void ph18(LAS unsigned char* L, int layer, int slot) {
    int tid = threadIdx.x; asm volatile("" : "+v"(tid)); const int lane = tid & 63, wave = __builtin_amdgcn_readfirstlane(tid >> 6);
    int G = gridDim.x, bx = blockIdx.x; asm volatile("" : "+s"(G), "+s"(bx)); const int gw = bx * 8 + wave, NGW = G * 8;
    unsigned char* lds = (unsigned char*)L; LAS int* lcnt = (LAS int*)(L + 0); LAS int* gt = (LAS int*)(L + LDS_MISC + 512);
    (void)lane; (void)gw; (void)NGW; (void)lds; (void)lcnt; (void)gt; (void)layer; (void)slot; (void)tid; (void)bx; (void)G;
    {
                    KArgs A = kargs(); unsigned char* ws = A->ws;
                    MoeSched S{(const char*)(ws + WS_MHID), (const char*)(ws + WS_MWDN), 3584u, (size_t)D * DFF, 3584u, 0, gt[16], 4, 28, G, bx, (const int*)gt};
                    EpiDownMoe E{(const int*)(ws + WS_TOKMAP), (const float*)(ws + WS_ROWW), (bf16*)(ws + WS_XS), gt[8]};
                    pg8::gemm_stream<EpiDownMoe, MoeSched, 1>(L, S, E, 3584u, 3584u);
                }
}
__device__ __forceinline__ void ph19(LAS unsigned char* L, int layer, int slot) {
    int tid = threadIdx.x; asm volatile("" : "+v"(tid)); const int lane = tid & 63, wave = __builtin_amdgcn_readfirstlane(tid >> 6);
    int G = gridDim.x, bx = blockIdx.x; asm volatile("" : "+s"(G), "+s"(bx)); const int gw = bx * 8 + wave, NGW = G * 8;
    unsigned char* lds = (unsigned char*)L; LAS int* lcnt = (LAS int*)(L + 0); LAS int* gt = (LAS int*)(L + LDS_MISC + 512);
    (void)lane; (void)gw; (void)NGW; (void)lds; (void)lcnt; (void)gt; (void)layer; (void)slot; (void)tid; (void)bx; (void)G;
    { KArgs A = kargs(); float* xo = A->out; const float* gf = A->norm_final; const bf16* XB = (const bf16*)(A->ws + WS_HB); const bf16* Y0 = (const bf16*)(A->ws + WS_XS); const bf16* Y1 = Y0 + (size_t)M * D;
                for (int m = gw; m < M; m += NGW) {
                    const u32x2* xr = (const u32x2*)(XB + (size_t)m * D) + lane; const u32x2* y0 = (const u32x2*)(Y0 + (size_t)m * D) + lane; const u32x2* y1 = (const u32x2*)(Y1 + (size_t)m * D) + lane;
                    f32x4* orow = (f32x4*)(xo + (size_t)m * D) + lane; const f32x4* gr = (const f32x4*)gf + lane;
                    u32x2 a[4], b[4], c[4];
#pragma unroll
                    for (int j = 0; j < 4; ++j) { a[j] = xr[64 * j]; b[j] = y0[64 * j]; c[j] = y1[64 * j]; }
                    f32x4 v[4]; float q = 0.f;
#pragma unroll
                    for (int j = 0; j < 4; ++j) {
                        v[j] = (f32x4){__uint_as_float(a[j].x << 16), __uint_as_float(a[j].x & 0xffff0000u), __uint_as_float(a[j].y << 16), __uint_as_float(a[j].y & 0xffff0000u)}
                             + (f32x4){__uint_as_float(b[j].x << 16), __uint_as_float(b[j].x & 0xffff0000u), __uint_as_float(b[j].y << 16), __uint_as_float(b[j].y & 0xffff0000u)}
                             + (f32x4){__uint_as_float(c[j].x << 16), __uint_as_float(c[j].x & 0xffff0000u), __uint_as_float(c[j].y << 16), __uint_as_float(c[j].y & 0xffff0000u)};
                        q += (v[j].x * v[j].x + v[j].y * v[j].y) + (v[j].z * v[j].z + v[j].w * v[j].w); }
                    const float rstd = 1.f / sqrtf(wave_sum(q) * (1.f / D) + EPS);
#pragma unroll
                    for (int j = 0; j < 4; ++j) orow[64 * j] = v[j] * rstd * gr[64 * j];
                } }
}
__global__ void __launch_bounds__(512, 2) fwd_kernel(Args a_unused) {
    extern __shared__ __attribute__((aligned(16))) unsigned char lds[];
    LAS unsigned char* L = (LAS unsigned char*)lds;
    volatile LAS unsigned* MISC = (volatile LAS unsigned*)(L + LDS_MISC);
    const int tid = threadIdx.x, lane = tid & 63, wave = __builtin_amdgcn_readfirstlane(tid >> 6);
    const int G = gridDim.x, bx = blockIdx.x;
    for (int u = tid; u < 64; u += 512) MISC[u] = 0u;
    __syncthreads();
    XcdBarrier bar; bar.bar = (unsigned*)(kargs()->ws + WS_CTL) + CW_BAR; bar.x = 0; bar.st = nullptr;
    if (!MK_PER_PHASE) bar = xcd_barrier_post(bar.bar, MISC + 8);
    int pid = 0;
    const int lo = kargs()->ph_lo, hi = kargs()->ph_hi;
#define RUN() (pid >= lo && pid < hi)
#define SEAM() do { if (!MK_PER_PHASE) { xcd_barrier(bar); if (REP(30) > 1) xcd_barrier(bar); } ++pid; } while (0)
    int slotv = 0; (void)lane;

    if (PON(0) && RUN()) for (int r_ = 0; r_ < REP(8); ++r_) ph0(L, 0, 0);
    SEAM();

    for (int layer = 0; layer < DEPTH; ++layer) {
        if (PON(1) && RUN()) for (int r_ = 0; r_ < REP(9); ++r_) ph1(L, layer, slotv);
        SEAM();
        if (PON(2) && RUN()) for (int r_ = 0; r_ < REP(10); ++r_) ph2(L, layer, slotv);
        SEAM();
        if (PON(20) && RUN()) for (int r_ = 0; r_ < REP(28); ++r_) ph20(L, layer, slotv);
        SEAM();
        if (PON(3) && RUN()) for (int r_ = 0; r_ < REP(11); ++r_) ph3(L, layer, slotv);
        SEAM();
        if (PON(4) && RUN()) for (int r_ = 0; r_ < REP(12); ++r_) ph4(L, layer, slotv);
        SEAM();
        if (PON(5) && RUN()) for (int r_ = 0; r_ < REP(13); ++r_) ph5(L, layer, slotv);
        SEAM();
        if (PON(8) && RUN()) for (int r_ = 0; r_ < REP(16); ++r_) ph8(L, layer, slotv);
        SEAM();
        if (PON(10) && RUN()) for (int r_ = 0; r_ < REP(18); ++r_) ph10(L, layer, slotv);
        SEAM();
        if (layer == 0) {
            if (PON(12) && RUN()) for (int r_ = 0; r_ < REP(20); ++r_) ph12(L, layer, slotv);
            SEAM();
            if (PON(13) && RUN()) for (int r_ = 0; r_ < REP(21); ++r_) ph13(L, layer, slotv);
            SEAM();
        } else {
            if (PON(15) && RUN()) for (int r_ = 0; r_ < REP(23); ++r_) ph15(L, layer, slotv);
            SEAM();
            LAS int* gt = (LAS int*)(L + LDS_MISC + 512);
            if (tid == 0) { unsigned* ctl = (unsigned*)(kargs()->ws + WS_CTL); int acc = 0; for (int g = 0; g < 16; ++g) { gt[g] = acc; acc += ((int)__hip_atomic_load(ctl + CW_CNT + g, __ATOMIC_RELAXED, __HIP_MEMORY_SCOPE_AGENT) + 255) >> 8; } gt[16] = acc; }
            __syncthreads();
            if (PON(16) && RUN()) for (int r_ = 0; r_ < REP(24); ++r_) ph16(L, layer, slotv);
            SEAM();
            if (PON(17) && RUN()) for (int r_ = 0; r_ < REP(25); ++r_) ph17(L, layer, slotv);
            SEAM();
            if (PON(18) && RUN()) ph18(L, layer, 0);
            SEAM();
            if (PON(19) && RUN()) for (int r_ = 0; r_ < REP(27); ++r_) ph19(L, layer, slotv);
            ++pid;
        }
    }
#undef RUN
#undef SEAM
}


constexpr int NPHASE = 1 + 10 + 13;
extern "C" void kernel_launch(void* const* d_in, const int* in_sizes, int n_in, void* d_out, int out_size, void* d_ws, size_t ws_size, hipStream_t stream) {
    static int grid = 0;
    if (grid == 0) {
        if (n_in != 22 || out_size != M * D || ws_size < WS_END) { fprintf(stderr, "kernel_launch: unexpected problem (n_in %d out %d ws %zu)\n", n_in, out_size, ws_size); grid = -1; return; }
        int dev = 0, cus = 0;
        if (hipGetDevice(&dev) != hipSuccess || hipDeviceGetAttribute(&cus, hipDeviceAttributeMultiprocessorCount, dev) != hipSuccess) { grid = -1; return; }
        if (hipFuncSetAttribute((const void*)fwd_kernel, hipFuncAttributeMaxDynamicSharedMemorySize, LDS_BYTES) != hipSuccess) { fprintf(stderr, "kernel_launch: hipFuncSetAttribute failed\n"); grid = -1; return; }
        int per_cu = 0;
        (void)hipOccupancyMaxActiveBlocksPerMultiprocessor(&per_cu, (const void*)fwd_kernel, 512, LDS_BYTES);
        (void)hipGetLastError();
        if (per_cu < 1) fprintf(stderr, "kernel_launch: occupancy query says %d\n", per_cu);
        grid = cus;
    }
    if (grid < 0) return;
    (void)hipMemsetAsync((char*)d_ws + WS_CTL, 0, CTL_ZERO_BYTES, stream);
    Args a{};
    a.x = (const float*)d_in[0]; a.mem = (const float*)d_in[1]; a.positions = (const int*)d_in[2]; a.norm_mix = (const float*)d_in[3]; a.w_in = (const float*)d_in[4];
    a.attn_sink = (const float*)d_in[5]; a.w_branch = (const float*)d_in[6]; a.w_out = (const float*)d_in[7]; a.pool_w = (const float*)d_in[8]; a.pool_scale = (const float*)d_in[9];
    a.norm_cross = (const float*)d_in[10]; a.norm_mem = (const float*)d_in[11]; a.w_xq = (const float*)d_in[12]; a.w_xkv = (const float*)d_in[13]; a.w_xo = (const float*)d_in[14];
    a.norm_ffn = (const float*)d_in[15]; a.dense_w_gu = (const float*)d_in[16]; a.dense_w_down = (const float*)d_in[17]; a.router_w = (const float*)d_in[18];
    a.moe_w_gu = (const float*)d_in[19]; a.moe_w_down = (const float*)d_in[20]; a.norm_final = (const float*)d_in[21];
    a.out = (float*)d_out; a.ws = (unsigned char*)d_ws;
#if MK_PER_PHASE
    for (int p = 0; p < NPHASE; ++p) { a.ph_lo = p; a.ph_hi = p + 1; hipLaunchKernelGGL(fwd_kernel, dim3(grid), dim3(512), LDS_BYTES, stream, a); }
#else
    a.ph_lo = 0; a.ph_hi = NPHASE;
    hipLaunchKernelGGL(fwd_kernel, dim3(grid), dim3(512), LDS_BYTES, stream, a);
#endif
}
```

```cpp
#include <hip/hip_runtime.h>
#include <cstdio>
#include <cstdint>

#ifndef MK_PER_PHASE
#define MK_PER_PHASE 0
#endif

#ifndef PHASE_MASK
#define PHASE_MASK 0xFFFFFFFFu
#endif
#define PON(k) ((PHASE_MASK >> (k)) & 1u)
#ifndef REP_MASK
#define REP_MASK 0u
#endif
#define REP(k) (1 + (int)((REP_MASK >> (k)) & 1u))
#define LAS __attribute__((address_space(3)))
#define GAS __attribute__((address_space(1)))
typedef unsigned short bf16;
typedef short bf16x8 __attribute__((ext_vector_type(8)));
typedef float f32x4 __attribute__((ext_vector_type(4)));
typedef float f32x2 __attribute__((ext_vector_type(2)));
typedef unsigned u32x4 __attribute__((ext_vector_type(4)));
typedef int i32x4 __attribute__((ext_vector_type(4)));
typedef unsigned u32x2 __attribute__((ext_vector_type(2)));
typedef __bf16 bf16x2_t __attribute__((ext_vector_type(2)));
typedef _Float16 h16x8 __attribute__((ext_vector_type(8)));

constexpr int BATCH = 8, T = 4096, D = 1024, M = BATCH * T, DEPTH = 2;
constexpr int D_IN = 8004, NPROJ = 4096, DFF = 3584, NEXP = 8, MEMLEN = 256, MROWS = BATCH * MEMLEN;
constexpr float EPS = 1e-6f;
constexpr int C_AQ = 0, C_AK = 512, C_AV = 640, C_BQ = 768, C_BK = 1280, C_BV = 1408, C_IQ = 1536, C_IK = 1792, C_RQ = 1856, C_RK = 2112, C_RV = 2368, C_RG = 2880, C_PU = 3392, C_IW = 3904;
constexpr unsigned long long ROPE_MASK = 0x3FFull | (0x3FFull << 12) | (0x1FFFull << 24);

constexpr size_t MiB = 1u << 20;
constexpr size_t WS_CTL = 0, CTL_ZERO_BYTES = 2 * MiB;
constexpr size_t WS_SS = 128 * 1024;
constexpr size_t WS_ROUTE = 2 * MiB;
constexpr size_t WS_TOKMAP = 2 * MiB + 512 * 1024;
constexpr size_t WS_ROWW = 3 * MiB;
constexpr size_t WS_ROWSS = 3 * MiB + 384 * 1024;
constexpr size_t WS_HB = 4 * MiB;
constexpr size_t WS_ROPE = 68 * MiB;
constexpr size_t WS_MN = 76 * MiB;
constexpr size_t WS_KX = 84 * MiB;
constexpr size_t WS_VT = 92 * MiB;
constexpr size_t WS_W = 100 * MiB;
constexpr size_t W_IN = 0, W_G = 8 * MiB, W_B = 16 * MiB, W_OUT = 20 * MiB, W_XQ = 22 * MiB, W_XK = 24 * MiB, W_XV = 26 * MiB, W_XO = 28 * MiB, W_LAYER = 30 * MiB;
constexpr size_t WS_WGU = WS_W + 2 * W_LAYER;
constexpr size_t WS_WDN = WS_WGU + 14 * MiB;
constexpr size_t WS_R = 181 * MiB;
constexpr size_t WS_PROJ = WS_R;
constexpr size_t WS_BR01 = WS_R + 256 * MiB;
constexpr size_t WS_BR23 = WS_R + 320 * MiB;
constexpr size_t WS_U = WS_R + 384 * MiB;
constexpr size_t WS_R_END = WS_R + 416 * MiB;
constexpr size_t WS_AKV = 600 * MiB;
constexpr size_t WS_BKV = 616 * MiB;
constexpr size_t WS_IK = 632 * MiB;
constexpr size_t WS_VTB = 656 * MiB;
constexpr size_t WS_WPOOL = 652 * MiB;
constexpr size_t WS_ST = 636 * MiB;
constexpr size_t WS_MSCR = WS_PROJ;
constexpr size_t WS_MERGED = WS_PROJ + 192 * MiB;
constexpr size_t WS_XQ = WS_PROJ;
constexpr size_t WS_XP = WS_PROJ + 64 * MiB;
constexpr size_t WS_XO = WS_PROJ + 128 * MiB;
constexpr size_t WS_HID = WS_PROJ;
constexpr int MOE_ROWS = 2 * M + 16 * 256;
constexpr size_t WS_MWGU = 100 * MiB;
constexpr size_t WS_MWDN = 212 * MiB;
constexpr size_t WS_MHID = 268 * MiB;
constexpr size_t WS_XS = 744 * MiB;
constexpr size_t WS_XF8 = 812 * MiB;
constexpr size_t WS_END = 880 * MiB;
static_assert(WS_MHID + (size_t)MOE_ROWS * DFF * 2 <= WS_XS && WS_XS + (size_t)MOE_ROWS * D * 2 <= WS_END, "moe map");
static_assert(WS_WDN + 7 * MiB <= WS_R, "weights map");
constexpr int CW_BAR = 4096;
constexpr int CW_CNT = 16384;
constexpr int CW_CUR = 16384 + 64;

constexpr int LDS_STAGE = 131072;
constexpr int LDS_XCH = 131072;
constexpr int LDS_MISC = 131072 + 16384;
constexpr int LDS_BYTES = 131072 + 16384 + 8192;
constexpr int WAVE_LDS = 17408;

__device__ const float INV_FREQ[32] = {1.000000000e+00f, 7.498942018e-01f, 5.623413324e-01f, 4.216965139e-01f, 3.162277639e-01f, 2.371373922e-01f, 1.778279394e-01f, 1.333521456e-01f, 1.000000015e-01f, 7.498941571e-02f, 5.623412877e-02f, 4.216964915e-02f, 3.162277862e-02f, 2.371373586e-02f, 1.778279431e-02f, 1.333521493e-02f, 9.999999776e-03f, 7.498942316e-03f, 5.623413250e-03f, 4.216964822e-03f, 3.162277862e-03f, 2.371373819e-03f, 1.778279431e-03f, 1.333521446e-03f, 1.000000047e-03f, 7.498941850e-04f, 5.623413017e-04f, 4.216965463e-04f, 3.162277862e-04f, 2.371373848e-04f, 1.778279402e-04f, 1.333521504e-04f};
__device__ __forceinline__ float bf2f(unsigned short v) { return __uint_as_float(((unsigned)v) << 16); }
__device__ __forceinline__ unsigned f2bf(float f) { unsigned u = __float_as_uint(f); return (u + 0x7fffu + ((u >> 16) & 1u)) >> 16; }
__device__ __forceinline__ unsigned pk2(float lo, float hi) { return f2bf(lo) | (f2bf(hi) << 16); }
__device__ __forceinline__ unsigned f2bf1(float f) { return (unsigned)__builtin_bit_cast(unsigned short, (__bf16)f); }
__device__ __forceinline__ unsigned cvt_pk_bf16(float lo, float hi) { unsigned r; asm volatile("v_cvt_pk_bf16_f32 %0, %1, %2" : "=v"(r) : "v"(lo), "v"(hi)); return r; }
__device__ __forceinline__ float dot2(unsigned a, unsigned b, float acc) { return __builtin_amdgcn_fdot2_f32_bf16(__builtin_bit_cast(bf16x2_t, a), __builtin_bit_cast(bf16x2_t, b), acc, false); }
__device__ __forceinline__ float wave_sum(float v) {
#pragma unroll
    for (int o = 1; o < 64; o <<= 1) v += __shfl_xor(v, o);
    return v;
}
__device__ __forceinline__ float wave_max(float v) {
#pragma unroll
    for (int o = 1; o < 64; o <<= 1) v = fmaxf(v, __shfl_xor(v, o));
    return v;
}
#define LDS_WAIT() asm volatile("s_waitcnt lgkmcnt(0)" ::: "memory")
typedef unsigned long long u64;
__device__ __forceinline__ float rstd_of(u64 ssfix) { return 1.f / sqrtf((float)ssfix * (5.9604645e-8f / 1024.f) + 1e-6f); }
__device__ __forceinline__ u64 ss_fix(float q) { return (u64)(q * 16777216.f); }
__device__ __forceinline__ unsigned pk4_f8(float a, float b, float c, float d) {
    int w = 0;
    w = __builtin_amdgcn_cvt_pk_fp8_f32(__builtin_amdgcn_fmed3f(a, -448.f, 448.f), __builtin_amdgcn_fmed3f(b, -448.f, 448.f), w, false);
    w = __builtin_amdgcn_cvt_pk_fp8_f32(__builtin_amdgcn_fmed3f(c, -448.f, 448.f), __builtin_amdgcn_fmed3f(d, -448.f, 448.f), w, true);
    return (unsigned)w; }
constexpr float F8_MSCALE = 8.f, F8_OSCALE = 16.f;
constexpr float F8_HSCALE = 4.f;
constexpr float F8_WSCALE = 64.f;

namespace pg8 {
constexpr int BM = 256, BK = 64, HALF = 128, HTB = HALF * BK * 2, STAGE_BYTES = 8 * HTB, NXCD = 8, WGM = 8;
__host__ __device__ __forceinline__ int lds_byte(int r, int c) { const int st = (r >> 4) * 2 + (c >> 5), rr = r & 15, cc = c & 31, ob = rr * 64 + cc * 2; return st * 1024 + (ob ^ (((ob >> 9) & 1) << 5)); }
__host__ __device__ __forceinline__ void stage_rc(int b, int& R, int& C) { const int st = b / 1024, sb = b % 1024, swz = sb ^ (((sb >> 9) & 1) << 5); R = (st >> 1) * 16 + swz / 64; C = (st & 1) * 32 + (swz % 64) / 2; }
__host__ __device__ __forceinline__ int perm32(int rho) { const int n = rho >> 4, i = rho & 15; return 8 * (i >> 2) + 4 * n + (i & 3); }

struct Unit { const char* A; const char* B; int nt; int pm, pn, kind; };

__device__ __forceinline__ void tile_of(int wgid, int nM, int nN, int& pm, int& pn) {
    const int nwg = nM * nN;
    { const int q = nwg / NXCD, r = nwg % NXCD, xcd = wgid % NXCD, off = wgid / NXCD; wgid = (xcd < r ? xcd * (q + 1) : r * (q + 1) + (xcd - r) * q) + off; }
    const int nig = WGM * nN, gid = wgid / nig, fm = gid * WGM, gsz = (nM - fm) < WGM ? (nM - fm) : WGM;
    pm = fm + ((wgid % nig) % gsz); pn = (wgid % nig) / gsz;
}
struct GridSched {
    const char* A; const char* B; unsigned lda, ldb; int nM, nN, nt, G, c;
    __device__ __forceinline__ bool next(int i, Unit& u) const {
        const long L = (long)i * G + c; if (L >= (long)nM * nN) return false;
        tile_of((int)L, nM, nN, u.pm, u.pn);
        u.A = A + (size_t)u.pm * 256 * lda; u.B = B + (size_t)u.pn * 256 * ldb; u.nt = nt; u.kind = 0; return true;
    }
};

template <class Epi, class Sched, int F8 = 0>
__device__ __forceinline__ void gemm_stream(LAS unsigned char* lds, const Sched& S, const Epi& E, const unsigned lda, const unsigned ldb) {
    int tid = threadIdx.x; asm volatile("" : "+v"(tid));
    const int wid = __builtin_amdgcn_readfirstlane(tid >> 6), lane = tid & 63, wr = wid >> 2, wc = wid & 3, fr = lane & 15, fq = lane >> 4;
    unsigned voffA, voffB;
    { int R, C; stage_rc(tid * 16, R, C); const int Rb = (R & ~31) + perm32(R & 31); voffA = (unsigned)R * lda + (unsigned)C * 2u; voffB = (unsigned)Rb * ldb + (unsigned)C * 2u; }
    const size_t kstep = (size_t)(BK * 2);
    const size_t hA = (size_t)HALF * lda, hB = (size_t)HALF * ldb, qA = (size_t)64 * lda, qB = (size_t)64 * ldb;
    const unsigned ldsw = (unsigned)wid * 1024u;
    const int aoff = lds_byte(wr * 64 + fr, fq * 8), boff = lds_byte(wc * 32 + fr, fq * 8);
#define PG8_SA(b, h) (((b) * 2 + (h)) * HTB)
#define PG8_SB(b, h) ((4 + (b) * 2 + (h)) * HTB)
#define PG8_STAGE(bufoff, gbase, voff) do { \
        __builtin_amdgcn_global_load_lds((const unsigned*)((const char*)(gbase) + (voff)), (LAS unsigned*)(lds + (bufoff) + ldsw), 16, 0, 0); \
        __builtin_amdgcn_global_load_lds((const unsigned*)((const char*)(gbase) + ((&(voff) == &voffA) ? qA : qB) + (voff)), (LAS unsigned*)(lds + (bufoff) + ldsw + 8192), 16, 0, 0); } while (0)
#define PG8_LDA(dst, b, h) do { _Pragma("unroll") for (int m = 0; m < 4; ++m) _Pragma("unroll") for (int k = 0; k < 2; ++k) dst[m][k] = *(const LAS bf16x8*)(lds + PG8_SA(b, h) + aoff + m * 2048 + k * 1024); } while (0)
#define PG8_LDB(dst, b, h) do { _Pragma("unroll") for (int n = 0; n < 2; ++n) _Pragma("unroll") for (int k = 0; k < 2; ++k) dst[n][k] = *(const LAS bf16x8*)(lds + PG8_SB(b, h) + boff + n * 2048 + k * 1024); } while (0)
#define PG8_MMA(ai, bj, At, Bt) do { __builtin_amdgcn_s_setprio(1); _Pragma("unroll") for (int m = 0; m < 4; ++m) _Pragma("unroll") for (int n = 0; n < 2; ++n) _Pragma("unroll") for (int k = 0; k < 2; ++k) \
        acc[ai][bj][m][n] = __builtin_amdgcn_mfma_f32_16x16x32_bf16(Bt[n][k], At[m][k], acc[ai][bj][m][n], 0, 0, 0); __builtin_amdgcn_s_setprio(0); } while (0)
#define PG8_CAT(x) __builtin_shufflevector(__builtin_bit_cast(i32x4, x[0]), __builtin_bit_cast(i32x4, x[1]), 0, 1, 2, 3, 4, 5, 6, 7)
#define PG8_MMA8(ai, bj, At, Bt) do { __builtin_amdgcn_s_setprio(1); _Pragma("unroll") for (int m = 0; m < 4; ++m) _Pragma("unroll") for (int n = 0; n < 2; ++n) \
        asm volatile("v_mfma_f32_16x16x128_f8f6f4 %0, %1, %2, %0" : "+v"(acc[ai][bj][m][n]) : "v"(PG8_CAT(Bt[n])), "v"(PG8_CAT(At[m]))); __builtin_amdgcn_s_setprio(0); } while (0)
#define PG8_MM(ai, bj, At, Bt) do { if constexpr (F8) PG8_MMA8(ai, bj, At, Bt); else PG8_MMA(ai, bj, At, Bt); } while (0)
#define PG8_WAIT_V(n) asm volatile("s_waitcnt vmcnt(" #n ")" ::: "memory")
#define PG8_WAIT_L(n) asm volatile("s_waitcnt lgkmcnt(" #n ")" ::: "memory")
#define PG8_BAR __builtin_amdgcn_s_barrier()
#define PG8_SCHED __builtin_amdgcn_sched_barrier(0)
    Unit cur, nxt; int ui = 0;
    if (!S.next(0, cur)) return;
    f32x4 acc[2][2][4][2];
#pragma unroll
    for (int a = 0; a < 2; ++a)
#pragma unroll
        for (int b = 0; b < 2; ++b)
#pragma unroll
            for (int m = 0; m < 4; ++m)
#pragma unroll
                for (int n = 0; n < 2; ++n) acc[a][b][m][n] = (f32x4){0.f, 0.f, 0.f, 0.f};
    bf16x8 At[4][2], B0[2][2], B1[2][2];
    const char* cA = cur.A; const char* cB = cur.B;
    PG8_STAGE(PG8_SB(0, 0), cB, voffB); PG8_STAGE(PG8_SB(0, 1), cB + hB, voffB); PG8_STAGE(PG8_SA(0, 0), cA, voffA); PG8_STAGE(PG8_SA(0, 1), cA + hA, voffA);
    if (wr == 1) PG8_BAR;
    PG8_WAIT_V(2); PG8_BAR;
    PG8_STAGE(PG8_SB(1, 0), cB + kstep, voffB); PG8_STAGE(PG8_SA(1, 0), cA + kstep, voffA); PG8_STAGE(PG8_SB(1, 1), cB + hB + kstep, voffB);
    PG8_WAIT_V(6); PG8_BAR;
    for (;;) {
        const bool has_next = S.next(ui + 1, nxt);
        const char* nA = has_next ? nxt.A : cA; const char* nB = has_next ? nxt.B : cB;
        int nt = cur.nt; asm volatile("" : "+s"(nt));
        asm volatile(".p2align 8" ::: "memory");
#pragma unroll 1
        for (int t = 0; t < nt; t += 2) {
            const bool last = (t == nt - 2);
            const char* a1 = cA + (size_t)(t + 1) * kstep;
            const char* a2 = last ? nA : cA + (size_t)(t + 2) * kstep; const char* b2 = last ? nB : cB + (size_t)(t + 2) * kstep;
            const char* a3 = a2 + kstep; const char* b3 = b2 + kstep;
            if constexpr (Epi::HOOK) {
                if (last && has_next && nxt.kind >= 2) { asm volatile("s_waitcnt vmcnt(0)" ::: "memory"); PG8_BAR; PG8_BAR; asm volatile("" ::: "memory"); } }
            PG8_LDB(B0, 0, 0); PG8_LDB(B1, 0, 1); PG8_SCHED; PG8_LDA(At, 0, 0); PG8_STAGE(PG8_SA(1, 1), a1 + hA, voffA);
            PG8_WAIT_V(8); PG8_WAIT_L(0); PG8_BAR; PG8_MM(0, 0, At, B0); PG8_MM(0, 1, At, B1); PG8_BAR; PG8_SCHED;
            PG8_LDA(At, 0, 1); PG8_STAGE(PG8_SB(0, 0), b2, voffB); PG8_STAGE(PG8_SB(0, 1), b2 + hB, voffB); PG8_STAGE(PG8_SA(0, 0), a2, voffA);
            PG8_WAIT_V(8); PG8_WAIT_L(0); PG8_BAR; PG8_MM(1, 0, At, B0); PG8_MM(1, 1, At, B1); PG8_BAR; PG8_SCHED;
            PG8_LDB(B0, 1, 0); PG8_LDB(B1, 1, 1); PG8_SCHED; PG8_LDA(At, 1, 0); PG8_STAGE(PG8_SA(0, 1), a2 + hA, voffA);
            PG8_WAIT_V(8); PG8_WAIT_L(0); PG8_BAR; PG8_MM(0, 0, At, B0); PG8_MM(0, 1, At, B1); PG8_BAR; PG8_SCHED;
            PG8_LDA(At, 1, 1); PG8_STAGE(PG8_SB(1, 0), b3, voffB); PG8_STAGE(PG8_SB(1, 1), b3 + hB, voffB); PG8_STAGE(PG8_SA(1, 0), a3, voffA);
            PG8_WAIT_V(8); PG8_WAIT_L(0); PG8_BAR; PG8_MM(1, 0, At, B0); PG8_MM(1, 1, At, B1); PG8_BAR; PG8_SCHED;
        }
        if constexpr (F8) asm volatile("s_nop 7\n\ts_nop 7\n\ts_nop 7" ::: "memory");
        if constexpr (Epi::ALIGN) { if (wr == 0) PG8_BAR; }
        if constexpr (Epi::TWICE) { if (REP(26) > 1) (void)E(acc, cur, wr, wc, fr, fq); }
        const bool keep = E(acc, cur, wr, wc, fr, fq);
        if (!has_next) break;
        if constexpr (Epi::CHAIN) {
            const float kf = keep ? 1.f : 0.f;
#pragma unroll
            for (int a = 0; a < 2; ++a)
#pragma unroll
                for (int b = 0; b < 2; ++b)
#pragma unroll
                    for (int m = 0; m < 4; ++m)
#pragma unroll
                        for (int n = 0; n < 2; ++n) acc[a][b][m][n] = acc[a][b][m][n] * kf;
        } else {
#pragma unroll
            for (int a = 0; a < 2; ++a)
#pragma unroll
                for (int b = 0; b < 2; ++b)
#pragma unroll
                    for (int m = 0; m < 4; ++m)
#pragma unroll
                        for (int n = 0; n < 2; ++n) acc[a][b][m][n] = (f32x4){0.f, 0.f, 0.f, 0.f};
        }
        cur = nxt; cA = nA; cB = nB; ++ui;
        if constexpr (Epi::ALIGN) { if (wr == 1) PG8_BAR; }
    }
    PG8_WAIT_V(0);
    if constexpr (!Epi::ALIGN) { if (wr == 0) PG8_BAR; }
    PG8_BAR;
#undef PG8_SA
#undef PG8_SB
#undef PG8_STAGE
#undef PG8_LDA
#undef PG8_LDB
#undef PG8_MMA
#undef PG8_MMA8
#undef PG8_MM
#undef PG8_CAT
#undef PG8_WAIT_V
#undef PG8_WAIT_L
#undef PG8_BAR
#undef PG8_SCHED
}
}
using pg8::Unit;

#define EPI_ARGS f32x4 (&acc)[2][2][4][2], const Unit& u, int wr, int wc, int fr_in, int fq_in
#define EPI_LANE int lane_l = threadIdx.x & 63; asm volatile("" : "+v"(lane_l)); const int fr = lane_l & 15, fq = lane_l >> 4; (void)fr_in; (void)fq_in;
#ifndef EPI_ALIGN
#define EPI_ALIGN true
#endif
struct EpiProj {
    static constexpr bool CHAIN = false, TWICE = true;
    static constexpr bool HOOK = false;
    static constexpr bool ALIGN = true;
    bf16* O; const _Float16* cosT; const _Float16* sinT; bf16* AKV; bf16* BKV; bf16* IK; const u64* ss;
    __device__ __forceinline__ bool operator()(EPI_ARGS) const {
        EPI_LANE
        const int g = 4 * u.pn + wc; const bool rope = (ROPE_MASK >> g) & 1ull;
        const int row0 = u.pm * 256 + wr * 64 + fr;
        u64 sq[8];
#pragma unroll
        for (int k = 0; k < 8; ++k) sq[k] = ss[row0 + (k >> 2) * 128 + (k & 3) * 16];
#pragma unroll
        for (int ai = 0; ai < 2; ++ai) {
            h16x8 ct[4], st[4];
            if (rope) {
#pragma unroll
                for (int k = 0; k < 4; ++k) { const int rr = row0 + ai * 128 + k * 16; const size_t ro = ((size_t)((rr >> 4) * 4 + fq) * 16 + (rr & 15)) * 8;
                    ct[k] = *(const h16x8*)(cosT + ro); st[k] = *(const h16x8*)(sinT + ro); }
            }
#pragma unroll
            for (int m = 0; m < 4; ++m) {
                const int r = row0 + ai * 128 + m * 16;
                const float rs = rstd_of(sq[ai * 4 + m]);
                f32x4 x1a = acc[ai][0][m][0] * rs, x1b = acc[ai][0][m][1] * rs, x2a = acc[ai][1][m][0] * rs, x2b = acc[ai][1][m][1] * rs;
                if (rope) {
                    const h16x8 c8 = ct[m], s8 = st[m];
                    const f32x4 ca = (f32x4){(float)c8[0], (float)c8[1], (float)c8[2], (float)c8[3]}, cb = (f32x4){(float)c8[4], (float)c8[5], (float)c8[6], (float)c8[7]};
                    const f32x4 sa = (f32x4){(float)s8[0], (float)s8[1], (float)s8[2], (float)s8[3]}, sb = (f32x4){(float)s8[4], (float)s8[5], (float)s8[6], (float)s8[7]};
                    const f32x4 o1a = x1a * ca - x2a * sa, o1b = x1b * cb - x2b * sb, o2a = x2a * ca + x1a * sa, o2b = x2b * cb + x1b * sb;
                    x1a = o1a; x1b = o1b; x2a = o2a; x2b = o2b;
                }
                bf16* rowp = (g >= 8 && g < 12) ? AKV + (size_t)r * 256 + 64 * (g - 8) + 8 * fq : (g >= 20 && g < 24) ? BKV + (size_t)r * 256 + 64 * (g - 20) + 8 * fq
                           : (g == 28) ? IK + ((size_t)((r >> 5) * 4 + (fq >> 1)) * 64 + (fq & 1) * 32 + (r & 31)) * 8 : O + (size_t)r * NPROJ + 64 * g + 8 * fq;
                u32x4 w1, w2;
                w1.x = cvt_pk_bf16(x1a[0], x1a[1]); w1.y = cvt_pk_bf16(x1a[2], x1a[3]); w1.z = cvt_pk_bf16(x1b[0], x1b[1]); w1.w = cvt_pk_bf16(x1b[2], x1b[3]);
                w2.x = cvt_pk_bf16(x2a[0], x2a[1]); w2.y = cvt_pk_bf16(x2a[2], x2a[3]); w2.z = cvt_pk_bf16(x2b[0], x2b[1]); w2.w = cvt_pk_bf16(x2b[2], x2b[3]);
                *(u32x4*)(rowp) = w1; *(u32x4*)(rowp + ((g == 28) ? 1024 : 32)) = w2;
            }
        }
        return false;
    }
};
template <bool F8O> struct EpiPlainT {
    static constexpr bool CHAIN = false, TWICE = true;
    static constexpr bool HOOK = false;
#ifndef EPI_ALIGN
#define EPI_ALIGN true
#endif
    static constexpr bool ALIGN = EPI_ALIGN;
    bf16* O; int ldc; float scale; const u64* ss; size_t pn_stride = 0;
    __device__ __forceinline__ bool operator()(EPI_ARGS) const {
        EPI_LANE
        const int row0 = u.pm * 256 + wr * 64 + fr, col0 = (pn_stride ? 0 : u.pn * 256) + wc * 32 + 8 * fq;
        bf16* Ob = O + (size_t)u.pn * pn_stride;
        u64 sq[8];
#pragma unroll
        for (int k = 0; k < 8; ++k) sq[k] = ss ? ss[row0 + (k >> 2) * 128 + (k & 3) * 16] : 0ull;
#pragma unroll
        for (int ai = 0; ai < 2; ++ai)
#pragma unroll
            for (int m = 0; m < 4; ++m) { bf16* rowp = Ob + (size_t)(row0 + ai * 128 + m * 16) * ldc + col0;
                const float sc_ = ss ? rstd_of(sq[ai * 4 + m]) * scale : scale;
#pragma unroll
                for (int bj = 0; bj < 2; ++bj) { const f32x4 v0 = acc[ai][bj][m][0] * sc_, v1 = acc[ai][bj][m][1] * sc_;
                    if constexpr (F8O) {
                        u32x2 w8; w8.x = pk4_f8(v0[0], v0[1], v0[2], v0[3]); w8.y = pk4_f8(v1[0], v1[1], v1[2], v1[3]);
                        *(u32x2*)((unsigned char*)Ob + (size_t)(row0 + ai * 128 + m * 16) * ldc + col0 + bj * 128) = w8;
                    } else {
                    u32x4 w; w.x = cvt_pk_bf16(v0[0], v0[1]); w.y = cvt_pk_bf16(v0[2], v0[3]); w.z = cvt_pk_bf16(v1[0], v1[1]); w.w = cvt_pk_bf16(v1[2], v1[3]);
                    *(u32x4*)(rowp + bj * 128) = w; } } }
        return false;
    }
};
typedef EpiPlainT<false> EpiPlain;
template <bool F8OUT> struct EpiResT {
    static constexpr bool CHAIN = false, TWICE = false;
    static constexpr bool HOOK = false;
#ifndef EPI_ALIGN
#define EPI_ALIGN true
#endif
    static constexpr bool ALIGN = EPI_ALIGN;
    bf16* X; u64* ssn; unsigned char* X8 = nullptr; float sc = 1.f;
    __device__ __forceinline__ bool operator()(EPI_ARGS) const {
        EPI_LANE
        const int row0 = u.pm * 256 + wr * 64 + fr, col0 = u.pn * 256 + wc * 32 + 8 * fq;
#pragma unroll
        for (int ai = 0; ai < 2; ++ai) {
            u32x4 xv[4][2];
#pragma unroll
            for (int m = 0; m < 4; ++m)
#pragma unroll
                for (int bj = 0; bj < 2; ++bj) xv[m][bj] = *(const u32x4*)(X + (size_t)(row0 + ai * 128 + m * 16) * D + col0 + bj * 128);
#pragma unroll
            for (int m = 0; m < 4; ++m) { const int r = row0 + ai * 128 + m * 16; bf16* rowp = X + (size_t)r * D + col0; float q = 0.f;
#pragma unroll
                for (int bj = 0; bj < 2; ++bj) {
                    const u32x4 xq = xv[m][bj];
                    f32x4 v0 = acc[ai][bj][m][0] * sc, v1 = acc[ai][bj][m][1] * sc;
                    v0[0] += __uint_as_float(xq.x << 16); v0[1] += __uint_as_float(xq.x & 0xffff0000u); v0[2] += __uint_as_float(xq.y << 16); v0[3] += __uint_as_float(xq.y & 0xffff0000u);
                    v1[0] += __uint_as_float(xq.z << 16); v1[1] += __uint_as_float(xq.z & 0xffff0000u); v1[2] += __uint_as_float(xq.w << 16); v1[3] += __uint_as_float(xq.w & 0xffff0000u);
                    q += (v0[0] * v0[0] + v0[1] * v0[1]) + (v0[2] * v0[2] + v0[3] * v0[3]) + (v1[0] * v1[0] + v1[1] * v1[1]) + (v1[2] * v1[2] + v1[3] * v1[3]);
                    u32x4 w; w.x = cvt_pk_bf16(v0[0], v0[1]); w.y = cvt_pk_bf16(v0[2], v0[3]); w.z = cvt_pk_bf16(v1[0], v1[1]); w.w = cvt_pk_bf16(v1[2], v1[3]);
                    *(u32x4*)(rowp + bj * 128) = w;
                    if constexpr (F8OUT) { u32x2 w8; w8.x = pk4_f8(v0[0], v0[1], v0[2], v0[3]); w8.y = pk4_f8(v1[0], v1[1], v1[2], v1[3]); *(u32x2*)(X8 + (size_t)r * D + col0 + bj * 128) = w8; } }
                q += __shfl_xor(q, 16); q += __shfl_xor(q, 32);
                if (fq == 0) atomicAdd(ssn + r, ss_fix(q)); }
            asm volatile("" ::: "memory"); }
        return false;
    }
};
typedef EpiResT<false> EpiRes;
struct EpiGate {
    static constexpr bool CHAIN = false, TWICE = true;
    static constexpr bool HOOK = false;
#ifndef EPI_ALIGN
#define EPI_ALIGN true
#endif
    static constexpr bool ALIGN = EPI_ALIGN;
    unsigned* scr; const u64* ss; float wsc;
    __device__ __forceinline__ bool operator()(EPI_ARGS) const {
        EPI_LANE
        const unsigned voff = (unsigned)(((unsigned)__builtin_amdgcn_readfirstlane(threadIdx.x >> 6) * 64u + (unsigned)lane_l) * 16u);
        char* sb = (char*)scr + (size_t)u.kind * 131072;
        u64 sq[8];
#pragma unroll
        for (int k = 0; k < 8; ++k) sq[k] = ss[u.pm * 256 + (k >> 2) * 128 + wr * 64 + (k & 3) * 16 + fr];
#pragma unroll
        for (int ai = 0; ai < 2; ++ai)
#pragma unroll
            for (int m = 0; m < 4; ++m)
#pragma unroll
                for (int bj = 0; bj < 2; ++bj) {
                    const float ns = -1.44269504f * wsc * rstd_of(sq[ai * 4 + m]);
                    f32x4 v0 = acc[ai][bj][m][0], v1 = acc[ai][bj][m][1]; u32x4 w;
#pragma unroll
                    for (int j = 0; j < 4; ++j) { v0[j] = fmaxf(__builtin_amdgcn_rcpf(1.f + __builtin_amdgcn_exp2f(ns * v0[j])), 1e-6f); v1[j] = fmaxf(__builtin_amdgcn_rcpf(1.f + __builtin_amdgcn_exp2f(ns * v1[j])), 1e-6f); }
                    w.x = cvt_pk_bf16(v0[0], v0[1]); w.y = cvt_pk_bf16(v0[2], v0[3]); w.z = cvt_pk_bf16(v1[0], v1[1]); w.w = cvt_pk_bf16(v1[2], v1[3]);
                    *(u32x4*)(sb + (size_t)((ai * 4 + m) * 2 + bj) * 8192 + voff) = w; asm volatile("" ::: "memory"); }
        return false;
    }
};
struct EpiUp {
    static constexpr bool CHAIN = false, TWICE = false;
    static constexpr bool HOOK = false;
#ifndef EPI_ALIGN
#define EPI_ALIGN true
#endif
    static constexpr bool ALIGN = EPI_ALIGN;
    unsigned* scr; bf16* O;
    __device__ __forceinline__ bool operator()(EPI_ARGS) const {
        EPI_LANE
        const unsigned tl = (unsigned)__builtin_amdgcn_readfirstlane(threadIdx.x >> 6) * 64u + (unsigned)lane_l;
        const char* s0 = (const char*)scr + (size_t)u.kind * 131072;
        char* pb = (char*)scr + 4 * 131072;
        const int row0 = u.pm * 256 + wr * 64 + fr, col0 = u.pn * 256 + wc * 32 + 8 * fq;
#pragma unroll
        for (int ai = 0; ai < 2; ++ai) {
            u32x4 av[8], pv[8];
#pragma unroll
            for (int k = 0; k < 8; ++k) { const int slot = ai * 8 + k; av[k] = *(const u32x4*)(s0 + (size_t)slot * 8192 + tl * 16u);
                pv[k] = (u.kind > 0) ? *(const u32x4*)(pb + (size_t)slot * 8192 + tl * 16u) : (u32x4){0u, 0u, 0u, 0u}; }
#pragma unroll
            for (int m = 0; m < 4; ++m)
#pragma unroll
                for (int bj = 0; bj < 2; ++bj) {
                    const int k = m * 2 + bj, slot = ai * 8 + k; const u32x4 a = av[k], q = pv[k];
                    f32x4 p0 = (f32x4){__uint_as_float(q.x << 16), __uint_as_float(q.x & 0xffff0000u), __uint_as_float(q.y << 16), __uint_as_float(q.y & 0xffff0000u)};
                    f32x4 p1 = (f32x4){__uint_as_float(q.z << 16), __uint_as_float(q.z & 0xffff0000u), __uint_as_float(q.w << 16), __uint_as_float(q.w & 0xffff0000u)};
                    const f32x4 f0 = (f32x4){__uint_as_float(a.x << 16), __uint_as_float(a.x & 0xffff0000u), __uint_as_float(a.y << 16), __uint_as_float(a.y & 0xffff0000u)};
                    const f32x4 f1 = (f32x4){__uint_as_float(a.z << 16), __uint_as_float(a.z & 0xffff0000u), __uint_as_float(a.w << 16), __uint_as_float(a.w & 0xffff0000u)};
                    p0 = p0 + acc[ai][bj][m][0] * f0; p1 = p1 + acc[ai][bj][m][1] * f1;
                    u32x4 w; w.x = cvt_pk_bf16(p0[0], p0[1]); w.y = cvt_pk_bf16(p0[2], p0[3]); w.z = cvt_pk_bf16(p1[0], p1[1]); w.w = cvt_pk_bf16(p1[2], p1[3]);
                    if (u.kind < 3) *(u32x4*)(pb + (size_t)slot * 8192 + tl * 16u) = w;
                    else *(u32x4*)(O + (size_t)(row0 + ai * 128 + m * 16) * D + col0 + bj * 128) = w;
                }
            asm volatile("" ::: "memory"); }
        return false;
    }
};
struct EpiSoftmax {
    static constexpr bool CHAIN = false, TWICE = false;
    static constexpr bool HOOK = false;
#ifndef EPI_ALIGN
#define EPI_ALIGN true
#endif
    static constexpr bool ALIGN = true;
    bf16* P; LAS f32x2* xch; float scale_log2;
    __device__ __forceinline__ bool operator()(EPI_ARGS) const {
        EPI_LANE
        LAS f32x2* X = xch + (size_t)(u.kind & 1) * 1024;
#pragma unroll
        for (int ai = 0; ai < 2; ++ai)
#pragma unroll
            for (int m = 0; m < 4; ++m) {
                float v = -3.0e38f;
#pragma unroll
                for (int bj = 0; bj < 2; ++bj)
#pragma unroll
                    for (int n = 0; n < 2; ++n) { const f32x4 x = acc[ai][bj][m][n]; v = fmaxf(v, fmaxf(fmaxf(x[0], x[1]), fmaxf(x[2], x[3]))); }
                v *= scale_log2;
                v = fmaxf(v, __shfl_xor(v, 16)); v = fmaxf(v, __shfl_xor(v, 32));
                float s = 0.f;
#pragma unroll
                for (int bj = 0; bj < 2; ++bj)
#pragma unroll
                    for (int n = 0; n < 2; ++n) { const f32x4 x = acc[ai][bj][m][n];
#pragma unroll
                        for (int j = 0; j < 4; ++j) s += __builtin_amdgcn_exp2f(x[j] * scale_log2 - v); }
                s += __shfl_xor(s, 16); s += __shfl_xor(s, 32);
                if (fq == 0) X[(ai * 128 + wr * 64 + m * 16 + fr) * 4 + wc] = (f32x2){v, s};
            }
        asm volatile("s_waitcnt lgkmcnt(0)" ::: "memory"); __builtin_amdgcn_s_barrier(); asm volatile("" ::: "memory");
        const int row0 = u.pm * 256 + wr * 64 + fr, col0 = u.pn * 256 + wc * 32 + 8 * fq;
#pragma unroll
        for (int ai = 0; ai < 2; ++ai)
#pragma unroll
            for (int m = 0; m < 4; ++m) {
                const int rl = ai * 128 + wr * 64 + m * 16 + fr;
                const f32x2 p0 = X[rl * 4 + 0], p1 = X[rl * 4 + 1], p2 = X[rl * 4 + 2], p3 = X[rl * 4 + 3];
                const float gm = fmaxf(fmaxf(p0.x, p1.x), fmaxf(p2.x, p3.x));
                const float tot = p0.y * __builtin_amdgcn_exp2f(p0.x - gm) + p1.y * __builtin_amdgcn_exp2f(p1.x - gm) + p2.y * __builtin_amdgcn_exp2f(p2.x - gm) + p3.y * __builtin_amdgcn_exp2f(p3.x - gm);
                const float inv = 1.f / tot;
                bf16* rowp = P + (size_t)(row0 + ai * 128 + m * 16) * D + col0;
#pragma unroll
                for (int bj = 0; bj < 2; ++bj) { f32x4 v0 = acc[ai][bj][m][0], v1 = acc[ai][bj][m][1];
#pragma unroll
                    for (int j = 0; j < 4; ++j) { v0[j] = __builtin_amdgcn_exp2f(v0[j] * scale_log2 - gm) * inv; v1[j] = __builtin_amdgcn_exp2f(v1[j] * scale_log2 - gm) * inv; }
                    u32x4 w; w.x = cvt_pk_bf16(v0[0], v0[1]); w.y = cvt_pk_bf16(v0[2], v0[3]); w.z = cvt_pk_bf16(v1[0], v1[1]); w.w = cvt_pk_bf16(v1[2], v1[3]);
                    *(u32x4*)(rowp + bj * 128) = w; }
                asm volatile("" ::: "memory");
            }
        return false;
    }
};
struct EpiCross {
    static constexpr bool CHAIN = false, TWICE = false;
    static constexpr bool ALIGN = true, HOOK = true;
    EpiPlain q; EpiSoftmax sm; EpiPlainT<true> o;
    __device__ __forceinline__ bool operator()(EPI_ARGS) const {
        if (u.kind < 2) return q(acc, u, wr, wc, fr_in, fq_in);
        if (u.kind < 4) return sm(acc, u, wr, wc, fr_in, fq_in);
        return o(acc, u, wr, wc, fr_in, fq_in);
    }
};
struct EpiGU {
    static constexpr bool CHAIN = false, TWICE = true;
    static constexpr bool HOOK = false;
#ifndef EPI_ALIGN
#define EPI_ALIGN true
#endif
    static constexpr bool ALIGN = EPI_ALIGN;
    bf16* H; const u64* ss; float wsc;
    __device__ __forceinline__ bool operator()(EPI_ARGS) const {
        EPI_LANE
        const int row0 = u.pm * 256 + wr * 64 + fr, col0 = u.pn * 128 + wc * 32 + 8 * fq;
        u64 sq[8];
#pragma unroll
        for (int k = 0; k < 8; ++k) sq[k] = ss[row0 + (k >> 2) * 128 + (k & 3) * 16];
#pragma unroll
        for (int ai = 0; ai < 2; ++ai)
#pragma unroll
            for (int m = 0; m < 4; ++m) {
                const float rs = rstd_of(sq[ai * 4 + m]) * wsc, ns = -1.44269504f * rs;
                f32x4 v[2];
#pragma unroll
                for (int n = 0; n < 2; ++n) { const f32x4 g = acc[ai][0][m][n], uu = acc[ai][1][m][n];
#pragma unroll
                    for (int j = 0; j < 4; ++j) v[n][j] = (g[j] * rs) * __builtin_amdgcn_rcpf(1.f + __builtin_amdgcn_exp2f(ns * g[j])) * (uu[j] * (rs * F8_HSCALE)); }
                u32x2 w; w.x = pk4_f8(v[0][0], v[0][1], v[0][2], v[0][3]); w.y = pk4_f8(v[1][0], v[1][1], v[1][2], v[1][3]);
                *(u32x2*)((unsigned char*)H + (size_t)(row0 + ai * 128 + m * 16) * DFF + col0) = w; asm volatile("" ::: "memory");
            }
        return false;
    }
};
struct EpiDownMoe {
    static constexpr bool CHAIN = false, TWICE = false;
    static constexpr bool HOOK = false;
    static constexpr bool ALIGN = true;
    const int* tokmap; const float* roww; bf16* Y; int t_slot1;
    __device__ __forceinline__ bool operator()(EPI_ARGS) const {
        EPI_LANE
        const int row0 = u.pm * 256 + wr * 64 + fr, col0 = u.pn * 256 + wc * 32 + 8 * fq;
        bf16* Ys = Y + ((u.pm >= t_slot1) ? (size_t)M * D : (size_t)0);
        int tk[8]; float wg[8];
#pragma unroll
        for (int k = 0; k < 8; ++k) { const int r = row0 + (k >> 2) * 128 + (k & 3) * 16; tk[k] = tokmap[r]; wg[k] = roww[r] * (1.f / (F8_HSCALE * F8_WSCALE)); }
#pragma unroll
        for (int ai = 0; ai < 2; ++ai)
#pragma unroll
            for (int m = 0; m < 4; ++m) { const int t_ = tk[ai * 4 + m];
                if (t_ >= 0) { const float wgt = wg[ai * 4 + m]; bf16* rowp = Ys + (size_t)t_ * D + col0;
#pragma unroll
                    for (int bj = 0; bj < 2; ++bj) { const f32x4 v0 = acc[ai][bj][m][0] * wgt, v1 = acc[ai][bj][m][1] * wgt;
                        u32x4 w; w.x = cvt_pk_bf16(v0[0], v0[1]); w.y = cvt_pk_bf16(v0[2], v0[3]); w.z = cvt_pk_bf16(v1[0], v1[1]); w.w = cvt_pk_bf16(v1[2], v1[3]);
                        *(u32x4*)(rowp + bj * 128) = w; } } }
        return false;
    }
};

template <int MODE> struct MergeSched {
    const char* A0; const char* A1; const char* W; int pm, pn;
    __device__ __forceinline__ bool next(int i, Unit& u) const {
        if (i >= 4) return false;
        u.pm = pm; u.pn = pn; u.kind = i;
        if (MODE == 0) { u.A = A0 + (size_t)pm * 256 * 1024; u.B = W + (size_t)(i * 1024 + pn * 256) * 1024; u.nt = 8; }
        else { u.A = ((i < 2) ? A0 : A1) + (size_t)pm * 256 * 2048 + (i & 1) * 1024; u.B = W + (size_t)(i >> 1) * (2 * MiB) + (size_t)pn * 256 * 2048 + (i & 1) * 1024; u.nt = 8; }
        return true;
    }
};
struct CrossQSched {
    const char* X8; const char* Wq; int G, c;
    __device__ __forceinline__ bool next(int i, Unit& u) const {
        if (i >= 2) return false;
        int L = i * G + c; if (L >= 512) return false;
        { const int q = 512 / 8, xcd = L % 8, off = L / 8; L = xcd * q + off; }
        const int rt = L & 15, head = (L >> 4) & 3, b = L >> 6;
        u.pm = b * 16 + rt; u.pn = head; u.kind = i; u.nt = 8;
        u.A = X8 + (size_t)u.pm * 256 * 1024; u.B = Wq + (size_t)head * 256 * 1024; return true;
    }
};
struct CrossFusedSched {
    const char* XB; const char* Wq; const char* XQ; const char* Kx; const char* XP; const char* VTb; int G, c;
    __device__ __forceinline__ bool next(int i, Unit& u) const {
        if (i >= 4) return false;
        const int ti = i & 1, stage = (i >> 1) + 1;
        int L = ti * G + c; if (L >= 512) return false;
        { const int q = 512 / 8, xcd = L % 8, off = L / 8; L = xcd * q + off; }
        const int rt = L & 15, head = (L >> 4) & 3, b = L >> 6;
        u.pm = b * 16 + rt; u.pn = head; u.kind = 2 * stage + ti;
        if (stage == 0) { u.A = XB + (size_t)u.pm * 256 * 2048; u.B = Wq + (size_t)head * 256 * 2048; u.nt = 16; }
        else if (stage == 1) { u.A = XQ + (size_t)u.pm * 256 * 2048 + head * 512; u.B = Kx + (size_t)(b * 256) * 2048 + head * 512; u.nt = 4; }
        else { u.A = XP + (size_t)u.pm * 256 * 2048 + head * 512; u.B = VTb + (size_t)b * ((size_t)D * D * 2) + (size_t)(head * 256) * 2048; u.nt = 4; }
        return true;
    }
};
struct CrossSched {
    const char* A; const char* B; int mode, G, c;
    __device__ __forceinline__ bool next(int i, Unit& u) const {
        const long L0 = (long)i * G + c; if (L0 >= 512) return false;
        int L = (int)L0; { const int q = 512 / 8, xcd = L % 8, off = L / 8; L = xcd * q + off; }
        const int rt = L & 15, head = (L >> 4) & 3, b = L >> 6;
        u.pm = b * 16 + rt; u.pn = head; u.kind = i; u.nt = 4;
        u.A = A + (size_t)u.pm * 256 * 2048 + head * 512;
        u.B = (mode == 0) ? B + (size_t)(b * 256) * 2048 + head * 512 : B + (size_t)(head * 256) * 4096 + b * 512;
        return true;
    }
};
struct MoeSched {
    const char* A; const char* B; unsigned lda; size_t wstride; unsigned ldb; int t0, nT, nN, nt, G, c; const int* gt;
    __device__ __forceinline__ bool next(int i, Unit& u) const {
        const long L = (long)i * G + c; if (L >= (long)nT * nN) return false;
        int pm, pn; pg8::tile_of((int)L, nT, nN, pm, pn); pm += t0;
        int g = 0;
#pragma unroll
        for (int k = 1; k < 16; ++k) g += (pm >= gt[k]) ? 1 : 0;
        g = __builtin_amdgcn_readfirstlane(g);
        u.pm = pm; u.pn = pn; u.kind = 0; u.nt = nt;
        u.A = A + (size_t)pm * 256 * lda; u.B = B + (size_t)(g & 7) * wstride + (size_t)pn * 256 * ldb; return true;
    }
};

#define XB_TMO      128
#define XB_XCNT(j)  (256  + 64 * (j))
#define XB_XSUB(j)  (1280 + 64 * (j))
#define XB_XGEN(j)  (2304 + 64 * (j))
#define XB_TOP      3328
#define XB_TOPGEN   3392
#define XCD_BAR_WORDS 3456
#define XB_SPIN_CAP (1u << 22)
__device__ __forceinline__ unsigned xb_ld(unsigned* p)              { return __hip_atomic_load(p, __ATOMIC_RELAXED, __HIP_MEMORY_SCOPE_AGENT); }
__device__ __forceinline__ unsigned xb_add(unsigned* p, unsigned v) { return __hip_atomic_fetch_add(p, v, __ATOMIC_RELAXED, __HIP_MEMORY_SCOPE_AGENT); }
__device__ __forceinline__ unsigned xb_xcc_id() { return (unsigned)__builtin_amdgcn_s_getreg((3 << 11) | 20) & 0xFu; }
#define XB_SPIN(cond, bar) do { unsigned _sp = 0; while (cond) { __builtin_amdgcn_s_sleep(1); \
    if ((++_sp & 255u) == 0u) { if (xb_ld(&(bar)[XB_TMO])) break; if (_sp > XB_SPIN_CAP) { atomicAdd(&(bar)[XB_TMO], 1u); break; } } } } while (0)
struct XcdBarrier { unsigned* bar; unsigned x; volatile LAS unsigned* st; };
__device__ __forceinline__ XcdBarrier xcd_barrier_post(unsigned* bar, volatile LAS unsigned* st) {
    XcdBarrier b; b.bar = bar; b.x = xb_xcc_id(); b.st = st;
    if (threadIdx.x == 0) (void)xb_add(&bar[XB_XCNT(b.x)], 1u);
    return b;
}
__device__ __forceinline__ void xcd_barrier_complete(unsigned* bar, unsigned x, unsigned& nloc, unsigned& nx) {
    const unsigned G = gridDim.x * gridDim.y * gridDim.z;
    unsigned sum, cnt, mine, sp = 0u;
    for (;;) {
        sum = 0u; cnt = 0u; mine = 0u;
#pragma unroll
        for (unsigned j = 0; j < 16; ++j) { const unsigned c = xb_ld(&bar[XB_XCNT(j)]); sum += c; cnt += (c > 0u) ? 1u : 0u; mine = (j == x) ? c : mine; }
        if (sum == G) break;
        __builtin_amdgcn_s_sleep(1);
        if ((++sp & 255u) == 0u) { if (xb_ld(&bar[XB_TMO])) break; if (sp > XB_SPIN_CAP) { atomicAdd(&bar[XB_TMO], 1u); break; } }
    }
    nloc = mine > 0u ? mine : 1u; nx = cnt > 0u ? cnt : 1u;
}
__device__ __noinline__ void xcd_barrier_impl(unsigned* bar_, unsigned x_, volatile LAS unsigned* st_) {
    XcdBarrier b; b.bar = bar_; b.x = x_; b.st = st_;
    asm volatile("s_waitcnt vmcnt(0)" ::: "memory");
    __syncthreads();
    if (threadIdx.x == 0) {
        unsigned* bar = b.bar;
        __builtin_amdgcn_s_waitcnt(0);
        unsigned nloc = b.st[0], nx = b.st[1];
        if (nloc == 0u) { xcd_barrier_complete(bar, b.x, nloc, nx); b.st[0] = nloc; b.st[1] = nx; }
        const unsigned old = xb_add(&bar[XB_XSUB(b.x)], 1u);
        const unsigned gen = old / nloc;
        if (old + 1u == (gen + 1u) * nloc) {
            __builtin_amdgcn_fence(__ATOMIC_RELEASE, "agent");
            asm volatile("s_waitcnt vmcnt(0)" ::: "memory");
            const unsigned og = xb_add(&bar[XB_TOP], 1u);
            const unsigned tg = og / nx;
            if (og + 1u == (tg + 1u) * nx) xb_add(&bar[XB_TOPGEN], 1u);
            else XB_SPIN(xb_ld(&bar[XB_TOPGEN]) == tg, bar);
            __builtin_amdgcn_fence(__ATOMIC_ACQUIRE, "agent");
            xb_add(&bar[XB_XGEN(b.x)], 1u);
            asm volatile("s_waitcnt vmcnt(0)" ::: "memory");
        } else {
            XB_SPIN(xb_ld(&bar[XB_XGEN(b.x)]) == gen, bar);
            __builtin_amdgcn_fence(__ATOMIC_ACQUIRE, "agent");
            asm volatile("s_waitcnt vmcnt(0)" ::: "memory");
        }
    }
    __syncthreads();
}
__device__ __forceinline__ void xcd_barrier(const XcdBarrier& b) { xcd_barrier_impl(b.bar, b.x, b.st); }

struct Args {
    const float* x; const float* mem; const int* positions; const float* norm_mix; const float* w_in; const float* attn_sink; const float* w_branch; const float* w_out;
    const float* pool_w; const float* pool_scale; const float* norm_cross; const float* norm_mem; const float* w_xq; const float* w_xkv; const float* w_xo; const float* norm_ffn;
    const float* dense_w_gu; const float* dense_w_down; const float* router_w; const float* moe_w_gu; const float* moe_w_down; const float* norm_final;
    float* out; unsigned char* ws; int ph_lo, ph_hi;
};

template <int F8 = 0>
__device__ __forceinline__ void transpose_item(const float* W, int ldw, int k0, int src, int nv, bf16* WT, size_t dst_pitch, int dst_row0, int dst_k0, LAS float* scr, int lane, const float* gain) {
    f32x4 tv[8];
    const int n4 = (lane & 7) * 4, kr = lane >> 3;
#pragma unroll
    for (int i = 0; i < 8; ++i) tv[i] = (n4 < nv) ? *(const f32x4*)(W + (size_t)(k0 + 8 * i + kr) * ldw + src + n4) : (f32x4){0.f, 0.f, 0.f, 0.f};
    if (gain) {
#pragma unroll
        for (int i = 0; i < 8; ++i) tv[i] = tv[i] * gain[k0 + 8 * i + kr]; }
#pragma unroll
    for (int i = 0; i < 8; ++i) { LAS float* d = scr + (8 * i + kr) * 33 + n4; d[0] = tv[i].x; d[1] = tv[i].y; d[2] = tv[i].z; d[3] = tv[i].w; }
    LDS_WAIT(); asm volatile("" ::: "memory");
    const int c = lane & 7;
#pragma unroll
    for (int j = 0; j < 4; ++j) { const int n = (lane >> 3) + 8 * j; const LAS float* s = scr + (8 * c) * 33 + n;
        if constexpr (F8) {
            u32x2 o; o.x = pk4_f8(s[0 * 33] * F8_WSCALE, s[1 * 33] * F8_WSCALE, s[2 * 33] * F8_WSCALE, s[3 * 33] * F8_WSCALE); o.y = pk4_f8(s[4 * 33] * F8_WSCALE, s[5 * 33] * F8_WSCALE, s[6 * 33] * F8_WSCALE, s[7 * 33] * F8_WSCALE);
            *(u32x2*)((unsigned char*)WT + (size_t)(dst_row0 + n) * dst_pitch + dst_k0 + k0 + 8 * c) = o;
        } else {
        u32x4 o; o.x = pk2(s[0 * 33], s[1 * 33]); o.y = pk2(s[2 * 33], s[3 * 33]); o.z = pk2(s[4 * 33], s[5 * 33]); o.w = pk2(s[6 * 33], s[7 * 33]);
        *(u32x4*)(WT + (size_t)(dst_row0 + n) * dst_pitch + dst_k0 + k0 + 8 * c) = o; } }
    LDS_WAIT(); asm volatile("" ::: "memory");
}
template <int MAP, int F8 = 0>
__device__ __forceinline__ void conv_seg(const float* W, int K, int ldw, int src0, bf16* WT, size_t dst_pitch, int dst_k0, int nb, int item, LAS float* scr, int lane, const float* gain = nullptr) {
    const int kb = item / nb, vb = item % nb;
    int src, nv = 32;
    if (MAP == 0) src = src0 + 32 * vb;
    else if (MAP == 1) { const int pn = vb >> 3, bj = (vb >> 2) & 1, wc = vb & 3, g = 4 * pn + wc;
        if (g < 29) src = 64 * g + 32 * bj; else if (g < 61) src = 64 * g + 4 + 32 * bj; else if (g == 61) { src = 1856; nv = bj == 0 ? 4 : 0; } else { src = 0; nv = 0; } }
    else { const int pn = vb >> 3, bj = (vb >> 2) & 1, pb = vb & 3; src = src0 + bj * DFF + 128 * pn + 32 * pb; }
    transpose_item<F8>(W, ldw, 64 * kb, src, nv, WT, dst_pitch, 32 * vb, dst_k0, scr, lane, gain);
}
struct ConvItem { const float* W; int ldw, k0, src; const float* gain; unsigned char* WT; int dpitch, drow0; };
__device__ __forceinline__ void conv_load(const ConvItem& c, f32x4 (&tv)[8], float (&gv)[8], int lane) {
    const int n4 = (lane & 7) * 4, kr = lane >> 3;
#pragma unroll
    for (int i = 0; i < 8; ++i) tv[i] = *(const f32x4*)(c.W + (size_t)(c.k0 + 8 * i + kr) * c.ldw + c.src + n4);
#pragma unroll
    for (int i = 0; i < 8; ++i) gv[i] = c.gain ? c.gain[c.k0 + 8 * i + kr] : 1.f;
}
__device__ __forceinline__ void conv_finish8(const ConvItem& c, const f32x4 (&tv)[8], const float (&gv)[8], LAS float* scr, int lane) {
    const int n4 = (lane & 7) * 4, kr = lane >> 3;
#pragma unroll
    for (int i = 0; i < 8; ++i) { const float g = gv[i] * F8_WSCALE; LAS float* d = scr + (8 * i + kr) * 33 + n4; d[0] = tv[i].x * g; d[1] = tv[i].y * g; d[2] = tv[i].z * g; d[3] = tv[i].w * g; }
    LDS_WAIT(); asm volatile("" ::: "memory");
    const int cc = lane & 7;
#pragma unroll
    for (int j = 0; j < 4; ++j) { const int n = (lane >> 3) + 8 * j; const LAS float* sp = scr + (8 * cc) * 33 + n;
        u32x2 o; o.x = pk4_f8(sp[0 * 33], sp[1 * 33], sp[2 * 33], sp[3 * 33]); o.y = pk4_f8(sp[4 * 33], sp[5 * 33], sp[6 * 33], sp[7 * 33]);
        *(u32x2*)(c.WT + (size_t)(c.drow0 + n) * c.dpitch + c.k0 + 8 * cc) = o; }
    LDS_WAIT(); asm volatile("" ::: "memory");
}
__device__ __forceinline__ void norm_row_bf16(const float* xrow, const float* g, bf16* orow, int lane) {
    const f32x4* xr = (const f32x4*)xrow + lane; const f32x4* gr = (const f32x4*)g + lane;
    f32x4 v[4]; float s = 0.f;
#pragma unroll
    for (int j = 0; j < 4; ++j) { v[j] = xr[64 * j]; s += (v[j].x * v[j].x + v[j].y * v[j].y) + (v[j].z * v[j].z + v[j].w * v[j].w); }
    const float rstd = 1.f / sqrtf(wave_sum(s) * (1.f / D) + EPS);
    unsigned long long* o8 = (unsigned long long*)orow + lane;
#pragma unroll
    for (int j = 0; j < 4; ++j) { const f32x4 gg = gr[64 * j];
        o8[64 * j] = (unsigned long long)pk2(v[j].x * rstd * gg.x, v[j].y * rstd * gg.y) | ((unsigned long long)pk2(v[j].z * rstd * gg.z, v[j].w * rstd * gg.w) << 32); }
}

constexpr int RT_P = 136;
typedef float f32x4v __attribute__((ext_vector_type(4)));
__device__ __forceinline__ void pool_phase(const bf16* proj, const bf16* wpt, const float* pscale, bf16* br23, char* lds, int G) {
    int tid = threadIdx.x; asm volatile("" : "+v"(tid)); const int lane = tid & 63, wave = tid >> 6, fr = lane & 15, fq = lane >> 4;
    bf16* Dl = (bf16*)lds;
    for (int un = blockIdx.x; un < 2048; un += G) {
        const int g = un & 3, tb = (un >> 2) & 63, b = un >> 8;
        const int win = 2 << g;
        const bf16* wp = wpt + (size_t)g * 16384 + (16 * wave + fr) * 128 + 8 * fq;
        bf16x8 bw[4];
#pragma unroll
        for (int ks = 0; ks < 4; ++ks) bw[ks] = *(const bf16x8*)(wp + 32 * ks);
        const float sc = pscale[g * 128 + 16 * wave + fr];
#pragma unroll
        for (int i = 0; i < 2; ++i) { const int idx = tid + 512 * i, tt = idx >> 4, pc = idx & 15, t = tb * 64 + tt;
            const bf16* up = proj + ((size_t)(b * T + t)) * NPROJ + C_PU + g * 128 + 8 * pc;
            const int cnt = (t + 1 < win) ? t + 1 : win;
            float sm[8];
#pragma unroll
            for (int q = 0; q < 8; ++q) sm[q] = 0.f;
            u32x4 wv[16];
#pragma unroll
            for (int j = 0; j < 16; ++j) wv[j] = (j < cnt) ? *(const u32x4*)(up - (size_t)j * NPROJ) : (u32x4){0u, 0u, 0u, 0u};
            const u32x4 u0 = wv[0];
#pragma unroll
            for (int j = 0; j < 16; ++j) { const u32x4 v = wv[j];
                sm[0] += __uint_as_float(v.x << 16); sm[1] += __uint_as_float(v.x & 0xffff0000u); sm[2] += __uint_as_float(v.y << 16); sm[3] += __uint_as_float(v.y & 0xffff0000u);
                sm[4] += __uint_as_float(v.z << 16); sm[5] += __uint_as_float(v.z & 0xffff0000u); sm[6] += __uint_as_float(v.w << 16); sm[7] += __uint_as_float(v.w & 0xffff0000u); }
            const float ic = 1.f / (float)cnt;
            u32x4 o;
            o.x = pk2(sm[0] * ic - __uint_as_float(u0.x << 16), sm[1] * ic - __uint_as_float(u0.x & 0xffff0000u)); o.y = pk2(sm[2] * ic - __uint_as_float(u0.y << 16), sm[3] * ic - __uint_as_float(u0.y & 0xffff0000u));
            o.z = pk2(sm[4] * ic - __uint_as_float(u0.z << 16), sm[5] * ic - __uint_as_float(u0.z & 0xffff0000u)); o.w = pk2(sm[6] * ic - __uint_as_float(u0.w << 16), sm[7] * ic - __uint_as_float(u0.w & 0xffff0000u));
            *(u32x4*)(Dl + tt * RT_P + 8 * pc) = o; }
        __syncthreads();
#pragma unroll
        for (int tt = 0; tt < 4; ++tt) { f32x4v d = (f32x4v){0.f, 0.f, 0.f, 0.f};
#pragma unroll
            for (int ks = 0; ks < 4; ++ks) d = __builtin_amdgcn_mfma_f32_16x16x32_bf16(*(const bf16x8*)(Dl + (16 * tt + fr) * RT_P + 32 * ks + 8 * fq), bw[ks], d, 0, 0, 0);
#pragma unroll
            for (int r = 0; r < 4; ++r) br23[((size_t)(b * T + tb * 64 + 16 * tt + 4 * fq + r)) * D + 512 + g * 128 + 16 * wave + fr] = (bf16)f2bf1(d[r] * sc); }
        __syncthreads();
    }
}
__device__ __forceinline__ float row16_max(float v) {
    v = fmaxf(v, __builtin_bit_cast(float, __builtin_amdgcn_mov_dpp(__builtin_bit_cast(int, v), 0xB1, 0xf, 0xf, true)));
    v = fmaxf(v, __builtin_bit_cast(float, __builtin_amdgcn_mov_dpp(__builtin_bit_cast(int, v), 0x4E, 0xf, 0xf, true)));
    v = fmaxf(v, __builtin_bit_cast(float, __builtin_amdgcn_mov_dpp(__builtin_bit_cast(int, v), 0x141, 0xf, 0xf, true)));
    v = fmaxf(v, __builtin_bit_cast(float, __builtin_amdgcn_mov_dpp(__builtin_bit_cast(int, v), 0x140, 0xf, 0xf, true)));
    return v;
}
__device__ __forceinline__ float row16_sum(float v) {
    v += __builtin_bit_cast(float, __builtin_amdgcn_mov_dpp(__builtin_bit_cast(int, v), 0xB1, 0xf, 0xf, true));
    v += __builtin_bit_cast(float, __builtin_amdgcn_mov_dpp(__builtin_bit_cast(int, v), 0x4E, 0xf, 0xf, true));
    v += __builtin_bit_cast(float, __builtin_amdgcn_mov_dpp(__builtin_bit_cast(int, v), 0x141, 0xf, 0xf, true));
    v += __builtin_bit_cast(float, __builtin_amdgcn_mov_dpp(__builtin_bit_cast(int, v), 0x140, 0xf, 0xf, true));
    return v;
}
constexpr int SWA_KP = 72, SWA_VP = 264, SWA_PP = 168;
__device__ __forceinline__ void swa_phase(const bf16* proj, const bf16* akv, const float* sink, bf16* br01, char* lds, int G) {
    int tid = threadIdx.x; asm volatile("" : "+v"(tid)); const int lane = tid & 63, wave = tid >> 6;
    bf16* Kl = (bf16*)lds; bf16* Vt = (bf16*)(lds + 36864); bf16* Pw = (bf16*)(lds + 36864 + 33792) + wave * 16 * SWA_PP;
    for (int un = blockIdx.x; un < 512; un += G) {
        const int nb = un & 31, kvh = (un >> 5) & 1, b = un >> 6;
        const size_t m0 = (size_t)b * T + nb * 128;
        const int g = wave >> 1, head = kvh * 4 + g, fr = lane & 15, fq = lane >> 4;
        const float sk = sink[head];
        bf16x8 qf[4][2];
#pragma unroll
        for (int j = 0; j < 4; ++j) { const bf16* qp = proj + (m0 + 16 * ((wave & 1) * 4 + j) + fr) * NPROJ + C_AQ + head * 64 + 8 * fq; qf[j][0] = *(const bf16x8*)qp; qf[j][1] = *(const bf16x8*)(qp + 32); }
#pragma unroll
        for (int i = 0; i < 4; ++i) { const int idx = tid + 512 * i, key = idx >> 3, pc = idx & 7;
            u32x4 kv = (u32x4){0u, 0u, 0u, 0u}, vv = kv;
            if (nb > 0 || key >= 128) { const bf16* src = akv + (m0 - 128 + key) * 256 + kvh * 64 + pc * 8; kv = *(const u32x4*)src; vv = *(const u32x4*)(src + 128); }
            *(u32x4*)(Kl + key * SWA_KP + pc * 8) = kv;
            bf16* vd = Vt + (pc * 8) * SWA_VP + key;
            vd[0] = (bf16)(vv.x & 0xffffu); vd[SWA_VP] = (bf16)(vv.x >> 16); vd[2 * SWA_VP] = (bf16)(vv.y & 0xffffu); vd[3 * SWA_VP] = (bf16)(vv.y >> 16);
            vd[4 * SWA_VP] = (bf16)(vv.z & 0xffffu); vd[5 * SWA_VP] = (bf16)(vv.z >> 16); vd[6 * SWA_VP] = (bf16)(vv.w & 0xffffu); vd[7 * SWA_VP] = (bf16)(vv.w >> 16); }
        __syncthreads();
#pragma unroll
        for (int j = 0; j < 4; ++j) {
            const int a = (wave & 1) * 4 + j, i0 = 16 * a, ap = a & ~1;
            const bf16x8 q0 = qf[j][0], q1 = qf[j][1];
            f32x4v sv[10];
#pragma unroll
            for (int kt = 0; kt < 10; ++kt) {
                const bf16* kp = Kl + (16 * (ap + kt) + fr) * SWA_KP + 8 * fq;
                f32x4v d = (f32x4v){0.f, 0.f, 0.f, 0.f};
                d = __builtin_amdgcn_mfma_f32_16x16x32_bf16(q0, *(const bf16x8*)kp, d, 0, 0, 0);
                d = __builtin_amdgcn_mfma_f32_16x16x32_bf16(q1, *(const bf16x8*)(kp + 32), d, 0, 0, 0);
                sv[kt] = d;
            }
            float mx[4] = {-INFINITY, -INFINITY, -INFINITY, -INFINITY};
#pragma unroll
            for (int kt = 0; kt < 10; ++kt) { const int kabs = 16 * (ap + kt) + fr;
#pragma unroll
                for (int r = 0; r < 4; ++r) { const int i = i0 + 4 * fq + r; const bool ok = (kabs >= i + 1) && (kabs <= i + 128) && (nb > 0 || kabs >= 128);
                    const float x = ok ? sv[kt][r] * 0.125f : -INFINITY; sv[kt][r] = x; mx[r] = fmaxf(mx[r], x); } }
            float den[4];
#pragma unroll
            for (int r = 0; r < 4; ++r) { mx[r] = fmaxf(row16_max(mx[r]), sk); den[r] = 0.f; }
#pragma unroll
            for (int kt = 0; kt < 10; ++kt)
#pragma unroll
                for (int r = 0; r < 4; ++r) { const float pv = __expf(sv[kt][r] - mx[r]); den[r] += pv; Pw[(4 * fq + r) * SWA_PP + 16 * kt + fr] = (bf16)f2bf1(pv); }
#pragma unroll
            for (int r = 0; r < 4; ++r) den[r] = 1.f / (row16_sum(den[r]) + __expf(sk - mx[r]));
            LDS_WAIT();
            f32x4v o[4];
#pragma unroll
            for (int dt = 0; dt < 4; ++dt) o[dt] = (f32x4v){0.f, 0.f, 0.f, 0.f};
#pragma unroll
            for (int ks = 0; ks < 5; ++ks) { const bf16x8 pa = *(const bf16x8*)(Pw + fr * SWA_PP + 32 * ks + 8 * fq);
#pragma unroll
                for (int dt = 0; dt < 4; ++dt) o[dt] = __builtin_amdgcn_mfma_f32_16x16x32_bf16(pa, *(const bf16x8*)(Vt + (16 * dt + fr) * SWA_VP + 16 * ap + 32 * ks + 8 * fq), o[dt], 0, 0, 0); }
#pragma unroll
            for (int r = 0; r < 4; ++r) { bf16* op = br01 + (m0 + i0 + 4 * fq + r) * D + head * 64 + fr;
#pragma unroll
                for (int dt = 0; dt < 4; ++dt) op[16 * dt] = (bf16)f2bf1(o[dt][r] * den[r]); }
            LDS_WAIT();
        }
        __syncthreads();
    }
}
typedef float f32x16 __attribute__((ext_vector_type(16)));
constexpr int DSA_S = 4100;
constexpr int DSA_WOFF = 8 * DSA_S * 4;
__device__ __forceinline__ float dpp_x1(float x) { return __builtin_bit_cast(float, __builtin_amdgcn_mov_dpp(__builtin_bit_cast(int, x), 0xB1, 0xf, 0xf, true)); }
__device__ __forceinline__ float dpp_x2(float x) { return __builtin_bit_cast(float, __builtin_amdgcn_mov_dpp(__builtin_bit_cast(int, x), 0x4E, 0xf, 0xf, true)); }
__device__ __forceinline__ int wave_sum_i(int v) {
    v += __builtin_amdgcn_mov_dpp(v, 0xB1, 0xf, 0xf, true);
    v += __builtin_amdgcn_mov_dpp(v, 0x4E, 0xf, 0xf, true);
    v += __builtin_amdgcn_mov_dpp(v, 0x141, 0xf, 0xf, true);
    v += __builtin_amdgcn_mov_dpp(v, 0x140, 0xf, 0xf, true);
    v += __builtin_amdgcn_update_dpp(0, v, 0x142, 0xa, 0xf, false);
    v += __builtin_amdgcn_update_dpp(0, v, 0x143, 0xc, 0xf, false);
    return __builtin_amdgcn_readlane(v, 63);
}
__device__ __forceinline__ unsigned sortable(float f) { const unsigned u = __float_as_uint(f); return (u >> 31) ? ~u : (u | 0x80000000u); }
__device__ __forceinline__ void dsa_scores(const bf16* pb, const bf16* ikb, int t0, float* scl, int wave, int lane) {
    const int n = lane & 31, kh = lane >> 5, q = n >> 2, h = n & 3;
    const bf16* qrow = pb + (size_t)(t0 + q) * NPROJ;
    bf16x8 Bq[4];
#pragma unroll
    for (int ks = 0; ks < 4; ++ks) Bq[ks] = *(const bf16x8*)(qrow + C_IQ + h * 64 + 16 * ks + 8 * kh);
    const float wq = bf2f(qrow[C_IW + h]) * 0.0625f;
    const int ntile = (t0 + 8 + 31) >> 5;
    float* dst = scl + q * DSA_S + h + 4 * kh;
#pragma unroll 1
    for (int tile0 = wave; tile0 < ntile; tile0 += 32) {
        bf16x8 a[4][4];
#pragma unroll
        for (int u = 0; u < 4; ++u) { const int tile = tile0 + 8 * u; const int tc = (tile < ntile) ? tile : 0;
            const bf16* kf = ikb + ((size_t)tc * 256 + lane) * 8;
#pragma unroll
            for (int ks = 0; ks < 4; ++ks) a[u][ks] = *(const bf16x8*)(kf + ks * 512); }
#pragma unroll
        for (int u = 0; u < 4; ++u) { const int tile = tile0 + 8 * u;
            if (tile < ntile) {
                f32x16 d;
#pragma unroll
                for (int r = 0; r < 16; ++r) d[r] = 0.f;
#pragma unroll
                for (int ks = 0; ks < 4; ++ks) d = __builtin_amdgcn_mfma_f32_32x32x16_bf16(a[u][ks], Bq[ks], d, 0, 0, 0);
                float v[16];
#pragma unroll
                for (int r = 0; r < 16; ++r) { float x = fmaxf(d[r], 0.f) * wq; x += dpp_x1(x); x += dpp_x2(x); v[r] = x; }
#pragma unroll
                for (int k = 0; k < 4; ++k) { const float val = (h == 0) ? v[4 * k] : (h == 1) ? v[4 * k + 1] : (h == 2) ? v[4 * k + 2] : v[4 * k + 3]; dst[tile * 32 + 8 * k] = val + 0.f; }
            } }
    }
}
__device__ __forceinline__ int wave_scan_incl(int v) {
    v += __builtin_amdgcn_update_dpp(0, v, 0x111, 0xf, 0xf, false);
    v += __builtin_amdgcn_update_dpp(0, v, 0x112, 0xf, 0xf, false);
    v += __builtin_amdgcn_update_dpp(0, v, 0x114, 0xf, 0xf, false);
    v += __builtin_amdgcn_update_dpp(0, v, 0x118, 0xf, 0xf, false);
    v += __builtin_amdgcn_update_dpp(0, v, 0x142, 0xa, 0xf, false);
    v += __builtin_amdgcn_update_dpp(0, v, 0x143, 0xc, 0xf, false);
    return v;
}
template <int SMODE> __device__ __forceinline__ void dsa_select(int t, float* sc, char* wl, int lane) {
    unsigned short* sel = (unsigned short*)(wl + 512);
    const int nk = t + 1;
    const int K = nk < 256 ? nk : 256;
    const int nj = (nk + 63) >> 6;
    unsigned key[64];
#pragma unroll
    for (int j = 0; j < 64; ++j) { const int s = 64 * j + lane; const unsigned kq = sortable(sc[s]); key[j] = (s < nk) ? kq : 0u; }
    if (SMODE == 1) { unsigned x = 0u;
#pragma unroll
        for (int j = 0; j < 64; ++j) x ^= key[j];
        sel[255] = (unsigned short)x; return; }
    unsigned Tk = 1u; int cT = K;
    if (nk > 256) {
        unsigned* hist = (unsigned*)sc;
        auto find_bin = [&](int Kq, int& ge, int& in) -> unsigned {
            int sl = 0;
#pragma unroll
            for (int i = 0; i < 64; ++i) sl += (int)hist[64 * lane + ((i + lane) & 63)];
            const int pre = wave_scan_incl(sl);
            const int tot = __builtin_amdgcn_readlane(pre, 63);
            const int suf = tot - pre + sl;
            const unsigned long long m1 = __ballot(suf >= Kq);
            const int Ls = 63 - __builtin_clzll(m1);
            const int above = __builtin_amdgcn_readlane(suf - sl, Ls);
            const int hi = (int)hist[64 * Ls + lane];
            const int pre2 = wave_scan_incl(hi);
            const int tot2 = __builtin_amdgcn_readlane(pre2, 63);
            const int suf2 = above + tot2 - pre2 + hi;
            const unsigned long long m2 = __ballot(suf2 >= Kq);
            const int is = 63 - __builtin_clzll(m2);
            ge = __builtin_amdgcn_readlane(suf2, is); in = __builtin_amdgcn_readlane(hi, is);
            return (unsigned)(64 * Ls + is); };
        LDS_WAIT();
#pragma unroll
        for (int i = 0; i < 16; ++i) ((u32x4*)hist)[lane + 64 * i] = (u32x4){0u, 0u, 0u, 0u};
        LDS_WAIT();
#pragma unroll
        for (int jg = 0; jg < 4; ++jg) if (16 * jg < nj) {
#pragma unroll
            for (int j = 16 * jg; j < 16 * jg + 16; ++j) if (j < nj) atomicAdd(&hist[key[j] >> 20], key[j] != 0u ? 1u : 0u); }
        LDS_WAIT();
        int ge1, in1;
        const unsigned B = find_bin(K, ge1, in1);
        Tk = B << 20; cT = ge1;
        if (cT != K) {
            const int aboveB = ge1 - in1, K2 = K - aboveB;
            LDS_WAIT();
#pragma unroll
            for (int i = 0; i < 16; ++i) ((u32x4*)hist)[lane + 64 * i] = (u32x4){0u, 0u, 0u, 0u};
            LDS_WAIT();
#pragma unroll
            for (int jg = 0; jg < 4; ++jg) if (16 * jg < nj) {
#pragma unroll
                for (int j = 16 * jg; j < 16 * jg + 16; ++j) { if ((key[j] >> 20) == B) atomicAdd(&hist[(key[j] >> 8) & 0xfffu], key[j] != 0u ? 1u : 0u);
                    if ((j & 3) == 3) __builtin_amdgcn_sched_barrier(0); } }
            LDS_WAIT();
            int ge2, in2;
            const unsigned B2 = find_bin(K2, ge2, in2);
            Tk |= B2 << 8; cT = aboveB + ge2;
            for (int bit = 7; bit >= 0 && cT != K; --bit) {
                const unsigned cand = Tk | (1u << bit); int c = 0;
#pragma unroll
                for (int jg = 0; jg < 4; ++jg) if (16 * jg < nj) {
#pragma unroll
                    for (int j = 16 * jg; j < 16 * jg + 16; ++j) c += (key[j] >= cand) ? 1 : 0; }
                const int totc = wave_sum_i(c);
                if (totc >= K) { Tk = cand; cT = totc; }
            }
        }
    }
    if (SMODE == 2) { sel[255] = (unsigned short)Tk; return; }
    LDS_WAIT();
    if (cT == K) {
        int base = 0;
#pragma unroll
        for (int jg = 0; jg < 4; ++jg) if (16 * jg < nj) {
#pragma unroll
            for (int j = 16 * jg; j < 16 * jg + 16; ++j) {
                const bool tk = key[j] >= Tk;
                const unsigned long long mk = __ballot(tk);
                const int pos = base + (int)__builtin_amdgcn_mbcnt_hi((unsigned)(mk >> 32), __builtin_amdgcn_mbcnt_lo((unsigned)mk, 0u));
                if (tk) sel[pos] = (unsigned short)(64 * j + lane);
                base += __popcll(mk);
                if ((j & 3) == 3) __builtin_amdgcn_sched_barrier(0);
            } }
    } else {
        int cg = 0;
#pragma unroll
        for (int j = 0; j < 64; ++j) cg += (key[j] > Tk) ? 1 : 0;
        const int pg = wave_scan_incl(cg);
        const int totg = __builtin_amdgcn_readlane(pg, 63);
        const int need = K - totg;
        int pos = pg - cg;
#pragma unroll
        for (int jg = 0; jg < 4; ++jg) if (16 * jg < nj) {
#pragma unroll
            for (int j = 16 * jg; j < 16 * jg + 16; ++j) if (key[j] > Tk) { sel[pos] = (unsigned short)(64 * j + lane); ++pos; } }
        const unsigned long long lt = (1ull << lane) - 1ull;
        int ties = 0;
#pragma unroll
        for (int jg = 0; jg < 4; ++jg) if (16 * jg < nj) {
#pragma unroll
            for (int j = 16 * jg; j < 16 * jg + 16; ++j) {
                const unsigned long long meq = __ballot(key[j] == Tk);
                const int rk = ties + __popcll(meq & lt);
                if (key[j] == Tk && rk < need) sel[totg + rk] = (unsigned short)(64 * j + lane);
                ties += __popcll(meq);
            } }
    }
    LDS_WAIT();
}
typedef short v4i16_t __attribute__((ext_vector_type(4)));
constexpr int DSA_VP = 72, DSA_PP = 264;
template <int MODE> __device__ __forceinline__ void dsa_attend(const bf16x8 (&qa)[2][2], const bf16* kvb, bf16* br01, int b, int t, float* sc, char* wl, int lane) {
    const unsigned short* sel = (const unsigned short*)(wl + 512);
    const size_t m = (size_t)b * T + t;
    const int K = (t + 1) < 256 ? (t + 1) : 256;
    const int fr = lane & 15, fq = lane >> 4;
    bf16* Vst = (bf16*)sc; bf16* Pl = (bf16*)sc + 64 * DSA_VP;
    LAS const char* vst3 = (LAS const char*)Vst;
    const int nch = (MODE & 1) ? 0 : ((K + 63) >> 6);
#pragma unroll
    for (int kvh = 0; kvh < 2; ++kvh) {
        f32x4v lg[16];
        {
            u32x4 k0[8], k1[8];
#pragma unroll
            for (int i = 0; i < 8; ++i) k0[i] = *(const u32x4*)(kvb + (size_t)sel[8 * i + (lane >> 3)] * 256 + kvh * 64 + 8 * (lane & 7));
#pragma unroll
            for (int i = 0; i < 8; ++i) k1[i] = *(const u32x4*)(kvb + (size_t)sel[64 + 8 * i + (lane >> 3)] * 256 + kvh * 64 + 8 * (lane & 7));
#define DSA_QK_CHUNK(c, buf, nextc) do { \
            LDS_WAIT(); \
            _Pragma("unroll") for (int i = 0; i < 8; ++i) *(u32x4*)(Vst + (8 * i + (lane >> 3)) * DSA_VP + 8 * (lane & 7)) = buf[i]; \
            if ((nextc) < 4) { \
                _Pragma("unroll") for (int i = 0; i < 8; ++i) buf[i] = *(const u32x4*)(kvb + (size_t)sel[64 * ((nextc) & 3) + 8 * i + (lane >> 3)] * 256 + kvh * 64 + 8 * (lane & 7)); } \
            LDS_WAIT(); \
            _Pragma("unroll") for (int e4 = 0; e4 < 4; ++e4) { const int et = 4 * (c) + e4; \
                const bf16* kp = Vst + (16 * e4 + fr) * DSA_VP + 8 * fq; \
                f32x4v d = (f32x4v){0.f, 0.f, 0.f, 0.f}; \
                d = __builtin_amdgcn_mfma_f32_16x16x32_bf16(qa[kvh][0], *(const bf16x8*)kp, d, 0, 0, 0); \
                d = __builtin_amdgcn_mfma_f32_16x16x32_bf16(qa[kvh][1], *(const bf16x8*)(kp + 32), d, 0, 0, 0); \
                if (16 * et + fr >= K) d = (f32x4v){-INFINITY, -INFINITY, -INFINITY, -INFINITY}; \
                lg[et] = d; } } while (0)
            DSA_QK_CHUNK(0, k0, 2);
            DSA_QK_CHUNK(1, k1, 3);
            DSA_QK_CHUNK(2, k0, 4);
            DSA_QK_CHUNK(3, k1, 5);
#undef DSA_QK_CHUNK
        }
        if (MODE & 2) { float x = 0.f;
#pragma unroll
            for (int et = 0; et < 16; ++et) x += lg[et][0] + lg[et][1] + lg[et][2] + lg[et][3];
            Pl[lane] = (bf16)f2bf1(x); continue; }
        u32x4 va[8], vb[8];
#pragma unroll
        for (int i = 0; i < 8; ++i) va[i] = *(const u32x4*)(kvb + (size_t)sel[8 * i + (lane >> 3)] * 256 + 128 + kvh * 64 + 8 * (lane & 7));
#pragma unroll
        for (int i = 0; i < 8; ++i) vb[i] = *(const u32x4*)(kvb + (size_t)sel[64 + 8 * i + (lane >> 3)] * 256 + 128 + kvh * 64 + 8 * (lane & 7));
        {
            float x[16];
#pragma unroll
            for (int et = 0; et < 16; ++et) x[et] = (fq == 0) ? lg[et][0] : (fq == 1) ? lg[et][1] : (fq == 2) ? lg[et][2] : lg[et][3];
            float mx = x[0];
#pragma unroll
            for (int et = 1; et < 16; ++et) mx = fmaxf(mx, x[et]);
            mx = row16_max(mx);
            float sm = 0.f;
#pragma unroll
            for (int et = 0; et < 16; ++et) { x[et] = __builtin_amdgcn_exp2f((x[et] - mx) * (0.125f * 1.44269504f)); sm += x[et]; }
            const float inv = 1.f / row16_sum(sm);
#pragma unroll
            for (int et = 0; et < 16; ++et) Pl[fq * DSA_PP + 16 * et + fr] = (bf16)f2bf1(x[et] * inv);
        }
        f32x4v o[4];
#pragma unroll
        for (int dt = 0; dt < 4; ++dt) o[dt] = (f32x4v){0.f, 0.f, 0.f, 0.f};
#define DSA_PV_CHUNK(c, buf, nextc) do { \
            LDS_WAIT(); \
            _Pragma("unroll") for (int i = 0; i < 8; ++i) *(u32x4*)(Vst + (8 * i + (lane >> 3)) * DSA_VP + 8 * (lane & 7)) = buf[i]; \
            if ((nextc) < nch) { \
                _Pragma("unroll") for (int i = 0; i < 8; ++i) buf[i] = *(const u32x4*)(kvb + (size_t)sel[64 * (nextc) + 8 * i + (lane >> 3)] * 256 + 128 + kvh * 64 + 8 * (lane & 7)); } \
            LDS_WAIT(); \
            _Pragma("unroll") for (int ks = 0; ks < 2; ++ks) { \
                const bf16x8 pa = *(const bf16x8*)(Pl + (fr & 3) * DSA_PP + 64 * (c) + 32 * ks + 8 * fq); \
                _Pragma("unroll") for (int dt = 0; dt < 4; ++dt) { \
                    LAS const char* a0 = vst3 + ((32 * ks + 8 * fq + (fr >> 2)) * DSA_VP + 16 * dt + 4 * (fr & 3)) * 2; \
                    const v4i16_t lo = __builtin_amdgcn_ds_read_tr16_b64_v4i16((LAS v4i16_t*)a0); \
                    const v4i16_t hi = __builtin_amdgcn_ds_read_tr16_b64_v4i16((LAS v4i16_t*)(a0 + 4 * DSA_VP * 2)); \
                    bf16x8 bv; bv[0] = lo[0]; bv[1] = lo[1]; bv[2] = lo[2]; bv[3] = lo[3]; bv[4] = hi[0]; bv[5] = hi[1]; bv[6] = hi[2]; bv[7] = hi[3]; \
                    o[dt] = __builtin_amdgcn_mfma_f32_16x16x32_bf16(pa, bv, o[dt], 0, 0, 0); } } } while (0)
        if (nch > 0) DSA_PV_CHUNK(0, va, 2);
        if (nch > 1) DSA_PV_CHUNK(1, vb, 3);
        if (nch > 2) DSA_PV_CHUNK(2, va, 4);
        if (nch > 3) DSA_PV_CHUNK(3, vb, 5);
#undef DSA_PV_CHUNK
        const f32x4v ov = (fq == 0) ? o[0] : (fq == 1) ? o[1] : (fq == 2) ? o[2] : o[3];
        bf16* op = br01 + m * D + 512 + kvh * 256 + 16 * fq + fr;
#pragma unroll
        for (int r = 0; r < 4; ++r) op[r * 64] = (bf16)f2bf1(ov[r]);
        LDS_WAIT();
    }
}
__device__ __forceinline__ void dsa_phase(const bf16* proj, const bf16* bkv, const bf16* ik, bf16* br01, char* lds, int G) {
    int tid = threadIdx.x; asm volatile("" : "+v"(tid)); const int lane = tid & 63, wave = __builtin_amdgcn_readfirstlane(tid >> 6);
    float* scl = (float*)lds;
    char* wl = lds + DSA_WOFF + wave * 1024;
    const int c = blockIdx.x, b = c & 7, j = c >> 3, R = G >> 3;
    const bf16* pb = proj + (size_t)b * T * NPROJ; const bf16* kvb = bkv + (size_t)b * T * 256; const bf16* ikb = ik + (size_t)b * T * 64;
    ((unsigned*)(wl + 512))[lane] = 0u; ((unsigned*)(wl + 512))[lane + 64] = 0u;
    for (int k = 0; ; ++k) {
        const int u = (k & 1) ? (R - 1 - j) + R * k : j + R * k;
        if (u >= T / 8) break;
        const int t0 = 8 * u;
        int l1 = lane; asm volatile("" : "+v"(l1));
        for (int r_ = 0; r_ < REP(4); ++r_) dsa_scores(pb, ikb, t0, scl, wave, l1);
        __syncthreads();
        int l2 = lane; asm volatile("" : "+v"(l2));
        bf16x8 qa[2][2];
#pragma unroll
        for (int kvh = 0; kvh < 2; ++kvh) { const bf16* qp = pb + (size_t)(t0 + wave) * NPROJ + C_BQ + (kvh * 4 + (l2 & 3)) * 64 + 8 * (l2 >> 4); qa[kvh][0] = *(const bf16x8*)qp; qa[kvh][1] = *(const bf16x8*)(qp + 32); }
        dsa_select<0>(t0 + wave, scl + wave * DSA_S, wl, l2);
        int l3 = lane; asm volatile("" : "+v"(l3));
        dsa_attend<0>(qa, kvb, br01, b, t0 + wave, scl + wave * DSA_S, wl, l3);
        __syncthreads();
    }
}
__device__ __forceinline__ void ret_u_phase(const bf16* proj, float* U, char* lds, int G) {
    int tid = threadIdx.x; asm volatile("" : "+v"(tid)); const int lane = tid & 63, wave = tid >> 6, fr = lane & 15, fq = lane >> 4;
    bf16* KdT = (bf16*)lds; bf16* VT = (bf16*)(lds + 17408);
    for (int un = blockIdx.x; un < 1024; un += G) {
        const int c = un & 31, bh = un >> 5, h = bh & 3, b = bh >> 2;
        const float lg2 = log2f(1.f - exp2f(-5.f - (float)h));
        const size_t m0 = (size_t)b * T + c * 128;
#pragma unroll
        for (int i = 0; i < 2; ++i) { const int idx = tid + 512 * i, mm = idx >> 3, pc = idx & 7;
            const u32x4 kv = *(const u32x4*)(proj + (m0 + mm) * NPROJ + C_RK + 64 * h + 8 * pc);
            const float dc = 0.125f * exp2f(lg2 * (float)(127 - mm));
            bf16* kd = KdT + (8 * pc) * RT_P + mm;
            kd[0] = (bf16)f2bf1(__uint_as_float(kv.x << 16) * dc); kd[RT_P] = (bf16)f2bf1(__uint_as_float(kv.x & 0xffff0000u) * dc);
            kd[2 * RT_P] = (bf16)f2bf1(__uint_as_float(kv.y << 16) * dc); kd[3 * RT_P] = (bf16)f2bf1(__uint_as_float(kv.y & 0xffff0000u) * dc);
            kd[4 * RT_P] = (bf16)f2bf1(__uint_as_float(kv.z << 16) * dc); kd[5 * RT_P] = (bf16)f2bf1(__uint_as_float(kv.z & 0xffff0000u) * dc);
            kd[6 * RT_P] = (bf16)f2bf1(__uint_as_float(kv.w << 16) * dc); kd[7 * RT_P] = (bf16)f2bf1(__uint_as_float(kv.w & 0xffff0000u) * dc); }
#pragma unroll
        for (int i = 0; i < 4; ++i) { const int idx = tid + 512 * i, mm = idx >> 4, pc = idx & 15;
            const u32x4 vv = *(const u32x4*)(proj + (m0 + mm) * NPROJ + C_RV + 128 * h + 8 * pc);
            bf16* vd = VT + (8 * pc) * RT_P + mm;
            vd[0] = (bf16)(vv.x & 0xffffu); vd[RT_P] = (bf16)(vv.x >> 16); vd[2 * RT_P] = (bf16)(vv.y & 0xffffu); vd[3 * RT_P] = (bf16)(vv.y >> 16);
            vd[4 * RT_P] = (bf16)(vv.z & 0xffffu); vd[5 * RT_P] = (bf16)(vv.z >> 16); vd[6 * RT_P] = (bf16)(vv.w & 0xffffu); vd[7 * RT_P] = (bf16)(vv.w >> 16); }
        __syncthreads();
        f32x4v acc[4];
#pragma unroll
        for (int dt = 0; dt < 4; ++dt) acc[dt] = (f32x4v){0.f, 0.f, 0.f, 0.f};
#pragma unroll
        for (int ks = 0; ks < 4; ++ks) { const bf16x8 bv = *(const bf16x8*)(VT + (16 * wave + fr) * RT_P + 32 * ks + 8 * fq);
#pragma unroll
            for (int dt = 0; dt < 4; ++dt) acc[dt] = __builtin_amdgcn_mfma_f32_16x16x32_bf16(*(const bf16x8*)(KdT + (16 * dt + fr) * RT_P + 32 * ks + 8 * fq), bv, acc[dt], 0, 0, 0); }
        float* up = U + (size_t)un * 8192;
#pragma unroll
        for (int dt = 0; dt < 4; ++dt)
#pragma unroll
            for (int r = 0; r < 4; ++r) up[(16 * dt + 4 * fq + r) * 128 + 16 * wave + fr] = acc[dt][r];
        __syncthreads();
    }
}
__device__ __forceinline__ void ret_scan_phase(const float* U, bf16* ST, int G) {
    int tid = threadIdx.x; asm volatile("" : "+v"(tid));
    for (int w = blockIdx.x; w < 256; w += G) {
        const int bh = w >> 3, part = w & 7, h = bh & 3;
        const float cd = exp2f(128.f * log2f(1.f - exp2f(-5.f - (float)h)));
        const int e2 = part * 512 + tid, dv = e2 & 127, dp = e2 >> 7;
        const float* up = U + (size_t)bh * 32 * 8192 + (2 * dp) * 128 + dv;
        unsigned* sp = (unsigned*)(ST + (size_t)bh * 32 * 8192 + dv * 64 + 2 * dp);
        float u0[32], u1[32];
#pragma unroll
        for (int j = 0; j < 31; ++j) { u0[j] = up[(size_t)j * 8192]; u1[j] = up[(size_t)j * 8192 + 128]; }
        float s0 = 0.f, s1 = 0.f;
        sp[0] = 0u;
#pragma unroll
        for (int c = 1; c < 32; ++c) { s0 = s0 * cd + u0[c - 1]; s1 = s1 * cd + u1[c - 1]; sp[(size_t)c * 4096] = pk2(s0, s1); }
    }
}
__device__ __forceinline__ void ret_out_phase(const bf16* proj, const bf16* ST, bf16* br23, char* lds, int G) {
    int tid = threadIdx.x; asm volatile("" : "+v"(tid)); const int lane = tid & 63, wave = tid >> 6, fr = lane & 15, fq = lane >> 4;
    bf16* Kl = (bf16*)lds; bf16* VT = (bf16*)(lds + 18432); bf16* Pw = (bf16*)(lds + 18432 + 34816) + wave * 16 * RT_P;
    for (int un = blockIdx.x; un < 1024; un += G) {
        const int c = un & 31, bh = un >> 5, h = bh & 3, b = bh >> 2;
        const float lg2 = log2f(1.f - exp2f(-5.f - (float)h));
        const size_t m0 = (size_t)b * T + c * 128;
        const bf16* qp = proj + (m0 + 16 * wave + fr) * NPROJ + C_RQ + 64 * h + 8 * fq;
        const bf16x8 q0 = *(const bf16x8*)qp, q1 = *(const bf16x8*)(qp + 32);
        const bf16* stp = ST + (size_t)un * 8192;
        bf16x8 stf[8][2];
#pragma unroll
        for (int dt = 0; dt < 8; ++dt) { const bf16* sp = stp + (16 * dt + fr) * 64 + 8 * fq; stf[dt][0] = *(const bf16x8*)sp; stf[dt][1] = *(const bf16x8*)(sp + 32); }
#pragma unroll
        for (int i = 0; i < 2; ++i) { const int idx = tid + 512 * i, mm = idx >> 3, pc = idx & 7;
            *(u32x4*)(Kl + mm * 72 + 8 * pc) = *(const u32x4*)(proj + (m0 + mm) * NPROJ + C_RK + 64 * h + 8 * pc); }
#pragma unroll
        for (int i = 0; i < 4; ++i) { const int idx = tid + 512 * i, mm = idx >> 4, pc = idx & 15;
            const u32x4 vv = *(const u32x4*)(proj + (m0 + mm) * NPROJ + C_RV + 128 * h + 8 * pc);
            bf16* vd = VT + (8 * pc) * RT_P + mm;
            vd[0] = (bf16)(vv.x & 0xffffu); vd[RT_P] = (bf16)(vv.x >> 16); vd[2 * RT_P] = (bf16)(vv.y & 0xffffu); vd[3 * RT_P] = (bf16)(vv.y >> 16);
            vd[4 * RT_P] = (bf16)(vv.z & 0xffffu); vd[5 * RT_P] = (bf16)(vv.z >> 16); vd[6 * RT_P] = (bf16)(vv.w & 0xffffu); vd[7 * RT_P] = (bf16)(vv.w >> 16); }
        __syncthreads();
        f32x4v acc[8];
#pragma unroll
        for (int dt = 0; dt < 8; ++dt) { f32x4v d = (f32x4v){0.f, 0.f, 0.f, 0.f};
            d = __builtin_amdgcn_mfma_f32_16x16x32_bf16(q0, stf[dt][0], d, 0, 0, 0);
            d = __builtin_amdgcn_mfma_f32_16x16x32_bf16(q1, stf[dt][1], d, 0, 0, 0);
            acc[dt] = d; }
#pragma unroll
        for (int r = 0; r < 4; ++r) { const float qd = exp2f(lg2 * (float)(16 * wave + 4 * fq + r + 1));
#pragma unroll
            for (int dt = 0; dt < 8; ++dt) acc[dt][r] *= qd; }
#pragma unroll
        for (int mt = 0; mt < 8; ++mt) {
            f32x4v d = (f32x4v){0.f, 0.f, 0.f, 0.f};
            if (mt <= wave) { const bf16* kp = Kl + (16 * mt + fr) * 72 + 8 * fq;
                d = __builtin_amdgcn_mfma_f32_16x16x32_bf16(q0, *(const bf16x8*)kp, d, 0, 0, 0);
                d = __builtin_amdgcn_mfma_f32_16x16x32_bf16(q1, *(const bf16x8*)(kp + 32), d, 0, 0, 0); }
            const int mm = 16 * mt + fr;
#pragma unroll
            for (int r = 0; r < 4; ++r) { const int n = 16 * wave + 4 * fq + r;
                const float pv = (mm <= n) ? d[r] * 0.125f * exp2f(lg2 * (float)(n - mm)) : 0.f;
                Pw[(4 * fq + r) * RT_P + mm] = (bf16)f2bf1(pv); }
        }
        bf16 gh[4][8];
#pragma unroll
        for (int r = 0; r < 4; ++r) { const bf16* gp = proj + (m0 + 16 * wave + 4 * fq + r) * NPROJ + C_RG + 128 * h + fr;
#pragma unroll
            for (int dt = 0; dt < 8; ++dt) gh[r][dt] = gp[16 * dt]; }
        LDS_WAIT();
#pragma unroll
        for (int ks = 0; ks < 4; ++ks) { const bf16x8 pa = *(const bf16x8*)(Pw + fr * RT_P + 32 * ks + 8 * fq);
#pragma unroll
            for (int dt = 0; dt < 8; ++dt) acc[dt] = __builtin_amdgcn_mfma_f32_16x16x32_bf16(pa, *(const bf16x8*)(VT + (16 * dt + fr) * RT_P + 32 * ks + 8 * fq), acc[dt], 0, 0, 0); }
#pragma unroll
        for (int r = 0; r < 4; ++r) { float q = 0.f;
#pragma unroll
            for (int dt = 0; dt < 8; ++dt) q += acc[dt][r] * acc[dt][r];
            const float rs = 1.f / sqrtf(row16_sum(q) * (1.f / 128.f) + EPS);
            const size_t row = m0 + 16 * wave + 4 * fq + r;
            bf16* op = br23 + row * D + h * 128 + fr;
#pragma unroll
            for (int dt = 0; dt < 8; ++dt) { const float gv = bf2f(gh[r][dt]); op[16 * dt] = (bf16)f2bf1(gv / (1.f + __expf(-gv)) * acc[dt][r] * rs); } }
        __syncthreads();
    }
}

typedef const __attribute__((address_space(4))) Args* KArgs;
__device__ __forceinline__ KArgs kargs() { KArgs p = (KArgs)__builtin_amdgcn_kernarg_segment_ptr(); asm volatile("" : "+s"(p)); return p; }

__device__ __forceinline__ void ph0(LAS unsigned char* L, int layer, int slot) {
    int tid = threadIdx.x; asm volatile("" : "+v"(tid)); const int lane = tid & 63, wave = __builtin_amdgcn_readfirstlane(tid >> 6);
    int G = gridDim.x, bx = blockIdx.x; asm volatile("" : "+s"(G), "+s"(bx)); const int gw = bx * 8 + wave, NGW = G * 8;
    unsigned char* lds = (unsigned char*)L; LAS int* lcnt = (LAS int*)(L + 0); LAS int* gt = (LAS int*)(L + LDS_MISC + 512);
    (void)lane; (void)gw; (void)NGW; (void)lds; (void)lcnt; (void)gt; (void)layer; (void)slot; (void)tid; (void)bx; (void)G;
    {
        KArgs A = kargs(); unsigned char* ws = A->ws;
        LAS float* scr = (LAS float*)(L + wave * 16384);
        constexpr int I_IN = 16 * 128, I_G = 16 * 128, I_B = 8 * 32, I_SQ = 16 * 32, I_L = I_IN + I_G + 4 * I_B + 5 * I_SQ;
        constexpr int I_GU = 16 * 224, I_DN = 56 * 32, NITEMS = 2 * I_L + I_GU + I_DN;
        for (int it = gw; it < NITEMS; it += NGW) {
            int r = it;
            if (r < 2 * I_L) {
                const int l = r / I_L; r -= l * I_L;
                unsigned char* wb = ws + WS_W + (size_t)l * W_LAYER;
                const float* win = A->w_in + (size_t)l * D * D_IN;
                if (r < I_IN) { conv_seg<1>(win, D, D_IN, 0, (bf16*)(wb + W_IN), D, 0, 128, r, scr, lane, A->norm_mix + (size_t)l * D); continue; } r -= I_IN;
                if (r < I_G) { conv_seg<0, 1>(win, D, D_IN, 3908, (bf16*)(wb + W_G), D, 0, 128, r, scr, lane, A->norm_mix + (size_t)l * D); continue; } r -= I_G;
                if (r < 4 * I_B) { const int i = r / I_B; r -= i * I_B;
                    conv_seg<0>(A->w_branch + ((size_t)l * 4 + i) * 512 * D, 512, D, 0, (bf16*)(wb + W_B) + (size_t)(i >> 1) * D * D, D, (i & 1) * 512, 32, r, scr, lane); continue; } r -= 4 * I_B;
                if (r < I_SQ) { conv_seg<0>(A->w_out + (size_t)l * D * D, D, D, 0, (bf16*)(wb + W_OUT), D, 0, 32, r, scr, lane); continue; } r -= I_SQ;
                if (r < I_SQ) { conv_seg<0, 1>(A->w_xq + (size_t)l * D * D, D, D, 0, (bf16*)(wb + W_XQ), D, 0, 32, r, scr, lane, A->norm_cross + (size_t)l * D); continue; } r -= I_SQ;
                if (r < I_SQ) { conv_seg<0>(A->w_xkv + (size_t)l * D * 2 * D, D, 2 * D, 0, (bf16*)(wb + W_XK), D, 0, 32, r, scr, lane); continue; } r -= I_SQ;
                if (r < I_SQ) { conv_seg<0>(A->w_xkv + (size_t)l * D * 2 * D, D, 2 * D, D, (bf16*)(wb + W_XV), D, 0, 32, r, scr, lane); continue; } r -= I_SQ;
                conv_seg<0, 1>(A->w_xo + (size_t)l * D * D, D, D, 0, (bf16*)(wb + W_XO), D, 0, 32, r, scr, lane); continue;
            }
            r -= 2 * I_L;
            if (r < I_GU) { conv_seg<2, 1>(A->dense_w_gu, D, 2 * DFF, 0, (bf16*)(ws + WS_WGU), D, 0, 224, r, scr, lane, A->norm_ffn); continue; } r -= I_GU;
            conv_seg<0, 1>(A->dense_w_down, DFF, D, 0, (bf16*)(ws + WS_WDN), DFF, 0, 32, r, scr, lane);
        }
        for (int it = gw; it < 64; it += NGW) { const int lg = it >> 3;
            conv_seg<0>(A->pool_w + (size_t)lg * 16384, 128, 128, 0, (bf16*)(ws + WS_WPOOL) + (size_t)lg * 16384, 128, 0, 4, it & 7, scr, lane); }
        {
            _Float16* cosT = (_Float16*)(ws + WS_ROPE); _Float16* sinT = cosT + (size_t)M * 32; const int* pos = A->positions;
            for (int i = bx * 512 + tid; i < M * 32; i += G * 512) { const int m = i >> 5, j = i & 31;
                const float ang = (float)pos[m] * INV_FREQ[j];
                const double rev = (double)ang * 0.15915494309189533577; const float fr_ = (float)(rev - rint(rev));
                const size_t to = ((size_t)((m >> 4) * 4 + (j >> 3)) * 16 + (m & 15)) * 8 + (j & 7);
                cosT[to] = (_Float16)__builtin_amdgcn_cosf(fr_); sinT[to] = (_Float16)__builtin_amdgcn_sinf(fr_); }
        }
        {
            const float* mem = A->mem; const float* nm = A->norm_mem; bf16* MN = (bf16*)(ws + WS_MN);
            for (int r = gw; r < 2 * MROWS; r += NGW) { const int l = r / MROWS, mr = r % MROWS; norm_row_bf16(mem + (size_t)mr * D, nm + (size_t)l * D, MN + (size_t)r * D, lane); }
            const float* x = A->x; bf16* XB = (bf16*)(ws + WS_HB); u64* ss0 = (u64*)(ws + WS_SS);
            for (int m = gw; m < M; m += NGW) {
                const f32x4* xr = (const f32x4*)(x + (size_t)m * D) + lane; unsigned long long* o8 = (unsigned long long*)(XB + (size_t)m * D) + lane; float q = 0.f;
#pragma unroll
                for (int j = 0; j < 4; ++j) { const f32x4 v = xr[64 * j]; q += (v.x * v.x + v.y * v.y) + (v.z * v.z + v.w * v.w);
                    o8[64 * j] = (unsigned long long)pk2(v.x, v.y) | ((unsigned long long)pk2(v.z, v.w) << 32);
                    ((unsigned*)(ws + WS_XF8 + (size_t)m * D))[lane + 64 * j] = pk4_f8(v.x, v.y, v.z, v.w); }
                q = wave_sum(q); if (lane == 0) ss0[m] = ss_fix(q); }
        }
    }
}
__device__ __forceinline__ void ph1(LAS unsigned char* L, int layer, int slot) {
    int tid = threadIdx.x; asm volatile("" : "+v"(tid)); const int lane = tid & 63, wave = __builtin_amdgcn_readfirstlane(tid >> 6);
    int G = gridDim.x, bx = blockIdx.x; asm volatile("" : "+s"(G), "+s"(bx)); const int gw = bx * 8 + wave, NGW = G * 8;
    unsigned char* lds = (unsigned char*)L; LAS int* lcnt = (LAS int*)(L + 0); LAS int* gt = (LAS int*)(L + LDS_MISC + 512);
    (void)lane; (void)gw; (void)NGW; (void)lds; (void)lcnt; (void)gt; (void)layer; (void)slot; (void)tid; (void)bx; (void)G;
    {
            unsigned char* ws = kargs()->ws; unsigned char* wb = ws + WS_W + (size_t)layer * W_LAYER;
            { pg8::GridSched S{(const char*)(ws + WS_HB), (const char*)(wb + W_IN), 2048u, 2048u, 128, 16, 16, G, bx};
              EpiProj E{(bf16*)(ws + WS_PROJ), (const _Float16*)(ws + WS_ROPE), (const _Float16*)(ws + WS_ROPE) + (size_t)M * 32, (bf16*)(ws + WS_AKV), (bf16*)(ws + WS_BKV), (bf16*)(ws + WS_IK), (const u64*)(ws + WS_SS) + (size_t)(3 * layer) * M};
              pg8::gemm_stream(L, S, E, 2048u, 2048u); }
            if (layer == 0) {
                for (int l = 0; l < 2; ++l) {
                    unsigned char* wl = ws + WS_W + (size_t)l * W_LAYER;
                    { pg8::GridSched S{(const char*)(ws + WS_MN) + (size_t)l * MROWS * D * 2, (const char*)(wl + W_XK), 2048u, 2048u, 8, 4, 16, G, bx};
                      EpiPlain E{(bf16*)(ws + WS_KX) + (size_t)l * MROWS * D, D, 1.f, nullptr};
                      pg8::gemm_stream(L, S, E, 2048u, 2048u); }
                    { pg8::GridSched S{(const char*)(wl + W_XV), (const char*)(ws + WS_MN) + (size_t)l * MROWS * D * 2, 2048u, 2048u, 4, 8, 16, G, bx};
                      EpiPlain E{(bf16*)(ws + WS_VTB) + (size_t)l * 8 * D * D, D, 1.f, nullptr, (size_t)D * D};
                      pg8::gemm_stream(L, S, E, 2048u, 2048u); }
                }
            }
        }
}
__device__ __forceinline__ void ph2(LAS unsigned char* L, int layer, int slot) {
    int tid = threadIdx.x; asm volatile("" : "+v"(tid)); const int lane = tid & 63, wave = __builtin_amdgcn_readfirstlane(tid >> 6);
    int G = gridDim.x, bx = blockIdx.x; asm volatile("" : "+s"(G), "+s"(bx)); const int gw = bx * 8 + wave, NGW = G * 8;
    unsigned char* lds = (unsigned char*)L; LAS int* lcnt = (LAS int*)(L + 0); LAS int* gt = (LAS int*)(L + LDS_MISC + 512);
    (void)lane; (void)gw; (void)NGW; (void)lds; (void)lcnt; (void)gt; (void)layer; (void)slot; (void)tid; (void)bx; (void)G;
    {
            KArgs A = kargs(); unsigned char* ws = A->ws;
            const bf16* PROJ = (const bf16*)(ws + WS_PROJ);
            for (int r_ = 0; r_ < REP(0); ++r_) ret_u_phase(PROJ, (float*)(ws + WS_U), (char*)lds, G);
            for (int r_ = 0; r_ < REP(1); ++r_) pool_phase(PROJ, (const bf16*)(ws + WS_WPOOL) + (size_t)layer * 4 * 16384, A->pool_scale + (size_t)layer * 512, (bf16*)(ws + WS_BR23), (char*)lds, G);
            for (int r_ = 0; r_ < REP(2); ++r_) swa_phase(PROJ, (const bf16*)(ws + WS_AKV), A->attn_sink + layer * 8, (bf16*)(ws + WS_BR01), (char*)lds, G);
            for (int r_ = 0; r_ < REP(3); ++r_) dsa_phase(PROJ, (const bf16*)(ws + WS_BKV), (const bf16*)(ws + WS_IK), (bf16*)(ws + WS_BR01), (char*)lds, G);
        }
}
__device__ __forceinline__ void ph3(LAS unsigned char* L, int layer, int slot) {
    int tid = threadIdx.x; asm volatile("" : "+v"(tid)); const int lane = tid & 63, wave = __builtin_amdgcn_readfirstlane(tid >> 6);
    int G = gridDim.x, bx = blockIdx.x; asm volatile("" : "+s"(G), "+s"(bx)); const int gw = bx * 8 + wave, NGW = G * 8;
    unsigned char* lds = (unsigned char*)L; LAS int* lcnt = (LAS int*)(L + 0); LAS int* gt = (LAS int*)(L + LDS_MISC + 512);
    (void)lane; (void)gw; (void)NGW; (void)lds; (void)lcnt; (void)gt; (void)layer; (void)slot; (void)tid; (void)bx; (void)G;
    { unsigned char* ws = kargs()->ws; ret_out_phase((const bf16*)(ws + WS_PROJ), (const bf16*)(ws + WS_ST), (bf16*)(ws + WS_BR23), (char*)lds, G); }
}
__device__ __forceinline__ void ph20(LAS unsigned char* L, int layer, int slot) {
    int tid = threadIdx.x; asm volatile("" : "+v"(tid)); const int lane = tid & 63, wave = __builtin_amdgcn_readfirstlane(tid >> 6);
    int G = gridDim.x, bx = blockIdx.x; asm volatile("" : "+s"(G), "+s"(bx)); const int gw = bx * 8 + wave, NGW = G * 8;
    unsigned char* lds = (unsigned char*)L; LAS int* lcnt = (LAS int*)(L + 0); LAS int* gt = (LAS int*)(L + LDS_MISC + 512);
    (void)lane; (void)gw; (void)NGW; (void)lds; (void)lcnt; (void)gt; (void)layer; (void)slot; (void)tid; (void)bx; (void)G;
    { unsigned char* ws = kargs()->ws; ret_scan_phase((const float*)(ws + WS_U), (bf16*)(ws + WS_ST), G); }
}
__device__ __forceinline__ void ph4(LAS unsigned char* L, int layer, int slot) {
    int tid = threadIdx.x; asm volatile("" : "+v"(tid)); const int lane = tid & 63, wave = __builtin_amdgcn_readfirstlane(tid >> 6);
    int G = gridDim.x, bx = blockIdx.x; asm volatile("" : "+s"(G), "+s"(bx)); const int gw = bx * 8 + wave, NGW = G * 8;
    unsigned char* lds = (unsigned char*)L; LAS int* lcnt = (LAS int*)(L + 0); LAS int* gt = (LAS int*)(L + LDS_MISC + 512);
    (void)lane; (void)gw; (void)NGW; (void)lds; (void)lcnt; (void)gt; (void)layer; (void)slot; (void)tid; (void)bx; (void)G;
    {
            unsigned char* ws = kargs()->ws; unsigned char* wb = ws + WS_W + (size_t)layer * W_LAYER;
            unsigned* scr = (unsigned*)(ws + WS_MSCR + (size_t)bx * 786432);
            for (int ti = 0; ti * G + bx < 512; ++ti) {
                int pm, pn; pg8::tile_of(ti * G + bx, 128, 4, pm, pn);
                { MergeSched<0> S{(const char*)(ws + WS_XF8), nullptr, (const char*)(wb + W_G), pm, pn};
                  EpiGate E{scr, (const u64*)(ws + WS_SS) + (size_t)(3 * layer) * M, 1.f / F8_WSCALE};
                  pg8::gemm_stream<EpiGate, MergeSched<0>, 1>(L, S, E, 1024u, 1024u); }
                { MergeSched<1> S{(const char*)(ws + WS_BR01), (const char*)(ws + WS_BR23), (const char*)(wb + W_B), pm, pn};
                  EpiUp E{scr, (bf16*)(ws + WS_MERGED)};
                  pg8::gemm_stream(L, S, E, 2048u, 2048u); }
            }
        }
}
__device__ __forceinline__ void ph5(LAS unsigned char* L, int layer, int slot) {
    int tid = threadIdx.x; asm volatile("" : "+v"(tid)); const int lane = tid & 63, wave = __builtin_amdgcn_readfirstlane(tid >> 6);
    int G = gridDim.x, bx = blockIdx.x; asm volatile("" : "+s"(G), "+s"(bx)); const int gw = bx * 8 + wave, NGW = G * 8;
    unsigned char* lds = (unsigned char*)L; LAS int* lcnt = (LAS int*)(L + 0); LAS int* gt = (LAS int*)(L + LDS_MISC + 512);
    (void)lane; (void)gw; (void)NGW; (void)lds; (void)lcnt; (void)gt; (void)layer; (void)slot; (void)tid; (void)bx; (void)G;
    {
            KArgs A = kargs(); unsigned char* ws = A->ws; unsigned char* wb = ws + WS_W + (size_t)layer * W_LAYER;
            pg8::GridSched S{(const char*)(ws + WS_MERGED), (const char*)(wb + W_OUT), 2048u, 2048u, 128, 4, 16, G, bx};
            EpiResT<true> E{(bf16*)(ws + WS_HB), (u64*)(ws + WS_SS) + (size_t)(3 * layer + 1) * M, ws + WS_XF8};
            pg8::gemm_stream(L, S, E, 2048u, 2048u);
        }
}
__device__ __forceinline__ void ph6(LAS unsigned char* L, int layer, int slot) {
    int tid = threadIdx.x; asm volatile("" : "+v"(tid)); const int lane = tid & 63, wave = __builtin_amdgcn_readfirstlane(tid >> 6);
    int G = gridDim.x, bx = blockIdx.x; asm volatile("" : "+s"(G), "+s"(bx)); const int gw = bx * 8 + wave, NGW = G * 8;
    unsigned char* lds = (unsigned char*)L; LAS int* lcnt = (LAS int*)(L + 0); LAS int* gt = (LAS int*)(L + LDS_MISC + 512);
    (void)lane; (void)gw; (void)NGW; (void)lds; (void)lcnt; (void)gt; (void)layer; (void)slot; (void)tid; (void)bx; (void)G;
    { KArgs A = kargs(); const float* x = A->out; const float* g = A->norm_cross + (size_t)layer * D; bf16* HB = (bf16*)(A->ws + WS_HB);
            for (int m = gw; m < M; m += NGW) norm_row_bf16(x + (size_t)m * D, g, HB + (size_t)m * D, lane); }
}
template <int COPY> __device__ __forceinline__ void ph7(LAS unsigned char* L, int layer, int slot) {
    if (COPY) asm volatile("s_nop 0" ::: "memory");
    int tid = threadIdx.x; asm volatile("" : "+v"(tid)); const int lane = tid & 63, wave = __builtin_amdgcn_readfirstlane(tid >> 6);
    int G = gridDim.x, bx = blockIdx.x; asm volatile("" : "+s"(G), "+s"(bx)); const int gw = bx * 8 + wave, NGW = G * 8;
    unsigned char* lds = (unsigned char*)L; LAS int* lcnt = (LAS int*)(L + 0); LAS int* gt = (LAS int*)(L + LDS_MISC + 512);
    (void)lane; (void)gw; (void)NGW; (void)lds; (void)lcnt; (void)gt; (void)layer; (void)slot; (void)tid; (void)bx; (void)G;
    {
            unsigned char* ws = kargs()->ws; unsigned char* wb = ws + WS_W + (size_t)layer * W_LAYER;
            pg8::GridSched S{(const char*)(ws + WS_HB), (const char*)(wb + W_XQ), 2048u, 2048u, 128, 4, 16, G, bx};
            EpiPlain E{(bf16*)(ws + WS_XQ), D, 1.f, (const u64*)(ws + WS_SS) + (size_t)(3 * layer + 1) * M};
            pg8::gemm_stream(L, S, E, 2048u, 2048u);
        }
}
__device__ __forceinline__ void ph8(LAS unsigned char* L, int layer, int slot) {
    int tid = threadIdx.x; asm volatile("" : "+v"(tid)); const int lane = tid & 63, wave = __builtin_amdgcn_readfirstlane(tid >> 6);
    int G = gridDim.x, bx = blockIdx.x; asm volatile("" : "+s"(G), "+s"(bx)); const int gw = bx * 8 + wave, NGW = G * 8;
    unsigned char* lds = (unsigned char*)L; LAS int* lcnt = (LAS int*)(L + 0); LAS int* gt = (LAS int*)(L + LDS_MISC + 512);
    (void)lane; (void)gw; (void)NGW; (void)lds; (void)lcnt; (void)gt; (void)layer; (void)slot; (void)tid; (void)bx; (void)G;
    {
            unsigned char* ws = kargs()->ws;
            unsigned char* wb = ws + WS_W + (size_t)layer * W_LAYER;
            { CrossQSched SQ{(const char*)(ws + WS_XF8), (const char*)(wb + W_XQ), G, bx};
              EpiPlain EQ{(bf16*)(ws + WS_XQ), D, 1.f / F8_WSCALE, (const u64*)(ws + WS_SS) + (size_t)(3 * layer + 1) * M};
              pg8::gemm_stream<EpiPlain, CrossQSched, 1>(L, SQ, EQ, 1024u, 1024u); }
            CrossFusedSched S{(const char*)(ws + WS_HB), (const char*)(wb + W_XQ), (const char*)(ws + WS_XQ), (const char*)(ws + WS_KX) + (size_t)layer * MROWS * D * 2,
                              (const char*)(ws + WS_XP), (const char*)(ws + WS_VTB) + (size_t)layer * 8 * D * D * 2, G, bx};
            EpiCross E{EpiPlain{(bf16*)(ws + WS_XQ), D, 1.f, (const u64*)(ws + WS_SS) + (size_t)(3 * layer + 1) * M},
                       EpiSoftmax{(bf16*)(ws + WS_XP), (LAS f32x2*)(L + LDS_XCH), 0.0625f * 1.44269504f},
                       EpiPlainT<true>{(bf16*)(ws + WS_XO), D, F8_OSCALE, nullptr}};
            pg8::gemm_stream(L, S, E, 2048u, 2048u);
        }
}
__device__ __forceinline__ void ph9(LAS unsigned char* L, int layer, int slot) {
    int tid = threadIdx.x; asm volatile("" : "+v"(tid)); const int lane = tid & 63, wave = __builtin_amdgcn_readfirstlane(tid >> 6);
    int G = gridDim.x, bx = blockIdx.x; asm volatile("" : "+s"(G), "+s"(bx)); const int gw = bx * 8 + wave, NGW = G * 8;
    unsigned char* lds = (unsigned char*)L; LAS int* lcnt = (LAS int*)(L + 0); LAS int* gt = (LAS int*)(L + LDS_MISC + 512);
    (void)lane; (void)gw; (void)NGW; (void)lds; (void)lcnt; (void)gt; (void)layer; (void)slot; (void)tid; (void)bx; (void)G;
    {
            unsigned char* ws = kargs()->ws;
            CrossSched S{(const char*)(ws + WS_XP), (const char*)(ws + WS_VT) + (size_t)layer * D * MROWS * 2, 1, G, bx};
            EpiPlain E{(bf16*)(ws + WS_XO), D, 1.f, nullptr};
            pg8::gemm_stream(L, S, E, 2048u, 4096u);
        }
}
__device__ __forceinline__ void ph10(LAS unsigned char* L, int layer, int slot) {
    int tid = threadIdx.x; asm volatile("" : "+v"(tid)); const int lane = tid & 63, wave = __builtin_amdgcn_readfirstlane(tid >> 6);
    int G = gridDim.x, bx = blockIdx.x; asm volatile("" : "+s"(G), "+s"(bx)); const int gw = bx * 8 + wave, NGW = G * 8;
    unsigned char* lds = (unsigned char*)L; LAS int* lcnt = (LAS int*)(L + 0); LAS int* gt = (LAS int*)(L + LDS_MISC + 512);
    (void)lane; (void)gw; (void)NGW; (void)lds; (void)lcnt; (void)gt; (void)layer; (void)slot; (void)tid; (void)bx; (void)G;
    {
            KArgs A = kargs(); unsigned char* ws = A->ws; unsigned char* wb = ws + WS_W + (size_t)layer * W_LAYER;
            pg8::GridSched S{(const char*)(ws + WS_XO), (const char*)(wb + W_XO), 1024u, 1024u, 128, 4, 8, G, bx};
            EpiResT<true> E{(bf16*)(ws + WS_HB), (u64*)(ws + WS_SS) + (size_t)(3 * layer + 2) * M, ws + WS_XF8, 1.f / (F8_OSCALE * F8_WSCALE)};
            pg8::gemm_stream<EpiResT<true>, pg8::GridSched, 1>(L, S, E, 1024u, 1024u);
        }
}
__device__ __forceinline__ void ph11(LAS unsigned char* L, int layer, int slot) {
    int tid = threadIdx.x; asm volatile("" : "+v"(tid)); const int lane = tid & 63, wave = __builtin_amdgcn_readfirstlane(tid >> 6);
    int G = gridDim.x, bx = blockIdx.x; asm volatile("" : "+s"(G), "+s"(bx)); const int gw = bx * 8 + wave, NGW = G * 8;
    unsigned char* lds = (unsigned char*)L; LAS int* lcnt = (LAS int*)(L + 0); LAS int* gt = (LAS int*)(L + LDS_MISC + 512);
    (void)lane; (void)gw; (void)NGW; (void)lds; (void)lcnt; (void)gt; (void)layer; (void)slot; (void)tid; (void)bx; (void)G;
    { KArgs A = kargs(); const float* x = A->out; const float* g = A->norm_ffn; bf16* HB = (bf16*)(A->ws + WS_HB);
                for (int m = gw; m < M; m += NGW) norm_row_bf16(x + (size_t)m * D, g, HB + (size_t)m * D, lane); }
}
__device__ __forceinline__ void ph12(LAS unsigned char* L, int layer, int slot) {
    int tid = threadIdx.x; asm volatile("" : "+v"(tid)); const int lane = tid & 63, wave = __builtin_amdgcn_readfirstlane(tid >> 6);
    int G = gridDim.x, bx = blockIdx.x; asm volatile("" : "+s"(G), "+s"(bx)); const int gw = bx * 8 + wave, NGW = G * 8;
    unsigned char* lds = (unsigned char*)L; LAS int* lcnt = (LAS int*)(L + 0); LAS int* gt = (LAS int*)(L + LDS_MISC + 512);
    (void)lane; (void)gw; (void)NGW; (void)lds; (void)lcnt; (void)gt; (void)layer; (void)slot; (void)tid; (void)bx; (void)G;
    {
                unsigned char* ws = kargs()->ws;
                pg8::GridSched S{(const char*)(ws + WS_XF8), (const char*)(ws + WS_WGU), 1024u, 1024u, 128, 28, 8, G, bx};
                EpiGU E{(bf16*)(ws + WS_HID), (const u64*)(ws + WS_SS) + (size_t)2 * M, 1.f / F8_WSCALE};
                pg8::gemm_stream<EpiGU, pg8::GridSched, 1>(L, S, E, 1024u, 1024u);
            }
}
__device__ __forceinline__ void ph13(LAS unsigned char* L, int layer, int slot) {
    int tid = threadIdx.x; asm volatile("" : "+v"(tid)); const int lane = tid & 63, wave = __builtin_amdgcn_readfirstlane(tid >> 6);
    int G = gridDim.x, bx = blockIdx.x; asm volatile("" : "+s"(G), "+s"(bx)); const int gw = bx * 8 + wave, NGW = G * 8;
    unsigned char* lds = (unsigned char*)L; LAS int* lcnt = (LAS int*)(L + 0); LAS int* gt = (LAS int*)(L + LDS_MISC + 512);
    (void)lane; (void)gw; (void)NGW; (void)lds; (void)lcnt; (void)gt; (void)layer; (void)slot; (void)tid; (void)bx; (void)G;
    {
                KArgs A = kargs(); unsigned char* ws = A->ws;
                pg8::GridSched S{(const char*)(ws + WS_HID), (const char*)(ws + WS_WDN), 3584u, 3584u, 128, 4, 28, G, bx};
                EpiResT<true> E{(bf16*)(ws + WS_HB), (u64*)(ws + WS_SS) + (size_t)(3) * M, ws + WS_XF8, 1.f / (F8_HSCALE * F8_WSCALE)};
                pg8::gemm_stream<EpiResT<true>, pg8::GridSched, 1>(L, S, E, 3584u, 3584u);
            }
}
__device__ __forceinline__ void ph14(LAS unsigned char* L, int layer, int slot) {
    int tid = threadIdx.x; asm volatile("" : "+v"(tid)); const int lane = tid & 63, wave = __builtin_amdgcn_readfirstlane(tid >> 6);
    int G = gridDim.x, bx = blockIdx.x; asm volatile("" : "+s"(G), "+s"(bx)); const int gw = bx * 8 + wave, NGW = G * 8;
    unsigned char* lds = (unsigned char*)L; LAS int* lcnt = (LAS int*)(L + 0); LAS int* gt = (LAS int*)(L + LDS_MISC + 512);
    (void)lane; (void)gw; (void)NGW; (void)lds; (void)lcnt; (void)gt; (void)layer; (void)slot; (void)tid; (void)bx; (void)G;
    { KArgs A = kargs(); const float* x = A->out; const float* g = A->norm_mix + D; bf16* HB = (bf16*)(A->ws + WS_HB);
                for (int m = gw; m < M; m += NGW) norm_row_bf16(x + (size_t)m * D, g, HB + (size_t)m * D, lane); }
}
__device__ __forceinline__ void ph15(LAS unsigned char* L, int layer, int slot) {
    int tid = threadIdx.x; asm volatile("" : "+v"(tid)); const int lane = tid & 63, wave = __builtin_amdgcn_readfirstlane(tid >> 6);
    int G = gridDim.x, bx = blockIdx.x; asm volatile("" : "+s"(G), "+s"(bx)); const int gw = bx * 8 + wave, NGW = G * 8;
    unsigned char* lds = (unsigned char*)L; LAS int* lcnt = (LAS int*)(L + 0); LAS int* gt = (LAS int*)(L + LDS_MISC + 512);
    (void)lane; (void)gw; (void)NGW; (void)lds; (void)lcnt; (void)gt; (void)layer; (void)slot; (void)tid; (void)bx; (void)G;
    {
                KArgs A = kargs(); unsigned char* ws = A->ws; unsigned* ctl = (unsigned*)(ws + WS_CTL);
                int* route = (int*)(ws + WS_ROUTE); bf16* HB = (bf16*)(ws + WS_HB);
                if (tid < 16) lcnt[tid] = 0;
                __syncthreads();
                const float* gn = A->norm_ffn + D; const float* rwt = A->router_w; const u64* ss5 = (const u64*)(ws + WS_SS) + (size_t)5 * M;
                f32x4 rwr[4][4][2];
#pragma unroll
                for (int j = 0; j < 4; ++j) { const f32x4 gg = ((const f32x4*)gn + lane)[64 * j]; const float* rw = rwt + (size_t)(256 * j + 4 * lane) * 8;
#pragma unroll
                    for (int q = 0; q < 4; ++q) { rwr[j][q][0] = *(const f32x4*)(rw + 8 * q) * gg[q]; rwr[j][q][1] = *(const f32x4*)(rw + 8 * q + 4) * gg[q]; } }
                for (int m = gw; m < M; m += NGW) {
                    const u32x2* xr = (const u32x2*)(HB + (size_t)m * D) + lane;
                    const float rstd = rstd_of(ss5[m]);
                    float lg[8];
#pragma unroll
                    for (int e = 0; e < 8; ++e) lg[e] = 0.f;
#pragma unroll
                    for (int j = 0; j < 4; ++j) { const u32x2 xv = xr[64 * j];
                        const f32x4 hv = (f32x4){__uint_as_float(xv.x << 16), __uint_as_float(xv.x & 0xffff0000u), __uint_as_float(xv.y << 16), __uint_as_float(xv.y & 0xffff0000u)} * rstd;
#pragma unroll
                        for (int q = 0; q < 4; ++q) { const f32x4 r0 = rwr[j][q][0], r1 = rwr[j][q][1]; const float hq = hv[q];
                            lg[0] += hq * r0.x; lg[1] += hq * r0.y; lg[2] += hq * r0.z; lg[3] += hq * r0.w; lg[4] += hq * r1.x; lg[5] += hq * r1.y; lg[6] += hq * r1.z; lg[7] += hq * r1.w; } }
#pragma unroll
                    for (int e = 0; e < 8; ++e) lg[e] = wave_sum(lg[e]);
                    int e0 = 0; float v0 = lg[0];
#pragma unroll
                    for (int e = 1; e < 8; ++e) if (lg[e] > v0) { v0 = lg[e]; e0 = e; }
                    int e1 = -1; float v1 = -INFINITY;
#pragma unroll
                    for (int e = 0; e < 8; ++e) if (e != e0 && lg[e] > v1) { v1 = lg[e]; e1 = e; }
                    const float ww1 = 1.f / (1.f + __expf(v0 - v1)), ww0 = 1.f - ww1;
                    if (lane == 0) { route[4 * m] = e0; route[4 * m + 1] = e1; ((float*)route)[4 * m + 2] = ww0; ((float*)route)[4 * m + 3] = ww1; atomicAdd((int*)&lcnt[e0], 1); atomicAdd((int*)&lcnt[8 + e1], 1); }
                }
                __syncthreads();
                if (tid < 16) atomicAdd(ctl + CW_CNT + tid, (unsigned)lcnt[tid]);
                __syncthreads();
                LAS float* scr = (LAS float*)(L + wave * 16384);
                constexpr int I_GU = 16 * 224, I_DN = 56 * 32;
                const float* mgu = A->moe_w_gu; const float* mdn = A->moe_w_down;
                for (int r_ = 0; r_ < REP(7); ++r_) {
                    auto decode = [&](int it, ConvItem& c) {
                        const int e = it / (I_GU + I_DN); int r = it % (I_GU + I_DN);
                        if (r < I_GU) { const int kb = r / 224, vb = r % 224, pn = vb >> 3, bj = (vb >> 2) & 1, pb = vb & 3;
                            c.W = mgu + (size_t)e * D * 2 * DFF; c.ldw = 2 * DFF; c.k0 = 64 * kb; c.src = bj * DFF + 128 * pn + 32 * pb; c.gain = gn; c.WT = ws + WS_MWGU + (size_t)e * 2 * DFF * D; c.dpitch = D; c.drow0 = 32 * vb; }
                        else { r -= I_GU; const int kb = r / 32, vb = r % 32;
                            c.W = mdn + (size_t)e * DFF * D; c.ldw = D; c.k0 = 64 * kb; c.src = 32 * vb; c.gain = nullptr; c.WT = ws + WS_MWDN + (size_t)e * D * DFF; c.dpitch = DFF; c.drow0 = 32 * vb; } };
                    const int NIT = 8 * (I_GU + I_DN);
                    int it = gw; ConvItem cur, nxt; f32x4 tvA[8], tvB[8]; float gA[8], gB[8];
                    if (it < NIT) { decode(it, cur); conv_load(cur, tvA, gA, lane); }
                    while (it < NIT) {
                        const int itn = it + NGW;
                        if (itn < NIT) { decode(itn, nxt); conv_load(nxt, tvB, gB, lane); }
                        conv_finish8(cur, tvA, gA, scr, lane);
                        cur = nxt; it = itn;
#pragma unroll
                        for (int i = 0; i < 8; ++i) { tvA[i] = tvB[i]; gA[i] = gB[i]; }
                    }
                }
            }
}
__device__ __forceinline__ void ph16(LAS unsigned char* L, int layer, int slot) {
    int tid = threadIdx.x; asm volatile("" : "+v"(tid)); const int lane = tid & 63, wave = __builtin_amdgcn_readfirstlane(tid >> 6);
    int G = gridDim.x, bx = blockIdx.x; asm volatile("" : "+s"(G), "+s"(bx)); const int gw = bx * 8 + wave, NGW = G * 8;
    unsigned char* lds = (unsigned char*)L; LAS int* lcnt = (LAS int*)(L + 0); LAS int* gt = (LAS int*)(L + LDS_MISC + 512);
    (void)lane; (void)gw; (void)NGW; (void)lds; (void)lcnt; (void)gt; (void)layer; (void)slot; (void)tid; (void)bx; (void)G;
    {
                unsigned char* ws = kargs()->ws; unsigned* ctl = (unsigned*)(ws + WS_CTL);
                int* route = (int*)(ws + WS_ROUTE); int* tokmap = (int*)(ws + WS_TOKMAP); float* roww = (float*)(ws + WS_ROWW); bf16* HB = (bf16*)(ws + WS_HB);
                LAS int* lbase = (LAS int*)(L + 64); LAS int* lc2 = (LAS int*)(L + 128);
                for (int chunk = bx; chunk < M / 128; chunk += G) {
                    if (tid < 16) { lcnt[tid] = 0; lc2[tid] = 0; }
                    __syncthreads();
                    const int m = chunk * 128 + (tid >> 2);
                    const int e0 = route[4 * m], e1 = route[4 * m + 1];
                    if ((tid & 3) == 0) { atomicAdd((int*)&lcnt[e0], 1); atomicAdd((int*)&lcnt[8 + e1], 1); }
                    __syncthreads();
                    if (tid < 16) lbase[tid] = (int)atomicAdd(ctl + CW_CUR + tid, (unsigned)lcnt[tid]) + gt[tid] * 256;
                    __syncthreads();
                    int p0 = 0, p1 = 0;
                    if ((tid & 3) == 0) { p0 = lbase[e0] + atomicAdd((int*)&lc2[e0], 1); p1 = lbase[8 + e1] + atomicAdd((int*)&lc2[8 + e1], 1);
                        tokmap[p0] = m; tokmap[p1] = m; roww[p0] = ((const float*)route)[4 * m + 2]; roww[p1] = ((const float*)route)[4 * m + 3];
                        const u64 sq = ((const u64*)(ws + WS_SS))[(size_t)5 * M + m]; ((u64*)(ws + WS_ROWSS))[p0] = sq; ((u64*)(ws + WS_ROWSS))[p1] = sq; }
                    p0 = __shfl(p0, lane & ~3); p1 = __shfl(p1, lane & ~3);
                    const u32x4* src = (const u32x4*)(ws + WS_XF8 + (size_t)m * D) + (tid & 3) * 16;
                    u32x4* d0 = (u32x4*)(ws + WS_XS + (size_t)p0 * D) + (tid & 3) * 16; u32x4* d1 = (u32x4*)(ws + WS_XS + (size_t)p1 * D) + (tid & 3) * 16;
                    u32x4 gv[16];
#pragma unroll
                    for (int q = 0; q < 16; ++q) gv[q] = src[q];
#pragma unroll
                    for (int q = 0; q < 16; ++q) { d0[q] = gv[q]; d1[q] = gv[q]; }
                    __syncthreads();
                }
                if (bx < 16) { const int g = bx; const int cntg = (int)__hip_atomic_load(ctl + CW_CNT + g, __ATOMIC_RELAXED, __HIP_MEMORY_SCOPE_AGENT);
                    for (int r = gt[g] * 256 + cntg + tid; r < gt[g + 1] * 256; r += 512) { tokmap[r] = -1; roww[r] = 0.f; ((u64*)(ws + WS_ROWSS))[r] = (u64)1 << 34; } }
            }
}
__device__ __forceinline__ void ph17(LAS unsigned char* L, int layer, int slot) {
    int tid = threadIdx.x; asm volatile("" : "+v"(tid)); const int lane = tid & 63, wave = __builtin_amdgcn_readfirstlane(tid >> 6);
    int G = gridDim.x, bx = blockIdx.x; asm volatile("" : "+s"(G), "+s"(bx)); const int gw = bx * 8 + wave, NGW = G * 8;
    unsigned char* lds = (unsigned char*)L; LAS int* lcnt = (LAS int*)(L + 0); LAS int* gt = (LAS int*)(L + LDS_MISC + 512);
    (void)lane; (void)gw; (void)NGW; (void)lds; (void)lcnt; (void)gt; (void)layer; (void)slot; (void)tid; (void)bx; (void)G;
    {
                unsigned char* ws = kargs()->ws;
                MoeSched S{(const char*)(ws + WS_XS), (const char*)(ws + WS_MWGU), 1024u, (size_t)2 * DFF * D, 1024u, 0, gt[16], 28, 8, G, bx, (const int*)gt};
                EpiGU E{(bf16*)(ws + WS_MHID), (const u64*)(ws + WS_ROWSS), 1.f / F8_WSCALE};
                pg8::gemm_stream<EpiGU, MoeSched, 1>(L, S, E, 1024u, 1024u);
            }
}
__device__ __forceinline__ void ph18(LAS unsigned char* L, int layer, int slot) {
    int tid = threadIdx.x; asm volatile("" : "+v"(tid)); const int lane = tid & 63, wave = __builtin_amdgcn_readfirstlane(tid >> 6);
    int G = gridDim.x, bx = blockIdx.x; asm volatile("" : "+s"(G), "+s"(bx)); const int gw = bx * 8 + wave, NGW = G * 8;
    unsigned char* lds = (unsigned char*)L; LAS int* lcnt = (LAS int*)(L + 0); LAS int* gt = (LAS int*)(L + LDS_MISC + 512);
    (void)lane; (void)gw; (void)NGW; (void)lds; (void)lcnt; (void)gt; (void)layer; (void)slot; (void)tid; (void)bx; (void)G;
    {
                    KArgs A = kargs(); unsigned char* ws = A->ws;
                    MoeSched S{(const char*)(ws + WS_MHID), (const char*)(ws + WS_MWDN), 3584u, (size_t)D * DFF, 3584u, 0, gt[16], 4, 28, G, bx, (const int*)gt};
                    EpiDownMoe E{(const int*)(ws + WS_TOKMAP), (const float*)(ws + WS_ROWW), (bf16*)(ws + WS_XS), gt[8]};
                    pg8::gemm_stream<EpiDownMoe, MoeSched, 1>(L, S, E, 3584u, 3584u);
                }
}
__device__ __forceinline__ void ph19(LAS unsigned char* L, int layer, int slot) {
    int tid = threadIdx.x; asm volatile("" : "+v"(tid)); const int lane = tid & 63, wave = __builtin_amdgcn_readfirstlane(tid >> 6);
    int G = gridDim.x, bx = blockIdx.x; asm volatile("" : "+s"(G), "+s"(bx)); const int gw = bx * 8 + wave, NGW = G * 8;
    unsigned char* lds = (unsigned char*)L; LAS int* lcnt = (LAS int*)(L + 0); LAS int* gt = (LAS int*)(L + LDS_MISC + 512);
    (void)lane; (void)gw; (void)NGW; (void)lds; (void)lcnt; (void)gt; (void)layer; (void)slot; (void)tid; (void)bx; (void)G;
    { KArgs A = kargs(); float* xo = A->out; const float* gf = A->norm_final; const bf16* XB = (const bf16*)(A->ws + WS_HB); const bf16* Y0 = (const bf16*)(A->ws + WS_XS); const bf16* Y1 = Y0 + (size_t)M * D;
                for (int m = gw; m < M; m += NGW) {
                    const u32x2* xr = (const u32x2*)(XB + (size_t)m * D) + lane; const u32x2* y0 = (const u32x2*)(Y0 + (size_t)m * D) + lane; const u32x2* y1 = (const u32x2*)(Y1 + (size_t)m * D) + lane;
                    f32x4* orow = (f32x4*)(xo + (size_t)m * D) + lane; const f32x4* gr = (const f32x4*)gf + lane;
                    u32x2 a[4], b[4], c[4];
#pragma unroll
                    for (int j = 0; j < 4; ++j) { a[j] = xr[64 * j]; b[j] = y0[64 * j]; c[j] = y1[64 * j]; }
                    f32x4 v[4]; float q = 0.f;
#pragma unroll
                    for (int j = 0; j < 4; ++j) {
                        v[j] = (f32x4){__uint_as_float(a[j].x << 16), __uint_as_float(a[j].x & 0xffff0000u), __uint_as_float(a[j].y << 16), __uint_as_float(a[j].y & 0xffff0000u)}
                             + (f32x4){__uint_as_float(b[j].x << 16), __uint_as_float(b[j].x & 0xffff0000u), __uint_as_float(b[j].y << 16), __uint_as_float(b[j].y & 0xffff0000u)}
                             + (f32x4){__uint_as_float(c[j].x << 16), __uint_as_float(c[j].x & 0xffff0000u), __uint_as_float(c[j].y << 16), __uint_as_float(c[j].y & 0xffff0000u)};
                        q += (v[j].x * v[j].x + v[j].y * v[j].y) + (v[j].z * v[j].z + v[j].w * v[j].w); }
                    const float rstd = 1.f / sqrtf(wave_sum(q) * (1.f / D) + EPS);
#pragma unroll
                    for (int j = 0; j < 4; ++j) orow[64 * j] = v[j] * rstd * gr[64 * j];
                } }
}
__global__ void __launch_bounds__(512, 2) fwd_kernel(Args a_unused) {
    extern __shared__ __attribute__((aligned(16))) unsigned char lds[];
    LAS unsigned char* L = (LAS unsigned char*)lds;
    volatile LAS unsigned* MISC = (volatile LAS unsigned*)(L + LDS_MISC);
    const int tid = threadIdx.x, lane = tid & 63, wave = __builtin_amdgcn_readfirstlane(tid >> 6);
    const int G = gridDim.x, bx = blockIdx.x;
    for (int u = tid; u < 64; u += 512) MISC[u] = 0u;
    __syncthreads();
    XcdBarrier bar; bar.bar = (unsigned*)(kargs()->ws + WS_CTL) + CW_BAR; bar.x = 0; bar.st = nullptr;
    if (!MK_PER_PHASE) bar = xcd_barrier_post(bar.bar, MISC + 8);
    int pid = 0;
    const int lo = kargs()->ph_lo, hi = kargs()->ph_hi;
#define RUN() (pid >= lo && pid < hi)
#define SEAM() do { if (!MK_PER_PHASE) { xcd_barrier(bar); if (REP(30) > 1) xcd_barrier(bar); } ++pid; } while (0)
    int slotv = 0; (void)lane;

    if (PON(0) && RUN()) for (int r_ = 0; r_ < REP(8); ++r_) ph0(L, 0, 0);
    SEAM();

    for (int layer = 0; layer < DEPTH; ++layer) {
        if (PON(1) && RUN()) for (int r_ = 0; r_ < REP(9); ++r_) ph1(L, layer, slotv);
        SEAM();
        if (PON(2) && RUN()) for (int r_ = 0; r_ < REP(10); ++r_) ph2(L, layer, slotv);
        SEAM();
        if (PON(20) && RUN()) for (int r_ = 0; r_ < REP(28); ++r_) ph20(L, layer, slotv);
        SEAM();
        if (PON(3) && RUN()) for (int r_ = 0; r_ < REP(11); ++r_) ph3(L, layer, slotv);
        SEAM();
        if (PON(4) && RUN()) for (int r_ = 0; r_ < REP(12); ++r_) ph4(L, layer, slotv);
        SEAM();
        if (PON(5) && RUN()) for (int r_ = 0; r_ < REP(13); ++r_) ph5(L, layer, slotv);
        SEAM();
        if (PON(8) && RUN()) for (int r_ = 0; r_ < REP(16); ++r_) ph8(L, layer, slotv);
        SEAM();
        if (PON(10) && RUN()) for (int r_ = 0; r_ < REP(18); ++r_) ph10(L, layer, slotv);
        SEAM();
        if (layer == 0) {
            if (PON(12) && RUN()) for (int r_ = 0; r_ < REP(20); ++r_) ph12(L, layer, slotv);
            SEAM();
            if (PON(13) && RUN()) for (int r_ = 0; r_ < REP(21); ++r_) ph13(L, layer, slotv);
            SEAM();
        } else {
            if (PON(15) && RUN()) for (int r_ = 0; r_ < REP(23); ++r_) ph15(L, layer, slotv);
            SEAM();
            LAS int* gt = (LAS int*)(L + LDS_MISC + 512);
            if (tid == 0) { unsigned* ctl = (unsigned*)(kargs()->ws + WS_CTL); int acc = 0; for (int g = 0; g < 16; ++g) { gt[g] = acc; acc += ((int)__hip_atomic_load(ctl + CW_CNT + g, __ATOMIC_RELAXED, __HIP_MEMORY_SCOPE_AGENT) + 255) >> 8; } gt[16] = acc; }
            __syncthreads();
            if (PON(16) && RUN()) for (int r_ = 0; r_ < REP(24); ++r_) ph16(L, layer, slotv);
            SEAM();
            if (PON(17) && RUN()) for (int r_ = 0; r_ < REP(25); ++r_) ph17(L, layer, slotv);
            SEAM();
            if (PON(18) && RUN()) ph18(L, layer, 0);
            SEAM();
            if (PON(19) && RUN()) for (int r_ = 0; r_ < REP(27); ++r_) ph19(L, layer, slotv);
            ++pid;
        }
    }
#undef RUN
#undef SEAM
}


constexpr int NPHASE = 1 + 10 + 13;
extern "C" void kernel_launch(void* const* d_in, const int* in_sizes, int n_in, void* d_out, int out_size, void* d_ws, size_t ws_size, hipStream_t stream) {
    static int grid = 0;
    if (grid == 0) {
        if (n_in != 22 || out_size != M * D || ws_size < WS_END) { fprintf(stderr, "kernel_launch: unexpected problem (n_in %d out %d ws %zu)\n", n_in, out_size, ws_size); grid = -1; return; }
        int dev = 0, cus = 0;
        if (hipGetDevice(&dev) != hipSuccess || hipDeviceGetAttribute(&cus, hipDeviceAttributeMultiprocessorCount, dev) != hipSuccess) { grid = -1; return; }
        if (hipFuncSetAttribute((const void*)fwd_kernel, hipFuncAttributeMaxDynamicSharedMemorySize, LDS_BYTES) != hipSuccess) { fprintf(stderr, "kernel_launch: hipFuncSetAttribute failed\n"); grid = -1; return; }
        int per_cu = 0;
        (void)hipOccupancyMaxActiveBlocksPerMultiprocessor(&per_cu, (const void*)fwd_kernel, 512, LDS_BYTES);
        (void)hipGetLastError();
        if (per_cu < 1) fprintf(stderr, "kernel_launch: occupancy query says %d\n", per_cu);
        grid = cus;
    }
    if (grid < 0) return;
    (void)hipMemsetAsync((char*)d_ws + WS_CTL, 0, CTL_ZERO_BYTES, stream);
    Args a{};
    a.x = (const float*)d_in[0]; a.mem = (const float*)d_in[1]; a.positions = (const int*)d_in[2]; a.norm_mix = (const float*)d_in[3]; a.w_in = (const float*)d_in[4];
    a.attn_sink = (const float*)d_in[5]; a.w_branch = (const float*)d_in[6]; a.w_out = (const float*)d_in[7]; a.pool_w = (const float*)d_in[8]; a.pool_scale = (const float*)d_in[9];
    a.norm_cross = (const float*)d_in[10]; a.norm_mem = (const float*)d_in[11]; a.w_xq = (const float*)d_in[12]; a.w_xkv = (const float*)d_in[13]; a.w_xo = (const float*)d_in[14];
    a.norm_ffn = (const float*)d_in[15]; a.dense_w_gu = (const float*)d_in[16]; a.dense_w_down = (const float*)d_in[17]; a.router_w = (const float*)d_in[18];
    a.moe_w_gu = (const float*)d_in[19]; a.moe_w_down = (const float*)d_in[20]; a.norm_final = (const float*)d_in[21];
    a.out = (float*)d_out; a.ws = (unsigned char*)d_ws;
#if MK_PER_PHASE
    for (int p = 0; p < NPHASE; ++p) { a.ph_lo = p; a.ph_hi = p + 1; hipLaunchKernelGGL(fwd_kernel, dim3(grid), dim3(512), LDS_BYTES, stream, a); }
#else
    a.ph_lo = 0; a.ph_hi = NPHASE;
    hipLaunchKernelGGL(fwd_kernel, dim3(grid), dim3(512), LDS_BYTES, stream, a);
#endif
}
```
